# Optimizing an MI355X kernel written in HIP

```python
import math
import jax
import jax.numpy as jnp
from jax import lax
import numpy as np

D_MODEL = 1024
BATCH = 4
SEQ = 4096
DEPTH = 1

EPS = 1e-5
SSD_EXPAND = 2
D_SSD = SSD_EXPAND * D_MODEL
SSD_HEAD_DIM = 64
SSD_HEADS = D_SSD // SSD_HEAD_DIM
SSD_GROUPS = 4
SSD_STATE = 128
SSD_CONV = 4
SSD_CHUNK = 128
D_CONV_IN = D_SSD + 2 * SSD_GROUPS * SSD_STATE
POOL_WINDOWS = (2, 4, 8, 16)
N_POOL_GROUPS = len(POOL_WINDOWS)
D_POOL = D_MODEL
POOL_GROUP_DIM = D_POOL // N_POOL_GROUPS
N_BRANCHES = 2
IN_SPLITS = (D_SSD, D_CONV_IN, SSD_HEADS, D_POOL, N_BRANCHES * D_MODEL)
D_IN_PROJ = sum(IN_SPLITS)
N_EXPERTS = 32
TOP_K = 4
D_EXPERT = D_MODEL
SWIGLU_LIMIT = 7.0
SWIGLU_ALPHA = 1.702
MOE_BLOCK = 128

kernel_name = 'hybrid_ssd_pool_moe_adaln_block'


def rms_norm(x, w):
    xf = x.astype(jnp.float32)
    y = xf * lax.rsqrt(jnp.mean(xf * xf, axis=-1, keepdims=True) + EPS)
    return (y * w.astype(jnp.float32)).astype(x.dtype)


def causal_depthwise_conv(u, w, b):
    k, ch = w.shape
    out = lax.conv_general_dilated(u, w[:, None, :], window_strides=(1,), padding=[(k - 1, 0)],
                                   dimension_numbers=('NWC', 'WIO', 'NWC'), feature_group_count=ch)
    return out + b


def ssd_chunked(xh, dt, A, Bm, Cm):
    f32 = jnp.float32
    b, s = xh.shape[0], xh.shape[1]
    nc, L = s // SSD_CHUNK, SSD_CHUNK
    G, E, P, N = SSD_GROUPS, SSD_HEADS // SSD_GROUPS, SSD_HEAD_DIM, SSD_STATE
    X = (xh.astype(f32) * dt[..., None]).reshape(b, nc, L, G, E, P)
    a = jnp.transpose((dt * A).reshape(b, nc, L, G, E), (0, 1, 3, 4, 2))
    Bc = Bm.astype(f32).reshape(b, nc, L, G, N)
    Cc = Cm.astype(f32).reshape(b, nc, L, G, N)
    a_cum = jnp.cumsum(a, axis=-1)
    causal = jnp.tril(jnp.ones((L, L), dtype=bool))
    seg = a_cum[..., :, None] - a_cum[..., None, :]
    decay = jnp.exp(jnp.where(causal, seg, -jnp.inf))
    CB = jnp.einsum('bclgn,bcsgn->bcgls', Cc, Bc)
    y_diag = jnp.einsum('bcgls,bcgels,bcsgep->bclgep', CB, decay, X)
    decay_to_end = jnp.exp(a_cum[..., -1:] - a_cum)
    states = jnp.einsum('bclgn,bcgel,bclgep->bcgepn', Bc, decay_to_end, X)
    chunk_decay = jnp.exp(a_cum[..., -1])

    def step(h, inp):
        st, dec = inp
        return h * dec[..., None, None] + st, h

    h0 = jnp.zeros((b, G, E, P, N), f32)
    _, prev = lax.scan(step, h0, (jnp.moveaxis(states, 1, 0), jnp.moveaxis(chunk_decay, 1, 0)))
    prev = jnp.moveaxis(prev, 0, 1)
    y_off = jnp.einsum('bclgn,bcgepn,bcgel->bclgep', Cc, prev, jnp.exp(a_cum))
    return (y_diag + y_off).reshape(b, s, SSD_HEADS, P)


def multiscale_causal_pool(u):
    f32 = jnp.float32
    b, s, ch = u.shape
    uf = u.astype(f32)
    cs = jnp.concatenate([jnp.zeros((b, 1, ch), f32), jnp.cumsum(uf, axis=1)], axis=1)
    t = jnp.arange(s)
    outs = []
    for gi, w in enumerate(POOL_WINDOWS):
        lo, hi = gi * POOL_GROUP_DIM, (gi + 1) * POOL_GROUP_DIM
        csg = cs[:, :, lo:hi]
        upper = csg[:, 1:]
        lower = jnp.pad(csg[:, :s + 1 - w], ((0, 0), (w - 1, 0), (0, 0)))
        cnt = jnp.minimum(t + 1, w).astype(f32)[None, :, None]
        outs.append((upper - lower) / cnt - uf[:, :, lo:hi])
    return jnp.concatenate(outs, axis=-1).astype(u.dtype)


def hybrid_mixer(h, w_in, conv_w, conv_b, dt_bias, a_log, d_skip, ssd_norm_w, w_ssd_out,
                 w_pool, pool_scale, w_pool_out, w_out):
    f32 = jnp.float32
    b, s, _ = h.shape
    proj = h @ w_in
    z, xbc, dt_raw, u_pool, gates = jnp.split(proj, list(np.cumsum(IN_SPLITS)[:-1]), axis=-1)
    xbc = jax.nn.silu(causal_depthwise_conv(xbc, conv_w, conv_b))
    xs, Bm, Cm = jnp.split(xbc, [D_SSD, D_SSD + SSD_GROUPS * SSD_STATE], axis=-1)
    dt = jax.nn.softplus(dt_raw.astype(f32) + dt_bias.astype(f32))
    A = -jnp.exp(a_log.astype(f32))
    xh = xs.reshape(b, s, SSD_HEADS, SSD_HEAD_DIM)
    y = ssd_chunked(xh, dt, A, Bm.reshape(b, s, SSD_GROUPS, SSD_STATE),
                    Cm.reshape(b, s, SSD_GROUPS, SSD_STATE))
    y = y + d_skip.astype(f32)[:, None] * xh.astype(f32)
    y = y.reshape(b, s, D_SSD) * jax.nn.silu(z.astype(f32))
    yg = y.reshape(b, s, SSD_GROUPS, D_SSD // SSD_GROUPS)
    yg = yg * lax.rsqrt(jnp.mean(yg * yg, axis=-1, keepdims=True) + EPS)
    y = (yg.reshape(b, s, D_SSD) * ssd_norm_w.astype(f32)).astype(h.dtype)
    y_ssd = y @ w_ssd_out
    p = multiscale_causal_pool(u_pool).reshape(b, s, N_POOL_GROUPS, POOL_GROUP_DIM)
    p = jnp.einsum('bsgc,gcd->bsgd', p, w_pool).reshape(b, s, D_POOL) * pool_scale
    y_pool = p @ w_pool_out
    g = jax.nn.sigmoid(gates.astype(f32)).astype(h.dtype)
    g_ssd, g_pool = jnp.split(g, N_BRANCHES, axis=-1)
    return (g_ssd * y_ssd + g_pool * y_pool) @ w_out


def moe_ffn(h, w_router, b_router, w_gu, b_gu, w_down, b_down):
    f32 = jnp.float32
    b, s, d = h.shape
    T = b * s
    xt = h.reshape(T, d)
    logits = xt.astype(f32) @ w_router.astype(f32) + b_router.astype(f32)
    top_val, top_idx = lax.top_k(logits, TOP_K)
    gate = jax.nn.softmax(top_val, axis=-1)
    e_flat = top_idx.reshape(-1).astype(jnp.int32)
    tok_flat = jnp.arange(T * TOP_K, dtype=jnp.int32) // TOP_K
    g_flat = gate.reshape(-1)
    order = jnp.argsort(e_flat)
    e_sorted = e_flat[order]
    counts = jnp.bincount(e_flat, length=N_EXPERTS).astype(jnp.int32)
    starts = jnp.cumsum(counts) - counts
    pad_counts = (counts + MOE_BLOCK - 1) // MOE_BLOCK * MOE_BLOCK
    pad_ends = jnp.cumsum(pad_counts)
    pad_starts = pad_ends - pad_counts
    dest = pad_starts[e_sorted] + (jnp.arange(T * TOP_K, dtype=jnp.int32) - starts[e_sorted])
    n_blocks = (T * TOP_K + MOE_BLOCK - 1) // MOE_BLOCK + N_EXPERTS
    n_rows = n_blocks * MOE_BLOCK
    row_tok = jnp.full((n_rows,), T, jnp.int32).at[dest].set(tok_flat[order])
    row_gate = jnp.zeros((n_rows,), f32).at[dest].set(g_flat[order])
    block_exp = jnp.minimum(jnp.searchsorted(pad_ends, jnp.arange(n_blocks, dtype=jnp.int32) * MOE_BLOCK,
                                             side='right'), N_EXPERTS - 1)
    x_pad = jnp.concatenate([xt, jnp.zeros((1, d), xt.dtype)], axis=0)
    xb = x_pad[row_tok].reshape(n_blocks, MOE_BLOCK, d)

    def expert_block(args):
        xblk, e = args
        gu = xblk @ w_gu[e] + b_gu[e]
        glu, lin = jnp.split(gu, 2, axis=-1)
        glu = jnp.minimum(glu, SWIGLU_LIMIT)
        lin = jnp.clip(lin, -SWIGLU_LIMIT, SWIGLU_LIMIT)
        act = glu * jax.nn.sigmoid(SWIGLU_ALPHA * glu) * (lin + 1.0)
        return act @ w_down[e] + b_down[e]

    yb = lax.map(expert_block, (xb, block_exp)).reshape(n_rows, d)
    y = jax.ops.segment_sum(yb.astype(f32) * row_gate[:, None], row_tok, num_segments=T + 1)[:T]
    return y.reshape(b, s, d).astype(h.dtype)


def setup_inputs(seed: int = 0) -> dict:
    key = jax.random.key(seed)
    ks = jax.random.split(key, 28)
    f32 = jnp.float32
    L = DEPTH

    def nrm(k, shape, scale):
        return jax.random.normal(k, shape, f32) * scale

    dt0 = jnp.exp(jax.random.uniform(ks[8], (L, SSD_HEADS), f32, minval=math.log(1e-3), maxval=math.log(1e-1)))
    return {
        'x': nrm(ks[0], (BATCH, SEQ, D_MODEL), 1.0),
        'c': nrm(ks[1], (BATCH, D_MODEL), 1.0),
        'w_ada': nrm(ks[2], (L, D_MODEL, 6 * D_MODEL), 0.5 * D_MODEL ** -0.5),
        'b_ada': nrm(ks[3], (L, 6 * D_MODEL), 0.02),
        'norm_mix_w': 1.0 + nrm(ks[4], (L, D_MODEL), 0.02),
        'w_in': nrm(ks[5], (L, D_MODEL, D_IN_PROJ), D_MODEL ** -0.5),
        'conv_w': nrm(ks[6], (L, SSD_CONV, D_CONV_IN), SSD_CONV ** -0.5),
        'conv_b': nrm(ks[7], (L, D_CONV_IN), 0.02),
        'dt_bias': dt0 + jnp.log(-jnp.expm1(-dt0)),
        'a_log': jnp.log(jax.random.uniform(ks[9], (L, SSD_HEADS), f32, minval=1.0, maxval=16.0)),
        'd_skip': 1.0 + nrm(ks[10], (L, SSD_HEADS), 0.1),
        'ssd_norm_w': 1.0 + nrm(ks[11], (L, D_SSD), 0.02),
        'w_ssd_out': nrm(ks[12], (L, D_SSD, D_MODEL), D_SSD ** -0.5),
        'w_pool': nrm(ks[13], (L, N_POOL_GROUPS, POOL_GROUP_DIM, POOL_GROUP_DIM), POOL_GROUP_DIM ** -0.5),
        'pool_scale': 1.0 + nrm(ks[14], (L, D_POOL), 0.1),
        'w_pool_out': nrm(ks[15], (L, D_POOL, D_MODEL), D_POOL ** -0.5),
        'w_out': nrm(ks[16], (L, D_MODEL, D_MODEL), D_MODEL ** -0.5),
        'norm_ffn_w': 1.0 + nrm(ks[17], (L, D_MODEL), 0.02),
        'w_router': nrm(ks[18], (L, D_MODEL, N_EXPERTS), D_MODEL ** -0.5),
        'b_router': nrm(ks[19], (L, N_EXPERTS), 0.01),
        'w_gu': nrm(ks[20], (L, N_EXPERTS, D_MODEL, 2 * D_EXPERT), D_MODEL ** -0.5),
        'b_gu': nrm(ks[21], (L, N_EXPERTS, 2 * D_EXPERT), 0.02),
        'w_down': nrm(ks[22], (L, N_EXPERTS, D_EXPERT, D_MODEL), D_EXPERT ** -0.5),
        'b_down': nrm(ks[23], (L, N_EXPERTS, D_MODEL), 0.02),
        'norm_final_w': 1.0 + nrm(ks[24], (D_MODEL,), 0.02),
    }


def reference(x, c, w_ada, b_ada, norm_mix_w, w_in, conv_w, conv_b, dt_bias, a_log, d_skip,
              ssd_norm_w, w_ssd_out, w_pool, pool_scale, w_pool_out, w_out, norm_ffn_w,
              w_router, b_router, w_gu, b_gu, w_down, b_down, norm_final_w):
    c_act = jax.nn.silu(c)
    for l in range(DEPTH):
        mod = (c_act @ w_ada[l] + b_ada[l])[:, None, :]
        sh_m, sc_m, ga_m, sh_f, sc_f, ga_f = jnp.split(mod, 6, axis=-1)
        h = rms_norm(x, norm_mix_w[l]) * (1.0 + sc_m) + sh_m
        x = x + ga_m * hybrid_mixer(h, w_in[l], conv_w[l], conv_b[l], dt_bias[l], a_log[l], d_skip[l],
                                    ssd_norm_w[l], w_ssd_out[l], w_pool[l], pool_scale[l],
                                    w_pool_out[l], w_out[l])
        h = rms_norm(x, norm_ffn_w[l]) * (1.0 + sc_f) + sh_f
        x = x + ga_f * moe_ffn(h, w_router[l], b_router[l], w_gu[l], b_gu[l], w_down[l], b_down[l])
    return rms_norm(x, norm_final_w)
```

```cpp
#include <hip/hip_runtime.h>
#include <cstdio>
#include <cstdint>
#include <cmath>
namespace nv {
constexpr int T = 16384, D = 1024, S = 4096, NB = 4;
constexpr int DSSD = 2048, DCONV = 3072, NPROJ = 8224, NH = 32, HP = 64, NST = 128;
constexpr int OFF_Z = 0, OFF_XBC = 2048, OFF_DT = 5120, OFF_U = 5152, OFF_G = 6176;
constexpr int NE = 32;
constexpr float EPS = 1e-5f;

__device__ __forceinline__ float sigm(float x) { return 1.f / (1.f + expf(-x)); }
__device__ __forceinline__ float silu(float x) { return x * sigm(x); }

__global__ void k_mod(const float* c, const float* w_ada, const float* b_ada, float* mod) {
    int j = blockIdx.x * blockDim.x + threadIdx.x; int b = blockIdx.y;
    if (j >= 6 * D) return;
    float acc = b_ada[j];
    for (int k = 0; k < D; ++k) acc += silu(c[b * D + k]) * w_ada[(size_t)k * 6 * D + j];
    mod[b * 6 * D + j] = acc;
}
__global__ void k_norm_mod(const float* x, const float* w, const float* mod, int sh_off, int sc_off, float* h) {
    int t = blockIdx.x, b = t / S; __shared__ float red[256];
    float s = 0.f; for (int i = threadIdx.x; i < D; i += 256) { float v = x[(size_t)t * D + i]; s += v * v; }
    red[threadIdx.x] = s; __syncthreads();
    for (int o = 128; o > 0; o >>= 1) { if (threadIdx.x < o) red[threadIdx.x] += red[threadIdx.x + o]; __syncthreads(); }
    float rstd = rsqrtf(red[0] / D + EPS);
    for (int i = threadIdx.x; i < D; i += 256) {
        float v = x[(size_t)t * D + i] * rstd * w[i];
        h[(size_t)t * D + i] = v * (1.f + mod[b * 6 * D + sc_off + i]) + mod[b * 6 * D + sh_off + i];
    }
}
struct SG { const float* A; const int* rowidx; const int* Mptr; const float* B; size_t bstride_z; int lda, rshift, M, ldb, N, K; };
template <class Epi>
__global__ void __launch_bounds__(256) k_sgemm(SG g, Epi epi) {
    __shared__ float As[16][65], Bs[16][65];
    const float* A = g.A; const int* rowidx = g.rowidx; const int* Mptr = g.Mptr; const float* B = g.B; const size_t bstride_z = g.bstride_z;
    const int lda = g.lda, rshift = g.rshift, ldb = g.ldb, N = g.N, K = g.K; int M = g.M;
    const int z = blockIdx.z; if (Mptr) M = Mptr[z]; if (rowidx) rowidx += (size_t)z * T;
    const int m0 = blockIdx.y * 64, n0 = blockIdx.x * 64; if (m0 >= M) return;
    B += (size_t)z * bstride_z;
    const int tx = threadIdx.x & 15, ty = threadIdx.x >> 4;
    float acc[4][4] = {};
    const int lr = threadIdx.x >> 2, lc = (threadIdx.x & 3) * 4;
    int arow = m0 + lr; long asrc = -1; if (arow < M) { asrc = rowidx ? (rowidx[arow] >> rshift) : arow; }
    const int bk = threadIdx.x >> 4, bn = (threadIdx.x & 15) * 4;
    for (int k0 = 0; k0 < K; k0 += 16) {
#pragma unroll
        for (int i = 0; i < 4; ++i) As[lc + i][lr] = asrc >= 0 ? A[(size_t)asrc * lda + k0 + lc + i] : 0.f;
#pragma unroll
        for (int i = 0; i < 4; ++i) Bs[bk][bn + i] = (n0 + bn + i < N) ? B[(size_t)(k0 + bk) * ldb + n0 + bn + i] : 0.f;
        __syncthreads();
#pragma unroll
        for (int k = 0; k < 16; ++k) {
            float a[4], b[4];
#pragma unroll
            for (int i = 0; i < 4; ++i) { a[i] = As[k][ty * 4 + i]; b[i] = Bs[k][tx * 4 + i]; }
#pragma unroll
            for (int i = 0; i < 4; ++i)
#pragma unroll
                for (int j = 0; j < 4; ++j) acc[i][j] += a[i] * b[j];
        }
        __syncthreads();
    }
#pragma unroll
    for (int i = 0; i < 4; ++i) { int r = m0 + ty * 4 + i; if (r >= M) continue;
#pragma unroll
        for (int j = 0; j < 4; ++j) { int cc = n0 + tx * 4 + j; if (cc < N) epi(z, r, cc, acc[i][j]); } }
}
struct EpiStore { float* C; int ldc; int pad; __device__ void operator()(int, int r, int c, float v) const { C[(size_t)r * ldc + c] = v; } };
struct EpiScaleCol { float* C; const float* s; int ldc; int pad; __device__ void operator()(int, int r, int c, float v) const { C[(size_t)r * ldc + c] = v * s[c]; } };
struct EpiResid { float* C; const float* x; const float* mod; int ga_off; int pad; __device__ void operator()(int, int r, int c, float v) const { int b = r / S; C[(size_t)r * D + c] = x[(size_t)r * D + c] + mod[b * 6 * D + ga_off + c] * v; } };

__global__ void k_conv(const float* proj, const float* cw, const float* cb, float* out) {
    size_t i = (size_t)blockIdx.x * blockDim.x + threadIdx.x; if (i >= (size_t)T * DCONV) return;
    int ch = i % DCONV, t = i / DCONV, tt = t % S;
    float acc = cb[ch];
    for (int k = 0; k < 4; ++k) { int ts = tt - 3 + k; if (ts >= 0) acc += cw[k * DCONV + ch] * proj[(size_t)(t - 3 + k) * NPROJ + OFF_XBC + ch]; }
    out[i] = silu(acc);
}
__global__ void __launch_bounds__(256) k_ssd_seq(const float* proj, const float* xbc, const float* dt_bias, const float* a_log, const float* d_skip, float* y) {
    const int b = blockIdx.x / NH, h = blockIdx.x % NH, g = h / 8;
    const int p = threadIdx.x >> 2, nq = threadIdx.x & 3;
    float st[32]; for (int i = 0; i < 32; ++i) st[i] = 0.f;
    const float A = -expf(a_log[h]), Dk = d_skip[h], db = dt_bias[h];
    __shared__ float Bs[128], Cs[128];
    for (int t = 0; t < S; ++t) {
        const size_t row = (size_t)b * S + t;
        if (threadIdx.x < 128) Bs[threadIdx.x] = xbc[row * DCONV + 2048 + g * 128 + threadIdx.x];
        else Cs[threadIdx.x - 128] = xbc[row * DCONV + 2560 + g * 128 + threadIdx.x - 128];
        __syncthreads();
        float dtr = proj[row * NPROJ + OFF_DT + h] + db;
        float dt = dtr > 20.f ? dtr : log1pf(expf(dtr));
        float dA = expf(dt * A);
        float xv = xbc[row * DCONV + h * 64 + p];
        float xd = xv * dt, part = 0.f;
#pragma unroll
        for (int i = 0; i < 32; ++i) { st[i] = st[i] * dA + xd * Bs[nq * 32 + i]; part += st[i] * Cs[nq * 32 + i]; }
        part += __shfl_xor(part, 1); part += __shfl_xor(part, 2);
        if (nq == 0) y[row * DSSD + h * 64 + p] = part + Dk * xv;
        __syncthreads();
    }
}
__global__ void k_gated_norm(float* y, const float* proj, const float* nw) {
    int t = blockIdx.x; int g = threadIdx.x >> 6, l = threadIdx.x & 63;
    float v[8]; float s = 0.f;
    for (int i = 0; i < 8; ++i) { int c = g * 512 + l + 64 * i; float z = proj[(size_t)t * NPROJ + OFF_Z + c]; v[i] = y[(size_t)t * DSSD + c] * silu(z); s += v[i] * v[i]; }
    for (int o = 1; o < 64; o <<= 1) s += __shfl_xor(s, o);
    float rstd = rsqrtf(s / 512.f + EPS);
    for (int i = 0; i < 8; ++i) { int c = g * 512 + l + 64 * i; y[(size_t)t * DSSD + c] = v[i] * rstd * nw[c]; }
}
__global__ void k_pool(const float* proj, float* p) {
    size_t i = (size_t)blockIdx.x * blockDim.x + threadIdx.x; if (i >= (size_t)T * D) return;
    int ch = i % D, t = i / D, tt = t % S; int w = 2 << (ch / 256);
    float s = 0.f; int cnt = 0;
    for (int j = 0; j < w; ++j) { if (tt - j >= 0) { s += proj[(size_t)(t - j) * NPROJ + OFF_U + ch]; ++cnt; } }
    p[i] = s / (float)cnt - proj[(size_t)t * NPROJ + OFF_U + ch];
}
__global__ void k_merge(const float* proj, const float* yssd, const float* ypool, float* merged) {
    size_t i = (size_t)blockIdx.x * blockDim.x + threadIdx.x; if (i >= (size_t)T * D) return;
    int ch = i % D; size_t t = i / D;
    merged[i] = sigm(proj[t * NPROJ + OFF_G + ch]) * yssd[i] + sigm(proj[t * NPROJ + OFF_G + D + ch]) * ypool[i];
}
__global__ void k_router(const float* h2, const float* wr, const float* br, int* cnt, int* list, float* gate) {
    int t = blockIdx.x, l = threadIdx.x;
    int e = l & 31, half = l >> 5; float acc = 0.f;
    for (int k = half * 512; k < half * 512 + 512; ++k) acc += h2[(size_t)t * D + k] * wr[k * NE + e];
    acc += __shfl_xor(acc, 32); acc += br[e];
    float v = acc; float tv[4]; int ti[4];
    for (int r = 0; r < 4; ++r) {
        float m = v; int mi = e;
        for (int o = 1; o < 32; o <<= 1) { float om = __shfl_xor(m, o); int oi = __shfl_xor(mi, o); if (om > m || (om == m && oi < mi)) { m = om; mi = oi; } }
        tv[r] = m; ti[r] = mi; if (e == mi) v = -INFINITY;
    }
    if (l == 0) {
        float mx = tv[0]; float ex[4], s = 0.f; for (int r = 0; r < 4; ++r) { ex[r] = expf(tv[r] - mx); s += ex[r]; }
        for (int r = 0; r < 4; ++r) { int pos = atomicAdd(&cnt[ti[r]], 1); list[(size_t)ti[r] * T + pos] = t * 4 + r; gate[t * 4 + r] = ex[r] / s; }
    }
}
struct EpiGU { float* gu; const float* b_gu; const int* list; __device__ void operator()(int z, int r, int c, float v) const { int slot = list[(size_t)z * T + r]; gu[(size_t)slot * 2048 + c] = v + b_gu[z * 2048 + c]; } };
__global__ void k_act(const float* gu, float* act) {
    size_t i = (size_t)blockIdx.x * blockDim.x + threadIdx.x; if (i >= (size_t)T * 4 * D) return;
    size_t slot = i / D; int c = i % D;
    float glu = fminf(gu[slot * 2048 + c], 7.f), lin = fminf(fmaxf(gu[slot * 2048 + 1024 + c], -7.f), 7.f);
    act[i] = glu * sigm(1.702f * glu) * (lin + 1.f);
}
struct EpiDown { float* yb; const float* b_down; const int* list; const float* gate; __device__ void operator()(int z, int r, int c, float v) const { int slot = list[(size_t)z * T + r]; yb[(size_t)slot * D + c] = gate[slot] * (v + b_down[z * D + c]); } };
__global__ void k_final(const float* x1, const float* yb, const float* mod, const float* nw, float* out) {
    int t = blockIdx.x, b = t / S; __shared__ float red[256]; float v[4]; float s = 0.f;
    for (int j = 0; j < 4; ++j) { int i = threadIdx.x + 256 * j; float m = 0.f; for (int k = 0; k < 4; ++k) m += yb[((size_t)t * 4 + k) * D + i];
        v[j] = x1[(size_t)t * D + i] + mod[b * 6 * D + 5 * D + i] * m; s += v[j] * v[j]; }
    red[threadIdx.x] = s; __syncthreads();
    for (int o = 128; o > 0; o >>= 1) { if (threadIdx.x < o) red[threadIdx.x] += red[threadIdx.x + o]; __syncthreads(); }
    float rstd = rsqrtf(red[0] / D + EPS);
    for (int j = 0; j < 4; ++j) { int i = threadIdx.x + 256 * j; out[(size_t)t * D + i] = v[j] * rstd * nw[i]; }
}
}
namespace nv {
constexpr size_t MiB = 1u << 20;
constexpr size_t WS_MOD = 0, WS_CNT = 128 * 1024, WS_GATE = 256 * 1024, WS_LIST = 1 * MiB;
constexpr size_t WS_A = 4 * MiB, WS_B = 518 * MiB, WS_C = 710 * MiB, WS_D = 838 * MiB, WS_E = 902 * MiB;

static void run_naive(void* const* d_in, float* out, unsigned char* ws, hipStream_t st) {
    const float* x = (const float*)d_in[0]; const float* c = (const float*)d_in[1]; const float* w_ada = (const float*)d_in[2]; const float* b_ada = (const float*)d_in[3];
    const float* norm_mix_w = (const float*)d_in[4]; const float* w_in = (const float*)d_in[5]; const float* conv_w = (const float*)d_in[6]; const float* conv_b = (const float*)d_in[7];
    const float* dt_bias = (const float*)d_in[8]; const float* a_log = (const float*)d_in[9]; const float* d_skip = (const float*)d_in[10]; const float* ssd_norm_w = (const float*)d_in[11];
    const float* w_ssd_out = (const float*)d_in[12]; const float* w_pool = (const float*)d_in[13]; const float* pool_scale = (const float*)d_in[14]; const float* w_pool_out = (const float*)d_in[15];
    const float* w_out = (const float*)d_in[16]; const float* norm_ffn_w = (const float*)d_in[17]; const float* w_router = (const float*)d_in[18]; const float* b_router = (const float*)d_in[19];
    const float* w_gu = (const float*)d_in[20]; const float* b_gu = (const float*)d_in[21]; const float* w_down = (const float*)d_in[22]; const float* b_down = (const float*)d_in[23]; const float* norm_final_w = (const float*)d_in[24];
    float* mod = (float*)(ws + WS_MOD); int* cnt = (int*)(ws + WS_CNT); float* gate = (float*)(ws + WS_GATE); int* list = (int*)(ws + WS_LIST);
    float* proj = (float*)(ws + WS_A); float* xbc = (float*)(ws + WS_B); float* y = (float*)(ws + WS_C); float* h = (float*)(ws + WS_D); float* p2 = (float*)(ws + WS_E);
    float* p = h; float* yssd = xbc; float* ypool = xbc + (size_t)T * D; float* merged = xbc + (size_t)2 * T * D; float* x1 = out;
    float* gu = proj; float* act = xbc; float* yb = proj;
    (void)hipMemsetAsync(cnt, 0, 128, st);
    k_mod<<<dim3(6 * D / 256, NB), 256, 0, st>>>(c, w_ada, b_ada, mod);
    k_norm_mod<<<T, 256, 0, st>>>(x, norm_mix_w, mod, 0, D, h);
    k_sgemm<EpiStore><<<dim3((NPROJ + 63) / 64, T / 64, 1), 256, 0, st>>>(SG{h, nullptr, nullptr, w_in, 0, D, 0, T, NPROJ, NPROJ, D}, EpiStore{proj, NPROJ, 0});
    k_conv<<<(unsigned)(((size_t)T * DCONV + 255) / 256), 256, 0, st>>>(proj, conv_w, conv_b, xbc);
    k_ssd_seq<<<NB * NH, 256, 0, st>>>(proj, xbc, dt_bias, a_log, d_skip, y);
    k_gated_norm<<<T, 256, 0, st>>>(y, proj, ssd_norm_w);
    k_pool<<<(unsigned)(((size_t)T * D + 255) / 256), 256, 0, st>>>(proj, p);
    k_sgemm<EpiStore><<<dim3(D / 64, T / 64, 1), 256, 0, st>>>(SG{y, nullptr, nullptr, w_ssd_out, 0, DSSD, 0, T, D, D, DSSD}, EpiStore{yssd, D, 0});
    for (int g = 0; g < 4; ++g)
        k_sgemm<EpiScaleCol><<<dim3(256 / 64, T / 64, 1), 256, 0, st>>>(SG{p + g * 256, nullptr, nullptr, w_pool + (size_t)g * 256 * 256, 0, D, 0, T, 256, 256, 256}, EpiScaleCol{p2 + g * 256, pool_scale + g * 256, D, 0});
    k_sgemm<EpiStore><<<dim3(D / 64, T / 64, 1), 256, 0, st>>>(SG{p2, nullptr, nullptr, w_pool_out, 0, D, 0, T, D, D, D}, EpiStore{ypool, D, 0});
    k_merge<<<(unsigned)(((size_t)T * D + 255) / 256), 256, 0, st>>>(proj, yssd, ypool, merged);
    k_sgemm<EpiResid><<<dim3(D / 64, T / 64, 1), 256, 0, st>>>(SG{merged, nullptr, nullptr, w_out, 0, D, 0, T, D, D, D}, EpiResid{x1, x, mod, 2 * D, 0});
    k_norm_mod<<<T, 256, 0, st>>>(x1, norm_ffn_w, mod, 3 * D, 4 * D, h);
    k_router<<<T, 64, 0, st>>>(h, w_router, b_router, cnt, list, gate);
    k_sgemm<EpiGU><<<dim3(2048 / 64, T / 64, NE), 256, 0, st>>>(SG{h, list, cnt, w_gu, (size_t)D * 2048, D, 2, 0, 2048, 2048, D}, EpiGU{gu, b_gu, list});
    k_act<<<(unsigned)(((size_t)T * 4 * D + 255) / 256), 256, 0, st>>>(gu, act);
    k_sgemm<EpiDown><<<dim3(D / 64, T / 64, NE), 256, 0, st>>>(SG{act, list, cnt, w_down, (size_t)D * D, D, 0, 0, D, D, D}, EpiDown{yb, b_down, list, gate});
    k_final<<<T, 256, 0, st>>>(x1, yb, mod, norm_final_w, out);
}
}
extern "C" void kernel_launch(void* const* d_in, const int* in_sizes, int n_in, void* d_out, int out_size, void* d_ws, size_t ws_size, hipStream_t stream) {
    nv::run_naive(d_in, (float*)d_out, (unsigned char*)d_ws, stream);
}
```

```cpp
#define MK_N_LAUNCHES 12
#include <hip/hip_runtime.h>
#include <cstdio>
#include <cstdint>
#include <cmath>
namespace pg8 {
#define PG8_LAS __attribute__((address_space(3)))
typedef unsigned short bf16_t;
typedef short bf16x8 __attribute__((ext_vector_type(8)));
typedef float f32x4 __attribute__((ext_vector_type(4)));
typedef unsigned u32x4 __attribute__((ext_vector_type(4)));
typedef unsigned u32x2 __attribute__((ext_vector_type(2)));
constexpr int BM = 256, BK = 64, HALF = 128, HTB = HALF * BK * 2  , STAGE_BYTES = 8 * HTB, NXCD = 8, WGM = 8;

__host__ __device__ __forceinline__ int lds_byte(int r, int c) { const int st = (r >> 4) * 2 + (c >> 5), rr = r & 15, cc = c & 31, ob = rr * 64 + cc * 2; return st * 1024 + (ob ^ (((ob >> 9) & 1) << 5)); }
__host__ __device__ __forceinline__ void stage_rc(int b, int& R, int& C) { const int st = b / 1024, sb = b % 1024, swz = sb ^ (((sb >> 9) & 1) << 5); R = (st >> 1) * 16 + swz / 64; C = (st & 1) * 32 + (swz % 64) / 2; }
__host__ __device__ __forceinline__ int perm32(int rho) { const int n = rho >> 4, i = rho & 15; return 8 * (i >> 2) + 4 * n + (i & 3); }

struct Unit { int pm, pn, e, i; };

__device__ __forceinline__ unsigned cvt_pk_bf16(float lo, float hi) { unsigned r; asm volatile("v_cvt_pk_bf16_f32 %0, %1, %2" : "=v"(r) : "v"(lo), "v"(hi)); return r; }

struct StaticOrder {
    int nM, nN, nwg, G, c; const bf16_t* A; const bf16_t* Bt; int lda, ldb, a_pn_off, pad;
    __device__ void init(int M, int N, int G_, int c_, const bf16_t* A_, int lda_, const bf16_t* Bt_, int ldb_, int a_pn_off_) { nM = M / BM; nN = N / BM; nwg = nM * nN; G = G_; c = c_; A = A_; Bt = Bt_; lda = lda_; ldb = ldb_; a_pn_off = a_pn_off_; pad = 0; }
    __device__ bool next(int i, Unit& u) const {
        const long L = (long)i * G + c; if (L >= nwg) return false;
        int wgid = (int)L; { const int q = nwg / NXCD, r = nwg % NXCD, xcd = wgid % NXCD, off = wgid / NXCD; wgid = (xcd < r ? xcd * (q + 1) : r * (q + 1) + (xcd - r) * q) + off; }
        const int nig = WGM * nN, gid = wgid / nig, fm = gid * WGM, gsz = (nM - fm) < WGM ? (nM - fm) : WGM;
        u.pm = fm + ((wgid % nig) % gsz); u.pn = (wgid % nig) / gsz; u.e = 0; u.i = 0; return true;
    }
    __device__ __forceinline__ const char* a_base(const Unit& u) const { return (const char*)(A + (size_t)u.pm * BM * lda + (size_t)u.pn * a_pn_off); }
    __device__ __forceinline__ const char* b_base(const Unit& u) const { return (const char*)(Bt + (size_t)u.pn * BM * ldb); }
    __device__ __forceinline__ unsigned row_off(const Unit&, int) const { return 0u; }
};

template <class Epi, class Sched, bool ALIGN_EPI, bool SP2, bool GATHER>
__device__ __forceinline__ void gemm_phase(PG8_LAS unsigned char* lds, const int K, const int lda, const int ldb, const Sched& S, const Epi& E) {
    const int tid = threadIdx.x, wid = __builtin_amdgcn_readfirstlane(tid >> 6), lane = tid & 63, wr = wid >> 2, wc = wid & 3, fr = lane & 15, fq = lane >> 4;
    const int nt = K / BK;
    unsigned voffA[2][2], voffN[2][2], voffB[2]; int RA[2];
#pragma unroll
    for (int i = 0; i < 2; ++i) { int R, C; stage_rc(tid * 16 + i * 8192, R, C); const int Rb = Epi::PERM ? ((R & ~31) + perm32(R & 31)) : R;
        RA[i] = R; voffA[0][i] = GATHER ? (unsigned)C * 2u : (unsigned)(R * lda + C) * 2u; voffA[1][i] = voffA[0][i]; voffN[0][i] = 0; voffN[1][i] = 0; voffB[i] = (unsigned)(Rb * ldb + C) * 2u; }
    const unsigned cbytes[2] = {voffA[0][0], voffA[0][1]};
    const size_t kstep = (size_t)(BK * 2);
    const size_t hstepA = GATHER ? 0 : (size_t)HALF * lda * 2;
    const size_t hstepB = (size_t)HALF * ldb * 2;
    const unsigned ldsw = (unsigned)wid * 1024u;
    const int aoff = lds_byte(wr * 64 + fr, fq * 8), boff = lds_byte(wc * 32 + fr, fq * 8);
#define PG8_SA(b, h) (((b) * 2 + (h)) * HTB)
#define PG8_SB(b, h) ((4 + (b) * 2 + (h)) * HTB)
#define PG8_STAGE_B(bufoff, gbase) do { _Pragma("unroll") for (int _i = 0; _i < 2; ++_i) \
        __builtin_amdgcn_global_load_lds((const unsigned*)((const char*)(gbase) + voffB[_i]), (PG8_LAS unsigned*)(lds + (bufoff) + ldsw + _i * 8192), 16, 0, 0); } while (0)
#define PG8_STAGE_A(bufoff, gbase, h) do { _Pragma("unroll") for (int _i = 0; _i < 2; ++_i) \
        __builtin_amdgcn_global_load_lds((const unsigned*)((const char*)(gbase) + (h) * hstepA + voffA[GATHER ? (h) : 0][_i]), (PG8_LAS unsigned*)(lds + (bufoff) + ldsw + _i * 8192), 16, 0, 0); } while (0)
#define PG8_LDA(dst, b, h) do { _Pragma("unroll") for (int m = 0; m < 4; ++m) _Pragma("unroll") for (int k = 0; k < 2; ++k) dst[m][k] = *(const PG8_LAS bf16x8*)(lds + PG8_SA(b, h) + aoff + m * 2048 + k * 1024); } while (0)
#define PG8_LDB(dst, b, h) do { _Pragma("unroll") for (int n = 0; n < 2; ++n) _Pragma("unroll") for (int k = 0; k < 2; ++k) dst[n][k] = *(const PG8_LAS bf16x8*)(lds + PG8_SB(b, h) + boff + n * 2048 + k * 1024); } while (0)
#define PG8_MMA(ai, bj, At, Bt) do { __builtin_amdgcn_s_setprio(1); _Pragma("unroll") for (int m = 0; m < 4; ++m) _Pragma("unroll") for (int n = 0; n < 2; ++n) _Pragma("unroll") for (int k = 0; k < 2; ++k) \
        acc[ai][bj][m][n] = __builtin_amdgcn_mfma_f32_16x16x32_bf16(Bt[n][k], At[m][k], acc[ai][bj][m][n], 0, 0, 0); __builtin_amdgcn_s_setprio(0); } while (0)
#define PG8_WAIT_V(n) asm volatile("s_waitcnt vmcnt(" #n ")" ::: "memory")
#define PG8_WAIT_L(n) asm volatile("s_waitcnt lgkmcnt(" #n ")" ::: "memory")
#define PG8_BAR __builtin_amdgcn_s_barrier()
#define PG8_SCHED __builtin_amdgcn_sched_barrier(0)
#define PG8_GATHER_OFFS(dst, u) do { _Pragma("unroll") for (int _h = 0; _h < 2; ++_h) _Pragma("unroll") for (int _i = 0; _i < 2; ++_i) dst[_h][_i] = S.row_off(u, _h * HALF + RA[_i]) + cbytes[_i]; } while (0)
    Unit cur, nxt; int ui = 0;
    if (!S.next(0, cur)) return;
    f32x4 acc[2][2][4][2];
#pragma unroll
    for (int a = 0; a < 2; ++a)
#pragma unroll
        for (int b = 0; b < 2; ++b)
#pragma unroll
            for (int m = 0; m < 4; ++m)
#pragma unroll
                for (int n = 0; n < 2; ++n) acc[a][b][m][n] = (f32x4){0.f, 0.f, 0.f, 0.f};
    bf16x8 At[4][2], B0[2][2], B1[2][2];
    const char* cA = S.a_base(cur); const char* cB = S.b_base(cur);
    if constexpr (GATHER) { PG8_GATHER_OFFS(voffA, cur); }
    if constexpr (SP2) {
        PG8_STAGE_B(PG8_SB(0, 0), cB); PG8_STAGE_B(PG8_SB(0, 1), cB + hstepB); PG8_STAGE_A(PG8_SA(0, 0), cA, 0); PG8_STAGE_A(PG8_SA(0, 1), cA, 1);
        if (wr == 1) PG8_BAR;
        PG8_WAIT_V(2); PG8_BAR;
        PG8_STAGE_B(PG8_SB(1, 0), cB + kstep); PG8_STAGE_A(PG8_SA(1, 0), cA + kstep, 0); PG8_STAGE_B(PG8_SB(1, 1), cB + hstepB + kstep);
        PG8_WAIT_V(6); PG8_BAR;
    } else {
        PG8_STAGE_B(PG8_SB(0, 0), cB); PG8_STAGE_A(PG8_SA(0, 0), cA, 0); PG8_STAGE_B(PG8_SB(0, 1), cB + hstepB); PG8_STAGE_A(PG8_SA(0, 1), cA, 1);
        if (wr == 1) PG8_BAR;
        PG8_WAIT_V(4); PG8_BAR;
        PG8_STAGE_B(PG8_SB(1, 0), cB + kstep); PG8_STAGE_A(PG8_SA(1, 0), cA + kstep, 0); PG8_STAGE_B(PG8_SB(1, 1), cB + hstepB + kstep);
        PG8_WAIT_V(6); PG8_BAR;
    }
    for (;;) {
        const bool has_next = S.next(ui + 1, nxt);
        const char* nA = has_next ? S.a_base(nxt) : cA; const char* nB = has_next ? S.b_base(nxt) : cB;
#pragma unroll 1
        for (int t = 0; t < nt; t += 2) {
            const bool last = (t == nt - 2);
            const char* a1 = cA + (size_t)(t + 1) * kstep;
            const char* a2 = last ? nA : cA + (size_t)(t + 2) * kstep; const char* b2 = last ? nB : cB + (size_t)(t + 2) * kstep;
            const char* a3 = a2 + kstep; const char* b3 = b2 + kstep;
            if constexpr (GATHER) { if (last && has_next) { PG8_GATHER_OFFS(voffN, nxt); } }
            if constexpr (SP2) {
            PG8_LDB(B0, 0, 0); PG8_LDB(B1, 0, 1); PG8_SCHED; PG8_LDA(At, 0, 0); PG8_STAGE_A(PG8_SA(1, 1), a1, 1);
            PG8_WAIT_V(8); PG8_WAIT_L(0); PG8_BAR; PG8_MMA(0, 0, At, B0); PG8_MMA(0, 1, At, B1); PG8_BAR; PG8_SCHED;
            if constexpr (GATHER) { if (last && has_next) {
#pragma unroll
                for (int _h = 0; _h < 2; ++_h)
#pragma unroll
                    for (int _i = 0; _i < 2; ++_i) voffA[_h][_i] = voffN[_h][_i]; } }
            PG8_LDA(At, 0, 1); PG8_STAGE_B(PG8_SB(0, 0), b2); PG8_STAGE_B(PG8_SB(0, 1), b2 + hstepB); PG8_STAGE_A(PG8_SA(0, 0), a2, 0);
            PG8_WAIT_V(8); PG8_WAIT_L(0); PG8_BAR; PG8_MMA(1, 0, At, B0); PG8_MMA(1, 1, At, B1); PG8_BAR; PG8_SCHED;
            PG8_LDB(B0, 1, 0); PG8_LDB(B1, 1, 1); PG8_SCHED; PG8_LDA(At, 1, 0); PG8_STAGE_A(PG8_SA(0, 1), a2, 1);
            PG8_WAIT_V(8); PG8_WAIT_L(0); PG8_BAR; PG8_MMA(0, 0, At, B0); PG8_MMA(0, 1, At, B1); PG8_BAR; PG8_SCHED;
            PG8_LDA(At, 1, 1); PG8_STAGE_B(PG8_SB(1, 0), b3); PG8_STAGE_B(PG8_SB(1, 1), b3 + hstepB); PG8_STAGE_A(PG8_SA(1, 0), a3, 0);
            PG8_WAIT_V(8); PG8_WAIT_L(0); PG8_BAR; PG8_MMA(1, 0, At, B0); PG8_MMA(1, 1, At, B1); PG8_BAR; PG8_SCHED;
            } else {
            PG8_LDB(B0, 0, 0); PG8_SCHED; PG8_LDA(At, 0, 0); PG8_STAGE_A(PG8_SA(1, 1), a1, 1);
            PG8_WAIT_L(8); PG8_BAR; PG8_WAIT_L(0); PG8_MMA(0, 0, At, B0); PG8_BAR; PG8_SCHED;
            if constexpr (GATHER) { if (last && has_next) {
#pragma unroll
                for (int _h = 0; _h < 2; ++_h)
#pragma unroll
                    for (int _i = 0; _i < 2; ++_i) voffA[_h][_i] = voffN[_h][_i]; } }
            PG8_LDB(B1, 0, 1); PG8_STAGE_B(PG8_SB(0, 0), b2);
            PG8_BAR; PG8_WAIT_L(0); PG8_MMA(0, 1, At, B1); PG8_BAR;
            PG8_LDA(At, 0, 1); PG8_STAGE_A(PG8_SA(0, 0), a2, 0);
            PG8_BAR; PG8_WAIT_L(0); PG8_MMA(1, 0, At, B0); PG8_BAR; PG8_SCHED;
            PG8_STAGE_B(PG8_SB(0, 1), b2 + hstepB);
            PG8_WAIT_V(6); PG8_BAR; PG8_MMA(1, 1, At, B1); PG8_BAR;
            PG8_LDB(B0, 1, 0); PG8_SCHED; PG8_LDA(At, 1, 0); PG8_STAGE_A(PG8_SA(0, 1), a2, 1);
            PG8_WAIT_L(8); PG8_BAR; PG8_WAIT_L(0); PG8_MMA(0, 0, At, B0); PG8_BAR; PG8_SCHED;
            PG8_LDB(B1, 1, 1); PG8_STAGE_B(PG8_SB(1, 0), b3);
            PG8_BAR; PG8_WAIT_L(0); PG8_MMA(0, 1, At, B1); PG8_BAR;
            PG8_LDA(At, 1, 1); PG8_STAGE_A(PG8_SA(1, 0), a3, 0);
            PG8_BAR; PG8_WAIT_L(0); PG8_MMA(1, 0, At, B0); PG8_BAR; PG8_SCHED;
            PG8_STAGE_B(PG8_SB(1, 1), b3 + hstepB);
            PG8_WAIT_V(6); PG8_BAR; PG8_MMA(1, 1, At, B1); PG8_BAR;
            }
        }
        if constexpr (ALIGN_EPI) { if (wr == 0) PG8_BAR; }
        E(acc, cur, wr, wc, fr, fq);
        if (!has_next) break;
#pragma unroll
        for (int a = 0; a < 2; ++a)
#pragma unroll
            for (int b = 0; b < 2; ++b)
#pragma unroll
                for (int m = 0; m < 4; ++m)
#pragma unroll
                    for (int n = 0; n < 2; ++n) acc[a][b][m][n] = (f32x4){0.f, 0.f, 0.f, 0.f};
        cur = nxt; cA = nA; cB = nB; ++ui;
        if constexpr (ALIGN_EPI) { if (wr == 1) PG8_BAR; }
    }
    PG8_WAIT_V(0);
    if constexpr (!ALIGN_EPI) { if (wr == 0) PG8_BAR; }
    PG8_BAR;
#undef PG8_SA
#undef PG8_SB
#undef PG8_STAGE_A
#undef PG8_STAGE_B
#undef PG8_LDA
#undef PG8_LDB
#undef PG8_MMA
#undef PG8_WAIT_V
#undef PG8_WAIT_L
#undef PG8_BAR
#undef PG8_SCHED
#undef PG8_GATHER_OFFS
}
}
namespace mk {
constexpr int NWAVES = 8;
constexpr int T = 16384, D = 1024, SEQ = 4096, NB = 4, NE = 32, NH = 32;
constexpr int DSSD = 2048, DCONV = 3072, NPROJ = 8224;
constexpr float EPS = 1e-5f;
constexpr size_t MiB = 1u << 20;
constexpr size_t WS_CTL = 0, CTL_ZERO_BYTES = 256 * 1024;
constexpr size_t WS_MOD = 128 * 1024;
constexpr size_t WS_CD = 1 * MiB;
constexpr size_t WS_GATE = 1 * MiB + 256 * 1024;
constexpr size_t WS_DT = 2 * MiB;
constexpr size_t WS_LIST = 4 * MiB;
constexpr size_t WS_WDT = 6 * MiB;
constexpr size_t WS_WPOOL = 6 * MiB + 512 * 1024;
constexpr size_t WS_WIN = 8 * MiB, WS_WSSD = 24 * MiB, WS_WPO = 28 * MiB, WS_WOUT = 30 * MiB, WS_WGU = 32 * MiB, WS_WDN = 160 * MiB;
constexpr size_t WS_H = 224 * MiB, WS_Z = 256 * MiB, WS_XBC = 320 * MiB, WS_U = 416 * MiB, WS_GATES = 448 * MiB, WS_STATES = 512 * MiB, WS_Y = 576 * MiB;
constexpr size_t WS_P = 640 * MiB, WS_P2 = 672 * MiB, WS_M1 = 704 * MiB, WS_MERGED = 736 * MiB, WS_END = 768 * MiB;
constexpr size_t WS_ACT = 256 * MiB, WS_YB = 416 * MiB;
constexpr int ACT_ROWS = 73728;
constexpr int CW_TMO = 0, CW_CODE = 1, CW_GCNT = 1024, CW_BAR = 4096;
constexpr int RING_BYTES = 135168;
constexpr int LDSCTL_OFF = RING_BYTES, MISC_OFF = LDSCTL_OFF + 64;
constexpr int LDS_BYTES = 147456;

#define GAS __attribute__((address_space(1)))
#define LAS __attribute__((address_space(3)))
typedef unsigned short bf16;
typedef unsigned v4u __attribute__((ext_vector_type(4)));
typedef unsigned v2u __attribute__((ext_vector_type(2)));
typedef float f32x4 __attribute__((ext_vector_type(4)));
typedef float f32x16 __attribute__((ext_vector_type(16)));
typedef short bf16x8 __attribute__((ext_vector_type(8)));
typedef GAS unsigned gu32;
#define RLX_AGENT __ATOMIC_RELAXED, __HIP_MEMORY_SCOPE_AGENT
#define LDS_WAIT() asm volatile("s_waitcnt lgkmcnt(0)" ::: "memory")
#define VM_WAIT() asm volatile("s_waitcnt vmcnt(0)" ::: "memory")
__device__ __forceinline__ unsigned f2bf(float f) { unsigned u = __builtin_bit_cast(unsigned, f); return (u + 0x7fffu + ((u >> 16) & 1u)) >> 16; }
__device__ __forceinline__ unsigned pk2(float lo, float hi) { return f2bf(lo) | (f2bf(hi) << 16); }
__device__ __forceinline__ float bflo(unsigned w) { return __builtin_bit_cast(float, w << 16); }
__device__ __forceinline__ float bfhi(unsigned w) { return __builtin_bit_cast(float, w & 0xffff0000u); }
__device__ __forceinline__ float bf2f(bf16 h) { return __builtin_bit_cast(float, (unsigned)h << 16); }
__device__ __forceinline__ float sigm(float x) { return 1.f / (1.f + __expf(-x)); }
__device__ __forceinline__ float silu(float x) { return x * sigm(x); }
__device__ __forceinline__ float wave_sum(float v) {
#pragma unroll
    for (int o = 1; o < 64; o <<= 1) v += __shfl_xor(v, o);
    return v;
}

#define XB_TMO      128
#define XB_XCNT(j)  (256  + 64 * (j))
#define XB_XSUB(j)  (1280 + 64 * (j))
#define XB_XGEN(j)  (2304 + 64 * (j))
#define XB_TOP      3328
#define XB_TOPGEN   3392
#define XCD_BAR_WORDS 3456
#define XB_SPIN_CAP (1u << 18)
__device__ __forceinline__ unsigned xb_ld(unsigned* p)              { return __hip_atomic_load(p, __ATOMIC_RELAXED, __HIP_MEMORY_SCOPE_AGENT); }
__device__ __forceinline__ unsigned xb_add(unsigned* p, unsigned v) { return __hip_atomic_fetch_add(p, v, __ATOMIC_RELAXED, __HIP_MEMORY_SCOPE_AGENT); }
__device__ __forceinline__ unsigned xb_xcc_id() { return (unsigned)__builtin_amdgcn_s_getreg((3 << 11) | 20) & 0xFu; }
#define XB_SPIN(cond, bar) do { unsigned _sp = 0; while (cond) { __builtin_amdgcn_s_sleep(1); \
    if ((++_sp & 255u) == 0u) { if (xb_ld(&(bar)[XB_TMO])) break; if (_sp > XB_SPIN_CAP) { atomicAdd(&(bar)[XB_TMO], 1u); break; } } } } while (0)
struct XcdBarrier { unsigned* bar; unsigned x; volatile LAS unsigned* st; };
__device__ __forceinline__ XcdBarrier xcd_barrier_post(unsigned* bar, volatile LAS unsigned* st) {
    XcdBarrier b; b.bar = bar; b.x = xb_xcc_id(); b.st = st;
    if (threadIdx.x == 0) (void)xb_add(&bar[XB_XCNT(b.x)], 1u);
    return b;
}
__device__ __forceinline__ void xcd_barrier_complete(unsigned* bar, unsigned x, unsigned& nloc, unsigned& nx) {
    const unsigned G = gridDim.x * gridDim.y * gridDim.z;
    unsigned sum, cnt, mine, sp = 0u;
    for (;;) {
        sum = 0u; cnt = 0u; mine = 0u;
#pragma unroll
        for (unsigned j = 0; j < 16; ++j) { const unsigned c = xb_ld(&bar[XB_XCNT(j)]); sum += c; cnt += (c > 0u) ? 1u : 0u; mine = (j == x) ? c : mine; }
        if (sum == G) break;
        __builtin_amdgcn_s_sleep(1);
        if ((++sp & 255u) == 0u) { if (xb_ld(&bar[XB_TMO])) break; if (sp > XB_SPIN_CAP) { atomicAdd(&bar[XB_TMO], 1u); break; } }
    }
    nloc = mine > 0u ? mine : 1u; nx = cnt > 0u ? cnt : 1u;
}
__device__ __forceinline__ void xcd_barrier(const XcdBarrier& b) {
    asm volatile("s_waitcnt vmcnt(0)" ::: "memory");
    __syncthreads();
    if (threadIdx.x == 0) {
        unsigned* bar = b.bar;
        __builtin_amdgcn_s_waitcnt(0);
        unsigned nloc = b.st[0], nx = b.st[1];
        if (nloc == 0u) { xcd_barrier_complete(bar, b.x, nloc, nx); b.st[0] = nloc; b.st[1] = nx; }
        const unsigned old = xb_add(&bar[XB_XSUB(b.x)], 1u);
        const unsigned gen = old / nloc;
        if (old + 1u == (gen + 1u) * nloc) {
            __builtin_amdgcn_fence(__ATOMIC_RELEASE, "agent");
            asm volatile("s_waitcnt vmcnt(0)" ::: "memory");
            const unsigned og = xb_add(&bar[XB_TOP], 1u);
            const unsigned tg = og / nx;
            if (og + 1u == (tg + 1u) * nx) xb_add(&bar[XB_TOPGEN], 1u);
            else XB_SPIN(xb_ld(&bar[XB_TOPGEN]) == tg, bar);
            __builtin_amdgcn_fence(__ATOMIC_ACQUIRE, "agent");
            xb_add(&bar[XB_XGEN(b.x)], 1u);
            asm volatile("s_waitcnt vmcnt(0)" ::: "memory");
        } else {
            XB_SPIN(xb_ld(&bar[XB_XGEN(b.x)]) == gen, bar);
            __builtin_amdgcn_fence(__ATOMIC_ACQUIRE, "agent");
            asm volatile("s_waitcnt vmcnt(0)" ::: "memory");
        }
    }
    __syncthreads();
}
}
namespace mk {
struct Frame {
    LAS unsigned char* lds; volatile LAS unsigned* MISC; gu32* ctl; unsigned char* ws; float* out; const float* const* in;
    int tid, lane, wave, vcu, G;
};
enum { I_X = 0, I_C, I_WADA, I_BADA, I_NMW, I_WIN, I_CONVW, I_CONVB, I_DTB, I_ALOG, I_DSKIP, I_SNW, I_WSSD, I_WPOOL, I_PSCALE, I_WPO, I_WOUT, I_NFW, I_WR, I_BR, I_WGU, I_BGU, I_WDN, I_BDN, I_NFINAL };

__device__ __forceinline__ void p0_tile(const float* src, int ldsrc, int srccol0, int k0, bf16* dst, int lddst, int dstrow0, int nvalid, LAS float* scr, int lane) {
    const int col = (lane & 15) * 4;
#pragma unroll 4
    for (int i = 0; i < 16; ++i) { const int kk = 4 * i + (lane >> 4);
        f32x4 v = (f32x4){0.f, 0.f, 0.f, 0.f};
        if (col < nvalid) v = *(const f32x4*)(src + (size_t)(k0 + kk) * ldsrc + srccol0 + col);
        LAS float* s = scr + kk * 65 + col; s[0] = v.x; s[1] = v.y; s[2] = v.z; s[3] = v.w; }
    LDS_WAIT(); asm volatile("" ::: "memory");
    const int c = lane & 7;
#pragma unroll
    for (int j = 0; j < 8; ++j) { const int n = (lane >> 3) + 8 * j; const LAS float* s = scr + (8 * c) * 65 + n;
        v4u o; o.x = pk2(s[0 * 65], s[1 * 65]); o.y = pk2(s[2 * 65], s[3 * 65]); o.z = pk2(s[4 * 65], s[5 * 65]); o.w = pk2(s[6 * 65], s[7 * 65]);
        if (n < nvalid) *(v4u*)(dst + (size_t)(dstrow0 + n) * lddst + k0 + 8 * c) = o; }
    LDS_WAIT(); asm volatile("" ::: "memory");
}
__device__ __forceinline__ void p0_prologue(Frame& F) {
    LAS float* scr = (LAS float*)(F.lds + F.wave * 16896);
    const int gw = F.vcu * NWAVES + F.wave, NGW = F.G * NWAVES;
    bf16* WIN_T = (bf16*)(F.ws + WS_WIN); bf16* WDT_T = (bf16*)(F.ws + WS_WDT); bf16* WSSD_T = (bf16*)(F.ws + WS_WSSD); bf16* WPO_T = (bf16*)(F.ws + WS_WPO);
    bf16* WOUT_T = (bf16*)(F.ws + WS_WOUT); bf16* WPOOL_T = (bf16*)(F.ws + WS_WPOOL); bf16* WGU_T = (bf16*)(F.ws + WS_WGU); bf16* WDN_T = (bf16*)(F.ws + WS_WDN);
    constexpr int N_IN = 2048, N_DT = 16, N_SSD = 512, N_PO = 256, N_OUT = 256, N_POOL = 64, N_GU = 16384, N_DN = 8192;
    constexpr int NITEMS = N_IN + N_DT + N_SSD + N_PO + N_OUT + N_POOL + N_GU + N_DN;
    for (int it = gw; it < NITEMS; it += NGW) {
        int r = it;
        if (r < N_GU) { const int e = r >> 9, q = r & 511, rb = q >> 4, kb = q & 15; const int rho = rb * 64, pn = rho >> 8, rr = rho & 255;
            const int sc = rr < 128 ? 128 * pn + rr : 1024 + 128 * pn + (rr - 128);
            p0_tile(F.in[I_WGU] + (size_t)e * 1024 * 2048, 2048, sc, kb * 64, WGU_T + (size_t)e * 2048 * 1024, 1024, rho, 64, scr, F.lane); continue; } r -= N_GU;
        if (r < N_DN) { const int e = r >> 8, q = r & 255, rb = q >> 4, kb = q & 15;
            p0_tile(F.in[I_WDN] + (size_t)e * 1024 * 1024, 1024, rb * 64, kb * 64, WDN_T + (size_t)e * 1024 * 1024, 1024, rb * 64, 64, scr, F.lane); continue; } r -= N_DN;
        if (r < N_IN) { const int rb = r >> 4, kb = r & 15; const int drow = rb * 64; const int sc = drow + (drow >= 5120 ? 32 : 0);
            p0_tile(F.in[I_WIN], NPROJ, sc, kb * 64, WIN_T, 1024, drow, 64, scr, F.lane); continue; } r -= N_IN;
        if (r < N_DT) { p0_tile(F.in[I_WIN], NPROJ, 5120, r * 64, WDT_T, 1024, 0, 32, scr, F.lane); continue; } r -= N_DT;
        if (r < N_SSD) { const int rb = r >> 5, kb = r & 31; p0_tile(F.in[I_WSSD], 1024, rb * 64, kb * 64, WSSD_T, 2048, rb * 64, 64, scr, F.lane); continue; } r -= N_SSD;
        if (r < N_PO) { const int rb = r >> 4, kb = r & 15; p0_tile(F.in[I_WPO], 1024, rb * 64, kb * 64, WPO_T, 1024, rb * 64, 64, scr, F.lane); continue; } r -= N_PO;
        if (r < N_OUT) { const int rb = r >> 4, kb = r & 15; p0_tile(F.in[I_WOUT], 1024, rb * 64, kb * 64, WOUT_T, 1024, rb * 64, 64, scr, F.lane); continue; } r -= N_OUT;
        { const int g = r >> 4, q = r & 15, rb = q >> 2, kb = q & 3; p0_tile(F.in[I_WPOOL] + (size_t)g * 65536, 256, rb * 64, kb * 64, WPOOL_T, 256, g * 256 + rb * 64, 64, scr, F.lane); }
    }
    float* mod = (float*)(F.ws + WS_MOD);
    for (int it = F.vcu; it < 24 * 16; it += F.G) {
        const int jb = it % 24, kp = it / 24; const int j = jb * 256 + (F.tid & 255), kbeg = kp * 64 + (F.tid >> 8) * 32;
        float a0 = 0.f, a1 = 0.f, a2 = 0.f, a3 = 0.f; const float* cc = F.in[I_C];
#pragma unroll 8
        for (int k = kbeg; k < kbeg + 32; ++k) { const float w = F.in[I_WADA][(size_t)k * 6144 + j];
            a0 += silu(cc[k]) * w; a1 += silu(cc[1024 + k]) * w; a2 += silu(cc[2048 + k]) * w; a3 += silu(cc[3072 + k]) * w; }
        if (kbeg == 0) { const float bb = F.in[I_BADA][j]; a0 += bb; a1 += bb; a2 += bb; a3 += bb; }
        atomicAdd(mod + j, a0); atomicAdd(mod + 6144 + j, a1); atomicAdd(mod + 2 * 6144 + j, a2); atomicAdd(mod + 3 * 6144 + j, a3);
    }
}

__device__ __forceinline__ void p1_norm_dt(Frame& F) {
    constexpr int PITCH = 2064;
    LAS unsigned char* tile = F.lds + F.wave * (8 * PITCH);
    for (int grp = F.vcu * NWAVES + F.wave; grp < T / 8; grp += F.G * NWAVES) {
    const int t0 = grp * 8, b = t0 / SEQ;
    const float* mod = (const float*)(F.ws + WS_MOD) + b * 6144; bf16* H = (bf16*)(F.ws + WS_H);
    f32x4 wv[4], scv[4], shv[4];
#pragma unroll
    for (int j = 0; j < 4; ++j) { const int col = 4 * F.lane + 256 * j; wv[j] = *(const f32x4*)(F.in[I_NMW] + col); scv[j] = *(const f32x4*)(mod + 1024 + col); shv[j] = *(const f32x4*)(mod + col); }
#pragma unroll 1
    for (int r = 0; r < 8; ++r) {
        const float* xr = F.in[I_X] + (size_t)(t0 + r) * D; f32x4 v[4]; float s = 0.f;
#pragma unroll
        for (int j = 0; j < 4; ++j) { v[j] = *(const f32x4*)(xr + 4 * F.lane + 256 * j); s += (v[j].x * v[j].x + v[j].y * v[j].y) + (v[j].z * v[j].z + v[j].w * v[j].w); }
        const float rstd = rsqrtf(wave_sum(s) * (1.f / D) + EPS);
#pragma unroll
        for (int j = 0; j < 4; ++j) { const f32x4 hv = v[j] * rstd * wv[j] * (scv[j] + 1.f) + shv[j];
            v2u o; o.x = pk2(hv.x, hv.y); o.y = pk2(hv.z, hv.w);
            *(v2u*)(H + (size_t)(t0 + r) * D + 4 * F.lane + 256 * j) = o;
            *(LAS v2u*)(tile + r * PITCH + (4 * F.lane + 256 * j) * 2) = o; }
    }
    LDS_WAIT(); asm volatile("" ::: "memory");
    const bf16* WDT_T = (const bf16*)(F.ws + WS_WDT);
    f32x4 acc0 = (f32x4){0.f, 0.f, 0.f, 0.f}, acc1 = acc0; const int fr = F.lane & 15, fq = F.lane >> 4;
#pragma unroll 4
    for (int s = 0; s < 32; ++s) {
        const bf16x8 a = *(const LAS bf16x8*)(tile + (fr & 7) * PITCH + (32 * s + 8 * fq) * 2);
        const bf16x8 b0 = *(const bf16x8*)(WDT_T + (size_t)fr * 1024 + 32 * s + 8 * fq), b1 = *(const bf16x8*)(WDT_T + (size_t)(fr + 16) * 1024 + 32 * s + 8 * fq);
        acc0 = __builtin_amdgcn_mfma_f32_16x16x32_bf16(a, b0, acc0, 0, 0, 0); acc1 = __builtin_amdgcn_mfma_f32_16x16x32_bf16(a, b1, acc1, 0, 0, 0);
    }
    if (fq < 2) { float* DT = (float*)(F.ws + WS_DT); const float db0 = F.in[I_DTB][fr], db1 = F.in[I_DTB][fr + 16];
#pragma unroll
        for (int i = 0; i < 4; ++i) { const int row = t0 + 4 * fq + i; float x0 = acc0[i] + db0, x1 = acc1[i] + db1;
            DT[(size_t)row * 32 + fr] = x0 > 20.f ? x0 : log1pf(__expf(x0)); DT[(size_t)row * 32 + 16 + fr] = x1 > 20.f ? x1 : log1pf(__expf(x1)); } }
    LDS_WAIT();
    }
}

__device__ __forceinline__ void pool_pass(Frame& F) {
    const bf16* U = (const bf16*)(F.ws + WS_U); bf16* P = (bf16*)(F.ws + WS_P);
    const int gid = F.vcu * 512 + F.tid;
    for (int it = gid; it < 1024 * 128; it += F.G * 512) {
        const int cg = it & 127, strip = it >> 7; const int t0 = strip * 16, tt0 = t0 % SEQ; const int w = 2 << (cg >> 5);
        float s[8];
#pragma unroll
        for (int i = 0; i < 8; ++i) s[i] = 0.f;
        for (int j = 1; j < w; ++j) { if (tt0 - j >= 0) { const v4u v = *(const v4u*)(U + (size_t)(t0 - j) * D + cg * 8);
                s[0] += bflo(v.x); s[1] += bfhi(v.x); s[2] += bflo(v.y); s[3] += bfhi(v.y); s[4] += bflo(v.z); s[5] += bfhi(v.z); s[6] += bflo(v.w); s[7] += bfhi(v.w); } }
        for (int i = 0; i < 16; ++i) { const int t = t0 + i, tt = tt0 + i;
            const v4u v = *(const v4u*)(U + (size_t)t * D + cg * 8); float u[8] = {bflo(v.x), bfhi(v.x), bflo(v.y), bfhi(v.y), bflo(v.z), bfhi(v.z), bflo(v.w), bfhi(v.w)};
#pragma unroll
            for (int q = 0; q < 8; ++q) s[q] += u[q];
            const float inv = 1.f / (float)(tt + 1 < w ? tt + 1 : w);
            v4u o; o.x = pk2(s[0] * inv - u[0], s[1] * inv - u[1]); o.y = pk2(s[2] * inv - u[2], s[3] * inv - u[3]); o.z = pk2(s[4] * inv - u[4], s[5] * inv - u[5]); o.w = pk2(s[6] * inv - u[6], s[7] * inv - u[7]);
            *(v4u*)(P + (size_t)t * D + cg * 8) = o;
            if (tt - w + 1 >= 0) { const v4u z = *(const v4u*)(U + (size_t)(t - w + 1) * D + cg * 8);
                s[0] -= bflo(z.x); s[1] -= bfhi(z.x); s[2] -= bflo(z.y); s[3] -= bfhi(z.y); s[4] -= bflo(z.z); s[5] -= bfhi(z.z); s[6] -= bflo(z.w); s[7] -= bfhi(z.w); } }
    }
}

__device__ __forceinline__ int swz16(int row) { return (row ^ (row >> 4)) & 15; }
__device__ __forceinline__ void conv8x8(const bf16* XBC, const float* cw, const float* cb, int trow0, bool seq_start, int col, float (&out)[8][8]) {
    v4u raw[11];
#pragma unroll
    for (int r = 0; r < 11; ++r) { if (r < 3 && seq_start) raw[r] = (v4u){0u, 0u, 0u, 0u}; else raw[r] = *(const v4u*)(XBC + (size_t)(trow0 - 3 + r) * DCONV + col); }
    f32x4 w[4][2], bb[2];
#pragma unroll
    for (int k = 0; k < 4; ++k) { w[k][0] = *(const f32x4*)(cw + k * DCONV + col); w[k][1] = *(const f32x4*)(cw + k * DCONV + col + 4); }
    bb[0] = *(const f32x4*)(cb + col); bb[1] = *(const f32x4*)(cb + col + 4);
#pragma unroll
    for (int i = 0; i < 8; ++i) {
        float a[8];
#pragma unroll
        for (int q = 0; q < 8; ++q) a[q] = bb[q >> 2][q & 3];
#pragma unroll
        for (int k = 0; k < 4; ++k) { const v4u v = raw[i + k]; const float u[8] = {bflo(v.x), bfhi(v.x), bflo(v.y), bfhi(v.y), bflo(v.z), bfhi(v.z), bflo(v.w), bfhi(v.w)};
#pragma unroll
            for (int q = 0; q < 8; ++q) a[q] += w[k][q >> 2][q & 3] * u[q]; }
#pragma unroll
        for (int q = 0; q < 8; ++q) out[i][q] = silu(a[q]);
    }
}
__device__ __forceinline__ void put_transposed(LAS unsigned char* img, int row0, int chunk, const float (&o)[8][8]) {
#pragma unroll
    for (int q = 0; q < 8; ++q) { const int row = row0 + q; v4u v; v.x = pk2(o[0][q], o[1][q]); v.y = pk2(o[2][q], o[3][q]); v.z = pk2(o[4][q], o[5][q]); v.w = pk2(o[6][q], o[7][q]);
        *(LAS v4u*)(img + row * 256 + ((chunk ^ swz16(row)) << 4)) = v; }
}
__device__ __forceinline__ void put_natural(LAS unsigned char* img, int l0, int chunk, const float (&o)[8][8]) {
#pragma unroll
    for (int i = 0; i < 8; ++i) { const int row = l0 + i; v4u v; v.x = pk2(o[i][0], o[i][1]); v.y = pk2(o[i][2], o[i][3]); v.z = pk2(o[i][4], o[i][5]); v.w = pk2(o[i][6], o[i][7]);
        *(LAS v4u*)(img + row * 256 + ((chunk ^ swz16(row)) << 4)) = v; }
}
__device__ __forceinline__ bf16x8 ld_frag(const LAS unsigned char* img, int row, int chunk) { return *(const LAS bf16x8*)(img + row * 256 + ((chunk ^ swz16(row)) << 4)); }

__device__ __forceinline__ void ssd_states_unit(Frame& F, int unit) {
    const int hh = unit & 1, g = (unit >> 1) & 3, c = (unit >> 3) & 31, b = unit >> 8; const int t0 = b * SEQ + c * 128;
    LAS float* sx = (LAS float*)F.lds;
    LAS unsigned char* Bt = F.lds + 4096; LAS unsigned char* Xt = F.lds + 4096 + 32768;
    const float* DT = (const float*)(F.ws + WS_DT); const bf16* XBC = (const bf16*)(F.ws + WS_XBC); float* CD = (float*)(F.ws + WS_CD);
    __syncthreads();
    if (F.wave < 4) {
        const int h = g * 8 + 4 * hh + F.wave; const float A = -__expf(F.in[I_ALOG][h]); const int l = 2 * F.lane;
        const float d0 = DT[(size_t)(t0 + l) * 32 + h], d1 = DT[(size_t)(t0 + l + 1) * 32 + h]; const float a0 = d0 * A, a1 = d1 * A, s = a0 + a1;
        float incl = s;
#pragma unroll
        for (int o = 1; o < 64; o <<= 1) { const float v = __shfl_up(incl, o); if (F.lane >= o) incl += v; }
        const float c0 = incl - s + a0, c1 = incl, total = __shfl(incl, 63);
        sx[F.wave * 128 + l] = d0 * __expf(total - c0); sx[F.wave * 128 + l + 1] = d1 * __expf(total - c1);
        if (F.lane == 0) CD[(b * 32 + c) * 32 + h] = __expf(total);
    }
    __syncthreads();
    {
        const int strip = F.tid >> 5, grp = F.tid & 31, l0 = strip * 8; float o[8][8];
        conv8x8(XBC, F.in[I_CONVW], F.in[I_CONVB], t0 + l0, (c == 0 && l0 == 0), g * 512 + hh * 256 + grp * 8, o);
        const LAS float* sxe = sx + (grp >> 3) * 128 + l0;
#pragma unroll
        for (int i = 0; i < 8; ++i) { const float sc = sxe[i];
#pragma unroll
            for (int q = 0; q < 8; ++q) o[i][q] *= sc; }
        put_transposed(Xt, grp * 8, strip, o);
    }
    if (F.tid < 256) { const int strip = F.tid >> 4, grp = F.tid & 15, l0 = strip * 8; float o[8][8];
        conv8x8(XBC, F.in[I_CONVW], F.in[I_CONVB], t0 + l0, (c == 0 && l0 == 0), 2048 + g * 128 + grp * 8, o);
        put_transposed(Bt, grp * 8, strip, o); }
    __syncthreads();
    const int li = F.lane & 31, half = F.lane >> 5, hp = (F.wave >> 1) * 64 + (F.wave & 1) * 32 + li;
    f32x16 acc[4];
#pragma unroll
    for (int nt = 0; nt < 4; ++nt)
#pragma unroll
        for (int r = 0; r < 16; ++r) acc[nt][r] = 0.f;
#pragma unroll 2
    for (int ks = 0; ks < 8; ++ks) { const bf16x8 xb = ld_frag(Xt, hp, 2 * ks + half);
#pragma unroll
        for (int nt = 0; nt < 4; ++nt) { const bf16x8 ba = ld_frag(Bt, 32 * nt + li, 2 * ks + half); acc[nt] = __builtin_amdgcn_mfma_f32_32x32x16_bf16(ba, xb, acc[nt], 0, 0, 0); } }
    __syncthreads();
    LAS unsigned char* OUT = Xt;
#pragma unroll
    for (int nt = 0; nt < 4; ++nt)
#pragma unroll
        for (int rq = 0; rq < 4; ++rq) { const int ch8 = 8 * nt + 2 * rq + half; v2u v; v.x = pk2(acc[nt][4 * rq], acc[nt][4 * rq + 1]); v.y = pk2(acc[nt][4 * rq + 2], acc[nt][4 * rq + 3]);
            *(LAS v2u*)(OUT + hp * 256 + ((ch8 ^ (hp & 31)) << 3)) = v; }
    __syncthreads();
    bf16* ST = (bf16*)(F.ws + WS_STATES) + ((size_t)((b * 32 + c) * 32 + g * 8 + 4 * hh)) * 8192;
#pragma unroll
    for (int it = 0; it < 8; ++it) { const int idx = it * 512 + F.tid, row = idx >> 4, j = idx & 15, k = row & 31;
        v4u v = *(const LAS v4u*)(OUT + row * 256 + ((j ^ (k >> 1)) << 4)); if (k & 1) v = (v4u){v.z, v.w, v.x, v.y};
        *(v4u*)(ST + (size_t)row * 128 + j * 8) = v; }
}

__device__ __forceinline__ void ssd_scan(Frame& F) {
    bf16* ST = (bf16*)(F.ws + WS_STATES); const float* CD = (const float*)(F.ws + WS_CD);
    for (int gid = F.vcu * 512 + F.tid; gid < 131072; gid += F.G * 512) {
        const int bh = gid >> 10, b = bh >> 5, h = bh & 31, el = (gid & 1023) * 8;
        float st[8];
#pragma unroll
        for (int q = 0; q < 8; ++q) st[q] = 0.f;
#pragma unroll 4
        for (int c = 0; c < 32; ++c) { bf16* p = ST + ((size_t)((b * 32 + c) * 32 + h)) * 8192 + el; const v4u v = *(const v4u*)p; const float cd = CD[(b * 32 + c) * 32 + h];
            v4u o; o.x = pk2(st[0], st[1]); o.y = pk2(st[2], st[3]); o.z = pk2(st[4], st[5]); o.w = pk2(st[6], st[7]); *(v4u*)p = o;
            st[0] = st[0] * cd + bflo(v.x); st[1] = st[1] * cd + bfhi(v.x); st[2] = st[2] * cd + bflo(v.y); st[3] = st[3] * cd + bfhi(v.y);
            st[4] = st[4] * cd + bflo(v.z); st[5] = st[5] * cd + bfhi(v.z); st[6] = st[6] * cd + bflo(v.w); st[7] = st[7] * cd + bfhi(v.w); }
    }
}

__device__ __forceinline__ void ssd_out_unit(Frame& F, int unit) {
    const int g = unit & 3, c = (unit >> 2) & 31, b = unit >> 7; const int t0 = b * SEQ + c * 128;
    LAS float* acum = (LAS float*)F.lds; LAS float* dtv = acum + 1024; LAS float* ssq = acum + 2048;
    LAS unsigned char* Bn = F.lds + 9216; LAS unsigned char* Cn = Bn + 32768; LAS unsigned char* Xt = Cn + 32768;
    const float* DT = (const float*)(F.ws + WS_DT); const bf16* XBC = (const bf16*)(F.ws + WS_XBC); const bf16* Z = (const bf16*)(F.ws + WS_Z); bf16* Y = (bf16*)(F.ws + WS_Y);
    __syncthreads();
    { const int h = g * 8 + F.wave; const float A = -__expf(F.in[I_ALOG][h]); const int l = 2 * F.lane;
        const float d0 = DT[(size_t)(t0 + l) * 32 + h], d1 = DT[(size_t)(t0 + l + 1) * 32 + h]; const float a0 = d0 * A, a1 = d1 * A, s = a0 + a1;
        float incl = s;
#pragma unroll
        for (int o = 1; o < 64; o <<= 1) { const float v = __shfl_up(incl, o); if (F.lane >= o) incl += v; }
        acum[F.wave * 128 + l] = incl - s + a0; acum[F.wave * 128 + l + 1] = incl; dtv[F.wave * 128 + l] = d0; dtv[F.wave * 128 + l + 1] = d1;
        if (F.tid < 128) ssq[F.tid] = 0.f; }
    { const int mat = F.tid >> 8, strip = (F.tid >> 4) & 15, grp = F.tid & 15, l0 = strip * 8; float o[8][8];
        conv8x8(XBC, F.in[I_CONVW], F.in[I_CONVB], t0 + l0, (c == 0 && l0 == 0), 2048 + mat * 512 + g * 128 + grp * 8, o);
        put_natural(mat ? Cn : Bn, l0, grp, o); }
    const int li = F.lane & 31, half = F.lane >> 5, ew = F.wave >> 1, lsel = F.wave & 1;
#pragma unroll
    for (int ps = 0; ps < 2; ++ps) {
        if (ps) __syncthreads();
        { const int strip = F.tid >> 5, grp = F.tid & 31, l0 = strip * 8; float o[8][8];
            conv8x8(XBC, F.in[I_CONVW], F.in[I_CONVB], t0 + l0, (c == 0 && l0 == 0), g * 512 + ps * 256 + grp * 8, o);
            put_transposed(Xt, grp * 8, strip, o); }
        __syncthreads();
        const int e = 4 * ps + ew, h = 8 * g + e; const float Dk = F.in[I_DSKIP][h];
        const bf16* prev = (const bf16*)(F.ws + WS_STATES) + ((size_t)((b * 32 + c) * 32 + h)) * 8192;
        const LAS float* ac = acum + e * 128; const LAS float* dv = dtv + e * 128;
#pragma unroll
        for (int it = 0; it < 2; ++it) {
            const int i = lsel ? (1 + it) : (it ? 3 : 0); const int l = 32 * i + li; const float acl = ac[l];
            f32x16 acc[2];
#pragma unroll
            for (int pt = 0; pt < 2; ++pt)
#pragma unroll
                for (int r = 0; r < 16; ++r) acc[pt][r] = 0.f;
#pragma unroll 2
            for (int ks = 0; ks < 8; ++ks) { const bf16x8 cf = ld_frag(Cn, l, 2 * ks + half);
#pragma unroll
                for (int pt = 0; pt < 2; ++pt) { const bf16x8 pf = *(const bf16x8*)(prev + (size_t)(32 * pt + li) * 128 + 16 * ks + 8 * half); acc[pt] = __builtin_amdgcn_mfma_f32_32x32x16_bf16(pf, cf, acc[pt], 0, 0, 0); } }
            { const float el = __expf(acl);
#pragma unroll
                for (int pt = 0; pt < 2; ++pt)
#pragma unroll
                    for (int r = 0; r < 16; ++r) acc[pt][r] *= el; }
#pragma unroll 1
            for (int j = 0; j <= i; ++j) {
                f32x16 gt;
#pragma unroll
                for (int r = 0; r < 16; ++r) gt[r] = 0.f;
#pragma unroll 2
                for (int ks = 0; ks < 8; ++ks) { const bf16x8 bfm = ld_frag(Bn, 32 * j + li, 2 * ks + half); const bf16x8 cf = ld_frag(Cn, l, 2 * ks + half); gt = __builtin_amdgcn_mfma_f32_32x32x16_bf16(bfm, cf, gt, 0, 0, 0); }
                unsigned wp[8];
#pragma unroll
                for (int rq = 0; rq < 4; ++rq) { const int sb = 32 * j + 8 * rq + 4 * half; const f32x4 as4 = *(const LAS f32x4*)(ac + sb), dt4 = *(const LAS f32x4*)(dv + sb); float wv[4];
#pragma unroll
                    for (int x = 0; x < 4; ++x) { const int s = sb + x; float w = gt[4 * rq + x] * __expf(fminf(acl - as4[x], 0.f)) * dt4[x];
                        if (j == i) { if (s > l) w = 0.f; if (s == l) w += Dk; } wv[x] = w; }
                    wp[2 * rq] = pk2(wv[0], wv[1]); wp[2 * rq + 1] = pk2(wv[2], wv[3]); }
                const bf16x8 wf0 = __builtin_bit_cast(bf16x8, (v4u){wp[0], wp[1], wp[2], wp[3]}), wf1 = __builtin_bit_cast(bf16x8, (v4u){wp[4], wp[5], wp[6], wp[7]});
#pragma unroll
                for (int pt = 0; pt < 2; ++pt) { const int hp = ew * 64 + 32 * pt + li; const LAS unsigned char* xr = Xt + hp * 256; const int fx = swz16(hp);
#pragma unroll
                    for (int ksub = 0; ksub < 2; ++ksub) { const v2u lo = *(const LAS v2u*)(xr + (((4 * j + 2 * ksub) ^ fx) << 4) + 8 * half), hi = *(const LAS v2u*)(xr + (((4 * j + 2 * ksub + 1) ^ fx) << 4) + 8 * half);
                        const bf16x8 xf = __builtin_bit_cast(bf16x8, (v4u){lo.x, lo.y, hi.x, hi.y});
                        acc[pt] = __builtin_amdgcn_mfma_f32_32x32x16_bf16(xf, ksub ? wf1 : wf0, acc[pt], 0, 0, 0); } }
            }
            float sq = 0.f;
#pragma unroll
            for (int pt = 0; pt < 2; ++pt)
#pragma unroll
                for (int rq = 0; rq < 4; ++rq) { const int ch = h * 64 + 32 * pt + 8 * rq + 4 * half; const v2u zz = *(const v2u*)(Z + (size_t)(t0 + l) * DSSD + ch);
                    const float y0 = acc[pt][4 * rq] * silu(bflo(zz.x)), y1 = acc[pt][4 * rq + 1] * silu(bfhi(zz.x)), y2 = acc[pt][4 * rq + 2] * silu(bflo(zz.y)), y3 = acc[pt][4 * rq + 3] * silu(bfhi(zz.y));
                    sq += (y0 * y0 + y1 * y1) + (y2 * y2 + y3 * y3); *(v2u*)(Y + (size_t)(t0 + l) * DSSD + ch) = (v2u){pk2(y0, y1), pk2(y2, y3)}; }
            __hip_atomic_fetch_add(ssq + l, sq, __ATOMIC_RELAXED, __HIP_MEMORY_SCOPE_WORKGROUP);
        }
    }
    VM_WAIT(); __syncthreads();
#pragma unroll
    for (int it = 0; it < 2; ++it) { const int i = lsel ? (1 + it) : (it ? 3 : 0); const int l = 32 * i + li; const float rstd = rsqrtf(ssq[l] * (1.f / 512.f) + EPS);
#pragma unroll
        for (int ps = 0; ps < 2; ++ps)
#pragma unroll
            for (int pt = 0; pt < 2; ++pt)
#pragma unroll
                for (int rq = 0; rq < 4; ++rq) { const int ch = (8 * g + 4 * ps + ew) * 64 + 32 * pt + 8 * rq + 4 * half; const f32x4 nw = *(const f32x4*)(F.in[I_SNW] + ch); const v2u v = *(const v2u*)(Y + (size_t)(t0 + l) * DSSD + ch);
                    v2u o; o.x = pk2(bflo(v.x) * rstd * nw.x, bfhi(v.x) * rstd * nw.y); o.y = pk2(bflo(v.y) * rstd * nw.z, bfhi(v.y) * rstd * nw.w);
                    *(v2u*)(Y + (size_t)(t0 + l) * DSSD + ch) = o; } }
}
}
namespace mk {
using pg8::Unit;
constexpr int MI_TSTART = 16, MI_CNT = 64;

struct Sched {
    int mode, nM, nN, nwg, G, c, lda, ldb, a_pn_off, npn;
    const bf16* A; const bf16* Bt; const int* list; const volatile LAS unsigned* misc;
    __device__ __forceinline__ void init_dense(int M, int N, int G_, int c_, const bf16* A_, int lda_, const bf16* Bt_, int ldb_, int a_pn_off_) {
        mode = 0; nM = M / 256; nN = N / 256; nwg = nM * nN; G = G_; c = c_; A = A_; Bt = Bt_; lda = lda_; ldb = ldb_; a_pn_off = a_pn_off_; npn = 0; list = nullptr; misc = nullptr; }
    __device__ __forceinline__ void init_moe(int mode_, int G_, int c_, const bf16* A_, const bf16* Bt_, const int* list_, const volatile LAS unsigned* misc_) {
        mode = mode_; G = G_; c = c_; A = A_; Bt = Bt_; lda = 1024; ldb = 1024; a_pn_off = 0; npn = (mode_ == 1) ? 8 : 4; list = list_; misc = misc_; nM = 0; nN = 0; nwg = (int)misc_[MI_TSTART + 32] * npn; }
    __device__ __forceinline__ bool next(int i, Unit& u) const {
        const long L = (long)i * G + c; if (L >= nwg) return false;
        if (mode == 0) {
            int wgid = (int)L; { const int q = nwg / 8, r = nwg % 8, xcd = wgid % 8, off = wgid / 8; wgid = (xcd < r ? xcd * (q + 1) : r * (q + 1) + (xcd - r) * q) + off; }
            const int nig = 8 * nN, gid = wgid / nig, fm = gid * 8, gsz = (nM - fm) < 8 ? (nM - fm) : 8;
            u.pm = fm + ((wgid % nig) % gsz); u.pn = (wgid % nig) / gsz; u.e = 0; u.i = 0; return true;
        }
        const int rt = (int)L / npn, pn = (int)L % npn; int e = 0;
        while (e < 31 && (int)misc[MI_TSTART + e + 1] <= rt) ++e;
        u.pm = rt; u.pn = pn; u.e = e; u.i = rt - (int)misc[MI_TSTART + e]; return true;
    }
    __device__ __forceinline__ const char* a_base(const Unit& u) const {
        if (mode == 0) return (const char*)(A + (size_t)u.pm * 256 * lda + (size_t)u.pn * a_pn_off);
        if (mode == 1) return (const char*)A;
        return (const char*)(A + (size_t)u.pm * 256 * 1024); }
    __device__ __forceinline__ const char* b_base(const Unit& u) const {
        if (mode == 0) return (const char*)(Bt + (size_t)u.pn * 256 * ldb);
        if (mode == 1) return (const char*)(Bt + (size_t)u.e * 2048 * 1024 + (size_t)u.pn * 256 * 1024);
        return (const char*)(Bt + (size_t)u.e * 1024 * 1024 + (size_t)u.pn * 256 * 1024); }
    __device__ __forceinline__ unsigned row_off(const Unit& u, int r) const {
        const int idx = u.i * 256 + r; const int cnt = (int)misc[MI_CNT + u.e];
        const int tok = idx < cnt ? (list[(size_t)u.e * T + idx] >> 2) : 0; return (unsigned)tok * 2048u; }
};

struct EpiAll {
    static constexpr bool PERM = true;
    int kind, pad; unsigned char* ws; const float* const* in; float* out; const volatile LAS unsigned* misc;
    __device__ __forceinline__ void operator()(const pg8::f32x4 (&acc)[2][2][4][2], const Unit& u, int wr, int wc, int fr, int fq) const {
        const int rl0 = wr * 64 + fr, row0 = u.pm * 256 + rl0, cl0 = wc * 32 + 8 * fq;
        if (kind == 0) {
            bf16* base; int ld, colt; bool sg = false;
            if (u.pn < 8) { base = (bf16*)(ws + WS_Z); ld = 2048; colt = u.pn * 256; }
            else if (u.pn < 20) { base = (bf16*)(ws + WS_XBC); ld = 3072; colt = (u.pn - 8) * 256; }
            else if (u.pn < 24) { base = (bf16*)(ws + WS_U); ld = 1024; colt = (u.pn - 20) * 256; }
            else { base = (bf16*)(ws + WS_GATES); ld = 2048; colt = (u.pn - 24) * 256; sg = true; }
#pragma unroll
            for (int ai = 0; ai < 2; ++ai)
#pragma unroll
                for (int m = 0; m < 4; ++m) { bf16* rowp = base + (size_t)(row0 + ai * 128 + m * 16) * ld + colt + cl0;
#pragma unroll
                    for (int bj = 0; bj < 2; ++bj) { pg8::f32x4 v0 = acc[ai][bj][m][0], v1 = acc[ai][bj][m][1];
                        if (sg) { v0 = (pg8::f32x4){sigm(v0[0]), sigm(v0[1]), sigm(v0[2]), sigm(v0[3])}; v1 = (pg8::f32x4){sigm(v1[0]), sigm(v1[1]), sigm(v1[2]), sigm(v1[3])}; }
                        v4u w; w.x = pk2(v0[0], v0[1]); w.y = pk2(v0[2], v0[3]); w.z = pk2(v1[0], v1[1]); w.w = pk2(v1[2], v1[3]);
                        *(v4u*)(rowp + bj * 128) = w; } }
        } else if (kind == 1) {
            bf16* base = (bf16*)(ws + WS_P2); const float* ps = in[I_PSCALE];
#pragma unroll
            for (int bj = 0; bj < 2; ++bj) { const int col = u.pn * 256 + bj * 128 + cl0; const f32x4 s0 = *(const f32x4*)(ps + col), s1 = *(const f32x4*)(ps + col + 4);
#pragma unroll
                for (int ai = 0; ai < 2; ++ai)
#pragma unroll
                    for (int m = 0; m < 4; ++m) { const pg8::f32x4 v0 = acc[ai][bj][m][0] * s0, v1 = acc[ai][bj][m][1] * s1;
                        v4u w; w.x = pk2(v0[0], v0[1]); w.y = pk2(v0[2], v0[3]); w.z = pk2(v1[0], v1[1]); w.w = pk2(v1[2], v1[3]);
                        *(v4u*)(base + (size_t)(row0 + ai * 128 + m * 16) * 1024 + col) = w; } }
        } else if (kind == 2 || kind == 3) {
            const bf16* gates = (const bf16*)(ws + WS_GATES) + (kind == 3 ? 1024 : 0); bf16* m1 = (bf16*)(ws + WS_M1); bf16* mg = (bf16*)(ws + WS_MERGED);
#pragma unroll
            for (int ai = 0; ai < 2; ++ai)
#pragma unroll
                for (int m = 0; m < 4; ++m) { const size_t row = row0 + ai * 128 + m * 16;
#pragma unroll
                    for (int bj = 0; bj < 2; ++bj) { const int col = u.pn * 256 + bj * 128 + cl0; const v4u gq = *(const v4u*)(gates + row * 2048 + col);
                        float r[8] = {acc[ai][bj][m][0][0] * bflo(gq.x), acc[ai][bj][m][0][1] * bfhi(gq.x), acc[ai][bj][m][0][2] * bflo(gq.y), acc[ai][bj][m][0][3] * bfhi(gq.y),
                                      acc[ai][bj][m][1][0] * bflo(gq.z), acc[ai][bj][m][1][1] * bfhi(gq.z), acc[ai][bj][m][1][2] * bflo(gq.w), acc[ai][bj][m][1][3] * bfhi(gq.w)};
                        if (kind == 3) { const v4u mq = *(const v4u*)(m1 + row * 1024 + col);
                            r[0] += bflo(mq.x); r[1] += bfhi(mq.x); r[2] += bflo(mq.y); r[3] += bfhi(mq.y); r[4] += bflo(mq.z); r[5] += bfhi(mq.z); r[6] += bflo(mq.w); r[7] += bfhi(mq.w); }
                        v4u w; w.x = pk2(r[0], r[1]); w.y = pk2(r[2], r[3]); w.z = pk2(r[4], r[5]); w.w = pk2(r[6], r[7]);
                        *(v4u*)((kind == 3 ? mg : m1) + row * 1024 + col) = w; } }
        } else if (kind == 4) {
            const int b = (u.pm * 256) / SEQ; const float* ga = (const float*)(ws + WS_MOD) + b * 6144 + 2048; const float* x = in[I_X];
#pragma unroll
            for (int bj = 0; bj < 2; ++bj) { const int col = u.pn * 256 + bj * 128 + cl0; const f32x4 g0 = *(const f32x4*)(ga + col), g1 = *(const f32x4*)(ga + col + 4);
#pragma unroll
                for (int ai = 0; ai < 2; ++ai)
#pragma unroll
                    for (int m = 0; m < 4; ++m) { const size_t off = (size_t)(row0 + ai * 128 + m * 16) * 1024 + col;
                        *(f32x4*)(out + off) = *(const f32x4*)(x + off) + g0 * acc[ai][bj][m][0]; *(f32x4*)(out + off + 4) = *(const f32x4*)(x + off + 4) + g1 * acc[ai][bj][m][1]; } }
        } else if (kind == 5) {
            bf16* act = (bf16*)(ws + WS_ACT); const float* bgu = in[I_BGU] + (size_t)u.e * 2048; const int col = u.pn * 128 + cl0;
            const f32x4 bg0 = *(const f32x4*)(bgu + col), bg1 = *(const f32x4*)(bgu + col + 4), bl0 = *(const f32x4*)(bgu + 1024 + col), bl1 = *(const f32x4*)(bgu + 1024 + col + 4);
#pragma unroll
            for (int ai = 0; ai < 2; ++ai)
#pragma unroll
                for (int m = 0; m < 4; ++m) { float r[8];
#pragma unroll
                    for (int n = 0; n < 2; ++n)
#pragma unroll
                        for (int x = 0; x < 4; ++x) { float gl = acc[ai][0][m][n][x] + (n ? bg1[x] : bg0[x]), ln = acc[ai][1][m][n][x] + (n ? bl1[x] : bl0[x]);
                            gl = fminf(gl, 7.f); ln = fminf(fmaxf(ln, -7.f), 7.f); r[4 * n + x] = gl * sigm(1.702f * gl) * (ln + 1.f); }
                    v4u w; w.x = pk2(r[0], r[1]); w.y = pk2(r[2], r[3]); w.z = pk2(r[4], r[5]); w.w = pk2(r[6], r[7]);
                    *(v4u*)(act + (size_t)(row0 + ai * 128 + m * 16) * 1024 + col) = w; }
        } else {
            bf16* yb = (bf16*)(ws + WS_YB); const float* bdn = in[I_BDN] + (size_t)u.e * 1024; const int* list = (const int*)(ws + WS_LIST) + (size_t)u.e * T; const float* gate = (const float*)(ws + WS_GATE);
            const int cnt = (int)misc[MI_CNT + u.e];
#pragma unroll
            for (int ai = 0; ai < 2; ++ai)
#pragma unroll
                for (int m = 0; m < 4; ++m) { const int idx = u.i * 256 + rl0 + ai * 128 + m * 16;
                    if (idx < cnt) { const int slot = list[idx]; const float gt = gate[slot];
#pragma unroll
                        for (int bj = 0; bj < 2; ++bj) { const int col = u.pn * 256 + bj * 128 + cl0; const f32x4 b0 = *(const f32x4*)(bdn + col), b1 = *(const f32x4*)(bdn + col + 4);
                            const pg8::f32x4 v0 = (acc[ai][bj][m][0] + b0) * gt, v1 = (acc[ai][bj][m][1] + b1) * gt;
                            v4u w; w.x = pk2(v0[0], v0[1]); w.y = pk2(v0[2], v0[3]); w.z = pk2(v1[0], v1[1]); w.w = pk2(v1[2], v1[3]);
                            *(v4u*)(yb + (size_t)slot * 1024 + col) = w; } } }
        }
    }
};

__device__ __forceinline__ void p6_router(Frame& F) {
    LAS float* wrT = (LAS float*)F.lds;
    LAS int* lcnt = (LAS int*)(F.lds + 131072); LAS int* lbase = lcnt + 32; LAS int* rec = lcnt + 64;
    const float* wr = F.in[I_WR];
    __syncthreads();
    for (int idx = F.tid; idx < 32768; idx += 512) { const int k = idx >> 5, e = idx & 31; wrT[e * 1024 + k] = wr[idx]; }
    for (int rb = F.vcu; rb < T / 64; rb += F.G) {
    __syncthreads();
    if (F.tid < 32) lcnt[F.tid] = 0;
    __syncthreads();
    const int rowblk = rb * 64, b = rowblk / SEQ; const float* mod = (const float*)(F.ws + WS_MOD) + b * 6144; bf16* H = (bf16*)(F.ws + WS_H);
    const float* x1 = F.out;
#pragma unroll 1
    for (int pr = 0; pr < 4; ++pr) {
        float hv[2][16]; const int rl0 = F.wave * 8 + pr * 2;
#pragma unroll
        for (int rr = 0; rr < 2; ++rr) { const size_t t = rowblk + rl0 + rr; f32x4 v[4]; float s = 0.f;
#pragma unroll
            for (int j = 0; j < 4; ++j) { v[j] = *(const f32x4*)(x1 + t * D + 4 * F.lane + 256 * j); s += (v[j].x * v[j].x + v[j].y * v[j].y) + (v[j].z * v[j].z + v[j].w * v[j].w); }
            const float rstd = rsqrtf(wave_sum(s) * (1.f / D) + EPS);
#pragma unroll
            for (int j = 0; j < 4; ++j) { const int col = 4 * F.lane + 256 * j; const f32x4 w = *(const f32x4*)(F.in[I_NFW] + col), sc = *(const f32x4*)(mod + 4096 + col), sh = *(const f32x4*)(mod + 3072 + col);
                const f32x4 h = v[j] * rstd * w * (sc + 1.f) + sh; hv[rr][4 * j] = h.x; hv[rr][4 * j + 1] = h.y; hv[rr][4 * j + 2] = h.z; hv[rr][4 * j + 3] = h.w;
                *(v2u*)(H + t * D + col) = (v2u){pk2(h.x, h.y), pk2(h.z, h.w)}; } }
        float a[64];
#pragma unroll
        for (int e = 0; e < 32; ++e) { float s0 = 0.f, s1 = 0.f;
#pragma unroll
            for (int j = 0; j < 4; ++j) { const f32x4 w = *(const LAS f32x4*)(wrT + e * 1024 + 4 * F.lane + 256 * j);
                s0 += hv[0][4 * j] * w.x + hv[0][4 * j + 1] * w.y + hv[0][4 * j + 2] * w.z + hv[0][4 * j + 3] * w.w;
                s1 += hv[1][4 * j] * w.x + hv[1][4 * j + 1] * w.y + hv[1][4 * j + 2] * w.z + hv[1][4 * j + 3] * w.w; }
            a[2 * e] = s0; a[2 * e + 1] = s1; }
#define RED_STEP(N, M) { _Pragma("unroll") for (int i = 0; i < (N) / 2; ++i) { const bool up = (F.lane & (M)) != 0; const float keep = up ? a[i + (N) / 2] : a[i], send = up ? a[i] : a[i + (N) / 2]; a[i] = keep + __shfl_xor(send, (M)); } }
        RED_STEP(64, 32) RED_STEP(32, 16) RED_STEP(16, 8) RED_STEP(8, 4) RED_STEP(4, 2) RED_STEP(2, 1)
#undef RED_STEP
        const int e = F.lane >> 1, rr = F.lane & 1; float v = a[0] + F.in[I_BR][e];
        float tv[4]; int ti[4];
#pragma unroll
        for (int r = 0; r < 4; ++r) { float m = v; int mi = e;
#pragma unroll
            for (int o = 2; o < 64; o <<= 1) { const float om = __shfl_xor(m, o); const int oi = __shfl_xor(mi, o); if (om > m || (om == m && oi < mi)) { m = om; mi = oi; } }
            tv[r] = m; ti[r] = mi; if (e == mi) v = -INFINITY; }
        if (F.lane < 2) { const float e0 = 1.f, e1 = __expf(tv[1] - tv[0]), e2 = __expf(tv[2] - tv[0]), e3 = __expf(tv[3] - tv[0]); const float inv = 1.f / (e0 + e1 + e2 + e3);
            const float gt[4] = {e0 * inv, e1 * inv, e2 * inv, e3 * inv}; const int rl = rl0 + rr;
#pragma unroll
            for (int r = 0; r < 4; ++r) { const int pos = __hip_atomic_fetch_add(lcnt + ti[r], 1, __ATOMIC_RELAXED, __HIP_MEMORY_SCOPE_WORKGROUP);
                rec[(rl * 4 + r) * 3] = ti[r]; rec[(rl * 4 + r) * 3 + 1] = pos; rec[(rl * 4 + r) * 3 + 2] = __float_as_int(gt[r]); } }
    }
    __syncthreads();
    if (F.tid < 32) lbase[F.tid] = (int)__hip_atomic_fetch_add((unsigned*)(F.ctl + CW_GCNT) + F.tid, (unsigned)lcnt[F.tid], __ATOMIC_RELAXED, __HIP_MEMORY_SCOPE_AGENT);
    __syncthreads();
    if (F.tid < 256) { const int rl = F.tid >> 2, r = F.tid & 3; const int e = rec[F.tid * 3], pos = rec[F.tid * 3 + 1]; const int slot = (rowblk + rl) * 4 + r;
        ((int*)(F.ws + WS_LIST))[(size_t)e * T + lbase[e] + pos] = slot; ((float*)(F.ws + WS_GATE))[slot] = __int_as_float(rec[F.tid * 3 + 2]); }
    }
}

__device__ __forceinline__ void moe_setup(Frame& F) {
    __syncthreads();
    if (F.tid == 0) { int acc = 0; F.MISC[MI_TSTART] = 0;
        for (int e = 0; e < 32; ++e) { const unsigned cnt = __hip_atomic_load((unsigned*)(F.ctl + CW_GCNT) + e, RLX_AGENT); F.MISC[MI_CNT + e] = cnt; acc += (int)((cnt + 255u) >> 8); F.MISC[MI_TSTART + e + 1] = (unsigned)acc; } }
    __syncthreads();
}

__device__ __forceinline__ void p9_final(Frame& F) {
    const bf16* YB = (const bf16*)(F.ws + WS_YB);
#pragma unroll 1
    for (size_t t = F.vcu * NWAVES + F.wave; t < (size_t)T; t += F.G * NWAVES) { const int b = (int)(t / SEQ); const float* ga = (const float*)(F.ws + WS_MOD) + b * 6144 + 5120;
        f32x4 v[4]; float s = 0.f;
#pragma unroll
        for (int j = 0; j < 4; ++j) { const int col = 4 * F.lane + 256 * j; f32x4 m = (f32x4){0.f, 0.f, 0.f, 0.f};
#pragma unroll
            for (int k = 0; k < 4; ++k) { const v2u q = *(const v2u*)(YB + (t * 4 + k) * D + col); m += (f32x4){bflo(q.x), bfhi(q.x), bflo(q.y), bfhi(q.y)}; }
            v[j] = *(const f32x4*)(F.out + t * D + col) + *(const f32x4*)(ga + col) * m; s += (v[j].x * v[j].x + v[j].y * v[j].y) + (v[j].z * v[j].z + v[j].w * v[j].w); }
        const float rstd = rsqrtf(wave_sum(s) * (1.f / D) + EPS);
#pragma unroll
        for (int j = 0; j < 4; ++j) { const int col = 4 * F.lane + 256 * j; *(f32x4*)(F.out + t * D + col) = v[j] * rstd * *(const f32x4*)(F.in[I_NFINAL] + col); } }
}
}
namespace mk {
#ifndef MK_N_LAUNCHES
#define MK_N_LAUNCHES 1
#endif
constexpr int NPHASES = 12;
struct Args { const float* in[25]; float* out; unsigned char* ws; int ph_lo, ph_hi; };

__global__ void __launch_bounds__(NWAVES * 64, 2) mk_fwd(Args args) {
    extern __shared__ __attribute__((aligned(16))) unsigned char lds[];
    Frame F;
    F.lds = (LAS unsigned char*)lds; F.MISC = (volatile LAS unsigned*)(F.lds + MISC_OFF);
    F.tid = threadIdx.x; F.lane = F.tid & 63; F.wave = __builtin_amdgcn_readfirstlane(F.tid >> 6);
    F.G = gridDim.x; { const int bx = blockIdx.x; F.vcu = (F.G % 8 == 0) ? (bx % 8) * (F.G / 8) + bx / 8 : bx; }
    F.ws = args.ws; F.out = args.out; F.in = args.in; F.ctl = (gu32*)(args.ws + WS_CTL);
    for (int u = F.tid; u < (LDS_BYTES - LDSCTL_OFF) / 4; u += NWAVES * 64) ((LAS unsigned*)(F.lds + LDSCTL_OFF))[u] = 0u;
    __syncthreads();
    XcdBarrier bar; bar.bar = (unsigned*)(F.ctl + CW_BAR); bar.x = 0; bar.st = nullptr;
    if (MK_N_LAUNCHES == 1) bar = xcd_barrier_post((unsigned*)(F.ctl + CW_BAR), F.MISC + 0);
    const int lo = args.ph_lo, hi = args.ph_hi;
#ifndef MK_PH_MASK
#define MK_PH_MASK 0xFFF
#endif
#define IN(k) (((MK_PH_MASK >> (k)) & 1) && lo <= (k) && (k) < hi)
#define SEAM(k) do { if (IN(k) && IN((k) + 1)) xcd_barrier(bar); } while (0)
    LAS unsigned char* ring = F.lds;
    const int cid = (int)blockIdx.x;

    if (IN(0)) { p0_prologue(F); } SEAM(0);
    if (IN(1)) { p1_norm_dt(F); } SEAM(1);
    if (IN(2)) {
        Sched S; S.init_dense(T, 8192, F.G, cid, (const bf16*)(F.ws + WS_H), 1024, (const bf16*)(F.ws + WS_WIN), 1024, 0);
        EpiAll E{0, 0, F.ws, F.in, F.out, F.MISC}; __syncthreads();
        pg8::gemm_phase<EpiAll, Sched, true, true, false>(ring, 1024, 1024, 1024, S, E);
    } SEAM(2);
    if (IN(3)) { pool_pass(F); for (int u = F.vcu; u < 1024; u += F.G) ssd_states_unit(F, u); } SEAM(3);
    if (IN(4)) { ssd_scan(F);
        Sched S; S.init_dense(T, 1024, F.G, cid, (const bf16*)(F.ws + WS_P), 1024, (const bf16*)(F.ws + WS_WPOOL), 256, 256);
        EpiAll E{1, 0, F.ws, F.in, F.out, F.MISC};
        __syncthreads();
        pg8::gemm_phase<EpiAll, Sched, true, true, false>(ring, 256, 1024, 256, S, E);
    } SEAM(4);
    if (IN(5)) { for (int u = F.vcu; u < 512; u += F.G) ssd_out_unit(F, u); } SEAM(5);
    if (IN(6)) {
        { Sched S; S.init_dense(T, 1024, F.G, cid, (const bf16*)(F.ws + WS_Y), 2048, (const bf16*)(F.ws + WS_WSSD), 2048, 0);
          EpiAll E{2, 0, F.ws, F.in, F.out, F.MISC}; __syncthreads();
          pg8::gemm_phase<EpiAll, Sched, true, true, false>(ring, 2048, 2048, 2048, S, E); }
        VM_WAIT(); __syncthreads();
        { Sched S; S.init_dense(T, 1024, F.G, cid, (const bf16*)(F.ws + WS_P2), 1024, (const bf16*)(F.ws + WS_WPO), 1024, 0);
          EpiAll E{3, 0, F.ws, F.in, F.out, F.MISC}; __syncthreads();
          pg8::gemm_phase<EpiAll, Sched, true, true, false>(ring, 1024, 1024, 1024, S, E); }
    } SEAM(6);
    if (IN(7)) { Sched S; S.init_dense(T, 1024, F.G, cid, (const bf16*)(F.ws + WS_MERGED), 1024, (const bf16*)(F.ws + WS_WOUT), 1024, 0);
        EpiAll E{4, 0, F.ws, F.in, F.out, F.MISC}; __syncthreads();
        pg8::gemm_phase<EpiAll, Sched, true, true, false>(ring, 1024, 1024, 1024, S, E);
    } SEAM(7);
    if (IN(8)) { p6_router(F); } SEAM(8);
    if (IN(9)) { moe_setup(F);
        Sched S; S.init_moe(1, F.G, cid, (const bf16*)(F.ws + WS_H), (const bf16*)(F.ws + WS_WGU), (const int*)(F.ws + WS_LIST), F.MISC);
        EpiAll E{5, 0, F.ws, F.in, F.out, F.MISC}; __syncthreads();
        pg8::gemm_phase<EpiAll, Sched, true, true, true>(ring, 1024, 1024, 1024, S, E);
    } SEAM(9);
    if (IN(10)) { moe_setup(F);
        Sched S; S.init_moe(2, F.G, cid, (const bf16*)(F.ws + WS_ACT), (const bf16*)(F.ws + WS_WDN), (const int*)(F.ws + WS_LIST), F.MISC);
        EpiAll E{6, 0, F.ws, F.in, F.out, F.MISC}; __syncthreads();
        pg8::gemm_phase<EpiAll, Sched, true, true, false>(ring, 1024, 1024, 1024, S, E);
    } SEAM(10);
    if (IN(11)) { p9_final(F); }
#undef IN
#undef SEAM
}

static void run_mk(void* const* d_in, float* out, unsigned char* ws, hipStream_t stream) {
    static int grid = 0;
    if (grid == 0) {
        int dev = 0, cus = 0;
        if (hipGetDevice(&dev) != hipSuccess || hipDeviceGetAttribute(&cus, hipDeviceAttributeMultiprocessorCount, dev) != hipSuccess) { fprintf(stderr, "kernel_launch: device query failed\n"); grid = -1; return; }
        if (hipFuncSetAttribute((const void*)mk_fwd, hipFuncAttributeMaxDynamicSharedMemorySize, LDS_BYTES) != hipSuccess) { fprintf(stderr, "kernel_launch: hipFuncSetAttribute failed\n"); grid = -1; return; }
        (void)hipGetLastError();
        grid = cus;
    }
    if (grid < 0) return;
    (void)hipMemsetAsync(ws + WS_CTL, 0, CTL_ZERO_BYTES, stream);
    Args a{};
    for (int i = 0; i < 25; ++i) a.in[i] = (const float*)d_in[i];
    a.out = out; a.ws = ws;
    for (int li = 0; li < MK_N_LAUNCHES; ++li) {
        a.ph_lo = (MK_N_LAUNCHES == 1) ? 0 : li; a.ph_hi = (MK_N_LAUNCHES == 1) ? NPHASES : li + 1;
        hipLaunchKernelGGL(mk_fwd, dim3(grid), dim3(NWAVES * 64), LDS_BYTES, stream, a);
    }
}
}
extern "C" void kernel_launch(void* const* d_in, const int* in_sizes, int n_in, void* d_out, int out_size, void* d_ws, size_t ws_size, hipStream_t stream) {
    mk::run_mk(d_in, (float*)d_out, (unsigned char*)d_ws, stream);
}
```

```cpp
#define MK_N_LAUNCHES 1
#include <hip/hip_runtime.h>
#include <cstdio>
#include <cstdint>
#include <cmath>
namespace pg8 {
#define PG8_LAS __attribute__((address_space(3)))
typedef unsigned short bf16_t;
typedef short bf16x8 __attribute__((ext_vector_type(8)));
typedef float f32x4 __attribute__((ext_vector_type(4)));
typedef unsigned u32x4 __attribute__((ext_vector_type(4)));
typedef unsigned u32x2 __attribute__((ext_vector_type(2)));
constexpr int BM = 256, BK = 64, HALF = 128, HTB = HALF * BK * 2  , STAGE_BYTES = 8 * HTB, NXCD = 8, WGM = 8;

__host__ __device__ __forceinline__ int lds_byte(int r, int c) { const int st = (r >> 4) * 2 + (c >> 5), rr = r & 15, cc = c & 31, ob = rr * 64 + cc * 2; return st * 1024 + (ob ^ (((ob >> 9) & 1) << 5)); }
__host__ __device__ __forceinline__ void stage_rc(int b, int& R, int& C) { const int st = b / 1024, sb = b % 1024, swz = sb ^ (((sb >> 9) & 1) << 5); R = (st >> 1) * 16 + swz / 64; C = (st & 1) * 32 + (swz % 64) / 2; }
__host__ __device__ __forceinline__ int perm32(int rho) { const int n = rho >> 4, i = rho & 15; return 8 * (i >> 2) + 4 * n + (i & 3); }

struct Unit { int pm, pn, e, i; };

__device__ __forceinline__ unsigned cvt_pk_bf16(float lo, float hi) { unsigned r; asm volatile("v_cvt_pk_bf16_f32 %0, %1, %2" : "=v"(r) : "v"(lo), "v"(hi)); return r; }

struct StaticOrder {
    int nM, nN, nwg, G, c; const bf16_t* A; const bf16_t* Bt; int lda, ldb, a_pn_off, pad;
    __device__ void init(int M, int N, int G_, int c_, const bf16_t* A_, int lda_, const bf16_t* Bt_, int ldb_, int a_pn_off_) { nM = M / BM; nN = N / BM; nwg = nM * nN; G = G_; c = c_; A = A_; Bt = Bt_; lda = lda_; ldb = ldb_; a_pn_off = a_pn_off_; pad = 0; }
    __device__ bool next(int i, Unit& u) const {
        const long L = (long)i * G + c; if (L >= nwg) return false;
        int wgid = (int)L; { const int q = nwg / NXCD, r = nwg % NXCD, xcd = wgid % NXCD, off = wgid / NXCD; wgid = (xcd < r ? xcd * (q + 1) : r * (q + 1) + (xcd - r) * q) + off; }
        const int nig = WGM * nN, gid = wgid / nig, fm = gid * WGM, gsz = (nM - fm) < WGM ? (nM - fm) : WGM;
        u.pm = fm + ((wgid % nig) % gsz); u.pn = (wgid % nig) / gsz; u.e = 0; u.i = 0; return true;
    }
    __device__ __forceinline__ const char* a_base(const Unit& u) const { return (const char*)(A + (size_t)u.pm * BM * lda + (size_t)u.pn * a_pn_off); }
    __device__ __forceinline__ const char* b_base(const Unit& u) const { return (const char*)(Bt + (size_t)u.pn * BM * ldb); }
    __device__ __forceinline__ unsigned row_off(const Unit&, int) const { return 0u; }
};

template <class Epi, class Sched, bool ALIGN_EPI, bool SP2, bool GATHER>
__device__ __forceinline__ void gemm_phase(PG8_LAS unsigned char* lds, const int K, const int lda, const int ldb, const Sched& S, const Epi& E) {
    const int tid = threadIdx.x, wid = __builtin_amdgcn_readfirstlane(tid >> 6), lane = tid & 63, wr = wid >> 2, wc = wid & 3, fr = lane & 15, fq = lane >> 4;
    const int nt = K / BK;
    unsigned voffA[2][2], voffN[2][2], voffB[2]; int RA[2];
#pragma unroll
    for (int i = 0; i < 2; ++i) { int R, C; stage_rc(tid * 16 + i * 8192, R, C); const int Rb = Epi::PERM ? ((R & ~31) + perm32(R & 31)) : R;
        RA[i] = R; voffA[0][i] = GATHER ? (unsigned)C * 2u : (unsigned)(R * lda + C) * 2u; voffA[1][i] = voffA[0][i]; voffN[0][i] = 0; voffN[1][i] = 0; voffB[i] = (unsigned)(Rb * ldb + C) * 2u; }
    const unsigned cbytes[2] = {voffA[0][0], voffA[0][1]};
    const size_t kstep = (size_t)(BK * 2);
    const size_t hstepA = GATHER ? 0 : (size_t)HALF * lda * 2;
    const size_t hstepB = (size_t)HALF * ldb * 2;
    const unsigned ldsw = (unsigned)wid * 1024u;
    const int aoff = lds_byte(wr * 64 + fr, fq * 8), boff = lds_byte(wc * 32 + fr, fq * 8);
#define PG8_SA(b, h) (((b) * 2 + (h)) * HTB)
#define PG8_SB(b, h) ((4 + (b) * 2 + (h)) * HTB)
#define PG8_STAGE_B(bufoff, gbase) do { _Pragma("unroll") for (int _i = 0; _i < 2; ++_i) \
        __builtin_amdgcn_global_load_lds((const unsigned*)((const char*)(gbase) + voffB[_i]), (PG8_LAS unsigned*)(lds + (bufoff) + ldsw + _i * 8192), 16, 0, 0); } while (0)
#define PG8_STAGE_A(bufoff, gbase, h) do { _Pragma("unroll") for (int _i = 0; _i < 2; ++_i) \
        __builtin_amdgcn_global_load_lds((const unsigned*)((const char*)(gbase) + (h) * hstepA + voffA[GATHER ? (h) : 0][_i]), (PG8_LAS unsigned*)(lds + (bufoff) + ldsw + _i * 8192), 16, 0, 0); } while (0)
#define PG8_LDA(dst, b, h) do { _Pragma("unroll") for (int m = 0; m < 4; ++m) _Pragma("unroll") for (int k = 0; k < 2; ++k) dst[m][k] = *(const PG8_LAS bf16x8*)(lds + PG8_SA(b, h) + aoff + m * 2048 + k * 1024); } while (0)
#define PG8_LDB(dst, b, h) do { _Pragma("unroll") for (int n = 0; n < 2; ++n) _Pragma("unroll") for (int k = 0; k < 2; ++k) dst[n][k] = *(const PG8_LAS bf16x8*)(lds + PG8_SB(b, h) + boff + n * 2048 + k * 1024); } while (0)
#define PG8_MMA(ai, bj, At, Bt) do { __builtin_amdgcn_s_setprio(1); _Pragma("unroll") for (int m = 0; m < 4; ++m) _Pragma("unroll") for (int n = 0; n < 2; ++n) _Pragma("unroll") for (int k = 0; k < 2; ++k) \
        acc[ai][bj][m][n] = __builtin_amdgcn_mfma_f32_16x16x32_bf16(Bt[n][k], At[m][k], acc[ai][bj][m][n], 0, 0, 0); __builtin_amdgcn_s_setprio(0); } while (0)
#define PG8_WAIT_V(n) asm volatile("s_waitcnt vmcnt(" #n ")" ::: "memory")
#define PG8_WAIT_L(n) asm volatile("s_waitcnt lgkmcnt(" #n ")" ::: "memory")
#define PG8_BAR __builtin_amdgcn_s_barrier()
#define PG8_SCHED __builtin_amdgcn_sched_barrier(0)
#define PG8_GATHER_OFFS(dst, u) do { _Pragma("unroll") for (int _h = 0; _h < 2; ++_h) _Pragma("unroll") for (int _i = 0; _i < 2; ++_i) dst[_h][_i] = S.row_off(u, _h * HALF + RA[_i]) + cbytes[_i]; } while (0)
    Unit cur, nxt; int ui = 0;
    if (!S.next(0, cur)) return;
    f32x4 acc[2][2][4][2];
#pragma unroll
    for (int a = 0; a < 2; ++a)
#pragma unroll
        for (int b = 0; b < 2; ++b)
#pragma unroll
            for (int m = 0; m < 4; ++m)
#pragma unroll
                for (int n = 0; n < 2; ++n) acc[a][b][m][n] = (f32x4){0.f, 0.f, 0.f, 0.f};
    bf16x8 At[4][2], B0[2][2], B1[2][2];
    const char* cA = S.a_base(cur); const char* cB = S.b_base(cur);
    if constexpr (GATHER) { PG8_GATHER_OFFS(voffA, cur); }
    if constexpr (SP2) {
        PG8_STAGE_B(PG8_SB(0, 0), cB); PG8_STAGE_B(PG8_SB(0, 1), cB + hstepB); PG8_STAGE_A(PG8_SA(0, 0), cA, 0); PG8_STAGE_A(PG8_SA(0, 1), cA, 1);
        if (wr == 1) PG8_BAR;
        PG8_WAIT_V(2); PG8_BAR;
        PG8_STAGE_B(PG8_SB(1, 0), cB + kstep); PG8_STAGE_A(PG8_SA(1, 0), cA + kstep, 0); PG8_STAGE_B(PG8_SB(1, 1), cB + hstepB + kstep);
        PG8_WAIT_V(6); PG8_BAR;
    } else {
        PG8_STAGE_B(PG8_SB(0, 0), cB); PG8_STAGE_A(PG8_SA(0, 0), cA, 0); PG8_STAGE_B(PG8_SB(0, 1), cB + hstepB); PG8_STAGE_A(PG8_SA(0, 1), cA, 1);
        if (wr == 1) PG8_BAR;
        PG8_WAIT_V(4); PG8_BAR;
        PG8_STAGE_B(PG8_SB(1, 0), cB + kstep); PG8_STAGE_A(PG8_SA(1, 0), cA + kstep, 0); PG8_STAGE_B(PG8_SB(1, 1), cB + hstepB + kstep);
        PG8_WAIT_V(6); PG8_BAR;
    }
    for (;;) {
        const bool has_next = S.next(ui + 1, nxt);
        const char* nA = has_next ? S.a_base(nxt) : cA; const char* nB = has_next ? S.b_base(nxt) : cB;
#pragma unroll 1
        for (int t = 0; t < nt; t += 2) {
            const bool last = (t == nt - 2);
            const char* a1 = cA + (size_t)(t + 1) * kstep;
            const char* a2 = last ? nA : cA + (size_t)(t + 2) * kstep; const char* b2 = last ? nB : cB + (size_t)(t + 2) * kstep;
            const char* a3 = a2 + kstep; const char* b3 = b2 + kstep;
            if constexpr (GATHER) { if (last && has_next) { PG8_GATHER_OFFS(voffN, nxt); } }
            if constexpr (SP2) {
            PG8_LDB(B0, 0, 0); PG8_LDB(B1, 0, 1); PG8_SCHED; PG8_LDA(At, 0, 0); PG8_STAGE_A(PG8_SA(1, 1), a1, 1);
            PG8_WAIT_V(8); PG8_WAIT_L(0); PG8_BAR; PG8_MMA(0, 0, At, B0); PG8_MMA(0, 1, At, B1); PG8_BAR; PG8_SCHED;
            if constexpr (GATHER) { if (last && has_next) {
#pragma unroll
                for (int _h = 0; _h < 2; ++_h)
#pragma unroll
                    for (int _i = 0; _i < 2; ++_i) voffA[_h][_i] = voffN[_h][_i]; } }
            PG8_LDA(At, 0, 1); PG8_STAGE_B(PG8_SB(0, 0), b2); PG8_STAGE_B(PG8_SB(0, 1), b2 + hstepB); PG8_STAGE_A(PG8_SA(0, 0), a2, 0);
            PG8_WAIT_V(8); PG8_WAIT_L(0); PG8_BAR; PG8_MMA(1, 0, At, B0); PG8_MMA(1, 1, At, B1); PG8_BAR; PG8_SCHED;
            PG8_LDB(B0, 1, 0); PG8_LDB(B1, 1, 1); PG8_SCHED; PG8_LDA(At, 1, 0); PG8_STAGE_A(PG8_SA(0, 1), a2, 1);
            PG8_WAIT_V(8); PG8_WAIT_L(0); PG8_BAR; PG8_MMA(0, 0, At, B0); PG8_MMA(0, 1, At, B1); PG8_BAR; PG8_SCHED;
            PG8_LDA(At, 1, 1); PG8_STAGE_B(PG8_SB(1, 0), b3); PG8_STAGE_B(PG8_SB(1, 1), b3 + hstepB); PG8_STAGE_A(PG8_SA(1, 0), a3, 0);
            PG8_WAIT_V(8); PG8_WAIT_L(0); PG8_BAR; PG8_MMA(1, 0, At, B0); PG8_MMA(1, 1, At, B1); PG8_BAR; PG8_SCHED;
            } else {
            PG8_LDB(B0, 0, 0); PG8_SCHED; PG8_LDA(At, 0, 0); PG8_STAGE_A(PG8_SA(1, 1), a1, 1);
            PG8_WAIT_L(8); PG8_BAR; PG8_WAIT_L(0); PG8_MMA(0, 0, At, B0); PG8_BAR; PG8_SCHED;
            if constexpr (GATHER) { if (last && has_next) {
#pragma unroll
                for (int _h = 0; _h < 2; ++_h)
#pragma unroll
                    for (int _i = 0; _i < 2; ++_i) voffA[_h][_i] = voffN[_h][_i]; } }
            PG8_LDB(B1, 0, 1); PG8_STAGE_B(PG8_SB(0, 0), b2);
            PG8_BAR; PG8_WAIT_L(0); PG8_MMA(0, 1, At, B1); PG8_BAR;
            PG8_LDA(At, 0, 1); PG8_STAGE_A(PG8_SA(0, 0), a2, 0);
            PG8_BAR; PG8_WAIT_L(0); PG8_MMA(1, 0, At, B0); PG8_BAR; PG8_SCHED;
            PG8_STAGE_B(PG8_SB(0, 1), b2 + hstepB);
            PG8_WAIT_V(6); PG8_BAR; PG8_MMA(1, 1, At, B1); PG8_BAR;
            PG8_LDB(B0, 1, 0); PG8_SCHED; PG8_LDA(At, 1, 0); PG8_STAGE_A(PG8_SA(0, 1), a2, 1);
            PG8_WAIT_L(8); PG8_BAR; PG8_WAIT_L(0); PG8_MMA(0, 0, At, B0); PG8_BAR; PG8_SCHED;
            PG8_LDB(B1, 1, 1); PG8_STAGE_B(PG8_SB(1, 0), b3);
            PG8_BAR; PG8_WAIT_L(0); PG8_MMA(0, 1, At, B1); PG8_BAR;
            PG8_LDA(At, 1, 1); PG8_STAGE_A(PG8_SA(1, 0), a3, 0);
            PG8_BAR; PG8_WAIT_L(0); PG8_MMA(1, 0, At, B0); PG8_BAR; PG8_SCHED;
            PG8_STAGE_B(PG8_SB(1, 1), b3 + hstepB);
            PG8_WAIT_V(6); PG8_BAR; PG8_MMA(1, 1, At, B1); PG8_BAR;
            }
        }
        if constexpr (ALIGN_EPI) { if (wr == 0) PG8_BAR; }
        E(acc, cur, wr, wc, fr, fq);
        if (!has_next) break;
#pragma unroll
        for (int a = 0; a < 2; ++a)
#pragma unroll
            for (int b = 0; b < 2; ++b)
#pragma unroll
                for (int m = 0; m < 4; ++m)
#pragma unroll
                    for (int n = 0; n < 2; ++n) acc[a][b][m][n] = (f32x4){0.f, 0.f, 0.f, 0.f};
        cur = nxt; cA = nA; cB = nB; ++ui;
        if constexpr (ALIGN_EPI) { if (wr == 1) PG8_BAR; }
    }
    PG8_WAIT_V(0);
    if constexpr (!ALIGN_EPI) { if (wr == 0) PG8_BAR; }
    PG8_BAR;
#undef PG8_SA
#undef PG8_SB
#undef PG8_STAGE_A
#undef PG8_STAGE_B
#undef PG8_LDA
#undef PG8_LDB
#undef PG8_MMA
#undef PG8_WAIT_V
#undef PG8_WAIT_L
#undef PG8_BAR
#undef PG8_SCHED
#undef PG8_GATHER_OFFS
}
}
namespace mk {
constexpr int NWAVES = 8;
constexpr int T = 16384, D = 1024, SEQ = 4096, NB = 4, NE = 32, NH = 32;
constexpr int DSSD = 2048, DCONV = 3072, NPROJ = 8224;
constexpr float EPS = 1e-5f;
constexpr size_t MiB = 1u << 20;
constexpr size_t WS_CTL = 0, CTL_ZERO_BYTES = 256 * 1024;
constexpr size_t WS_MOD = 128 * 1024;
constexpr size_t WS_CD = 1 * MiB;
constexpr size_t WS_GATE = 1 * MiB + 256 * 1024;
constexpr size_t WS_DT = 2 * MiB;
constexpr size_t WS_LIST = 4 * MiB;
constexpr size_t WS_WDT = 6 * MiB;
constexpr size_t WS_WPOOL = 6 * MiB + 512 * 1024;
constexpr size_t WS_WIN = 8 * MiB, WS_WSSD = 24 * MiB, WS_WPO = 28 * MiB, WS_WOUT = 30 * MiB, WS_WGU = 32 * MiB, WS_WDN = 160 * MiB;
constexpr size_t WS_H = 224 * MiB, WS_Z = 256 * MiB, WS_XBC = 320 * MiB, WS_U = 416 * MiB, WS_GATES = 448 * MiB, WS_STATES = 512 * MiB, WS_Y = 576 * MiB;
constexpr size_t WS_P = 640 * MiB, WS_P2 = 672 * MiB, WS_M1 = 704 * MiB, WS_MERGED = 736 * MiB, WS_END = 768 * MiB;
constexpr size_t WS_ACT = 256 * MiB, WS_YB = 416 * MiB;
constexpr int ACT_ROWS = 73728;
constexpr int CW_TMO = 0, CW_CODE = 1, CW_GCNT = 1024, CW_BAR = 4096;
constexpr int RING_BYTES = 143360;
constexpr int LDSCTL_OFF = RING_BYTES, MISC_OFF = LDSCTL_OFF + 64;
constexpr int LDS_BYTES = 147456;

#define GAS __attribute__((address_space(1)))
#define LAS __attribute__((address_space(3)))
typedef unsigned short bf16;
typedef unsigned v4u __attribute__((ext_vector_type(4)));
typedef unsigned v2u __attribute__((ext_vector_type(2)));
typedef float f32x4 __attribute__((ext_vector_type(4)));
typedef float f32x16 __attribute__((ext_vector_type(16)));
typedef short bf16x8 __attribute__((ext_vector_type(8)));
typedef GAS unsigned gu32;
#define RLX_AGENT __ATOMIC_RELAXED, __HIP_MEMORY_SCOPE_AGENT
#define LDS_WAIT() asm volatile("s_waitcnt lgkmcnt(0)" ::: "memory")
#define VM_WAIT() asm volatile("s_waitcnt vmcnt(0)" ::: "memory")
__device__ __forceinline__ unsigned f2bf(float f) { unsigned u = __builtin_bit_cast(unsigned, f); return (u + 0x7fffu + ((u >> 16) & 1u)) >> 16; }
__device__ __forceinline__ unsigned pk2(float lo, float hi) { return f2bf(lo) | (f2bf(hi) << 16); }
__device__ __forceinline__ float bflo(unsigned w) { return __builtin_bit_cast(float, w << 16); }
__device__ __forceinline__ float bfhi(unsigned w) { return __builtin_bit_cast(float, w & 0xffff0000u); }
__device__ __forceinline__ float bf2f(bf16 h) { return __builtin_bit_cast(float, (unsigned)h << 16); }
__device__ __forceinline__ float sigm(float x) { return 1.f / (1.f + __expf(-x)); }
__device__ __forceinline__ float silu(float x) { return x * sigm(x); }
__device__ __forceinline__ float wave_sum(float v) {
#pragma unroll
    for (int o = 1; o < 64; o <<= 1) v += __shfl_xor(v, o);
    return v;
}

#define XB_TMO      128
#define XB_XCNT(j)  (256  + 64 * (j))
#define XB_XSUB(j)  (1280 + 64 * (j))
#define XB_XGEN(j)  (2304 + 64 * (j))
#define XB_TOP      3328
#define XB_TOPGEN   3392
#define XCD_BAR_WORDS 3456
#define XB_SPIN_CAP (1u << 18)
__device__ __forceinline__ unsigned xb_ld(unsigned* p)              { return __hip_atomic_load(p, __ATOMIC_RELAXED, __HIP_MEMORY_SCOPE_AGENT); }
__device__ __forceinline__ unsigned xb_add(unsigned* p, unsigned v) { return __hip_atomic_fetch_add(p, v, __ATOMIC_RELAXED, __HIP_MEMORY_SCOPE_AGENT); }
__device__ __forceinline__ unsigned xb_xcc_id() { return (unsigned)__builtin_amdgcn_s_getreg((3 << 11) | 20) & 0xFu; }
#define XB_SPIN(cond, bar) do { unsigned _sp = 0; while (cond) { __builtin_amdgcn_s_sleep(1); \
    if ((++_sp & 255u) == 0u) { if (xb_ld(&(bar)[XB_TMO])) break; if (_sp > XB_SPIN_CAP) { atomicAdd(&(bar)[XB_TMO], 1u); break; } } } } while (0)
struct XcdBarrier { unsigned* bar; unsigned x; volatile LAS unsigned* st; };
__device__ __forceinline__ XcdBarrier xcd_barrier_post(unsigned* bar, volatile LAS unsigned* st) {
    XcdBarrier b; b.bar = bar; b.x = xb_xcc_id(); b.st = st;
    if (threadIdx.x == 0) (void)xb_add(&bar[XB_XCNT(b.x)], 1u);
    return b;
}
__device__ __forceinline__ void xcd_barrier_complete(unsigned* bar, unsigned x, unsigned& nloc, unsigned& nx) {
    const unsigned G = gridDim.x * gridDim.y * gridDim.z;
    unsigned sum, cnt, mine, sp = 0u;
    for (;;) {
        sum = 0u; cnt = 0u; mine = 0u;
#pragma unroll
        for (unsigned j = 0; j < 16; ++j) { const unsigned c = xb_ld(&bar[XB_XCNT(j)]); sum += c; cnt += (c > 0u) ? 1u : 0u; mine = (j == x) ? c : mine; }
        if (sum == G) break;
        __builtin_amdgcn_s_sleep(1);
        if ((++sp & 255u) == 0u) { if (xb_ld(&bar[XB_TMO])) break; if (sp > XB_SPIN_CAP) { atomicAdd(&bar[XB_TMO], 1u); break; } }
    }
    nloc = mine > 0u ? mine : 1u; nx = cnt > 0u ? cnt : 1u;
}
__device__ __forceinline__ void xcd_barrier(const XcdBarrier& b) {
    asm volatile("s_waitcnt vmcnt(0)" ::: "memory");
    __syncthreads();
    if (threadIdx.x == 0) {
        unsigned* bar = b.bar;
        __builtin_amdgcn_s_waitcnt(0);
        unsigned nloc = b.st[0], nx = b.st[1];
        if (nloc == 0u) { xcd_barrier_complete(bar, b.x, nloc, nx); b.st[0] = nloc; b.st[1] = nx; }
        const unsigned old = xb_add(&bar[XB_XSUB(b.x)], 1u);
        const unsigned gen = old / nloc;
        if (old + 1u == (gen + 1u) * nloc) {
            __builtin_amdgcn_fence(__ATOMIC_RELEASE, "agent");
            asm volatile("s_waitcnt vmcnt(0)" ::: "memory");
            const unsigned og = xb_add(&bar[XB_TOP], 1u);
            const unsigned tg = og / nx;
            if (og + 1u == (tg + 1u) * nx) xb_add(&bar[XB_TOPGEN], 1u);
            else XB_SPIN(xb_ld(&bar[XB_TOPGEN]) == tg, bar);
            __builtin_amdgcn_fence(__ATOMIC_ACQUIRE, "agent");
            xb_add(&bar[XB_XGEN(b.x)], 1u);
            asm volatile("s_waitcnt vmcnt(0)" ::: "memory");
        } else {
            XB_SPIN(xb_ld(&bar[XB_XGEN(b.x)]) == gen, bar);
            __builtin_amdgcn_fence(__ATOMIC_ACQUIRE, "agent");
            asm volatile("s_waitcnt vmcnt(0)" ::: "memory");
        }
    }
    __syncthreads();
}
}
namespace mk {
struct Frame {
    LAS unsigned char* lds; volatile LAS unsigned* MISC; gu32* ctl; unsigned char* ws; float* out; const float* const* in;
    int tid, lane, wave, vcu, G;
};
enum { I_X = 0, I_C, I_WADA, I_BADA, I_NMW, I_WIN, I_CONVW, I_CONVB, I_DTB, I_ALOG, I_DSKIP, I_SNW, I_WSSD, I_WPOOL, I_PSCALE, I_WPO, I_WOUT, I_NFW, I_WR, I_BR, I_WGU, I_BGU, I_WDN, I_BDN, I_NFINAL };

__device__ __forceinline__ void p0_tile(const float* src, int ldsrc, int srccol0, int k0, bf16* dst, int lddst, int dstrow0, int nvalid, LAS float* scr, int lane) {
    const int col = (lane & 15) * 4;
#pragma unroll 4
    for (int i = 0; i < 16; ++i) { const int kk = 4 * i + (lane >> 4);
        f32x4 v = (f32x4){0.f, 0.f, 0.f, 0.f};
        if (col < nvalid) v = *(const f32x4*)(src + (size_t)(k0 + kk) * ldsrc + srccol0 + col);
        LAS float* s = scr + kk * 65 + col; s[0] = v.x; s[1] = v.y; s[2] = v.z; s[3] = v.w; }
    LDS_WAIT(); asm volatile("" ::: "memory");
    const int c = lane & 7;
#pragma unroll
    for (int j = 0; j < 8; ++j) { const int n = (lane >> 3) + 8 * j; const LAS float* s = scr + (8 * c) * 65 + n;
        v4u o; o.x = pk2(s[0 * 65], s[1 * 65]); o.y = pk2(s[2 * 65], s[3 * 65]); o.z = pk2(s[4 * 65], s[5 * 65]); o.w = pk2(s[6 * 65], s[7 * 65]);
        if (n < nvalid) *(v4u*)(dst + (size_t)(dstrow0 + n) * lddst + k0 + 8 * c) = o; }
    LDS_WAIT(); asm volatile("" ::: "memory");
}
__device__ __forceinline__ void p0_prologue(Frame& F) {
    LAS float* scr = (LAS float*)(F.lds + F.wave * 16896);
    const int gw = F.vcu * NWAVES + F.wave, NGW = F.G * NWAVES;
    bf16* WIN_T = (bf16*)(F.ws + WS_WIN); bf16* WDT_T = (bf16*)(F.ws + WS_WDT); bf16* WSSD_T = (bf16*)(F.ws + WS_WSSD); bf16* WPO_T = (bf16*)(F.ws + WS_WPO);
    bf16* WOUT_T = (bf16*)(F.ws + WS_WOUT); bf16* WPOOL_T = (bf16*)(F.ws + WS_WPOOL); bf16* WGU_T = (bf16*)(F.ws + WS_WGU); bf16* WDN_T = (bf16*)(F.ws + WS_WDN);
    constexpr int N_IN = 2048, N_DT = 16, N_SSD = 512, N_PO = 256, N_OUT = 256, N_POOL = 64, N_GU = 16384, N_DN = 8192;
    constexpr int NITEMS = N_IN + N_DT + N_SSD + N_PO + N_OUT + N_POOL + N_GU + N_DN;
    for (int it = gw; it < NITEMS; it += NGW) {
        int r = it;
        if (r < N_GU) { const int e = r >> 9, q = r & 511, rb = q >> 4, kb = q & 15; const int rho = rb * 64, pn = rho >> 8, rr = rho & 255;
            const int sc = rr < 128 ? 128 * pn + rr : 1024 + 128 * pn + (rr - 128);
            p0_tile(F.in[I_WGU] + (size_t)e * 1024 * 2048, 2048, sc, kb * 64, WGU_T + (size_t)e * 2048 * 1024, 1024, rho, 64, scr, F.lane); continue; } r -= N_GU;
        if (r < N_DN) { const int e = r >> 8, q = r & 255, rb = q >> 4, kb = q & 15;
            p0_tile(F.in[I_WDN] + (size_t)e * 1024 * 1024, 1024, rb * 64, kb * 64, WDN_T + (size_t)e * 1024 * 1024, 1024, rb * 64, 64, scr, F.lane); continue; } r -= N_DN;
        if (r < N_IN) { const int rb = r >> 4, kb = r & 15; const int drow = rb * 64; const int sc = drow + (drow >= 5120 ? 32 : 0);
            p0_tile(F.in[I_WIN], NPROJ, sc, kb * 64, WIN_T, 1024, drow, 64, scr, F.lane); continue; } r -= N_IN;
        if (r < N_DT) { p0_tile(F.in[I_WIN], NPROJ, 5120, r * 64, WDT_T, 1024, 0, 32, scr, F.lane); continue; } r -= N_DT;
        if (r < N_SSD) { const int rb = r >> 5, kb = r & 31; p0_tile(F.in[I_WSSD], 1024, rb * 64, kb * 64, WSSD_T, 2048, rb * 64, 64, scr, F.lane); continue; } r -= N_SSD;
        if (r < N_PO) { const int rb = r >> 4, kb = r & 15; p0_tile(F.in[I_WPO], 1024, rb * 64, kb * 64, WPO_T, 1024, rb * 64, 64, scr, F.lane); continue; } r -= N_PO;
        if (r < N_OUT) { const int rb = r >> 4, kb = r & 15; p0_tile(F.in[I_WOUT], 1024, rb * 64, kb * 64, WOUT_T, 1024, rb * 64, 64, scr, F.lane); continue; } r -= N_OUT;
        { const int g = r >> 4, q = r & 15, rb = q >> 2, kb = q & 3; p0_tile(F.in[I_WPOOL] + (size_t)g * 65536, 256, rb * 64, kb * 64, WPOOL_T, 256, g * 256 + rb * 64, 64, scr, F.lane); }
    }
    __syncthreads();
    { float* mod = (float*)(F.ws + WS_MOD); LAS float* red = (LAS float*)F.lds;
      for (int jb = F.vcu; jb < 256; jb += F.G) {
        const int jj = F.tid & 31, sl = F.tid >> 5, j = jb * 24 + jj; float a0 = 0.f, a1 = 0.f, a2 = 0.f, a3 = 0.f; const float* cc = F.in[I_C];
        if (jj < 24) {
#pragma unroll 8
            for (int k = sl * 64; k < sl * 64 + 64; ++k) { const float w = F.in[I_WADA][(size_t)k * 6144 + j];
                a0 += silu(cc[k]) * w; a1 += silu(cc[1024 + k]) * w; a2 += silu(cc[2048 + k]) * w; a3 += silu(cc[3072 + k]) * w; } }
        red[(sl * 4 + 0) * 32 + jj] = a0; red[(sl * 4 + 1) * 32 + jj] = a1; red[(sl * 4 + 2) * 32 + jj] = a2; red[(sl * 4 + 3) * 32 + jj] = a3;
        __syncthreads();
        if (F.tid < 128) { const int b = F.tid >> 5, q = F.tid & 31; if (q < 24) { float s = F.in[I_BADA][jb * 24 + q];
#pragma unroll
                for (int i = 0; i < 16; ++i) s += red[(i * 4 + b) * 32 + q];
                mod[b * 6144 + jb * 24 + q] = s; } }
        __syncthreads();
      } }
}

__device__ __forceinline__ void p1_norm_dt(Frame& F) {
    constexpr int PITCH = 2064;
    LAS unsigned char* tile = F.lds + F.wave * (8 * PITCH);
    for (int grp = F.vcu * NWAVES + F.wave; grp < T / 8; grp += F.G * NWAVES) {
    const int t0 = grp * 8, b = t0 / SEQ;
    const float* mod = (const float*)(F.ws + WS_MOD) + b * 6144; bf16* H = (bf16*)(F.ws + WS_H);
    f32x4 wv[4], scv[4], shv[4];
#pragma unroll
    for (int j = 0; j < 4; ++j) { const int col = 4 * F.lane + 256 * j; wv[j] = *(const f32x4*)(F.in[I_NMW] + col); scv[j] = *(const f32x4*)(mod + 1024 + col); shv[j] = *(const f32x4*)(mod + col); }
#pragma unroll 1
    for (int r = 0; r < 8; ++r) {
        const float* xr = F.in[I_X] + (size_t)(t0 + r) * D; f32x4 v[4]; float s = 0.f;
#pragma unroll
        for (int j = 0; j < 4; ++j) { v[j] = *(const f32x4*)(xr + 4 * F.lane + 256 * j); s += (v[j].x * v[j].x + v[j].y * v[j].y) + (v[j].z * v[j].z + v[j].w * v[j].w); }
        const float rstd = rsqrtf(wave_sum(s) * (1.f / D) + EPS);
#pragma unroll
        for (int j = 0; j < 4; ++j) { const f32x4 hv = v[j] * rstd * wv[j] * (scv[j] + 1.f) + shv[j];
            v2u o; o.x = pk2(hv.x, hv.y); o.y = pk2(hv.z, hv.w);
            *(v2u*)(H + (size_t)(t0 + r) * D + 4 * F.lane + 256 * j) = o;
            *(LAS v2u*)(tile + r * PITCH + (4 * F.lane + 256 * j) * 2) = o; }
    }
    LDS_WAIT(); asm volatile("" ::: "memory");
    const bf16* WDT_T = (const bf16*)(F.ws + WS_WDT);
    f32x4 acc0 = (f32x4){0.f, 0.f, 0.f, 0.f}, acc1 = acc0; const int fr = F.lane & 15, fq = F.lane >> 4;
#pragma unroll 4
    for (int s = 0; s < 32; ++s) {
        const bf16x8 a = *(const LAS bf16x8*)(tile + (fr & 7) * PITCH + (32 * s + 8 * fq) * 2);
        const bf16x8 b0 = *(const bf16x8*)(WDT_T + (size_t)fr * 1024 + 32 * s + 8 * fq), b1 = *(const bf16x8*)(WDT_T + (size_t)(fr + 16) * 1024 + 32 * s + 8 * fq);
        acc0 = __builtin_amdgcn_mfma_f32_16x16x32_bf16(a, b0, acc0, 0, 0, 0); acc1 = __builtin_amdgcn_mfma_f32_16x16x32_bf16(a, b1, acc1, 0, 0, 0);
    }
    if (fq < 2) { float* DT = (float*)(F.ws + WS_DT); const float db0 = F.in[I_DTB][fr], db1 = F.in[I_DTB][fr + 16];
#pragma unroll
        for (int i = 0; i < 4; ++i) { const int row = t0 + 4 * fq + i; float x0 = acc0[i] + db0, x1 = acc1[i] + db1;
            DT[(size_t)row * 32 + fr] = x0 > 20.f ? x0 : log1pf(__expf(x0)); DT[(size_t)row * 32 + 16 + fr] = x1 > 20.f ? x1 : log1pf(__expf(x1)); } }
    LDS_WAIT();
    }
}

__device__ __forceinline__ void pool_pass(Frame& F) {
    const bf16* U = (const bf16*)(F.ws + WS_U); bf16* P = (bf16*)(F.ws + WS_P);
    const int gid = F.vcu * 512 + F.tid;
    for (int it = gid; it < 1024 * 128; it += F.G * 512) {
        const int cg = it & 127, strip = it >> 7; const int t0 = strip * 16, tt0 = t0 % SEQ; const int w = 2 << (cg >> 5);
        float s[8];
#pragma unroll
        for (int i = 0; i < 8; ++i) s[i] = 0.f;
        for (int j = 1; j < w; ++j) { if (tt0 - j >= 0) { const v4u v = *(const v4u*)(U + (size_t)(t0 - j) * D + cg * 8);
                s[0] += bflo(v.x); s[1] += bfhi(v.x); s[2] += bflo(v.y); s[3] += bfhi(v.y); s[4] += bflo(v.z); s[5] += bfhi(v.z); s[6] += bflo(v.w); s[7] += bfhi(v.w); } }
        for (int i = 0; i < 16; ++i) { const int t = t0 + i, tt = tt0 + i;
            const v4u v = *(const v4u*)(U + (size_t)t * D + cg * 8); float u[8] = {bflo(v.x), bfhi(v.x), bflo(v.y), bfhi(v.y), bflo(v.z), bfhi(v.z), bflo(v.w), bfhi(v.w)};
#pragma unroll
            for (int q = 0; q < 8; ++q) s[q] += u[q];
            const float inv = 1.f / (float)(tt + 1 < w ? tt + 1 : w);
            v4u o; o.x = pk2(s[0] * inv - u[0], s[1] * inv - u[1]); o.y = pk2(s[2] * inv - u[2], s[3] * inv - u[3]); o.z = pk2(s[4] * inv - u[4], s[5] * inv - u[5]); o.w = pk2(s[6] * inv - u[6], s[7] * inv - u[7]);
            *(v4u*)(P + (size_t)t * D + cg * 8) = o;
            if (tt - w + 1 >= 0) { const v4u z = *(const v4u*)(U + (size_t)(t - w + 1) * D + cg * 8);
                s[0] -= bflo(z.x); s[1] -= bfhi(z.x); s[2] -= bflo(z.y); s[3] -= bfhi(z.y); s[4] -= bflo(z.z); s[5] -= bfhi(z.z); s[6] -= bflo(z.w); s[7] -= bfhi(z.w); } }
    }
}

__device__ __forceinline__ int swz16(int row) { return (row ^ (row >> 4)) & 15; }
__device__ __forceinline__ void conv8x8(const bf16* XBC, const float* cw, const float* cb, int trow0, bool seq_start, int col, float (&out)[8][8]) {
    v4u raw[11];
#pragma unroll
    for (int r = 0; r < 11; ++r) { if (r < 3 && seq_start) raw[r] = (v4u){0u, 0u, 0u, 0u}; else raw[r] = *(const v4u*)(XBC + (size_t)(trow0 - 3 + r) * DCONV + col); }
    f32x4 w[4][2], bb[2];
#pragma unroll
    for (int k = 0; k < 4; ++k) { w[k][0] = *(const f32x4*)(cw + k * DCONV + col); w[k][1] = *(const f32x4*)(cw + k * DCONV + col + 4); }
    bb[0] = *(const f32x4*)(cb + col); bb[1] = *(const f32x4*)(cb + col + 4);
#pragma unroll
    for (int i = 0; i < 8; ++i) {
        float a[8];
#pragma unroll
        for (int q = 0; q < 8; ++q) a[q] = bb[q >> 2][q & 3];
#pragma unroll
        for (int k = 0; k < 4; ++k) { const v4u v = raw[i + k]; const float u[8] = {bflo(v.x), bfhi(v.x), bflo(v.y), bfhi(v.y), bflo(v.z), bfhi(v.z), bflo(v.w), bfhi(v.w)};
#pragma unroll
            for (int q = 0; q < 8; ++q) a[q] += w[k][q >> 2][q & 3] * u[q]; }
#pragma unroll
        for (int q = 0; q < 8; ++q) out[i][q] = silu(a[q]);
    }
}
__device__ __forceinline__ void put_transposed(LAS unsigned char* img, int row0, int chunk, const float (&o)[8][8]) {
#pragma unroll
    for (int q = 0; q < 8; ++q) { const int row = row0 + q; v4u v; v.x = pk2(o[0][q], o[1][q]); v.y = pk2(o[2][q], o[3][q]); v.z = pk2(o[4][q], o[5][q]); v.w = pk2(o[6][q], o[7][q]);
        *(LAS v4u*)(img + row * 256 + ((chunk ^ swz16(row)) << 4)) = v; }
}
__device__ __forceinline__ void put_natural(LAS unsigned char* img, int l0, int chunk, const float (&o)[8][8]) {
#pragma unroll
    for (int i = 0; i < 8; ++i) { const int row = l0 + i; v4u v; v.x = pk2(o[i][0], o[i][1]); v.y = pk2(o[i][2], o[i][3]); v.z = pk2(o[i][4], o[i][5]); v.w = pk2(o[i][6], o[i][7]);
        *(LAS v4u*)(img + row * 256 + ((chunk ^ swz16(row)) << 4)) = v; }
}
__device__ __forceinline__ bf16x8 ld_frag(const LAS unsigned char* img, int row, int chunk) { return *(const LAS bf16x8*)(img + row * 256 + ((chunk ^ swz16(row)) << 4)); }

__device__ __forceinline__ void ssd_states_unit(Frame& F, int unit) {
    const int hh = unit & 1, g = (unit >> 1) & 3, c = (unit >> 3) & 31, b = unit >> 8; const int t0 = b * SEQ + c * 128;
    LAS float* sx = (LAS float*)F.lds;
    LAS unsigned char* Bt = F.lds + 4096; LAS unsigned char* Xt = F.lds + 4096 + 32768;
    const float* DT = (const float*)(F.ws + WS_DT); const bf16* XBC = (const bf16*)(F.ws + WS_XBC); float* CD = (float*)(F.ws + WS_CD);
    __syncthreads();
    if (F.wave < 4) {
        const int h = g * 8 + 4 * hh + F.wave; const float A = -__expf(F.in[I_ALOG][h]); const int l = 2 * F.lane;
        const float d0 = DT[(size_t)(t0 + l) * 32 + h], d1 = DT[(size_t)(t0 + l + 1) * 32 + h]; const float a0 = d0 * A, a1 = d1 * A, s = a0 + a1;
        float incl = s;
#pragma unroll
        for (int o = 1; o < 64; o <<= 1) { const float v = __shfl_up(incl, o); if (F.lane >= o) incl += v; }
        const float c0 = incl - s + a0, c1 = incl, total = __shfl(incl, 63);
        sx[F.wave * 128 + l] = d0 * __expf(total - c0); sx[F.wave * 128 + l + 1] = d1 * __expf(total - c1);
        if (F.lane == 0) CD[(b * 32 + c) * 32 + h] = __expf(total);
    }
    __syncthreads();
    {
        const int strip = F.tid >> 5, grp = F.tid & 31, l0 = strip * 8; float o[8][8];
        conv8x8(XBC, F.in[I_CONVW], F.in[I_CONVB], t0 + l0, (c == 0 && l0 == 0), g * 512 + hh * 256 + grp * 8, o);
        const LAS float* sxe = sx + (grp >> 3) * 128 + l0;
#pragma unroll
        for (int i = 0; i < 8; ++i) { const float sc = sxe[i];
#pragma unroll
            for (int q = 0; q < 8; ++q) o[i][q] *= sc; }
        put_transposed(Xt, grp * 8, strip, o);
    }
    if (F.tid < 256) { const int strip = F.tid >> 4, grp = F.tid & 15, l0 = strip * 8; float o[8][8];
        conv8x8(XBC, F.in[I_CONVW], F.in[I_CONVB], t0 + l0, (c == 0 && l0 == 0), 2048 + g * 128 + grp * 8, o);
        put_transposed(Bt, grp * 8, strip, o); }
    __syncthreads();
    const int li = F.lane & 31, half = F.lane >> 5, hp = (F.wave >> 1) * 64 + (F.wave & 1) * 32 + li;
    f32x16 acc[4];
#pragma unroll
    for (int nt = 0; nt < 4; ++nt)
#pragma unroll
        for (int r = 0; r < 16; ++r) acc[nt][r] = 0.f;
#pragma unroll 2
    for (int ks = 0; ks < 8; ++ks) { const bf16x8 xb = ld_frag(Xt, hp, 2 * ks + half);
#pragma unroll
        for (int nt = 0; nt < 4; ++nt) { const bf16x8 ba = ld_frag(Bt, 32 * nt + li, 2 * ks + half); acc[nt] = __builtin_amdgcn_mfma_f32_32x32x16_bf16(ba, xb, acc[nt], 0, 0, 0); } }
    __syncthreads();
    LAS unsigned char* OUT = Xt;
#pragma unroll
    for (int nt = 0; nt < 4; ++nt)
#pragma unroll
        for (int rq = 0; rq < 4; ++rq) { const int ch8 = 8 * nt + 2 * rq + half; v2u v; v.x = pk2(acc[nt][4 * rq], acc[nt][4 * rq + 1]); v.y = pk2(acc[nt][4 * rq + 2], acc[nt][4 * rq + 3]);
            *(LAS v2u*)(OUT + hp * 256 + ((ch8 ^ (hp & 31)) << 3)) = v; }
    __syncthreads();
    bf16* ST = (bf16*)(F.ws + WS_STATES) + ((size_t)((b * 32 + c) * 32 + g * 8 + 4 * hh)) * 8192;
#pragma unroll
    for (int it = 0; it < 8; ++it) { const int idx = it * 512 + F.tid, row = idx >> 4, j = idx & 15, k = row & 31;
        v4u v = *(const LAS v4u*)(OUT + row * 256 + ((j ^ (k >> 1)) << 4)); if (k & 1) v = (v4u){v.z, v.w, v.x, v.y};
        *(v4u*)(ST + (size_t)row * 128 + j * 8) = v; }
}

__device__ __forceinline__ void ssd_scan(Frame& F) {
    bf16* ST = (bf16*)(F.ws + WS_STATES); const float* CD = (const float*)(F.ws + WS_CD);
    for (int gid = F.vcu * 512 + F.tid; gid < 131072; gid += F.G * 512) {
        const int bh = gid >> 10, b = bh >> 5, h = bh & 31, el = (gid & 1023) * 8;
        float st[8];
#pragma unroll
        for (int q = 0; q < 8; ++q) st[q] = 0.f;
#pragma unroll 4
        for (int c = 0; c < 32; ++c) { bf16* p = ST + ((size_t)((b * 32 + c) * 32 + h)) * 8192 + el; const v4u v = *(const v4u*)p; const float cd = CD[(b * 32 + c) * 32 + h];
            v4u o; o.x = pk2(st[0], st[1]); o.y = pk2(st[2], st[3]); o.z = pk2(st[4], st[5]); o.w = pk2(st[6], st[7]); *(v4u*)p = o;
            st[0] = st[0] * cd + bflo(v.x); st[1] = st[1] * cd + bfhi(v.x); st[2] = st[2] * cd + bflo(v.y); st[3] = st[3] * cd + bfhi(v.y);
            st[4] = st[4] * cd + bflo(v.z); st[5] = st[5] * cd + bfhi(v.z); st[6] = st[6] * cd + bflo(v.w); st[7] = st[7] * cd + bfhi(v.w); }
    }
}

__device__ __forceinline__ void ssd_out_unit(Frame& F, int unit) {
    const int g = unit & 3, c = (unit >> 2) & 31, b = unit >> 7; const int t0 = b * SEQ + c * 128;
    LAS float* acum = (LAS float*)F.lds; LAS float* dtv = acum + 1024; LAS float* ssq = acum + 2048;
    LAS unsigned char* Bn = F.lds + 12288; LAS unsigned char* Cn = Bn + 32768; LAS unsigned char* Xt = Cn + 32768;
    const float* DT = (const float*)(F.ws + WS_DT); const bf16* XBC = (const bf16*)(F.ws + WS_XBC); const bf16* Z = (const bf16*)(F.ws + WS_Z); bf16* Y = (bf16*)(F.ws + WS_Y);
    __syncthreads();
    { const int h = g * 8 + F.wave; const float A = -__expf(F.in[I_ALOG][h]); const int l = 2 * F.lane;
        const float d0 = DT[(size_t)(t0 + l) * 32 + h], d1 = DT[(size_t)(t0 + l + 1) * 32 + h]; const float a0 = d0 * A, a1 = d1 * A, s = a0 + a1;
        float incl = s;
#pragma unroll
        for (int o = 1; o < 64; o <<= 1) { const float v = __shfl_up(incl, o); if (F.lane >= o) incl += v; }
        acum[F.wave * 128 + l] = incl - s + a0; acum[F.wave * 128 + l + 1] = incl; dtv[F.wave * 128 + l] = d0; dtv[F.wave * 128 + l + 1] = d1;
    }
    { const int mat = F.tid >> 8, strip = (F.tid >> 4) & 15, grp = F.tid & 15, l0 = strip * 8; float o[8][8];
        conv8x8(XBC, F.in[I_CONVW], F.in[I_CONVB], t0 + l0, (c == 0 && l0 == 0), 2048 + mat * 512 + g * 128 + grp * 8, o);
        put_natural(mat ? Cn : Bn, l0, grp, o); }
    const int li = F.lane & 31, half = F.lane >> 5, ew = F.wave >> 1, lsel = F.wave & 1;
#pragma unroll
    for (int ps = 0; ps < 2; ++ps) {
        if (ps) __syncthreads();
        { const int strip = F.tid >> 5, grp = F.tid & 31, l0 = strip * 8; float o[8][8];
            conv8x8(XBC, F.in[I_CONVW], F.in[I_CONVB], t0 + l0, (c == 0 && l0 == 0), g * 512 + ps * 256 + grp * 8, o);
            put_transposed(Xt, grp * 8, strip, o); }
        __syncthreads();
        const int e = 4 * ps + ew, h = 8 * g + e; const float Dk = F.in[I_DSKIP][h];
        const bf16* prev = (const bf16*)(F.ws + WS_STATES) + ((size_t)((b * 32 + c) * 32 + h)) * 8192;
        const LAS float* ac = acum + e * 128; const LAS float* dv = dtv + e * 128;
#pragma unroll
        for (int it = 0; it < 2; ++it) {
            const int i = lsel ? (1 + it) : (it ? 3 : 0); const int l = 32 * i + li; const float acl = ac[l];
            f32x16 acc[2];
#pragma unroll
            for (int pt = 0; pt < 2; ++pt)
#pragma unroll
                for (int r = 0; r < 16; ++r) acc[pt][r] = 0.f;
#pragma unroll 2
            for (int ks = 0; ks < 8; ++ks) { const bf16x8 cf = ld_frag(Cn, l, 2 * ks + half);
#pragma unroll
                for (int pt = 0; pt < 2; ++pt) { const bf16x8 pf = *(const bf16x8*)(prev + (size_t)(32 * pt + li) * 128 + 16 * ks + 8 * half); acc[pt] = __builtin_amdgcn_mfma_f32_32x32x16_bf16(pf, cf, acc[pt], 0, 0, 0); } }
            { const float el = __expf(acl);
#pragma unroll
                for (int pt = 0; pt < 2; ++pt)
#pragma unroll
                    for (int r = 0; r < 16; ++r) acc[pt][r] *= el; }
#pragma unroll 1
            for (int j = 0; j <= i; ++j) {
                f32x16 gt;
#pragma unroll
                for (int r = 0; r < 16; ++r) gt[r] = 0.f;
#pragma unroll 2
                for (int ks = 0; ks < 8; ++ks) { const bf16x8 bfm = ld_frag(Bn, 32 * j + li, 2 * ks + half); const bf16x8 cf = ld_frag(Cn, l, 2 * ks + half); gt = __builtin_amdgcn_mfma_f32_32x32x16_bf16(bfm, cf, gt, 0, 0, 0); }
                unsigned wp[8];
#pragma unroll
                for (int rq = 0; rq < 4; ++rq) { const int sb = 32 * j + 8 * rq + 4 * half; const f32x4 as4 = *(const LAS f32x4*)(ac + sb), dt4 = *(const LAS f32x4*)(dv + sb); float wv[4];
#pragma unroll
                    for (int x = 0; x < 4; ++x) { const int s = sb + x; float w = gt[4 * rq + x] * __expf(fminf(acl - as4[x], 0.f)) * dt4[x];
                        if (j == i) { if (s > l) w = 0.f; if (s == l) w += Dk; } wv[x] = w; }
                    wp[2 * rq] = pk2(wv[0], wv[1]); wp[2 * rq + 1] = pk2(wv[2], wv[3]); }
                const bf16x8 wf0 = __builtin_bit_cast(bf16x8, (v4u){wp[0], wp[1], wp[2], wp[3]}), wf1 = __builtin_bit_cast(bf16x8, (v4u){wp[4], wp[5], wp[6], wp[7]});
#pragma unroll
                for (int pt = 0; pt < 2; ++pt) { const int hp = ew * 64 + 32 * pt + li; const LAS unsigned char* xr = Xt + hp * 256; const int fx = swz16(hp);
#pragma unroll
                    for (int ksub = 0; ksub < 2; ++ksub) { const v2u lo = *(const LAS v2u*)(xr + (((4 * j + 2 * ksub) ^ fx) << 4) + 8 * half), hi = *(const LAS v2u*)(xr + (((4 * j + 2 * ksub + 1) ^ fx) << 4) + 8 * half);
                        const bf16x8 xf = __builtin_bit_cast(bf16x8, (v4u){lo.x, lo.y, hi.x, hi.y});
                        acc[pt] = __builtin_amdgcn_mfma_f32_32x32x16_bf16(xf, ksub ? wf1 : wf0, acc[pt], 0, 0, 0); } }
            }
            float sq = 0.f;
#pragma unroll
            for (int pt = 0; pt < 2; ++pt)
#pragma unroll
                for (int rq = 0; rq < 4; ++rq) { const int ch = h * 64 + 32 * pt + 8 * rq + 4 * half; const v2u zz = *(const v2u*)(Z + (size_t)(t0 + l) * DSSD + ch);
                    const float y0 = acc[pt][4 * rq] * silu(bflo(zz.x)), y1 = acc[pt][4 * rq + 1] * silu(bfhi(zz.x)), y2 = acc[pt][4 * rq + 2] * silu(bflo(zz.y)), y3 = acc[pt][4 * rq + 3] * silu(bfhi(zz.y));
                    sq += (y0 * y0 + y1 * y1) + (y2 * y2 + y3 * y3); *(v2u*)(Y + (size_t)(t0 + l) * DSSD + ch) = (v2u){pk2(y0, y1), pk2(y2, y3)}; }
            sq += __shfl_xor(sq, 32); if (half == 0) ssq[(ps * 4 + ew) * 128 + l] = sq;
        }
    }
    VM_WAIT(); __syncthreads();
#pragma unroll
    for (int it = 0; it < 2; ++it) { const int i = lsel ? (1 + it) : (it ? 3 : 0); const int l = 32 * i + li; float sqt = 0.f;
#pragma unroll
        for (int q = 0; q < 8; ++q) sqt += ssq[q * 128 + l];
        const float rstd = rsqrtf(sqt * (1.f / 512.f) + EPS);
#pragma unroll
        for (int ps = 0; ps < 2; ++ps)
#pragma unroll
            for (int pt = 0; pt < 2; ++pt)
#pragma unroll
                for (int rq = 0; rq < 4; ++rq) { const int ch = (8 * g + 4 * ps + ew) * 64 + 32 * pt + 8 * rq + 4 * half; const f32x4 nw = *(const f32x4*)(F.in[I_SNW] + ch); const v2u v = *(const v2u*)(Y + (size_t)(t0 + l) * DSSD + ch);
                    v2u o; o.x = pk2(bflo(v.x) * rstd * nw.x, bfhi(v.x) * rstd * nw.y); o.y = pk2(bflo(v.y) * rstd * nw.z, bfhi(v.y) * rstd * nw.w);
                    *(v2u*)(Y + (size_t)(t0 + l) * DSSD + ch) = o; } }
}
}
namespace mk {
using pg8::Unit;
constexpr int MI_TSTART = 16, MI_CNT = 64;

struct Sched {
    int mode, nM, nN, nwg, G, c, lda, ldb, a_pn_off, npn;
    const bf16* A; const bf16* Bt; const int* list; const volatile LAS unsigned* misc;
    __device__ __forceinline__ void init_dense(int M, int N, int G_, int c_, const bf16* A_, int lda_, const bf16* Bt_, int ldb_, int a_pn_off_) {
        mode = 0; nM = M / 256; nN = N / 256; nwg = nM * nN; G = G_; c = c_; A = A_; Bt = Bt_; lda = lda_; ldb = ldb_; a_pn_off = a_pn_off_; npn = 0; list = nullptr; misc = nullptr; }
    __device__ __forceinline__ void init_moe(int mode_, int G_, int c_, const bf16* A_, const bf16* Bt_, const int* list_, const volatile LAS unsigned* misc_) {
        mode = mode_; G = G_; c = c_; A = A_; Bt = Bt_; lda = 1024; ldb = 1024; a_pn_off = 0; npn = (mode_ == 1) ? 8 : 4; list = list_; misc = misc_; nM = 0; nN = 0; nwg = (int)misc_[MI_TSTART + 32] * npn; }
    __device__ __forceinline__ bool next(int i, Unit& u) const {
        const long L = (long)i * G + c; if (L >= nwg) return false;
        if (mode == 0) {
            int wgid = (int)L; { const int q = nwg / 8, r = nwg % 8, xcd = wgid % 8, off = wgid / 8; wgid = (xcd < r ? xcd * (q + 1) : r * (q + 1) + (xcd - r) * q) + off; }
            const int nig = 8 * nN, gid = wgid / nig, fm = gid * 8, gsz = (nM - fm) < 8 ? (nM - fm) : 8;
            u.pm = fm + ((wgid % nig) % gsz); u.pn = (wgid % nig) / gsz; u.e = 0; u.i = 0; return true;
        }
        const int rt = (int)L / npn, pn = (int)L % npn; int e = 0;
        while (e < 31 && (int)misc[MI_TSTART + e + 1] <= rt) ++e;
        u.pm = rt; u.pn = pn; u.e = e; u.i = rt - (int)misc[MI_TSTART + e]; return true;
    }
    __device__ __forceinline__ const char* a_base(const Unit& u) const {
        if (mode == 0) return (const char*)(A + (size_t)u.pm * 256 * lda + (size_t)u.pn * a_pn_off);
        if (mode == 1) return (const char*)A;
        return (const char*)(A + (size_t)u.pm * 256 * 1024); }
    __device__ __forceinline__ const char* b_base(const Unit& u) const {
        if (mode == 0) return (const char*)(Bt + (size_t)u.pn * 256 * ldb);
        if (mode == 1) return (const char*)(Bt + (size_t)u.e * 2048 * 1024 + (size_t)u.pn * 256 * 1024);
        return (const char*)(Bt + (size_t)u.e * 1024 * 1024 + (size_t)u.pn * 256 * 1024); }
    __device__ __forceinline__ unsigned row_off(const Unit& u, int r) const {
        const int idx = u.i * 256 + r; const int cnt = (int)misc[MI_CNT + u.e];
        const int tok = idx < cnt ? (list[(size_t)u.e * T + idx] >> 2) : 0; return (unsigned)tok * 2048u; }
};

struct EpiAll {
    static constexpr bool PERM = true;
    int kind, pad; unsigned char* ws; const float* const* in; float* out; const volatile LAS unsigned* misc;
    __device__ __forceinline__ void operator()(const pg8::f32x4 (&acc)[2][2][4][2], const Unit& u, int wr, int wc, int fr, int fq) const {
        const int rl0 = wr * 64 + fr, row0 = u.pm * 256 + rl0, cl0 = wc * 32 + 8 * fq;
        if (kind == 0) {
            bf16* base; int ld, colt; bool sg = false;
            if (u.pn < 8) { base = (bf16*)(ws + WS_Z); ld = 2048; colt = u.pn * 256; }
            else if (u.pn < 20) { base = (bf16*)(ws + WS_XBC); ld = 3072; colt = (u.pn - 8) * 256; }
            else if (u.pn < 24) { base = (bf16*)(ws + WS_U); ld = 1024; colt = (u.pn - 20) * 256; }
            else { base = (bf16*)(ws + WS_GATES); ld = 2048; colt = (u.pn - 24) * 256; sg = true; }
#pragma unroll
            for (int ai = 0; ai < 2; ++ai)
#pragma unroll
                for (int m = 0; m < 4; ++m) { bf16* rowp = base + (size_t)(row0 + ai * 128 + m * 16) * ld + colt + cl0;
#pragma unroll
                    for (int bj = 0; bj < 2; ++bj) { pg8::f32x4 v0 = acc[ai][bj][m][0], v1 = acc[ai][bj][m][1];
                        if (sg) { v0 = (pg8::f32x4){sigm(v0[0]), sigm(v0[1]), sigm(v0[2]), sigm(v0[3])}; v1 = (pg8::f32x4){sigm(v1[0]), sigm(v1[1]), sigm(v1[2]), sigm(v1[3])}; }
                        v4u w; w.x = pk2(v0[0], v0[1]); w.y = pk2(v0[2], v0[3]); w.z = pk2(v1[0], v1[1]); w.w = pk2(v1[2], v1[3]);
                        *(v4u*)(rowp + bj * 128) = w; } }
        } else if (kind == 1) {
            bf16* base = (bf16*)(ws + WS_P2); const float* ps = in[I_PSCALE];
#pragma unroll
            for (int bj = 0; bj < 2; ++bj) { const int col = u.pn * 256 + bj * 128 + cl0; const f32x4 s0 = *(const f32x4*)(ps + col), s1 = *(const f32x4*)(ps + col + 4);
#pragma unroll
                for (int ai = 0; ai < 2; ++ai)
#pragma unroll
                    for (int m = 0; m < 4; ++m) { const pg8::f32x4 v0 = acc[ai][bj][m][0] * s0, v1 = acc[ai][bj][m][1] * s1;
                        v4u w; w.x = pk2(v0[0], v0[1]); w.y = pk2(v0[2], v0[3]); w.z = pk2(v1[0], v1[1]); w.w = pk2(v1[2], v1[3]);
                        *(v4u*)(base + (size_t)(row0 + ai * 128 + m * 16) * 1024 + col) = w; } }
        } else if (kind == 2 || kind == 3) {
            const bf16* gates = (const bf16*)(ws + WS_GATES) + (kind == 3 ? 1024 : 0); bf16* m1 = (bf16*)(ws + WS_M1); bf16* mg = (bf16*)(ws + WS_MERGED);
#pragma unroll
            for (int ai = 0; ai < 2; ++ai)
#pragma unroll
                for (int m = 0; m < 4; ++m) { const size_t row = row0 + ai * 128 + m * 16;
#pragma unroll
                    for (int bj = 0; bj < 2; ++bj) { const int col = u.pn * 256 + bj * 128 + cl0; const v4u gq = *(const v4u*)(gates + row * 2048 + col);
                        float r[8] = {acc[ai][bj][m][0][0] * bflo(gq.x), acc[ai][bj][m][0][1] * bfhi(gq.x), acc[ai][bj][m][0][2] * bflo(gq.y), acc[ai][bj][m][0][3] * bfhi(gq.y),
                                      acc[ai][bj][m][1][0] * bflo(gq.z), acc[ai][bj][m][1][1] * bfhi(gq.z), acc[ai][bj][m][1][2] * bflo(gq.w), acc[ai][bj][m][1][3] * bfhi(gq.w)};
                        if (kind == 3) { const v4u mq = *(const v4u*)(m1 + row * 1024 + col);
                            r[0] += bflo(mq.x); r[1] += bfhi(mq.x); r[2] += bflo(mq.y); r[3] += bfhi(mq.y); r[4] += bflo(mq.z); r[5] += bfhi(mq.z); r[6] += bflo(mq.w); r[7] += bfhi(mq.w); }
                        v4u w; w.x = pk2(r[0], r[1]); w.y = pk2(r[2], r[3]); w.z = pk2(r[4], r[5]); w.w = pk2(r[6], r[7]);
                        *(v4u*)((kind == 3 ? mg : m1) + row * 1024 + col) = w; } }
        } else if (kind == 4) {
            const int b = (u.pm * 256) / SEQ; const float* ga = (const float*)(ws + WS_MOD) + b * 6144 + 2048; const float* x = in[I_X];
#pragma unroll
            for (int bj = 0; bj < 2; ++bj) { const int col = u.pn * 256 + bj * 128 + cl0; const f32x4 g0 = *(const f32x4*)(ga + col), g1 = *(const f32x4*)(ga + col + 4);
#pragma unroll
                for (int ai = 0; ai < 2; ++ai)
#pragma unroll
                    for (int m = 0; m < 4; ++m) { const size_t off = (size_t)(row0 + ai * 128 + m * 16) * 1024 + col;
                        *(f32x4*)(out + off) = *(const f32x4*)(x + off) + g0 * acc[ai][bj][m][0]; *(f32x4*)(out + off + 4) = *(const f32x4*)(x + off + 4) + g1 * acc[ai][bj][m][1]; } }
        } else if (kind == 5) {
            bf16* act = (bf16*)(ws + WS_ACT); const float* bgu = in[I_BGU] + (size_t)u.e * 2048; const int col = u.pn * 128 + cl0;
            const f32x4 bg0 = *(const f32x4*)(bgu + col), bg1 = *(const f32x4*)(bgu + col + 4), bl0 = *(const f32x4*)(bgu + 1024 + col), bl1 = *(const f32x4*)(bgu + 1024 + col + 4);
#pragma unroll
            for (int ai = 0; ai < 2; ++ai)
#pragma unroll
                for (int m = 0; m < 4; ++m) { float r[8];
#pragma unroll
                    for (int n = 0; n < 2; ++n)
#pragma unroll
                        for (int x = 0; x < 4; ++x) { float gl = acc[ai][0][m][n][x] + (n ? bg1[x] : bg0[x]), ln = acc[ai][1][m][n][x] + (n ? bl1[x] : bl0[x]);
                            gl = fminf(gl, 7.f); ln = fminf(fmaxf(ln, -7.f), 7.f); r[4 * n + x] = gl * sigm(1.702f * gl) * (ln + 1.f); }
                    v4u w; w.x = pk2(r[0], r[1]); w.y = pk2(r[2], r[3]); w.z = pk2(r[4], r[5]); w.w = pk2(r[6], r[7]);
                    *(v4u*)(act + (size_t)(row0 + ai * 128 + m * 16) * 1024 + col) = w; }
        } else {
            bf16* yb = (bf16*)(ws + WS_YB); const float* bdn = in[I_BDN] + (size_t)u.e * 1024; const int* list = (const int*)(ws + WS_LIST) + (size_t)u.e * T; const float* gate = (const float*)(ws + WS_GATE);
            const int cnt = (int)misc[MI_CNT + u.e];
#pragma unroll
            for (int ai = 0; ai < 2; ++ai)
#pragma unroll
                for (int m = 0; m < 4; ++m) { const int idx = u.i * 256 + rl0 + ai * 128 + m * 16;
                    if (idx < cnt) { const int slot = list[idx]; const float gt = gate[slot];
#pragma unroll
                        for (int bj = 0; bj < 2; ++bj) { const int col = u.pn * 256 + bj * 128 + cl0; const f32x4 b0 = *(const f32x4*)(bdn + col), b1 = *(const f32x4*)(bdn + col + 4);
                            const pg8::f32x4 v0 = (acc[ai][bj][m][0] + b0) * gt, v1 = (acc[ai][bj][m][1] + b1) * gt;
                            v4u w; w.x = pk2(v0[0], v0[1]); w.y = pk2(v0[2], v0[3]); w.z = pk2(v1[0], v1[1]); w.w = pk2(v1[2], v1[3]);
                            *(v4u*)(yb + (size_t)slot * 1024 + col) = w; } } }
        }
    }
};

__device__ __forceinline__ void p6_router(Frame& F) {
    LAS float* wrT = (LAS float*)F.lds;
    LAS int* lcnt = (LAS int*)(F.lds + 131072); LAS int* lbase = lcnt + 32; LAS int* rec = lcnt + 64;
    const float* wr = F.in[I_WR];
    __syncthreads();
    for (int idx = F.tid; idx < 32768; idx += 512) { const int k = idx >> 5, e = idx & 31; wrT[e * 1024 + k] = wr[idx]; }
    for (int rb = F.vcu; rb < T / 64; rb += F.G) {
    __syncthreads();
    if (F.tid < 32) lcnt[F.tid] = 0;
    __syncthreads();
    const int rowblk = rb * 64, b = rowblk / SEQ; const float* mod = (const float*)(F.ws + WS_MOD) + b * 6144; bf16* H = (bf16*)(F.ws + WS_H);
    const float* x1 = F.out;
#pragma unroll 1
    for (int pr = 0; pr < 4; ++pr) {
        float hv[2][16]; const int rl0 = F.wave * 8 + pr * 2;
#pragma unroll
        for (int rr = 0; rr < 2; ++rr) { const size_t t = rowblk + rl0 + rr; f32x4 v[4]; float s = 0.f;
#pragma unroll
            for (int j = 0; j < 4; ++j) { v[j] = *(const f32x4*)(x1 + t * D + 4 * F.lane + 256 * j); s += (v[j].x * v[j].x + v[j].y * v[j].y) + (v[j].z * v[j].z + v[j].w * v[j].w); }
            const float rstd = rsqrtf(wave_sum(s) * (1.f / D) + EPS);
#pragma unroll
            for (int j = 0; j < 4; ++j) { const int col = 4 * F.lane + 256 * j; const f32x4 w = *(const f32x4*)(F.in[I_NFW] + col), sc = *(const f32x4*)(mod + 4096 + col), sh = *(const f32x4*)(mod + 3072 + col);
                const f32x4 h = v[j] * rstd * w * (sc + 1.f) + sh; hv[rr][4 * j] = h.x; hv[rr][4 * j + 1] = h.y; hv[rr][4 * j + 2] = h.z; hv[rr][4 * j + 3] = h.w;
                *(v2u*)(H + t * D + col) = (v2u){pk2(h.x, h.y), pk2(h.z, h.w)}; } }
        float a[64];
#pragma unroll
        for (int e = 0; e < 32; ++e) { float s0 = 0.f, s1 = 0.f;
#pragma unroll
            for (int j = 0; j < 4; ++j) { const f32x4 w = *(const LAS f32x4*)(wrT + e * 1024 + 4 * F.lane + 256 * j);
                s0 += hv[0][4 * j] * w.x + hv[0][4 * j + 1] * w.y + hv[0][4 * j + 2] * w.z + hv[0][4 * j + 3] * w.w;
                s1 += hv[1][4 * j] * w.x + hv[1][4 * j + 1] * w.y + hv[1][4 * j + 2] * w.z + hv[1][4 * j + 3] * w.w; }
            a[2 * e] = s0; a[2 * e + 1] = s1; }
#define RED_STEP(N, M) { _Pragma("unroll") for (int i = 0; i < (N) / 2; ++i) { const bool up = (F.lane & (M)) != 0; const float keep = up ? a[i + (N) / 2] : a[i], send = up ? a[i] : a[i + (N) / 2]; a[i] = keep + __shfl_xor(send, (M)); } }
        RED_STEP(64, 32) RED_STEP(32, 16) RED_STEP(16, 8) RED_STEP(8, 4) RED_STEP(4, 2) RED_STEP(2, 1)
#undef RED_STEP
        const int e = F.lane >> 1, rr = F.lane & 1; float v = a[0] + F.in[I_BR][e];
        float tv[4]; int ti[4];
#pragma unroll
        for (int r = 0; r < 4; ++r) { float m = v; int mi = e;
#pragma unroll
            for (int o = 2; o < 64; o <<= 1) { const float om = __shfl_xor(m, o); const int oi = __shfl_xor(mi, o); if (om > m || (om == m && oi < mi)) { m = om; mi = oi; } }
            tv[r] = m; ti[r] = mi; if (e == mi) v = -INFINITY; }
        if (F.lane < 2) { const float e0 = 1.f, e1 = __expf(tv[1] - tv[0]), e2 = __expf(tv[2] - tv[0]), e3 = __expf(tv[3] - tv[0]); const float inv = 1.f / (e0 + e1 + e2 + e3);
            const float gt[4] = {e0 * inv, e1 * inv, e2 * inv, e3 * inv}; const int rl = rl0 + rr;
#pragma unroll
            for (int r = 0; r < 4; ++r) { const int pos = __hip_atomic_fetch_add(lcnt + ti[r], 1, __ATOMIC_RELAXED, __HIP_MEMORY_SCOPE_WORKGROUP);
                rec[(rl * 4 + r) * 3] = ti[r]; rec[(rl * 4 + r) * 3 + 1] = pos; rec[(rl * 4 + r) * 3 + 2] = __float_as_int(gt[r]); } }
    }
    __syncthreads();
    if (F.tid < 32) lbase[F.tid] = (int)__hip_atomic_fetch_add((unsigned*)(F.ctl + CW_GCNT) + F.tid, (unsigned)lcnt[F.tid], __ATOMIC_RELAXED, __HIP_MEMORY_SCOPE_AGENT);
    __syncthreads();
    if (F.tid < 256) { const int rl = F.tid >> 2, r = F.tid & 3; const int e = rec[F.tid * 3], pos = rec[F.tid * 3 + 1]; const int slot = (rowblk + rl) * 4 + r;
        ((int*)(F.ws + WS_LIST))[(size_t)e * T + lbase[e] + pos] = slot; ((float*)(F.ws + WS_GATE))[slot] = __int_as_float(rec[F.tid * 3 + 2]); }
    }
}

__device__ __forceinline__ void moe_setup(Frame& F) {
    __syncthreads();
    if (F.tid == 0) { int acc = 0; F.MISC[MI_TSTART] = 0;
        for (int e = 0; e < 32; ++e) { const unsigned cnt = __hip_atomic_load((unsigned*)(F.ctl + CW_GCNT) + e, RLX_AGENT); F.MISC[MI_CNT + e] = cnt; acc += (int)((cnt + 255u) >> 8); F.MISC[MI_TSTART + e + 1] = (unsigned)acc; } }
    __syncthreads();
}

__device__ __forceinline__ void p9_final(Frame& F, const float dscale) {
    const bf16* YB = (const bf16*)(F.ws + WS_YB);
#pragma unroll 1
    for (size_t t = F.vcu * NWAVES + F.wave; t < (size_t)T; t += F.G * NWAVES) { const int b = (int)(t / SEQ); const float* ga = (const float*)(F.ws + WS_MOD) + b * 6144 + 5120;
        f32x4 v[4]; float s = 0.f;
#pragma unroll
        for (int j = 0; j < 4; ++j) { const int col = 4 * F.lane + 256 * j; f32x4 m = (f32x4){0.f, 0.f, 0.f, 0.f};
#pragma unroll
            for (int k = 0; k < 4; ++k) { const v2u q = *(const v2u*)(YB + (t * 4 + k) * D + col); m += (f32x4){bflo(q.x), bfhi(q.x), bflo(q.y), bfhi(q.y)}; }
            v[j] = *(const f32x4*)(F.out + t * D + col) + *(const f32x4*)(ga + col) * m; s += (v[j].x * v[j].x + v[j].y * v[j].y) + (v[j].z * v[j].z + v[j].w * v[j].w); }
        const float rstd = rsqrtf(wave_sum(s) * (1.f / D) + EPS);
#pragma unroll
        for (int j = 0; j < 4; ++j) { const int col = 4 * F.lane + 256 * j; *(f32x4*)(F.out + t * D + col) = v[j] * (rstd * dscale) * *(const f32x4*)(F.in[I_NFINAL] + col); } }
}
}
namespace mk {
#ifndef MK_N_LAUNCHES
#define MK_N_LAUNCHES 1
#endif
constexpr int NPHASES = 12;
struct Args { const float* in[25]; float* out; unsigned char* ws; int ph_lo, ph_hi; };

__global__ void __launch_bounds__(NWAVES * 64, 2) mk_fwd(Args args) {
    extern __shared__ __attribute__((aligned(16))) unsigned char lds[];
    Frame F;
    F.lds = (LAS unsigned char*)lds; F.MISC = (volatile LAS unsigned*)(F.lds + MISC_OFF);
    F.tid = threadIdx.x; F.lane = F.tid & 63; F.wave = __builtin_amdgcn_readfirstlane(F.tid >> 6);
    F.G = gridDim.x; { const int bx = blockIdx.x; F.vcu = (F.G % 8 == 0) ? (bx % 8) * (F.G / 8) + bx / 8 : bx; }
    F.ws = args.ws; F.out = args.out; F.in = args.in; F.ctl = (gu32*)(args.ws + WS_CTL);
    for (int u = F.tid; u < (LDS_BYTES - LDSCTL_OFF) / 4; u += NWAVES * 64) ((LAS unsigned*)(F.lds + LDSCTL_OFF))[u] = 0u;
    __syncthreads();
    XcdBarrier bar; bar.bar = (unsigned*)(F.ctl + CW_BAR); bar.x = 0; bar.st = nullptr;
    if (MK_N_LAUNCHES == 1) bar = xcd_barrier_post((unsigned*)(F.ctl + CW_BAR), F.MISC + 0);
    const int lo = args.ph_lo, hi = args.ph_hi;
#ifndef MK_PH_MASK
#define MK_PH_MASK 0xFFF
#endif
#define IN(k) (((MK_PH_MASK >> (k)) & 1) && lo <= (k) && (k) < hi)
#define SEAM(k) do { if (IN(k) && IN((k) + 1)) xcd_barrier(bar); } while (0)
    LAS unsigned char* ring = F.lds;
#ifdef MK_DIAG_A
#define STAMP(k) do { if (F.tid == 0) F.MISC[128 + (k)] = (unsigned)__builtin_amdgcn_s_memrealtime(); } while (0)
#else
#define STAMP(k) do { } while (0)
#endif
    STAMP(0);
    const int cid = (int)blockIdx.x;

    if (IN(0)) { p0_prologue(F); } SEAM(0); STAMP(1);
    if (IN(1)) { p1_norm_dt(F); } SEAM(1); STAMP(2);
    if (IN(2)) {
        Sched S; S.init_dense(T, 8192, F.G, cid, (const bf16*)(F.ws + WS_H), 1024, (const bf16*)(F.ws + WS_WIN), 1024, 0);
        EpiAll E{0, 0, F.ws, F.in, F.out, F.MISC}; __syncthreads();
        pg8::gemm_phase<EpiAll, Sched, true, true, false>(ring, 1024, 1024, 1024, S, E);
    } SEAM(2); STAMP(3);
    if (IN(3)) { pool_pass(F); for (int u = F.vcu; u < 1024; u += F.G) ssd_states_unit(F, u); } SEAM(3); STAMP(4);
    if (IN(4)) { ssd_scan(F);
        Sched S; S.init_dense(T, 1024, F.G, cid, (const bf16*)(F.ws + WS_P), 1024, (const bf16*)(F.ws + WS_WPOOL), 256, 256);
        EpiAll E{1, 0, F.ws, F.in, F.out, F.MISC};
        __syncthreads();
        pg8::gemm_phase<EpiAll, Sched, true, true, false>(ring, 256, 1024, 256, S, E);
    } SEAM(4); STAMP(5);
    if (IN(5)) { for (int u = F.vcu; u < 512; u += F.G) ssd_out_unit(F, u); } SEAM(5); STAMP(6);
    if (IN(6)) {
        { Sched S; S.init_dense(T, 1024, F.G, cid, (const bf16*)(F.ws + WS_Y), 2048, (const bf16*)(F.ws + WS_WSSD), 2048, 0);
          EpiAll E{2, 0, F.ws, F.in, F.out, F.MISC}; __syncthreads();
          pg8::gemm_phase<EpiAll, Sched, true, true, false>(ring, 2048, 2048, 2048, S, E); }
        VM_WAIT(); __syncthreads();
        { Sched S; S.init_dense(T, 1024, F.G, cid, (const bf16*)(F.ws + WS_P2), 1024, (const bf16*)(F.ws + WS_WPO), 1024, 0);
          EpiAll E{3, 0, F.ws, F.in, F.out, F.MISC}; __syncthreads();
          pg8::gemm_phase<EpiAll, Sched, true, true, false>(ring, 1024, 1024, 1024, S, E); }
    } SEAM(6); STAMP(7);
    if (IN(7)) { Sched S; S.init_dense(T, 1024, F.G, cid, (const bf16*)(F.ws + WS_MERGED), 1024, (const bf16*)(F.ws + WS_WOUT), 1024, 0);
        EpiAll E{4, 0, F.ws, F.in, F.out, F.MISC}; __syncthreads();
        pg8::gemm_phase<EpiAll, Sched, true, true, false>(ring, 1024, 1024, 1024, S, E);
    } SEAM(7); STAMP(8);
    if (IN(8)) { p6_router(F); } SEAM(8); STAMP(9);
    if (IN(9)) { moe_setup(F);
        Sched S; S.init_moe(1, F.G, cid, (const bf16*)(F.ws + WS_H), (const bf16*)(F.ws + WS_WGU), (const int*)(F.ws + WS_LIST), F.MISC);
        EpiAll E{5, 0, F.ws, F.in, F.out, F.MISC}; __syncthreads();
        pg8::gemm_phase<EpiAll, Sched, true, true, true>(ring, 1024, 1024, 1024, S, E);
    } SEAM(9); STAMP(10);
    if (IN(10)) { moe_setup(F);
        Sched S; S.init_moe(2, F.G, cid, (const bf16*)(F.ws + WS_ACT), (const bf16*)(F.ws + WS_WDN), (const int*)(F.ws + WS_LIST), F.MISC);
        EpiAll E{6, 0, F.ws, F.in, F.out, F.MISC}; __syncthreads();
        pg8::gemm_phase<EpiAll, Sched, true, true, false>(ring, 1024, 1024, 1024, S, E);
    } SEAM(10); STAMP(11);
    float dscale = 1.f;
#ifdef MK_DIAG_A
    __syncthreads();
    dscale = 1.f + (float)(F.MISC[128 + MK_DIAG_A + 1] - F.MISC[128 + MK_DIAG_A]) * 0.01f * (float)(MK_DIAG_SA);
#endif
    if (IN(11)) { p9_final(F, dscale); }
#ifdef MK_DIAG_A
    VM_WAIT(); __syncthreads();
    if (blockIdx.x == 0 && F.tid == 0) { const unsigned now = (unsigned)__builtin_amdgcn_s_memrealtime();
        const unsigned d = (MK_DIAG_B >= 12) ? (now - F.MISC[128]) : (MK_DIAG_B == 11 ? (now - F.MISC[128 + 11]) : (F.MISC[128 + MK_DIAG_B + 1] - F.MISC[128 + MK_DIAG_B]));
        F.out[0] += (float)d * 0.01f * (float)(MK_DIAG_SB); }
#endif
#undef IN
#undef SEAM
}

static void run_mk(void* const* d_in, float* out, unsigned char* ws, hipStream_t stream) {
    static int grid = 0;
    if (grid == 0) {
        int dev = 0, cus = 0;
        if (hipGetDevice(&dev) != hipSuccess || hipDeviceGetAttribute(&cus, hipDeviceAttributeMultiprocessorCount, dev) != hipSuccess) { fprintf(stderr, "kernel_launch: device query failed\n"); grid = -1; return; }
        if (hipFuncSetAttribute((const void*)mk_fwd, hipFuncAttributeMaxDynamicSharedMemorySize, LDS_BYTES) != hipSuccess) { fprintf(stderr, "kernel_launch: hipFuncSetAttribute failed\n"); grid = -1; return; }
        (void)hipGetLastError();
        grid = cus;
    }
    if (grid < 0) return;
    (void)hipMemsetAsync(ws + WS_CTL, 0, CTL_ZERO_BYTES, stream);
    Args a{};
    for (int i = 0; i < 25; ++i) a.in[i] = (const float*)d_in[i];
    a.out = out; a.ws = ws;
    for (int li = 0; li < MK_N_LAUNCHES; ++li) {
        a.ph_lo = (MK_N_LAUNCHES == 1) ? 0 : li; a.ph_hi = (MK_N_LAUNCHES == 1) ? NPHASES : li + 1;
        hipLaunchKernelGGL(mk_fwd, dim3(grid), dim3(NWAVES * 64), LDS_BYTES, stream, a);
    }
}
}
extern "C" void kernel_launch(void* const* d_in, const int* in_sizes, int n_in, void* d_out, int out_size, void* d_ws, size_t ws_size, hipStream_t stream) {
    mk::run_mk(d_in, (float*)d_out, (unsigned char*)d_ws, stream);
}
```

```cpp
#include <hip/hip_runtime.h>
#include <cstdio>
#include <cstdint>
#include <cmath>
namespace pg8 {
#define PG8_LAS __attribute__((address_space(3)))
typedef unsigned short bf16_t;
typedef short bf16x8 __attribute__((ext_vector_type(8)));
typedef float f32x4 __attribute__((ext_vector_type(4)));
typedef unsigned u32x4 __attribute__((ext_vector_type(4)));
typedef unsigned u32x2 __attribute__((ext_vector_type(2)));
constexpr int BM = 256, BK = 64, HALF = 128, HTB = HALF * BK * 2  , STAGE_BYTES = 8 * HTB, NXCD = 8, WGM = 8;

__host__ __device__ __forceinline__ int lds_byte(int r, int c) { const int st = (r >> 4) * 2 + (c >> 5), rr = r & 15, cc = c & 31, ob = rr * 64 + cc * 2; return st * 1024 + (ob ^ (((ob >> 9) & 1) << 5)); }
__host__ __device__ __forceinline__ void stage_rc(int b, int& R, int& C) { const int st = b / 1024, sb = b % 1024, swz = sb ^ (((sb >> 9) & 1) << 5); R = (st >> 1) * 16 + swz / 64; C = (st & 1) * 32 + (swz % 64) / 2; }
__host__ __device__ __forceinline__ int perm32(int rho) { const int n = rho >> 4, i = rho & 15; return 8 * (i >> 2) + 4 * n + (i & 3); }

struct Unit { int pm, pn, e, i; };

__device__ __forceinline__ unsigned cvt_pk_bf16(float lo, float hi) { unsigned r; asm volatile("v_cvt_pk_bf16_f32 %0, %1, %2" : "=v"(r) : "v"(lo), "v"(hi)); return r; }

struct StaticOrder {
    int nM, nN, nwg, G, c; const bf16_t* A; const bf16_t* Bt; int lda, ldb, a_pn_off, pad;
    __device__ void init(int M, int N, int G_, int c_, const bf16_t* A_, int lda_, const bf16_t* Bt_, int ldb_, int a_pn_off_) { nM = M / BM; nN = N / BM; nwg = nM * nN; G = G_; c = c_; A = A_; Bt = Bt_; lda = lda_; ldb = ldb_; a_pn_off = a_pn_off_; pad = 0; }
    __device__ bool next(int i, Unit& u) const {
        const long L = (long)i * G + c; if (L >= nwg) return false;
        int wgid = (int)L; { const int q = nwg / NXCD, r = nwg % NXCD, xcd = wgid % NXCD, off = wgid / NXCD; wgid = (xcd < r ? xcd * (q + 1) : r * (q + 1) + (xcd - r) * q) + off; }
        const int nig = WGM * nN, gid = wgid / nig, fm = gid * WGM, gsz = (nM - fm) < WGM ? (nM - fm) : WGM;
        u.pm = fm + ((wgid % nig) % gsz); u.pn = (wgid % nig) / gsz; u.e = 0; u.i = 0; return true;
    }
    __device__ __forceinline__ const char* a_base(const Unit& u) const { return (const char*)(A + (size_t)u.pm * BM * lda + (size_t)u.pn * a_pn_off); }
    __device__ __forceinline__ const char* b_base(const Unit& u) const { return (const char*)(Bt + (size_t)u.pn * BM * ldb); }
    __device__ __forceinline__ unsigned row_off(const Unit&, int) const { return 0u; }
};

template <class Epi, class Sched, bool ALIGN_EPI, bool SP2, bool GATHER>
__device__ __forceinline__ void gemm_phase(PG8_LAS unsigned char* lds, const int K, const int lda, const int ldb, const Sched& S, const Epi& E) {
    int tid_ = threadIdx.x; asm volatile("" : "+v"(tid_));
    const int tid = tid_, wid = __builtin_amdgcn_readfirstlane(tid >> 6), lane = tid & 63, wr = wid >> 2, wc = wid & 3, fr = lane & 15, fq = lane >> 4;
    const int nt = K / BK;
    unsigned voffA[2][2], voffN[2][2], voffB[2];
#pragma unroll
    for (int i = 0; i < 2; ++i) { int R, C; stage_rc(tid * 16 + i * 8192, R, C); const int Rb = Epi::PERM ? ((R & ~31) + perm32(R & 31)) : R;
        voffA[0][i] = GATHER ? (unsigned)C * 2u : (unsigned)(R * lda + C) * 2u; voffA[1][i] = voffA[0][i]; voffN[0][i] = 0; voffN[1][i] = 0; voffB[i] = (unsigned)(Rb * ldb + C) * 2u; }
    const size_t kstep = (size_t)(BK * 2);
    const size_t hstepA = GATHER ? 0 : (size_t)HALF * lda * 2;
    const size_t hstepB = (size_t)HALF * ldb * 2;
    const unsigned ldsw = (unsigned)wid * 1024u;
    const int aoff = lds_byte(wr * 64 + fr, fq * 8), boff = lds_byte(wc * 32 + fr, fq * 8);
#define PG8_SA(b, h) (((b) * 2 + (h)) * HTB)
#define PG8_SB(b, h) ((4 + (b) * 2 + (h)) * HTB)
#define PG8_STAGE_B(bufoff, gbase) do { _Pragma("unroll") for (int _i = 0; _i < 2; ++_i) \
        __builtin_amdgcn_global_load_lds((const unsigned*)((const char*)(gbase) + voffB[_i]), (PG8_LAS unsigned*)(lds + (bufoff) + ldsw + _i * 8192), 16, 0, 0); } while (0)
#define PG8_STAGE_A(bufoff, gbase, h) do { _Pragma("unroll") for (int _i = 0; _i < 2; ++_i) \
        __builtin_amdgcn_global_load_lds((const unsigned*)((const char*)(gbase) + (h) * hstepA + voffA[GATHER ? (h) : 0][_i]), (PG8_LAS unsigned*)(lds + (bufoff) + ldsw + _i * 8192), 16, 0, 0); } while (0)
#define PG8_LDA(dst, b, h) do { _Pragma("unroll") for (int m = 0; m < 4; ++m) _Pragma("unroll") for (int k = 0; k < 2; ++k) dst[m][k] = *(const PG8_LAS bf16x8*)(lds + PG8_SA(b, h) + aoff + m * 2048 + k * 1024); } while (0)
#define PG8_LDB(dst, b, h) do { _Pragma("unroll") for (int n = 0; n < 2; ++n) _Pragma("unroll") for (int k = 0; k < 2; ++k) dst[n][k] = *(const PG8_LAS bf16x8*)(lds + PG8_SB(b, h) + boff + n * 2048 + k * 1024); } while (0)
#define PG8_MMA(ai, bj, At, Bt) do { __builtin_amdgcn_s_setprio(1); _Pragma("unroll") for (int m = 0; m < 4; ++m) _Pragma("unroll") for (int n = 0; n < 2; ++n) _Pragma("unroll") for (int k = 0; k < 2; ++k) \
        acc[ai][bj][m][n] = __builtin_amdgcn_mfma_f32_16x16x32_bf16(Bt[n][k], At[m][k], acc[ai][bj][m][n], 0, 0, 0); __builtin_amdgcn_s_setprio(0); } while (0)
#define PG8_WAIT_V(n) asm volatile("s_waitcnt vmcnt(" #n ")" ::: "memory")
#define PG8_WAIT_L(n) asm volatile("s_waitcnt lgkmcnt(" #n ")" ::: "memory")
#define PG8_BAR __builtin_amdgcn_s_barrier()
#define PG8_SCHED __builtin_amdgcn_sched_barrier(0)
#define PG8_GATHER_OFFS(dst, u) do { _Pragma("unroll") for (int _i = 0; _i < 2; ++_i) { int R_, C_; stage_rc(tid * 16 + _i * 8192, R_, C_); _Pragma("unroll") for (int _h = 0; _h < 2; ++_h) dst[_h][_i] = S.row_off(u, _h * HALF + R_) + (unsigned)C_ * 2u; } } while (0)
    Unit cur, nxt; int ui = 0;
    if (!S.next(0, cur)) return;
    f32x4 acc[2][2][4][2];
#pragma unroll
    for (int a = 0; a < 2; ++a)
#pragma unroll
        for (int b = 0; b < 2; ++b)
#pragma unroll
            for (int m = 0; m < 4; ++m)
#pragma unroll
                for (int n = 0; n < 2; ++n) acc[a][b][m][n] = (f32x4){0.f, 0.f, 0.f, 0.f};
    bf16x8 At[4][2], B0[2][2], B1[2][2];
    const char* cA = S.a_base(cur); const char* cB = S.b_base(cur);
    if constexpr (GATHER) { PG8_GATHER_OFFS(voffA, cur); }
    if constexpr (SP2) {
        PG8_STAGE_B(PG8_SB(0, 0), cB); PG8_STAGE_B(PG8_SB(0, 1), cB + hstepB); PG8_STAGE_A(PG8_SA(0, 0), cA, 0); PG8_STAGE_A(PG8_SA(0, 1), cA, 1);
        if (wr == 1) PG8_BAR;
        PG8_WAIT_V(2); PG8_BAR;
        PG8_STAGE_B(PG8_SB(1, 0), cB + kstep); PG8_STAGE_A(PG8_SA(1, 0), cA + kstep, 0); PG8_STAGE_B(PG8_SB(1, 1), cB + hstepB + kstep);
        PG8_WAIT_V(6); PG8_BAR;
    } else {
        PG8_STAGE_B(PG8_SB(0, 0), cB); PG8_STAGE_A(PG8_SA(0, 0), cA, 0); PG8_STAGE_B(PG8_SB(0, 1), cB + hstepB); PG8_STAGE_A(PG8_SA(0, 1), cA, 1);
        if (wr == 1) PG8_BAR;
        PG8_WAIT_V(4); PG8_BAR;
        PG8_STAGE_B(PG8_SB(1, 0), cB + kstep); PG8_STAGE_A(PG8_SA(1, 0), cA + kstep, 0); PG8_STAGE_B(PG8_SB(1, 1), cB + hstepB + kstep);
        PG8_WAIT_V(6); PG8_BAR;
    }
    for (;;) {
        const bool has_next = S.next(ui + 1, nxt);
        const char* nA = has_next ? S.a_base(nxt) : cA; const char* nB = has_next ? S.b_base(nxt) : cB;
#pragma unroll 1
        for (int t = 0; t < nt; t += 2) {
            const bool last = (t == nt - 2);
            const char* a1 = cA + (size_t)(t + 1) * kstep;
            const char* a2 = last ? nA : cA + (size_t)(t + 2) * kstep; const char* b2 = last ? nB : cB + (size_t)(t + 2) * kstep;
            const char* a3 = a2 + kstep; const char* b3 = b2 + kstep;
            if constexpr (GATHER) { if (last && has_next) { PG8_GATHER_OFFS(voffN, nxt); } }
            if constexpr (SP2) {
            PG8_LDB(B0, 0, 0); PG8_LDB(B1, 0, 1); PG8_SCHED; PG8_LDA(At, 0, 0); PG8_STAGE_A(PG8_SA(1, 1), a1, 1);
            PG8_WAIT_V(8); PG8_WAIT_L(0); PG8_BAR; PG8_MMA(0, 0, At, B0); PG8_MMA(0, 1, At, B1); PG8_BAR; PG8_SCHED;
            if constexpr (GATHER) { if (last && has_next) {
#pragma unroll
                for (int _h = 0; _h < 2; ++_h)
#pragma unroll
                    for (int _i = 0; _i < 2; ++_i) voffA[_h][_i] = voffN[_h][_i]; } }
            PG8_LDA(At, 0, 1); PG8_STAGE_B(PG8_SB(0, 0), b2); PG8_STAGE_B(PG8_SB(0, 1), b2 + hstepB); PG8_STAGE_A(PG8_SA(0, 0), a2, 0);
            PG8_WAIT_V(8); PG8_WAIT_L(0); PG8_BAR; PG8_MMA(1, 0, At, B0); PG8_MMA(1, 1, At, B1); PG8_BAR; PG8_SCHED;
            PG8_LDB(B0, 1, 0); PG8_LDB(B1, 1, 1); PG8_SCHED; PG8_LDA(At, 1, 0); PG8_STAGE_A(PG8_SA(0, 1), a2, 1);
            PG8_WAIT_V(8); PG8_WAIT_L(0); PG8_BAR; PG8_MMA(0, 0, At, B0); PG8_MMA(0, 1, At, B1); PG8_BAR; PG8_SCHED;
            PG8_LDA(At, 1, 1); PG8_STAGE_B(PG8_SB(1, 0), b3); PG8_STAGE_B(PG8_SB(1, 1), b3 + hstepB); PG8_STAGE_A(PG8_SA(1, 0), a3, 0);
            PG8_WAIT_V(8); PG8_WAIT_L(0); PG8_BAR; PG8_MMA(1, 0, At, B0); PG8_MMA(1, 1, At, B1); PG8_BAR; PG8_SCHED;
            } else {
            PG8_LDB(B0, 0, 0); PG8_SCHED; PG8_LDA(At, 0, 0); PG8_STAGE_A(PG8_SA(1, 1), a1, 1);
            PG8_WAIT_L(8); PG8_BAR; PG8_WAIT_L(0); PG8_MMA(0, 0, At, B0); PG8_BAR; PG8_SCHED;
            if constexpr (GATHER) { if (last && has_next) {
#pragma unroll
                for (int _h = 0; _h < 2; ++_h)
#pragma unroll
                    for (int _i = 0; _i < 2; ++_i) voffA[_h][_i] = voffN[_h][_i]; } }
            PG8_LDB(B1, 0, 1); PG8_STAGE_B(PG8_SB(0, 0), b2);
            PG8_BAR; PG8_WAIT_L(0); PG8_MMA(0, 1, At, B1); PG8_BAR;
            PG8_LDA(At, 0, 1); PG8_STAGE_A(PG8_SA(0, 0), a2, 0);
            PG8_BAR; PG8_WAIT_L(0); PG8_MMA(1, 0, At, B0); PG8_BAR; PG8_SCHED;
            PG8_STAGE_B(PG8_SB(0, 1), b2 + hstepB);
            PG8_WAIT_V(6); PG8_BAR; PG8_MMA(1, 1, At, B1); PG8_BAR;
            PG8_LDB(B0, 1, 0); PG8_SCHED; PG8_LDA(At, 1, 0); PG8_STAGE_A(PG8_SA(0, 1), a2, 1);
            PG8_WAIT_L(8); PG8_BAR; PG8_WAIT_L(0); PG8_MMA(0, 0, At, B0); PG8_BAR; PG8_SCHED;
            PG8_LDB(B1, 1, 1); PG8_STAGE_B(PG8_SB(1, 0), b3);
            PG8_BAR; PG8_WAIT_L(0); PG8_MMA(0, 1, At, B1); PG8_BAR;
            PG8_LDA(At, 1, 1); PG8_STAGE_A(PG8_SA(1, 0), a3, 0);
            PG8_BAR; PG8_WAIT_L(0); PG8_MMA(1, 0, At, B0); PG8_BAR; PG8_SCHED;
            PG8_STAGE_B(PG8_SB(1, 1), b3 + hstepB);
            PG8_WAIT_V(6); PG8_BAR; PG8_MMA(1, 1, At, B1); PG8_BAR;
            }
        }
        if constexpr (ALIGN_EPI) { if (wr == 0) PG8_BAR; }
        E(acc, cur, wr, wc, fr, fq);
        if (!has_next) break;
#pragma unroll
        for (int a = 0; a < 2; ++a)
#pragma unroll
            for (int b = 0; b < 2; ++b)
#pragma unroll
                for (int m = 0; m < 4; ++m)
#pragma unroll
                    for (int n = 0; n < 2; ++n) acc[a][b][m][n] = (f32x4){0.f, 0.f, 0.f, 0.f};
        cur = nxt; cA = nA; cB = nB; ++ui;
        if constexpr (ALIGN_EPI) { if (wr == 1) PG8_BAR; }
    }
    PG8_WAIT_V(0);
    if constexpr (!ALIGN_EPI) { if (wr == 0) PG8_BAR; }
    PG8_BAR;
#undef PG8_SA
#undef PG8_SB
#undef PG8_STAGE_A
#undef PG8_STAGE_B
#undef PG8_LDA
#undef PG8_LDB
#undef PG8_MMA
#undef PG8_WAIT_V
#undef PG8_WAIT_L
#undef PG8_BAR
#undef PG8_SCHED
#undef PG8_GATHER_OFFS
}
}
namespace mk {
constexpr int NWAVES = 8;
constexpr int T = 16384, D = 1024, SEQ = 4096, NB = 4, NE = 32, NH = 32;
constexpr int DSSD = 2048, DCONV = 3072, NPROJ = 8224;
constexpr float EPS = 1e-5f;
constexpr size_t MiB = 1u << 20;
constexpr size_t WS_CTL = 0, CTL_ZERO_BYTES = 256 * 1024;
constexpr size_t WS_MOD = 128 * 1024;
constexpr size_t WS_CD = 1 * MiB;
constexpr size_t WS_GATE = 1 * MiB + 256 * 1024;
constexpr size_t WS_DT = 2 * MiB;
constexpr size_t WS_LIST = 4 * MiB;
constexpr size_t WS_WDT = 6 * MiB;
constexpr size_t WS_WPOOL = 6 * MiB + 512 * 1024;
constexpr size_t WS_WIN = 8 * MiB, WS_WSSD = 24 * MiB, WS_WPO = 28 * MiB, WS_WOUT = 30 * MiB, WS_WGU = 32 * MiB, WS_WDN = 160 * MiB;
constexpr size_t WS_H = 224 * MiB, WS_Z = 256 * MiB, WS_XBC = 320 * MiB, WS_U = 416 * MiB, WS_GATES = 448 * MiB, WS_STATES = 512 * MiB, WS_Y = 576 * MiB;
constexpr size_t WS_P = 640 * MiB, WS_P2 = 672 * MiB, WS_M1 = 704 * MiB, WS_MERGED = 736 * MiB, WS_END = 768 * MiB;
constexpr size_t WS_XC = 768 * MiB;
constexpr size_t WS_ACT = 256 * MiB, WS_YB = 416 * MiB;
constexpr int ACT_ROWS = 73728;
constexpr int CW_TMO = 0, CW_CODE = 1, CW_GCNT = 1024, CW_BAR = 4096;
constexpr int RING_BYTES = 143360;
constexpr int LDSCTL_OFF = RING_BYTES, MISC_OFF = LDSCTL_OFF + 64;
constexpr int LDS_BYTES = 147456;

#define GAS __attribute__((address_space(1)))
#define LAS __attribute__((address_space(3)))
typedef unsigned short bf16;
typedef unsigned v4u __attribute__((ext_vector_type(4)));
typedef unsigned v2u __attribute__((ext_vector_type(2)));
typedef float f32x4 __attribute__((ext_vector_type(4)));
typedef float f32x16 __attribute__((ext_vector_type(16)));
typedef short bf16x8 __attribute__((ext_vector_type(8)));
typedef GAS unsigned gu32;
#define RLX_AGENT __ATOMIC_RELAXED, __HIP_MEMORY_SCOPE_AGENT
#define LDS_WAIT() asm volatile("s_waitcnt lgkmcnt(0)" ::: "memory")
#define VM_WAIT() asm volatile("s_waitcnt vmcnt(0)" ::: "memory")
__device__ __forceinline__ unsigned f2bf(float f) { unsigned u = __builtin_bit_cast(unsigned, f); return (u + 0x7fffu + ((u >> 16) & 1u)) >> 16; }
typedef float f32x2_t __attribute__((ext_vector_type(2))); typedef __bf16 bf16x2_t __attribute__((ext_vector_type(2)));
__device__ __forceinline__ unsigned pk2(float lo, float hi) { const f32x2_t v = {lo, hi}; const bf16x2_t b = __builtin_convertvector(v, bf16x2_t); return __builtin_bit_cast(unsigned, b); }
__device__ __forceinline__ float bflo(unsigned w) { return __builtin_bit_cast(float, w << 16); }
__device__ __forceinline__ float bfhi(unsigned w) { return __builtin_bit_cast(float, w & 0xffff0000u); }
__device__ __forceinline__ float bf2f(bf16 h) { return __builtin_bit_cast(float, (unsigned)h << 16); }
__device__ __forceinline__ float sigm(float x) { return __builtin_amdgcn_rcpf(1.f + __builtin_amdgcn_exp2f(x * -1.4426950408889634f)); }
__device__ __forceinline__ float silu(float x) { return x * sigm(x); }
__device__ __forceinline__ float wave_sum(float v) {
#pragma unroll
    for (int o = 1; o < 64; o <<= 1) v += __shfl_xor(v, o);
    return v;
}

#define XB_TMO      128
#define XB_XCNT(j)  (256  + 64 * (j))
#define XB_XSUB(j)  (1280 + 64 * (j))
#define XB_XGEN(j)  (2304 + 64 * (j))
#define XB_TOP      3328
#define XB_TOPGEN   3392
#define XCD_BAR_WORDS 3456
#define XB_SPIN_CAP (1u << 18)
__device__ __forceinline__ unsigned xb_ld(unsigned* p)              { return __hip_atomic_load(p, __ATOMIC_RELAXED, __HIP_MEMORY_SCOPE_AGENT); }
__device__ __forceinline__ unsigned xb_add(unsigned* p, unsigned v) { return __hip_atomic_fetch_add(p, v, __ATOMIC_RELAXED, __HIP_MEMORY_SCOPE_AGENT); }
__device__ __forceinline__ unsigned xb_xcc_id() { return (unsigned)__builtin_amdgcn_s_getreg((3 << 11) | 20) & 0xFu; }
#define XB_SPIN(cond, bar) do { unsigned _sp = 0; while (cond) { __builtin_amdgcn_s_sleep(1); \
    if ((++_sp & 255u) == 0u) { if (xb_ld(&(bar)[XB_TMO])) break; if (_sp > XB_SPIN_CAP) { atomicAdd(&(bar)[XB_TMO], 1u); break; } } } } while (0)
struct XcdBarrier { unsigned* bar; unsigned x; volatile LAS unsigned* st; };
__device__ __forceinline__ XcdBarrier xcd_barrier_post(unsigned* bar, volatile LAS unsigned* st) {
    XcdBarrier b; b.bar = bar; b.x = xb_xcc_id(); b.st = st;
    if (threadIdx.x == 0) (void)xb_add(&bar[XB_XCNT(b.x)], 1u);
    return b;
}
__device__ __forceinline__ void xcd_barrier_complete(unsigned* bar, unsigned x, unsigned& nloc, unsigned& nx) {
    const unsigned G = gridDim.x * gridDim.y * gridDim.z;
    unsigned sum, cnt, mine, sp = 0u;
    for (;;) {
        sum = 0u; cnt = 0u; mine = 0u;
#pragma unroll
        for (unsigned j = 0; j < 16; ++j) { const unsigned c = xb_ld(&bar[XB_XCNT(j)]); sum += c; cnt += (c > 0u) ? 1u : 0u; mine = (j == x) ? c : mine; }
        if (sum == G) break;
        __builtin_amdgcn_s_sleep(1);
        if ((++sp & 255u) == 0u) { if (xb_ld(&bar[XB_TMO])) break; if (sp > XB_SPIN_CAP) { atomicAdd(&bar[XB_TMO], 1u); break; } }
    }
    nloc = mine > 0u ? mine : 1u; nx = cnt > 0u ? cnt : 1u;
}
__device__ __forceinline__ void xcd_barrier(const XcdBarrier& b) {
    asm volatile("s_waitcnt vmcnt(0)" ::: "memory");
    __syncthreads();
    if (threadIdx.x == 0) {
        unsigned* bar = b.bar;
        __builtin_amdgcn_s_waitcnt(0);
        unsigned nloc = b.st[0], nx = b.st[1];
        if (nloc == 0u) { xcd_barrier_complete(bar, b.x, nloc, nx); b.st[0] = nloc; b.st[1] = nx; }
        const unsigned old = xb_add(&bar[XB_XSUB(b.x)], 1u);
        const unsigned gen = old / nloc;
        if (old + 1u == (gen + 1u) * nloc) {
            __builtin_amdgcn_fence(__ATOMIC_RELEASE, "agent");
            asm volatile("s_waitcnt vmcnt(0)" ::: "memory");
            const unsigned og = xb_add(&bar[XB_TOP], 1u);
            const unsigned tg = og / nx;
            if (og + 1u == (tg + 1u) * nx) xb_add(&bar[XB_TOPGEN], 1u);
            else XB_SPIN(xb_ld(&bar[XB_TOPGEN]) == tg, bar);
            __builtin_amdgcn_fence(__ATOMIC_ACQUIRE, "agent");
            xb_add(&bar[XB_XGEN(b.x)], 1u);
            asm volatile("s_waitcnt vmcnt(0)" ::: "memory");
        } else {
            XB_SPIN(xb_ld(&bar[XB_XGEN(b.x)]) == gen, bar);
            __builtin_amdgcn_fence(__ATOMIC_ACQUIRE, "agent");
            asm volatile("s_waitcnt vmcnt(0)" ::: "memory");
        }
    }
    __syncthreads();
}
}
namespace mk {
struct Frame {
    LAS unsigned char* lds; volatile LAS unsigned* MISC; gu32* ctl; unsigned char* ws; float* out; const float* const* in;
    int tid, lane, wave, vcu, G;
};
enum { I_X = 0, I_C, I_WADA, I_BADA, I_NMW, I_WIN, I_CONVW, I_CONVB, I_DTB, I_ALOG, I_DSKIP, I_SNW, I_WSSD, I_WPOOL, I_PSCALE, I_WPO, I_WOUT, I_NFW, I_WR, I_BR, I_WGU, I_BGU, I_WDN, I_BDN, I_NFINAL };

__device__ __forceinline__ void p0_tile(const float* src, int ldsrc, int srccol0, int k0, bf16* dst, int lddst, int dstrow0, int nvalid, LAS float* scr, int lane) {
    const int col = (lane & 15) * 4;
#pragma unroll 4
    for (int i = 0; i < 16; ++i) { const int kk = 4 * i + (lane >> 4);
        f32x4 v = (f32x4){0.f, 0.f, 0.f, 0.f};
        if (col < nvalid) v = *(const f32x4*)(src + (size_t)(k0 + kk) * ldsrc + srccol0 + col);
        LAS float* s = scr + kk * 65 + col; s[0] = v.x; s[1] = v.y; s[2] = v.z; s[3] = v.w; }
    LDS_WAIT(); asm volatile("" ::: "memory");
    const int c = lane & 7;
#pragma unroll
    for (int j = 0; j < 8; ++j) { const int n = (lane >> 3) + 8 * j; const LAS float* s = scr + (8 * c) * 65 + n;
        v4u o; o.x = pk2(s[0 * 65], s[1 * 65]); o.y = pk2(s[2 * 65], s[3 * 65]); o.z = pk2(s[4 * 65], s[5 * 65]); o.w = pk2(s[6 * 65], s[7 * 65]);
        if (n < nvalid) *(v4u*)(dst + (size_t)(dstrow0 + n) * lddst + k0 + 8 * c) = o; }
    LDS_WAIT(); asm volatile("" ::: "memory");
}
__device__ __forceinline__ void p0_prologue(Frame& F) {
    LAS float* scr = (LAS float*)(F.lds + F.wave * 16896);
    const int gw = F.vcu * NWAVES + F.wave, NGW = F.G * NWAVES;
    bf16* WIN_T = (bf16*)(F.ws + WS_WIN); bf16* WDT_T = (bf16*)(F.ws + WS_WDT); bf16* WSSD_T = (bf16*)(F.ws + WS_WSSD); bf16* WPO_T = (bf16*)(F.ws + WS_WPO);
    bf16* WOUT_T = (bf16*)(F.ws + WS_WOUT); bf16* WPOOL_T = (bf16*)(F.ws + WS_WPOOL); bf16* WGU_T = (bf16*)(F.ws + WS_WGU); bf16* WDN_T = (bf16*)(F.ws + WS_WDN);
    constexpr int N_IN = 2048, N_DT = 16, N_SSD = 512, N_PO = 256, N_OUT = 256, N_POOL = 64, N_GU = 16384, N_DN = 8192;
    constexpr int NITEMS = N_IN + N_DT + N_SSD + N_PO + N_OUT + N_POOL + N_GU + N_DN;
    for (int it = gw; it < NITEMS; it += NGW) {
        int r = it;
        if (r < N_GU) { const int e = r >> 9, q = r & 511, rb = q >> 4, kb = q & 15; const int rho = rb * 64, pn = rho >> 8, rr = rho & 255;
            const int sc = rr < 128 ? 128 * pn + rr : 1024 + 128 * pn + (rr - 128);
            p0_tile(F.in[I_WGU] + (size_t)e * 1024 * 2048, 2048, sc, kb * 64, WGU_T + (size_t)e * 2048 * 1024, 1024, rho, 64, scr, F.lane); continue; } r -= N_GU;
        if (r < N_DN) { const int e = r >> 8, q = r & 255, rb = q >> 4, kb = q & 15;
            p0_tile(F.in[I_WDN] + (size_t)e * 1024 * 1024, 1024, rb * 64, kb * 64, WDN_T + (size_t)e * 1024 * 1024, 1024, rb * 64, 64, scr, F.lane); continue; } r -= N_DN;
        if (r < N_IN) { const int rb = r >> 4, kb = r & 15; const int drow = rb * 64; const int sc = drow + (drow >= 5120 ? 32 : 0);
            p0_tile(F.in[I_WIN], NPROJ, sc, kb * 64, WIN_T, 1024, drow, 64, scr, F.lane); continue; } r -= N_IN;
        if (r < N_DT) { p0_tile(F.in[I_WIN], NPROJ, 5120, r * 64, WDT_T, 1024, 0, 32, scr, F.lane); continue; } r -= N_DT;
        if (r < N_SSD) { const int rb = r >> 5, kb = r & 31; p0_tile(F.in[I_WSSD], 1024, rb * 64, kb * 64, WSSD_T, 2048, rb * 64, 64, scr, F.lane); continue; } r -= N_SSD;
        if (r < N_PO) { const int rb = r >> 4, kb = r & 15; p0_tile(F.in[I_WPO], 1024, rb * 64, kb * 64, WPO_T, 1024, rb * 64, 64, scr, F.lane); continue; } r -= N_PO;
        if (r < N_OUT) { const int rb = r >> 4, kb = r & 15; p0_tile(F.in[I_WOUT], 1024, rb * 64, kb * 64, WOUT_T, 1024, rb * 64, 64, scr, F.lane); continue; } r -= N_OUT;
        { const int g = r >> 4, q = r & 15, rb = q >> 2, kb = q & 3; p0_tile(F.in[I_WPOOL] + (size_t)g * 65536, 256, rb * 64, kb * 64, WPOOL_T, 256, g * 256 + rb * 64, 64, scr, F.lane); }
    }
    __syncthreads();
    { float* mod = (float*)(F.ws + WS_MOD); LAS float* red = (LAS float*)F.lds;
      for (int jb = F.vcu; jb < 256; jb += F.G) {
        const int jj = F.tid & 31, sl = F.tid >> 5, j = jb * 24 + jj; float a0 = 0.f, a1 = 0.f, a2 = 0.f, a3 = 0.f; const float* cc = F.in[I_C];
        if (jj < 24) {
#pragma unroll 8
            for (int k = sl * 64; k < sl * 64 + 64; ++k) { const float w = F.in[I_WADA][(size_t)k * 6144 + j];
                a0 += silu(cc[k]) * w; a1 += silu(cc[1024 + k]) * w; a2 += silu(cc[2048 + k]) * w; a3 += silu(cc[3072 + k]) * w; } }
        red[(sl * 4 + 0) * 32 + jj] = a0; red[(sl * 4 + 1) * 32 + jj] = a1; red[(sl * 4 + 2) * 32 + jj] = a2; red[(sl * 4 + 3) * 32 + jj] = a3;
        __syncthreads();
        if (F.tid < 128) { const int b = F.tid >> 5, q = F.tid & 31; if (q < 24) { float s = F.in[I_BADA][jb * 24 + q];
#pragma unroll
                for (int i = 0; i < 16; ++i) s += red[(i * 4 + b) * 32 + q];
                mod[b * 6144 + jb * 24 + q] = s; } }
        __syncthreads();
      } }
}

__device__ __forceinline__ void p1_norm_dt(Frame& F) {
    constexpr int PITCH = 2064;
    LAS unsigned char* tile = F.lds + F.wave * (8 * PITCH);
    for (int grp = F.vcu * NWAVES + F.wave; grp < T / 8; grp += F.G * NWAVES) {
    const int t0 = grp * 8, b = t0 / SEQ;
    const float* mod = (const float*)(F.ws + WS_MOD) + b * 6144; bf16* H = (bf16*)(F.ws + WS_H);
    f32x4 wv[4], scv[4], shv[4];
#pragma unroll
    for (int j = 0; j < 4; ++j) { const int col = 4 * F.lane + 256 * j; wv[j] = *(const f32x4*)(F.in[I_NMW] + col); scv[j] = *(const f32x4*)(mod + 1024 + col); shv[j] = *(const f32x4*)(mod + col); }
#pragma unroll 1
    for (int r = 0; r < 8; ++r) {
        const float* xr = F.in[I_X] + (size_t)(t0 + r) * D; f32x4 v[4]; float s = 0.f;
#pragma unroll
        for (int j = 0; j < 4; ++j) { v[j] = *(const f32x4*)(xr + 4 * F.lane + 256 * j); s += (v[j].x * v[j].x + v[j].y * v[j].y) + (v[j].z * v[j].z + v[j].w * v[j].w); }
        const float rstd = rsqrtf(wave_sum(s) * (1.f / D) + EPS);
#pragma unroll
        for (int j = 0; j < 4; ++j) { const f32x4 hv = v[j] * rstd * wv[j] * (scv[j] + 1.f) + shv[j];
            v2u o; o.x = pk2(hv.x, hv.y); o.y = pk2(hv.z, hv.w);
            *(v2u*)(H + (size_t)(t0 + r) * D + 4 * F.lane + 256 * j) = o;
            *(LAS v2u*)(tile + r * PITCH + (4 * F.lane + 256 * j) * 2) = o; }
    }
    LDS_WAIT(); asm volatile("" ::: "memory");
    const bf16* WDT_T = (const bf16*)(F.ws + WS_WDT);
    f32x4 acc0 = (f32x4){0.f, 0.f, 0.f, 0.f}, acc1 = acc0; const int fr = F.lane & 15, fq = F.lane >> 4;
#pragma unroll 4
    for (int s = 0; s < 32; ++s) {
        const bf16x8 a = *(const LAS bf16x8*)(tile + (fr & 7) * PITCH + (32 * s + 8 * fq) * 2);
        const bf16x8 b0 = *(const bf16x8*)(WDT_T + (size_t)fr * 1024 + 32 * s + 8 * fq), b1 = *(const bf16x8*)(WDT_T + (size_t)(fr + 16) * 1024 + 32 * s + 8 * fq);
        acc0 = __builtin_amdgcn_mfma_f32_16x16x32_bf16(a, b0, acc0, 0, 0, 0); acc1 = __builtin_amdgcn_mfma_f32_16x16x32_bf16(a, b1, acc1, 0, 0, 0);
    }
    if (fq < 2) { float* DT = (float*)(F.ws + WS_DT); const float db0 = F.in[I_DTB][fr], db1 = F.in[I_DTB][fr + 16];
#pragma unroll
        for (int i = 0; i < 4; ++i) { const int row = t0 + 4 * fq + i; float x0 = acc0[i] + db0, x1 = acc1[i] + db1;
            DT[(size_t)row * 32 + fr] = x0 > 20.f ? x0 : log1pf(__expf(x0)); DT[(size_t)row * 32 + 16 + fr] = x1 > 20.f ? x1 : log1pf(__expf(x1)); } }
    LDS_WAIT();
    }
}

template <int W> __device__ __forceinline__ void pool_item(const bf16* U, bf16* P, int t0, int tt0, int cg) {
    v4u raw[W + 7];
#pragma unroll
    for (int r = 0; r < W + 7; ++r) { const int d = r - (W - 1); raw[r] = (tt0 + d >= 0) ? *(const v4u*)(U + (size_t)(t0 + d) * D + cg * 8) : (v4u){0u, 0u, 0u, 0u}; }
    float s[8];
#pragma unroll
    for (int q = 0; q < 8; ++q) s[q] = 0.f;
#pragma unroll
    for (int r = 0; r < W - 1; ++r) { const v4u v = raw[r]; s[0] += bflo(v.x); s[1] += bfhi(v.x); s[2] += bflo(v.y); s[3] += bfhi(v.y); s[4] += bflo(v.z); s[5] += bfhi(v.z); s[6] += bflo(v.w); s[7] += bfhi(v.w); }
#pragma unroll
    for (int i = 0; i < 8; ++i) { const v4u v = raw[W - 1 + i]; const float u[8] = {bflo(v.x), bfhi(v.x), bflo(v.y), bfhi(v.y), bflo(v.z), bfhi(v.z), bflo(v.w), bfhi(v.w)};
#pragma unroll
        for (int q = 0; q < 8; ++q) s[q] += u[q];
        const int tt = tt0 + i; const float inv = 1.f / (float)(tt + 1 < W ? tt + 1 : W);
        v4u o; o.x = pk2(s[0] * inv - u[0], s[1] * inv - u[1]); o.y = pk2(s[2] * inv - u[2], s[3] * inv - u[3]); o.z = pk2(s[4] * inv - u[4], s[5] * inv - u[5]); o.w = pk2(s[6] * inv - u[6], s[7] * inv - u[7]);
        *(v4u*)(P + (size_t)(t0 + i) * D + cg * 8) = o;
        const v4u z = raw[i]; s[0] -= bflo(z.x); s[1] -= bfhi(z.x); s[2] -= bflo(z.y); s[3] -= bfhi(z.y); s[4] -= bflo(z.z); s[5] -= bfhi(z.z); s[6] -= bflo(z.w); s[7] -= bfhi(z.w); }
}
__device__ __forceinline__ void pool_pass(Frame& F) {
    const bf16* U = (const bf16*)(F.ws + WS_U); bf16* P = (bf16*)(F.ws + WS_P);
    for (int it = F.vcu * 512 + F.tid; it < 2048 * 128; it += F.G * 512) {
        const int wsel = __builtin_amdgcn_readfirstlane((it >> 6) & 3), cg = wsel * 32 + (it & 31), strip = (it >> 8) * 2 + ((it >> 5) & 1); const int t0 = strip * 8, tt0 = t0 % SEQ;
        if (wsel == 0) pool_item<2>(U, P, t0, tt0, cg); else if (wsel == 1) pool_item<4>(U, P, t0, tt0, cg); else if (wsel == 2) pool_item<8>(U, P, t0, tt0, cg); else pool_item<16>(U, P, t0, tt0, cg);
    }
}

__device__ __forceinline__ int swz16(int row) { return (row ^ (row >> 4)) & 15; }
__device__ __forceinline__ void conv8x8(const bf16* XBC, const float* cw, const float* cb, int trow0, bool seq_start, int col, float (&out)[8][8]) {
    float u[11][8];
#pragma unroll
    for (int r = 0; r < 11; ++r) { v4u v = (v4u){0u, 0u, 0u, 0u}; if (!(r < 3 && seq_start)) v = *(const v4u*)(XBC + (size_t)(trow0 - 3 + r) * DCONV + col);
        u[r][0] = bflo(v.x); u[r][1] = bfhi(v.x); u[r][2] = bflo(v.y); u[r][3] = bfhi(v.y); u[r][4] = bflo(v.z); u[r][5] = bfhi(v.z); u[r][6] = bflo(v.w); u[r][7] = bfhi(v.w); }
    float w[4][8], bb[8];
#pragma unroll
    for (int k = 0; k < 4; ++k) { const f32x4 a = *(const f32x4*)(cw + k * DCONV + col), b = *(const f32x4*)(cw + k * DCONV + col + 4);
        w[k][0] = a.x; w[k][1] = a.y; w[k][2] = a.z; w[k][3] = a.w; w[k][4] = b.x; w[k][5] = b.y; w[k][6] = b.z; w[k][7] = b.w; }
    { const f32x4 a = *(const f32x4*)(cb + col), b = *(const f32x4*)(cb + col + 4); bb[0] = a.x; bb[1] = a.y; bb[2] = a.z; bb[3] = a.w; bb[4] = b.x; bb[5] = b.y; bb[6] = b.z; bb[7] = b.w; }
#pragma unroll
    for (int i = 0; i < 8; ++i)
#pragma unroll
        for (int q = 0; q < 8; ++q) { const float a = bb[q] + w[0][q] * u[i][q] + w[1][q] * u[i + 1][q] + w[2][q] * u[i + 2][q] + w[3][q] * u[i + 3][q]; out[i][q] = silu(a); }
}
__device__ __forceinline__ void conv_item(const bf16* XBC, const float* cw, const float* cb, int trow0, bool seq_start, int col, bf16* gdst, const bool do_g, LAS unsigned char* img, const bool do_img, int row0, int chunk, const LAS float* sc, const bool do_sc) {
    v4u raw[11];
#pragma unroll
    for (int r = 0; r < 11; ++r) { raw[r] = (v4u){0u, 0u, 0u, 0u}; if (!(r < 3 && seq_start)) raw[r] = *(const v4u*)(XBC + (size_t)(trow0 - 3 + r) * DCONV + col); }
    f32x4 wa[4], wb[4];
#pragma unroll
    for (int k = 0; k < 4; ++k) { wa[k] = *(const f32x4*)(cw + k * DCONV + col); wb[k] = *(const f32x4*)(cw + k * DCONV + col + 4); }
    const f32x4 ba = *(const f32x4*)(cb + col), bbv = *(const f32x4*)(cb + col + 4);
    unsigned la[8];
#pragma unroll
    for (int q = 0; q < 8; ++q) la[q] = (unsigned)((row0 + q) * 256 + ((chunk ^ swz16(row0 + q)) << 4));
#define CI_U(R, Q) (((Q) & 1) ? bfhi(((Q) >> 1) == 0 ? raw[R].x : ((Q) >> 1) == 1 ? raw[R].y : ((Q) >> 1) == 2 ? raw[R].z : raw[R].w) : bflo(((Q) >> 1) == 0 ? raw[R].x : ((Q) >> 1) == 1 ? raw[R].y : ((Q) >> 1) == 2 ? raw[R].z : raw[R].w))
#define CI_W(K, Q) ((Q) < 4 ? wa[K][(Q) & 3] : wb[K][(Q) & 3])
#pragma unroll
    for (int ip = 0; ip < 4; ++ip) {
        float a0[8], a1[8];
#pragma unroll
        for (int q = 0; q < 8; ++q) { const float bq = q < 4 ? ba[q & 3] : bbv[q & 3];
            a0[q] = silu(bq + CI_W(0, q) * CI_U(2 * ip, q) + CI_W(1, q) * CI_U(2 * ip + 1, q) + CI_W(2, q) * CI_U(2 * ip + 2, q) + CI_W(3, q) * CI_U(2 * ip + 3, q));
            a1[q] = silu(bq + CI_W(0, q) * CI_U(2 * ip + 1, q) + CI_W(1, q) * CI_U(2 * ip + 2, q) + CI_W(2, q) * CI_U(2 * ip + 3, q) + CI_W(3, q) * CI_U(2 * ip + 4, q)); }
        if (do_g) { *(v4u*)(gdst + (size_t)(2 * ip) * DCONV) = (v4u){pk2(a0[0], a0[1]), pk2(a0[2], a0[3]), pk2(a0[4], a0[5]), pk2(a0[6], a0[7])};
                    *(v4u*)(gdst + (size_t)(2 * ip + 1) * DCONV) = (v4u){pk2(a1[0], a1[1]), pk2(a1[2], a1[3]), pk2(a1[4], a1[5]), pk2(a1[6], a1[7])}; }
        if (do_img) { float s0 = 1.f, s1 = 1.f; if (do_sc) { s0 = sc[2 * ip]; s1 = sc[2 * ip + 1]; }
#pragma unroll
            for (int q = 0; q < 8; ++q) *(LAS unsigned*)(img + la[q] + 4 * ip) = pk2(a0[q] * s0, a1[q] * s1); }
    }
#undef CI_U
#undef CI_W
}
__device__ __forceinline__ void put_transposed(LAS unsigned char* img, int row0, int chunk, const float (&o)[8][8]) {
#pragma unroll
    for (int q = 0; q < 8; ++q) { const int row = row0 + q; v4u v; v.x = pk2(o[0][q], o[1][q]); v.y = pk2(o[2][q], o[3][q]); v.z = pk2(o[4][q], o[5][q]); v.w = pk2(o[6][q], o[7][q]);
        *(LAS v4u*)(img + row * 256 + ((chunk ^ swz16(row)) << 4)) = v; }
}
__device__ __forceinline__ void put_global(bf16* dst, const float (&o)[8][8]) {
#pragma unroll
    for (int i = 0; i < 8; ++i) { v4u v; v.x = pk2(o[i][0], o[i][1]); v.y = pk2(o[i][2], o[i][3]); v.z = pk2(o[i][4], o[i][5]); v.w = pk2(o[i][6], o[i][7]); *(v4u*)(dst + (size_t)i * DCONV) = v; }
}
__device__ __forceinline__ void put_natural(LAS unsigned char* img, int l0, int chunk, const float (&o)[8][8]) {
#pragma unroll
    for (int i = 0; i < 8; ++i) { const int row = l0 + i; v4u v; v.x = pk2(o[i][0], o[i][1]); v.y = pk2(o[i][2], o[i][3]); v.z = pk2(o[i][4], o[i][5]); v.w = pk2(o[i][6], o[i][7]);
        *(LAS v4u*)(img + row * 256 + ((chunk ^ swz16(row)) << 4)) = v; }
}
__device__ __forceinline__ bf16x8 ld_frag(const LAS unsigned char* img, int row, int chunk) { return *(const LAS bf16x8*)(img + row * 256 + ((chunk ^ swz16(row)) << 4)); }

__device__ __forceinline__ void ssd_states_unit(Frame& F, int unit) {
    const int hh = unit & 1, g = (unit >> 1) & 3, c = (unit >> 3) & 31, b = unit >> 8; const int t0 = b * SEQ + c * 128;
    LAS float* sx = (LAS float*)F.lds;
    LAS unsigned char* Bt = F.lds + 4096; LAS unsigned char* Xt = F.lds + 4096 + 32768;
    const float* DT = (const float*)(F.ws + WS_DT); const bf16* XBC = (const bf16*)(F.ws + WS_XBC); bf16* XC = (bf16*)(F.ws + WS_XC); float* CD = (float*)(F.ws + WS_CD);
    __syncthreads();
    if (F.wave < 4) {
        const int h = g * 8 + 4 * hh + F.wave; const float A = -__expf(F.in[I_ALOG][h]); const int l = 2 * F.lane;
        const float d0 = DT[(size_t)(t0 + l) * 32 + h], d1 = DT[(size_t)(t0 + l + 1) * 32 + h]; const float a0 = d0 * A, a1 = d1 * A, s = a0 + a1;
        float incl = s;
#pragma unroll
        for (int o = 1; o < 64; o <<= 1) { const float v = __shfl_up(incl, o); if (F.lane >= o) incl += v; }
        const float c0 = incl - s + a0, c1 = incl, total = __shfl(incl, 63);
        sx[F.wave * 128 + l] = d0 * __expf(total - c0); sx[F.wave * 128 + l + 1] = d1 * __expf(total - c1);
        if (F.lane == 0) CD[(b * 32 + c) * 32 + h] = __expf(total);
    }
    __syncthreads();
#pragma unroll 1
    for (int itx = 0; itx < 2; ++itx) {
        int kind, strip, grp, col;
        if (itx == 0) { kind = 0; strip = F.tid >> 5; grp = F.tid & 31; col = g * 512 + hh * 256 + grp * 8; }
        else if (F.tid < 256) { kind = 1; strip = F.tid >> 4; grp = F.tid & 15; col = 2048 + g * 128 + grp * 8; }
        else if (F.tid < 384) { kind = 2; strip = 8 * hh + ((F.tid - 256) >> 4); grp = F.tid & 15; col = 2560 + g * 128 + grp * 8; }
        else { kind = 3; strip = 0; grp = 0; col = 0; }
        if (kind < 3) { const int l0 = strip * 8;
            conv_item(XBC, F.in[I_CONVW], F.in[I_CONVB], t0 + l0, (c == 0 && l0 == 0), col, XC + (size_t)(t0 + l0) * DCONV + col, (kind != 1 || hh == 0),
                      kind ? Bt : Xt, kind < 2, grp * 8, strip, sx + (grp >> 3) * 128 + l0, kind == 0); }
    }
    __syncthreads();
    const int li = F.lane & 31, half = F.lane >> 5, hp = (F.wave >> 1) * 64 + (F.wave & 1) * 32 + li;
    f32x16 acc[4];
#pragma unroll
    for (int nt = 0; nt < 4; ++nt)
#pragma unroll
        for (int r = 0; r < 16; ++r) acc[nt][r] = 0.f;
#pragma unroll 2
    for (int ks = 0; ks < 8; ++ks) { const bf16x8 xb = ld_frag(Xt, hp, 2 * ks + half);
#pragma unroll
        for (int nt = 0; nt < 4; ++nt) { const bf16x8 ba = ld_frag(Bt, 32 * nt + li, 2 * ks + half); acc[nt] = __builtin_amdgcn_mfma_f32_32x32x16_bf16(ba, xb, acc[nt], 0, 0, 0); } }
    __syncthreads();
    LAS unsigned char* OUT = Xt;
#pragma unroll
    for (int nt = 0; nt < 4; ++nt)
#pragma unroll
        for (int rq = 0; rq < 4; ++rq) { const int ch8 = 8 * nt + 2 * rq + half; v2u v; v.x = pk2(acc[nt][4 * rq], acc[nt][4 * rq + 1]); v.y = pk2(acc[nt][4 * rq + 2], acc[nt][4 * rq + 3]);
            *(LAS v2u*)(OUT + hp * 256 + ((ch8 ^ (hp & 31)) << 3)) = v; }
    __syncthreads();
    bf16* ST = (bf16*)(F.ws + WS_STATES) + ((size_t)((b * 32 + c) * 32 + g * 8 + 4 * hh)) * 8192;
#pragma unroll
    for (int it = 0; it < 8; ++it) { const int idx = it * 512 + F.tid, row = idx >> 4, j = idx & 15, k = row & 31;
        v4u v = *(const LAS v4u*)(OUT + row * 256 + ((j ^ (k >> 1)) << 4)); if (k & 1) v = (v4u){v.z, v.w, v.x, v.y};
        *(v4u*)(ST + (size_t)row * 128 + j * 8) = v; }
}

__device__ __forceinline__ void ssd_scan(Frame& F) {
    bf16* ST = (bf16*)(F.ws + WS_STATES); const float* CD = (const float*)(F.ws + WS_CD);
    for (int gid = F.vcu * 512 + F.tid; gid < 131072; gid += F.G * 512) {
        const int bh = gid >> 10, b = bh >> 5, h = bh & 31, el = (gid & 1023) * 8;
        float st[8];
#pragma unroll
        for (int q = 0; q < 8; ++q) st[q] = 0.f;
#pragma unroll 4
        for (int c = 0; c < 32; ++c) { bf16* p = ST + ((size_t)((b * 32 + c) * 32 + h)) * 8192 + el; const v4u v = *(const v4u*)p; const float cd = CD[(b * 32 + c) * 32 + h];
            v4u o; o.x = pk2(st[0], st[1]); o.y = pk2(st[2], st[3]); o.z = pk2(st[4], st[5]); o.w = pk2(st[6], st[7]); *(v4u*)p = o;
            st[0] = st[0] * cd + bflo(v.x); st[1] = st[1] * cd + bfhi(v.x); st[2] = st[2] * cd + bflo(v.y); st[3] = st[3] * cd + bfhi(v.y);
            st[4] = st[4] * cd + bflo(v.z); st[5] = st[5] * cd + bfhi(v.z); st[6] = st[6] * cd + bflo(v.w); st[7] = st[7] * cd + bfhi(v.w); }
    }
}

__device__ __forceinline__ int off256(int row, int ch) { return 256 * row + 16 * (ch ^ (((row & 3) << 2) | ((row >> 2) & 3))); }
__device__ __forceinline__ int off512(int row, int ch) { return 512 * row + 16 * (ch ^ ((row & 3) << 2)); }
typedef short v4i16_t __attribute__((ext_vector_type(4)));
__device__ __forceinline__ v4i16_t tr_read(const LAS unsigned char* p) { return __builtin_amdgcn_ds_read_tr16_b64_v4i16((LAS v4i16_t*)p); }
__device__ __forceinline__ void ssd_out_unit(Frame& F, int unit) {
    const int g = unit & 3, c = (unit >> 2) & 31, b = unit >> 7; const int t0 = b * SEQ + c * 128;
    LAS float* acum = (LAS float*)F.lds; LAS float* dtv = acum + 1024; LAS float* ssq = acum + 2048;
    LAS unsigned char* Bn = F.lds + 12288; LAS unsigned char* Cn = Bn + 32768; LAS unsigned char* Xn = Cn + 32768;
    const float* DT = (const float*)(F.ws + WS_DT); const bf16* XC = (const bf16*)(F.ws + WS_XC); const bf16* Z = (const bf16*)(F.ws + WS_Z); bf16* Y = (bf16*)(F.ws + WS_Y);
    __syncthreads();
#pragma unroll
    for (int i = 0; i < 4; ++i) { const int k = F.wave * 4 + i, row = 4 * k + (F.lane >> 4), pc = F.lane & 15, lc = pc ^ (((row & 3) << 2) | ((row >> 2) & 3));
        const bf16* src = XC + (size_t)(t0 + row) * DCONV + 2048 + g * 128 + lc * 8;
        __builtin_amdgcn_global_load_lds((const unsigned*)src, (LAS unsigned*)(Bn + k * 1024), 16, 0, 0);
        __builtin_amdgcn_global_load_lds((const unsigned*)(src + 512), (LAS unsigned*)(Cn + k * 1024), 16, 0, 0); }
    { const int h = g * 8 + F.wave; const float A = -__expf(F.in[I_ALOG][h]); const int l = 2 * F.lane;
        const float d0 = DT[(size_t)(t0 + l) * 32 + h], d1 = DT[(size_t)(t0 + l + 1) * 32 + h]; const float a0 = d0 * A, a1 = d1 * A, s = a0 + a1;
        float incl = s;
#pragma unroll
        for (int o = 1; o < 64; o <<= 1) { const float v = __shfl_up(incl, o); if (F.lane >= o) incl += v; }
        acum[F.wave * 128 + l] = incl - s + a0; acum[F.wave * 128 + l + 1] = incl; dtv[F.wave * 128 + l] = d0; dtv[F.wave * 128 + l + 1] = d1; }
    const int li = F.lane & 31, half = F.lane >> 5, ew = F.wave >> 1, lsel = F.wave & 1;
    const int trq = (F.lane & 15) >> 2, trp = F.lane & 3, trblk = (F.lane >> 4) & 1;
#pragma unroll 1
    for (int ps = 0; ps < 2; ++ps) {
        if (ps) __syncthreads();
#pragma unroll
        for (int i = 0; i < 8; ++i) { const int k = F.wave * 8 + i, row = 2 * k + (F.lane >> 5), pc = F.lane & 31, lc = pc ^ ((row & 3) << 2);
            __builtin_amdgcn_global_load_lds((const unsigned*)(XC + (size_t)(t0 + row) * DCONV + g * 512 + ps * 256 + lc * 8), (LAS unsigned*)(Xn + k * 1024), 16, 0, 0); }
        const int e = 4 * ps + ew, h = 8 * g + e; const float Dk = F.in[I_DSKIP][h];
        const bf16* prev = (const bf16*)(F.ws + WS_STATES) + ((size_t)((b * 32 + c) * 32 + h)) * 8192;
        bf16x8 pf[2][8];
#pragma unroll
        for (int pt = 0; pt < 2; ++pt)
#pragma unroll
            for (int ks = 0; ks < 8; ++ks) pf[pt][ks] = *(const bf16x8*)(prev + (size_t)(32 * pt + li) * 128 + 16 * ks + 8 * half);
        VM_WAIT(); __syncthreads();
        const LAS float* ac = acum + e * 128; const LAS float* dv = dtv + e * 128;
#pragma unroll 1
        for (int it = 0; it < 2; ++it) {
            const int i = lsel ? (1 + it) : (it ? 3 : 0); const int l = 32 * i + li; const float acl = ac[l];
            f32x16 acc[2];
#pragma unroll
            for (int pt = 0; pt < 2; ++pt)
#pragma unroll
                for (int r = 0; r < 16; ++r) acc[pt][r] = 0.f;
#pragma unroll
            for (int ks = 0; ks < 8; ++ks) { const bf16x8 cf = *(const LAS bf16x8*)(Cn + off256(l, 2 * ks + half));
#pragma unroll
                for (int pt = 0; pt < 2; ++pt) acc[pt] = __builtin_amdgcn_mfma_f32_32x32x16_bf16(pf[pt][ks], cf, acc[pt], 0, 0, 0); }
            { const float el = __expf(acl);
#pragma unroll
                for (int pt = 0; pt < 2; ++pt)
#pragma unroll
                    for (int r = 0; r < 16; ++r) acc[pt][r] *= el; }
#pragma unroll 1
            for (int j = 0; j <= i; ++j) {
                f32x16 gt;
#pragma unroll
                for (int r = 0; r < 16; ++r) gt[r] = 0.f;
#pragma unroll 4
                for (int ks = 0; ks < 8; ++ks) { const bf16x8 bfm = *(const LAS bf16x8*)(Bn + off256(32 * j + li, 2 * ks + half)); const bf16x8 cf = *(const LAS bf16x8*)(Cn + off256(l, 2 * ks + half)); gt = __builtin_amdgcn_mfma_f32_32x32x16_bf16(bfm, cf, gt, 0, 0, 0); }
                unsigned wp[8];
#pragma unroll
                for (int rq = 0; rq < 4; ++rq) { const int sb = 32 * j + 8 * rq + 4 * half; const f32x4 as4 = *(const LAS f32x4*)(ac + sb), dt4 = *(const LAS f32x4*)(dv + sb); float wv[4];
#pragma unroll
                    for (int x = 0; x < 4; ++x) { const int s = sb + x; float w = gt[4 * rq + x] * __expf(fminf(acl - as4[x], 0.f)) * dt4[x];
                        if (j == i) { if (s > l) w = 0.f; if (s == l) w += Dk; } wv[x] = w; }
                    wp[2 * rq] = pk2(wv[0], wv[1]); wp[2 * rq + 1] = pk2(wv[2], wv[3]); }
                const bf16x8 wf0 = __builtin_bit_cast(bf16x8, (v4u){wp[0], wp[1], wp[2], wp[3]}), wf1 = __builtin_bit_cast(bf16x8, (v4u){wp[4], wp[5], wp[6], wp[7]});
#pragma unroll
                for (int pt = 0; pt < 2; ++pt) { const int chunk = ew * 8 + 4 * pt + 2 * trblk + (trp >> 1);
#pragma unroll
                    for (int ksub = 0; ksub < 2; ++ksub) { const int r0 = 32 * j + 16 * ksub + 4 * half + trq;
                        const v4i16_t lo = tr_read(Xn + off512(r0, chunk) + 8 * (trp & 1)), hi = tr_read(Xn + off512(r0 + 8, chunk) + 8 * (trp & 1));
                        const bf16x8 xf = (bf16x8){lo[0], lo[1], lo[2], lo[3], hi[0], hi[1], hi[2], hi[3]};
                        acc[pt] = __builtin_amdgcn_mfma_f32_32x32x16_bf16(xf, ksub ? wf1 : wf0, acc[pt], 0, 0, 0); } }
            }
            float sq = 0.f; v2u zz[2][4];
#pragma unroll
            for (int pt = 0; pt < 2; ++pt)
#pragma unroll
                for (int rq = 0; rq < 4; ++rq) zz[pt][rq] = *(const v2u*)(Z + (size_t)(t0 + l) * DSSD + h * 64 + 32 * pt + 8 * rq + 4 * half);
#pragma unroll
            for (int pt = 0; pt < 2; ++pt)
#pragma unroll
                for (int rq = 0; rq < 4; ++rq) { const int ch = h * 64 + 32 * pt + 8 * rq + 4 * half; const v2u z2 = zz[pt][rq];
                    const float y0 = acc[pt][4 * rq] * silu(bflo(z2.x)), y1 = acc[pt][4 * rq + 1] * silu(bfhi(z2.x)), y2 = acc[pt][4 * rq + 2] * silu(bflo(z2.y)), y3 = acc[pt][4 * rq + 3] * silu(bfhi(z2.y));
                    sq += (y0 * y0 + y1 * y1) + (y2 * y2 + y3 * y3); *(v2u*)(Y + (size_t)(t0 + l) * DSSD + ch) = (v2u){pk2(y0, y1), pk2(y2, y3)}; }
            sq += __shfl_xor(sq, 32); if (half == 0) ssq[(ps * 4 + ew) * 128 + l] = sq;
        }
    }
    VM_WAIT(); __syncthreads();
#pragma unroll
    for (int it = 0; it < 2; ++it) { const int i = lsel ? (1 + it) : (it ? 3 : 0); const int l = 32 * i + li; float sqt = 0.f;
#pragma unroll
        for (int q = 0; q < 8; ++q) sqt += ssq[q * 128 + l];
        const float rstd = rsqrtf(sqt * (1.f / 512.f) + EPS);
        v2u yv[2][2][4];
#pragma unroll
        for (int ps = 0; ps < 2; ++ps)
#pragma unroll
            for (int pt = 0; pt < 2; ++pt)
#pragma unroll
                for (int rq = 0; rq < 4; ++rq) yv[ps][pt][rq] = *(const v2u*)(Y + (size_t)(t0 + l) * DSSD + (8 * g + 4 * ps + ew) * 64 + 32 * pt + 8 * rq + 4 * half);
#pragma unroll
        for (int ps = 0; ps < 2; ++ps)
#pragma unroll
            for (int pt = 0; pt < 2; ++pt)
#pragma unroll
                for (int rq = 0; rq < 4; ++rq) { const int ch = (8 * g + 4 * ps + ew) * 64 + 32 * pt + 8 * rq + 4 * half; const f32x4 nw = *(const f32x4*)(F.in[I_SNW] + ch); const v2u v = yv[ps][pt][rq];
                    v2u o; o.x = pk2(bflo(v.x) * rstd * nw.x, bfhi(v.x) * rstd * nw.y); o.y = pk2(bflo(v.y) * rstd * nw.z, bfhi(v.y) * rstd * nw.w);
                    *(v2u*)(Y + (size_t)(t0 + l) * DSSD + ch) = o; } }
}
}
namespace mk {
using pg8::Unit;
constexpr int MI_TSTART = 16, MI_CNT = 64;

struct Sched {
    int mode, nM, nN, nwg, G, c, lda, ldb, a_pn_off, npn;
    const bf16* A; const bf16* Bt; const int* list; const volatile LAS unsigned* misc;
    __device__ __forceinline__ void init_dense(int M, int N, int G_, int c_, const bf16* A_, int lda_, const bf16* Bt_, int ldb_, int a_pn_off_) {
        mode = 0; nM = M / 256; nN = N / 256; nwg = nM * nN; G = G_; c = c_; A = A_; Bt = Bt_; lda = lda_; ldb = ldb_; a_pn_off = a_pn_off_; npn = 0; list = nullptr; misc = nullptr; }
    __device__ __forceinline__ void init_moe(int mode_, int G_, int c_, const bf16* A_, const bf16* Bt_, const int* list_, const volatile LAS unsigned* misc_) {
        mode = mode_; G = G_; c = c_; A = A_; Bt = Bt_; lda = 1024; ldb = 1024; a_pn_off = 0; npn = (mode_ == 1) ? 8 : 4; list = list_; misc = misc_; nM = 0; nN = 0; nwg = __builtin_amdgcn_readfirstlane((int)misc_[MI_TSTART + 32]) * npn; }
    __device__ __forceinline__ bool next(int i, Unit& u) const {
        const long L = (long)i * G + c; if (L >= nwg) return false;
        if (mode == 0) {
            int wgid = (int)L; { const int q = nwg / 8, r = nwg % 8, xcd = wgid % 8, off = wgid / 8; wgid = (xcd < r ? xcd * (q + 1) : r * (q + 1) + (xcd - r) * q) + off; }
            const int nig = 8 * nN, gid = wgid / nig, fm = gid * 8, gsz = (nM - fm) < 8 ? (nM - fm) : 8;
            u.pm = fm + ((wgid % nig) % gsz); u.pn = (wgid % nig) / gsz; u.e = 0; u.i = 0; return true;
        }
        const int rt = (int)L / npn, pn = (int)L % npn; int e = 0;
        while (e < 31 && __builtin_amdgcn_readfirstlane((int)misc[MI_TSTART + e + 1]) <= rt) ++e;
        u.pm = rt; u.pn = pn; u.e = e; u.i = rt - __builtin_amdgcn_readfirstlane((int)misc[MI_TSTART + e]); return true;
    }
    __device__ __forceinline__ const char* a_base(const Unit& u) const {
        if (mode == 0) return (const char*)(A + (size_t)u.pm * 256 * lda + (size_t)u.pn * a_pn_off);
        if (mode == 1) return (const char*)A;
        return (const char*)(A + (size_t)u.pm * 256 * 1024); }
    __device__ __forceinline__ const char* b_base(const Unit& u) const {
        if (mode == 0) return (const char*)(Bt + (size_t)u.pn * 256 * ldb);
        if (mode == 1) return (const char*)(Bt + (size_t)u.e * 2048 * 1024 + (size_t)u.pn * 256 * 1024);
        return (const char*)(Bt + (size_t)u.e * 1024 * 1024 + (size_t)u.pn * 256 * 1024); }
    __device__ __forceinline__ unsigned row_off(const Unit& u, int r) const {
        const int idx = u.i * 256 + r; const int cnt = (int)misc[MI_CNT + u.e];
        const int tok = idx < cnt ? (list[(size_t)u.e * T + idx] >> 2) : 0; return (unsigned)tok * 2048u; }
};

struct EpiAll {
    static constexpr bool PERM = true;
    int kind, pad; unsigned char* ws; const float* const* in; float* out; const volatile LAS unsigned* misc;
    __device__ __forceinline__ void operator()(const pg8::f32x4 (&acc)[2][2][4][2], const Unit& u, int wr, int wc, int fr, int fq) const {
        const int rl0 = wr * 64 + fr, row0 = u.pm * 256 + rl0, cl0 = wc * 32 + 8 * fq;
        if (kind == 0) {
            bf16* base; int ld, colt; bool sg = false;
            if (u.pn < 8) { base = (bf16*)(ws + WS_Z); ld = 2048; colt = u.pn * 256; }
            else if (u.pn < 20) { base = (bf16*)(ws + WS_XBC); ld = 3072; colt = (u.pn - 8) * 256; }
            else if (u.pn < 24) { base = (bf16*)(ws + WS_U); ld = 1024; colt = (u.pn - 20) * 256; }
            else { base = (bf16*)(ws + WS_GATES); ld = 2048; colt = (u.pn - 24) * 256; sg = true; }
#pragma unroll
            for (int ai = 0; ai < 2; ++ai)
#pragma unroll
                for (int m = 0; m < 4; ++m) { bf16* rowp = base + (size_t)(row0 + ai * 128 + m * 16) * ld + colt + cl0;
#pragma unroll
                    for (int bj = 0; bj < 2; ++bj) { pg8::f32x4 v0 = acc[ai][bj][m][0], v1 = acc[ai][bj][m][1];
                        if (sg) { v0 = (pg8::f32x4){sigm(v0[0]), sigm(v0[1]), sigm(v0[2]), sigm(v0[3])}; v1 = (pg8::f32x4){sigm(v1[0]), sigm(v1[1]), sigm(v1[2]), sigm(v1[3])}; }
                        v4u w; w.x = pk2(v0[0], v0[1]); w.y = pk2(v0[2], v0[3]); w.z = pk2(v1[0], v1[1]); w.w = pk2(v1[2], v1[3]);
                        *(v4u*)(rowp + bj * 128) = w; } }
        } else if (kind == 1) {
            bf16* base = (bf16*)(ws + WS_P2); const float* ps = in[I_PSCALE];
#pragma unroll
            for (int bj = 0; bj < 2; ++bj) { const int col = u.pn * 256 + bj * 128 + cl0; const f32x4 s0 = *(const f32x4*)(ps + col), s1 = *(const f32x4*)(ps + col + 4);
#pragma unroll
                for (int ai = 0; ai < 2; ++ai)
#pragma unroll
                    for (int m = 0; m < 4; ++m) { const pg8::f32x4 v0 = acc[ai][bj][m][0] * s0, v1 = acc[ai][bj][m][1] * s1;
                        v4u w; w.x = pk2(v0[0], v0[1]); w.y = pk2(v0[2], v0[3]); w.z = pk2(v1[0], v1[1]); w.w = pk2(v1[2], v1[3]);
                        *(v4u*)(base + (size_t)(row0 + ai * 128 + m * 16) * 1024 + col) = w; } }
        } else if (kind == 2 || kind == 3) {
            const bf16* gates = (const bf16*)(ws + WS_GATES) + (kind == 3 ? 1024 : 0); bf16* m1 = (bf16*)(ws + WS_M1); bf16* mg = (bf16*)(ws + WS_MERGED);
#pragma unroll
            for (int ai = 0; ai < 2; ++ai) { v4u gq[4][2], mq[4][2];
#pragma unroll
                for (int m = 0; m < 4; ++m)
#pragma unroll
                    for (int bj = 0; bj < 2; ++bj) { const size_t row = row0 + ai * 128 + m * 16; const int col = u.pn * 256 + bj * 128 + cl0; gq[m][bj] = *(const v4u*)(gates + row * 2048 + col);
                        if (kind == 3) mq[m][bj] = *(const v4u*)(m1 + row * 1024 + col); else mq[m][bj] = (v4u){0u, 0u, 0u, 0u}; }
#pragma unroll
                for (int m = 0; m < 4; ++m)
#pragma unroll
                    for (int bj = 0; bj < 2; ++bj) { const size_t row = row0 + ai * 128 + m * 16; const int col = u.pn * 256 + bj * 128 + cl0; const v4u g4 = gq[m][bj], m4 = mq[m][bj];
                        float r[8] = {acc[ai][bj][m][0][0] * bflo(g4.x), acc[ai][bj][m][0][1] * bfhi(g4.x), acc[ai][bj][m][0][2] * bflo(g4.y), acc[ai][bj][m][0][3] * bfhi(g4.y),
                                      acc[ai][bj][m][1][0] * bflo(g4.z), acc[ai][bj][m][1][1] * bfhi(g4.z), acc[ai][bj][m][1][2] * bflo(g4.w), acc[ai][bj][m][1][3] * bfhi(g4.w)};
                        if (kind == 3) { r[0] += bflo(m4.x); r[1] += bfhi(m4.x); r[2] += bflo(m4.y); r[3] += bfhi(m4.y); r[4] += bflo(m4.z); r[5] += bfhi(m4.z); r[6] += bflo(m4.w); r[7] += bfhi(m4.w); }
                        v4u w; w.x = pk2(r[0], r[1]); w.y = pk2(r[2], r[3]); w.z = pk2(r[4], r[5]); w.w = pk2(r[6], r[7]);
                        *(v4u*)((kind == 3 ? mg : m1) + row * 1024 + col) = w; } }
        } else if (kind == 4) {
            const int b = (u.pm * 256) / SEQ; const float* ga = (const float*)(ws + WS_MOD) + b * 6144 + 2048; const float* x = in[I_X];
            f32x4 g0[2], g1[2];
#pragma unroll
            for (int bj = 0; bj < 2; ++bj) { const int col = u.pn * 256 + bj * 128 + cl0; g0[bj] = *(const f32x4*)(ga + col); g1[bj] = *(const f32x4*)(ga + col + 4); }
#pragma unroll
            for (int ai = 0; ai < 2; ++ai) { f32x4 xa[4][2], xb[4][2];
#pragma unroll
                for (int m = 0; m < 4; ++m)
#pragma unroll
                    for (int bj = 0; bj < 2; ++bj) { const size_t off = (size_t)(row0 + ai * 128 + m * 16) * 1024 + u.pn * 256 + bj * 128 + cl0; xa[m][bj] = *(const f32x4*)(x + off); xb[m][bj] = *(const f32x4*)(x + off + 4); }
#pragma unroll
                for (int m = 0; m < 4; ++m)
#pragma unroll
                    for (int bj = 0; bj < 2; ++bj) { const size_t off = (size_t)(row0 + ai * 128 + m * 16) * 1024 + u.pn * 256 + bj * 128 + cl0;
                        *(f32x4*)(out + off) = xa[m][bj] + g0[bj] * acc[ai][bj][m][0]; *(f32x4*)(out + off + 4) = xb[m][bj] + g1[bj] * acc[ai][bj][m][1]; } }
        } else if (kind == 5) {
            bf16* act = (bf16*)(ws + WS_ACT); const float* bgu = in[I_BGU] + (size_t)u.e * 2048; const int col = u.pn * 128 + cl0;
            const f32x4 bg0 = *(const f32x4*)(bgu + col), bg1 = *(const f32x4*)(bgu + col + 4), bl0 = *(const f32x4*)(bgu + 1024 + col), bl1 = *(const f32x4*)(bgu + 1024 + col + 4);
#pragma unroll
            for (int ai = 0; ai < 2; ++ai)
#pragma unroll
                for (int m = 0; m < 4; ++m) { float r[8];
#pragma unroll
                    for (int n = 0; n < 2; ++n)
#pragma unroll
                        for (int x = 0; x < 4; ++x) { float gl = acc[ai][0][m][n][x] + (n ? bg1[x] : bg0[x]), ln = acc[ai][1][m][n][x] + (n ? bl1[x] : bl0[x]);
                            gl = fminf(gl, 7.f); ln = fminf(fmaxf(ln, -7.f), 7.f); r[4 * n + x] = gl * sigm(1.702f * gl) * (ln + 1.f); }
                    v4u w; w.x = pk2(r[0], r[1]); w.y = pk2(r[2], r[3]); w.z = pk2(r[4], r[5]); w.w = pk2(r[6], r[7]);
                    *(v4u*)(act + (size_t)(row0 + ai * 128 + m * 16) * 1024 + col) = w; }
        } else {
            bf16* yb = (bf16*)(ws + WS_YB); const float* bdn = in[I_BDN] + (size_t)u.e * 1024; const int* list = (const int*)(ws + WS_LIST) + (size_t)u.e * T; const float* gate = (const float*)(ws + WS_GATE);
            const int cnt = (int)misc[MI_CNT + u.e]; int slot[2][4]; float gt[2][4];
#pragma unroll
            for (int ai = 0; ai < 2; ++ai)
#pragma unroll
                for (int m = 0; m < 4; ++m) { const int idx = u.i * 256 + rl0 + ai * 128 + m * 16; slot[ai][m] = idx < cnt ? list[idx] : -1; }
#pragma unroll
            for (int ai = 0; ai < 2; ++ai)
#pragma unroll
                for (int m = 0; m < 4; ++m) gt[ai][m] = slot[ai][m] >= 0 ? gate[slot[ai][m]] : 0.f;
            f32x4 b0[2], b1[2];
#pragma unroll
            for (int bj = 0; bj < 2; ++bj) { const int col = u.pn * 256 + bj * 128 + cl0; b0[bj] = *(const f32x4*)(bdn + col); b1[bj] = *(const f32x4*)(bdn + col + 4); }
#pragma unroll
            for (int ai = 0; ai < 2; ++ai)
#pragma unroll
                for (int m = 0; m < 4; ++m) {
                    if (slot[ai][m] >= 0) {
#pragma unroll
                        for (int bj = 0; bj < 2; ++bj) { const int col = u.pn * 256 + bj * 128 + cl0;
                            const pg8::f32x4 v0 = (acc[ai][bj][m][0] + b0[bj]) * gt[ai][m], v1 = (acc[ai][bj][m][1] + b1[bj]) * gt[ai][m];
                            v4u w; w.x = pk2(v0[0], v0[1]); w.y = pk2(v0[2], v0[3]); w.z = pk2(v1[0], v1[1]); w.w = pk2(v1[2], v1[3]);
                            *(v4u*)(yb + (size_t)slot[ai][m] * 1024 + col) = w; } } }
        }
    }
};

__device__ __forceinline__ void p6_router(Frame& F) {
    LAS float* wrT = (LAS float*)F.lds;
    LAS int* lcnt = (LAS int*)(F.lds + 131072); LAS int* lbase = lcnt + 32; LAS int* rec = lcnt + 64;
    const float* wr = F.in[I_WR];
    __syncthreads();
    for (int idx = F.tid; idx < 32768; idx += 512) { const int k = idx >> 5, e = idx & 31; wrT[e * 1024 + k] = wr[idx]; }
    for (int rb = F.vcu; rb < T / 64; rb += F.G) {
    __syncthreads();
    if (F.tid < 32) lcnt[F.tid] = 0;
    __syncthreads();
    const int rowblk = rb * 64, b = rowblk / SEQ; const float* mod = (const float*)(F.ws + WS_MOD) + b * 6144; bf16* H = (bf16*)(F.ws + WS_H);
    const float* x1 = F.out;
#pragma unroll 1
    for (int pr = 0; pr < 4; ++pr) {
        float hv[2][16]; const int rl0 = F.wave * 8 + pr * 2;
#pragma unroll
        for (int rr = 0; rr < 2; ++rr) { const size_t t = rowblk + rl0 + rr; f32x4 v[4]; float s = 0.f;
#pragma unroll
            for (int j = 0; j < 4; ++j) { v[j] = *(const f32x4*)(x1 + t * D + 4 * F.lane + 256 * j); s += (v[j].x * v[j].x + v[j].y * v[j].y) + (v[j].z * v[j].z + v[j].w * v[j].w); }
            const float rstd = rsqrtf(wave_sum(s) * (1.f / D) + EPS);
#pragma unroll
            for (int j = 0; j < 4; ++j) { const int col = 4 * F.lane + 256 * j; const f32x4 w = *(const f32x4*)(F.in[I_NFW] + col), sc = *(const f32x4*)(mod + 4096 + col), sh = *(const f32x4*)(mod + 3072 + col);
                const f32x4 h = v[j] * rstd * w * (sc + 1.f) + sh; hv[rr][4 * j] = h.x; hv[rr][4 * j + 1] = h.y; hv[rr][4 * j + 2] = h.z; hv[rr][4 * j + 3] = h.w;
                *(v2u*)(H + t * D + col) = (v2u){pk2(h.x, h.y), pk2(h.z, h.w)}; } }
        float a[64];
#pragma unroll
        for (int e = 0; e < 32; ++e) { float s0 = 0.f, s1 = 0.f;
#pragma unroll
            for (int j = 0; j < 4; ++j) { const f32x4 w = *(const LAS f32x4*)(wrT + e * 1024 + 4 * F.lane + 256 * j);
                s0 += hv[0][4 * j] * w.x + hv[0][4 * j + 1] * w.y + hv[0][4 * j + 2] * w.z + hv[0][4 * j + 3] * w.w;
                s1 += hv[1][4 * j] * w.x + hv[1][4 * j + 1] * w.y + hv[1][4 * j + 2] * w.z + hv[1][4 * j + 3] * w.w; }
            a[2 * e] = s0; a[2 * e + 1] = s1; }
#define RED_STEP(N, M) { _Pragma("unroll") for (int i = 0; i < (N) / 2; ++i) { const bool up = (F.lane & (M)) != 0; const float keep = up ? a[i + (N) / 2] : a[i], send = up ? a[i] : a[i + (N) / 2]; a[i] = keep + __shfl_xor(send, (M)); } }
        RED_STEP(64, 32) RED_STEP(32, 16) RED_STEP(16, 8) RED_STEP(8, 4) RED_STEP(4, 2) RED_STEP(2, 1)
#undef RED_STEP
        const int e = F.lane >> 1, rr = F.lane & 1; float v = a[0] + F.in[I_BR][e];
        float tv[4]; int ti[4];
#pragma unroll
        for (int r = 0; r < 4; ++r) { float m = v; int mi = e;
#pragma unroll
            for (int o = 2; o < 64; o <<= 1) { const float om = __shfl_xor(m, o); const int oi = __shfl_xor(mi, o); if (om > m || (om == m && oi < mi)) { m = om; mi = oi; } }
            tv[r] = m; ti[r] = mi; if (e == mi) v = -INFINITY; }
        if (F.lane < 2) { const float e0 = 1.f, e1 = __expf(tv[1] - tv[0]), e2 = __expf(tv[2] - tv[0]), e3 = __expf(tv[3] - tv[0]); const float inv = 1.f / (e0 + e1 + e2 + e3);
            const float gt[4] = {e0 * inv, e1 * inv, e2 * inv, e3 * inv}; const int rl = rl0 + rr;
#pragma unroll
            for (int r = 0; r < 4; ++r) { const int pos = __hip_atomic_fetch_add(lcnt + ti[r], 1, __ATOMIC_RELAXED, __HIP_MEMORY_SCOPE_WORKGROUP);
                rec[(rl * 4 + r) * 3] = ti[r]; rec[(rl * 4 + r) * 3 + 1] = pos; rec[(rl * 4 + r) * 3 + 2] = __float_as_int(gt[r]); } }
    }
    __syncthreads();
    if (F.tid < 32) lbase[F.tid] = (int)__hip_atomic_fetch_add((unsigned*)(F.ctl + CW_GCNT) + F.tid, (unsigned)lcnt[F.tid], __ATOMIC_RELAXED, __HIP_MEMORY_SCOPE_AGENT);
    __syncthreads();
    if (F.tid < 256) { const int rl = F.tid >> 2, r = F.tid & 3; const int e = rec[F.tid * 3], pos = rec[F.tid * 3 + 1]; const int slot = (rowblk + rl) * 4 + r;
        ((int*)(F.ws + WS_LIST))[(size_t)e * T + lbase[e] + pos] = slot; ((float*)(F.ws + WS_GATE))[slot] = __int_as_float(rec[F.tid * 3 + 2]); }
    }
}

__device__ __forceinline__ void moe_setup(Frame& F) {
    __syncthreads();
    if (F.tid == 0) { int acc = 0; F.MISC[MI_TSTART] = 0;
        for (int e = 0; e < 32; ++e) { const unsigned cnt = __hip_atomic_load((unsigned*)(F.ctl + CW_GCNT) + e, RLX_AGENT); F.MISC[MI_CNT + e] = cnt; acc += (int)((cnt + 255u) >> 8); F.MISC[MI_TSTART + e + 1] = (unsigned)acc; } }
    __syncthreads();
}

__device__ __forceinline__ void p9_final(Frame& F, const float dscale) {
    const bf16* YB = (const bf16*)(F.ws + WS_YB);
#pragma unroll 1
    for (size_t t = F.vcu * NWAVES + F.wave; t < (size_t)T; t += F.G * NWAVES) { const int b = (int)(t / SEQ); const float* ga = (const float*)(F.ws + WS_MOD) + b * 6144 + 5120;
        f32x4 v[4]; float s = 0.f;
#pragma unroll
        for (int j = 0; j < 4; ++j) { const int col = 4 * F.lane + 256 * j; f32x4 m = (f32x4){0.f, 0.f, 0.f, 0.f};
#pragma unroll
            for (int k = 0; k < 4; ++k) { const v2u q = *(const v2u*)(YB + (t * 4 + k) * D + col); m += (f32x4){bflo(q.x), bfhi(q.x), bflo(q.y), bfhi(q.y)}; }
            v[j] = *(const f32x4*)(F.out + t * D + col) + *(const f32x4*)(ga + col) * m; s += (v[j].x * v[j].x + v[j].y * v[j].y) + (v[j].z * v[j].z + v[j].w * v[j].w); }
        const float rstd = rsqrtf(wave_sum(s) * (1.f / D) + EPS);
#pragma unroll
        for (int j = 0; j < 4; ++j) { const int col = 4 * F.lane + 256 * j; *(f32x4*)(F.out + t * D + col) = v[j] * (rstd * dscale) * *(const f32x4*)(F.in[I_NFINAL] + col); } }
}
}
namespace mk {
#ifndef MK_N_LAUNCHES
#define MK_N_LAUNCHES 1
#endif
constexpr int NPHASES = 12;
struct Args { const float* in[25]; float* out; unsigned char* ws; int ph_lo, ph_hi, li, pad; };

__global__ void __launch_bounds__(NWAVES * 64, 2) mk_fwd(Args args) {
    extern __shared__ __attribute__((aligned(16))) unsigned char lds[];
    Frame F;
    F.lds = (LAS unsigned char*)lds; F.MISC = (volatile LAS unsigned*)(F.lds + MISC_OFF);
    F.tid = threadIdx.x; F.lane = F.tid & 63; F.wave = __builtin_amdgcn_readfirstlane(F.tid >> 6);
    F.G = gridDim.x; { const int bx = blockIdx.x; F.vcu = (F.G % 8 == 0) ? (bx % 8) * (F.G / 8) + bx / 8 : bx; }
    F.ws = args.ws; F.out = args.out; F.in = args.in; F.ctl = (gu32*)(args.ws + WS_CTL);
    for (int u = F.tid; u < (LDS_BYTES - LDSCTL_OFF) / 4; u += NWAVES * 64) ((LAS unsigned*)(F.lds + LDSCTL_OFF))[u] = 0u;
    __syncthreads();
    XcdBarrier bar = xcd_barrier_post((unsigned*)(F.ctl + CW_BAR) + args.li * XCD_BAR_WORDS, F.MISC + 0);
    const int lo = args.ph_lo, hi = args.ph_hi;
#ifndef MK_PH_MASK
#define MK_PH_MASK 0xFFF
#endif
#define IN(k) (((MK_PH_MASK >> (k)) & 1) && lo <= (k) && (k) < hi)
#define SEAM(k) do { if (IN(k) && IN((k) + 1)) xcd_barrier(bar); } while (0)
    LAS unsigned char* ring = F.lds;
    const int cid = (int)blockIdx.x;

    if (IN(0)) { p0_prologue(F); } SEAM(0);
    if (IN(1)) { p1_norm_dt(F); } SEAM(1);
    if (IN(2)) {
        Sched S; S.init_dense(T, 8192, F.G, cid, (const bf16*)(F.ws + WS_H), 1024, (const bf16*)(F.ws + WS_WIN), 1024, 0);
        EpiAll E{0, 0, F.ws, F.in, F.out, F.MISC}; __syncthreads();
        pg8::gemm_phase<EpiAll, Sched, true, true, false>(ring, 1024, 1024, 1024, S, E);
    } SEAM(2);
    if (IN(3)) {
#ifndef MK_NOPOOL
        pool_pass(F);
#endif
        asm volatile("" ::: "memory"); __builtin_amdgcn_sched_barrier(0); for (int u = F.vcu; u < 1024; u += F.G) ssd_states_unit(F, u); } SEAM(3);
    if (IN(4)) { if (args.li != 1) ssd_scan(F);
        Sched S; S.init_dense(T, 1024, F.G, cid, (const bf16*)(F.ws + WS_P), 1024, (const bf16*)(F.ws + WS_WPOOL), 256, 256);
        EpiAll E{1, 0, F.ws, F.in, F.out, F.MISC};
        __syncthreads();
        pg8::gemm_phase<EpiAll, Sched, true, true, false>(ring, 256, 1024, 256, S, E);
    } SEAM(4);
    if (IN(5)) { for (int u = F.vcu; u < 512; u += F.G) ssd_out_unit(F, u); } SEAM(5);
    if (IN(6)) {
        { Sched S; S.init_dense(T, 1024, F.G, cid, (const bf16*)(F.ws + WS_Y), 2048, (const bf16*)(F.ws + WS_WSSD), 2048, 0);
          EpiAll E{2, 0, F.ws, F.in, F.out, F.MISC}; __syncthreads();
          pg8::gemm_phase<EpiAll, Sched, true, true, false>(ring, 2048, 2048, 2048, S, E); }
        VM_WAIT(); __syncthreads();
        { Sched S; S.init_dense(T, 1024, F.G, cid, (const bf16*)(F.ws + WS_P2), 1024, (const bf16*)(F.ws + WS_WPO), 1024, 0);
          EpiAll E{3, 0, F.ws, F.in, F.out, F.MISC}; __syncthreads();
          pg8::gemm_phase<EpiAll, Sched, true, true, false>(ring, 1024, 1024, 1024, S, E); }
    } SEAM(6);
    if (IN(7)) { Sched S; S.init_dense(T, 1024, F.G, cid, (const bf16*)(F.ws + WS_MERGED), 1024, (const bf16*)(F.ws + WS_WOUT), 1024, 0);
        EpiAll E{4, 0, F.ws, F.in, F.out, F.MISC}; __syncthreads();
        pg8::gemm_phase<EpiAll, Sched, true, true, false>(ring, 1024, 1024, 1024, S, E);
    } SEAM(7);
    if (IN(8)) { p6_router(F); } SEAM(8);
    if (IN(9)) { moe_setup(F);
        Sched S; S.init_moe(1, F.G, cid, (const bf16*)(F.ws + WS_H), (const bf16*)(F.ws + WS_WGU), (const int*)(F.ws + WS_LIST), F.MISC);
        EpiAll E{5, 0, F.ws, F.in, F.out, F.MISC}; __syncthreads();
        pg8::gemm_phase<EpiAll, Sched, true, true, true>(ring, 1024, 1024, 1024, S, E);
    } SEAM(9);
    if (IN(10)) { moe_setup(F);
        Sched S; S.init_moe(2, F.G, cid, (const bf16*)(F.ws + WS_ACT), (const bf16*)(F.ws + WS_WDN), (const int*)(F.ws + WS_LIST), F.MISC);
        EpiAll E{6, 0, F.ws, F.in, F.out, F.MISC}; __syncthreads();
        pg8::gemm_phase<EpiAll, Sched, true, true, false>(ring, 1024, 1024, 1024, S, E);
    } SEAM(10);
    if (IN(11)) { p9_final(F, 1.f); }
#undef IN
#undef SEAM
}

static void run_mk(void* const* d_in, float* out, unsigned char* ws, hipStream_t stream) {
    static int grid = 0;
    if (grid == 0) {
        int dev = 0, cus = 0;
        if (hipGetDevice(&dev) != hipSuccess || hipDeviceGetAttribute(&cus, hipDeviceAttributeMultiprocessorCount, dev) != hipSuccess) { fprintf(stderr, "kernel_launch: device query failed\n"); grid = -1; return; }
        if (hipFuncSetAttribute((const void*)mk_fwd, hipFuncAttributeMaxDynamicSharedMemorySize, LDS_BYTES) != hipSuccess) { fprintf(stderr, "kernel_launch: hipFuncSetAttribute failed\n"); grid = -1; return; }
        (void)hipGetLastError();
        grid = cus;
    }
    if (grid < 0) return;
    (void)hipMemsetAsync(ws + WS_CTL, 0, CTL_ZERO_BYTES, stream);
    Args a{};
    for (int i = 0; i < 25; ++i) a.in[i] = (const float*)d_in[i];
    a.out = out; a.ws = ws;
#ifdef MK_DUP
    const int nl = 3, los[3] = {0, MK_DUP, MK_DUP + 1}, his[3] = {MK_DUP + 1, MK_DUP + 1, NPHASES};
#else
    const int nl = 1, los[1] = {0}, his[1] = {NPHASES};
#endif
    for (int li = 0; li < nl; ++li) {
        if (los[li] >= his[li]) continue;
        a.ph_lo = los[li]; a.ph_hi = his[li]; a.li = li;
        hipLaunchKernelGGL(mk_fwd, dim3(grid), dim3(NWAVES * 64), LDS_BYTES, stream, a);
    }
}
}
extern "C" void kernel_launch(void* const* d_in, const int* in_sizes, int n_in, void* d_out, int out_size, void* d_ws, size_t ws_size, hipStream_t stream) {
    mk::run_mk(d_in, (float*)d_out, (unsigned char*)d_ws, stream);
}
```

```cpp
#include <hip/hip_runtime.h>
#include <cstdio>
#include <cstdint>
#include <cmath>
namespace pg8 {
#define PG8_LAS __attribute__((address_space(3)))
typedef unsigned short bf16_t;
typedef short bf16x8 __attribute__((ext_vector_type(8)));
typedef float f32x4 __attribute__((ext_vector_type(4)));
typedef unsigned u32x4 __attribute__((ext_vector_type(4)));
typedef unsigned u32x2 __attribute__((ext_vector_type(2)));
constexpr int BM = 256, BK = 64, HALF = 128, HTB = HALF * BK * 2  , STAGE_BYTES = 8 * HTB, NXCD = 8, WGM = 8;

__host__ __device__ __forceinline__ int lds_byte(int r, int c) { const int st = (r >> 4) * 2 + (c >> 5), rr = r & 15, cc = c & 31, ob = rr * 64 + cc * 2; return st * 1024 + (ob ^ (((ob >> 9) & 1) << 5)); }
__host__ __device__ __forceinline__ void stage_rc(int b, int& R, int& C) { const int st = b / 1024, sb = b % 1024, swz = sb ^ (((sb >> 9) & 1) << 5); R = (st >> 1) * 16 + swz / 64; C = (st & 1) * 32 + (swz % 64) / 2; }
__host__ __device__ __forceinline__ int perm32(int rho) { const int n = rho >> 4, i = rho & 15; return 8 * (i >> 2) + 4 * n + (i & 3); }

struct Unit { int pm, pn, e, i; };

__device__ __forceinline__ unsigned cvt_pk_bf16(float lo, float hi) { unsigned r; asm volatile("v_cvt_pk_bf16_f32 %0, %1, %2" : "=v"(r) : "v"(lo), "v"(hi)); return r; }

struct StaticOrder {
    int nM, nN, nwg, G, c; const bf16_t* A; const bf16_t* Bt; int lda, ldb, a_pn_off, pad;
    __device__ void init(int M, int N, int G_, int c_, const bf16_t* A_, int lda_, const bf16_t* Bt_, int ldb_, int a_pn_off_) { nM = M / BM; nN = N / BM; nwg = nM * nN; G = G_; c = c_; A = A_; Bt = Bt_; lda = lda_; ldb = ldb_; a_pn_off = a_pn_off_; pad = 0; }
    __device__ bool next(int i, Unit& u) const {
        const long L = (long)i * G + c; if (L >= nwg) return false;
        int wgid = (int)L; { const int q = nwg / NXCD, r = nwg % NXCD, xcd = wgid % NXCD, off = wgid / NXCD; wgid = (xcd < r ? xcd * (q + 1) : r * (q + 1) + (xcd - r) * q) + off; }
        const int nig = WGM * nN, gid = wgid / nig, fm = gid * WGM, gsz = (nM - fm) < WGM ? (nM - fm) : WGM;
        u.pm = fm + ((wgid % nig) % gsz); u.pn = (wgid % nig) / gsz; u.e = 0; u.i = 0; return true;
    }
    __device__ __forceinline__ const char* a_base(const Unit& u) const { return (const char*)(A + (size_t)u.pm * BM * lda + (size_t)u.pn * a_pn_off); }
    __device__ __forceinline__ const char* b_base(const Unit& u) const { return (const char*)(Bt + (size_t)u.pn * BM * ldb); }
    __device__ __forceinline__ unsigned row_off(const Unit&, int) const { return 0u; }
};

typedef int v8i32 __attribute__((ext_vector_type(8))); typedef int i32x4 __attribute__((ext_vector_type(4)));
template <class Epi, class Sched, bool ALIGN_EPI, bool SP2, bool GATHER, bool FP8>
__device__ __forceinline__ void gemm_phase(PG8_LAS unsigned char* lds, const int K, const int lda, const int ldb, const Sched& S, const Epi& E) {
    int tid_ = threadIdx.x; asm volatile("" : "+v"(tid_));
    const int tid = tid_, wid = __builtin_amdgcn_readfirstlane(tid >> 6), lane = tid & 63, wr = wid >> 2, wc = wid & 3, fr = lane & 15, fq = lane >> 4;
    const int nt = K / BK;
    unsigned voffA[2][2], voffN[2][2], voffB[2];
#pragma unroll
    for (int i = 0; i < 2; ++i) { int R, C; stage_rc(tid * 16 + i * 8192, R, C); const int Rb = Epi::PERM ? ((R & ~31) + perm32(R & 31)) : R;
        voffA[0][i] = GATHER ? (unsigned)C * 2u : (unsigned)(R * lda + C) * 2u; voffA[1][i] = voffA[0][i]; voffN[0][i] = 0; voffN[1][i] = 0; voffB[i] = (unsigned)(Rb * ldb + C) * 2u; }
    const size_t kstep = (size_t)(BK * 2);
    const size_t hstepA = GATHER ? 0 : (size_t)HALF * lda * 2;
    const size_t hstepB = (size_t)HALF * ldb * 2;
    const unsigned ldsw = (unsigned)wid * 1024u;
    const int aoff = lds_byte(wr * 64 + fr, fq * 8), boff = lds_byte(wc * 32 + fr, fq * 8);
#define PG8_SA(b, h) (((b) * 2 + (h)) * HTB)
#define PG8_SB(b, h) ((4 + (b) * 2 + (h)) * HTB)
#define PG8_STAGE_B(bufoff, gbase) do { _Pragma("unroll") for (int _i = 0; _i < 2; ++_i) \
        __builtin_amdgcn_global_load_lds((const unsigned*)((const char*)(gbase) + voffB[_i]), (PG8_LAS unsigned*)(lds + (bufoff) + ldsw + _i * 8192), 16, 0, 0); } while (0)
#define PG8_STAGE_A(bufoff, gbase, h) do { _Pragma("unroll") for (int _i = 0; _i < 2; ++_i) \
        __builtin_amdgcn_global_load_lds((const unsigned*)((const char*)(gbase) + (h) * hstepA + voffA[GATHER ? (h) : 0][_i]), (PG8_LAS unsigned*)(lds + (bufoff) + ldsw + _i * 8192), 16, 0, 0); } while (0)
#define PG8_LDA(dst, b, h) do { _Pragma("unroll") for (int m = 0; m < 4; ++m) _Pragma("unroll") for (int k = 0; k < 2; ++k) dst[m][k] = *(const PG8_LAS bf16x8*)(lds + PG8_SA(b, h) + aoff + m * 2048 + k * 1024); } while (0)
#define PG8_LDB(dst, b, h) do { _Pragma("unroll") for (int n = 0; n < 2; ++n) _Pragma("unroll") for (int k = 0; k < 2; ++k) dst[n][k] = *(const PG8_LAS bf16x8*)(lds + PG8_SB(b, h) + boff + n * 2048 + k * 1024); } while (0)
#define PG8_CAT(x) (__builtin_shufflevector(__builtin_bit_cast(i32x4, x[0]), __builtin_bit_cast(i32x4, x[1]), 0, 1, 2, 3, 4, 5, 6, 7))
#define PG8_MMA(ai, bj, At, Bt) do { __builtin_amdgcn_s_setprio(1); _Pragma("unroll") for (int m = 0; m < 4; ++m) _Pragma("unroll") for (int n = 0; n < 2; ++n) { \
        if constexpr (FP8) acc[ai][bj][m][n] = __builtin_amdgcn_mfma_scale_f32_16x16x128_f8f6f4(PG8_CAT(Bt[n]), PG8_CAT(At[m]), acc[ai][bj][m][n], 0, 0, 0, 0x7f7f7f7f, 0, 0x7f7f7f7f); \
        else { _Pragma("unroll") for (int k = 0; k < 2; ++k) acc[ai][bj][m][n] = __builtin_amdgcn_mfma_f32_16x16x32_bf16(Bt[n][k], At[m][k], acc[ai][bj][m][n], 0, 0, 0); } } __builtin_amdgcn_s_setprio(0); } while (0)
#define PG8_WAIT_V(n) asm volatile("s_waitcnt vmcnt(" #n ")" ::: "memory")
#define PG8_WAIT_L(n) asm volatile("s_waitcnt lgkmcnt(" #n ")" ::: "memory")
#define PG8_BAR __builtin_amdgcn_s_barrier()
#define PG8_SCHED __builtin_amdgcn_sched_barrier(0)
#define PG8_GATHER_OFFS(dst, u) do { _Pragma("unroll") for (int _i = 0; _i < 2; ++_i) { int R_, C_; stage_rc(tid * 16 + _i * 8192, R_, C_); _Pragma("unroll") for (int _h = 0; _h < 2; ++_h) dst[_h][_i] = S.row_off(u, _h * HALF + R_) + (unsigned)C_ * 2u; } } while (0)
    Unit cur, nxt; int ui = 0;
    if (!S.next(0, cur)) return;
    f32x4 acc[2][2][4][2];
#pragma unroll
    for (int a = 0; a < 2; ++a)
#pragma unroll
        for (int b = 0; b < 2; ++b)
#pragma unroll
            for (int m = 0; m < 4; ++m)
#pragma unroll
                for (int n = 0; n < 2; ++n) acc[a][b][m][n] = (f32x4){0.f, 0.f, 0.f, 0.f};
    bf16x8 At[4][2], B0[2][2], B1[2][2];
    const char* cA = S.a_base(cur); const char* cB = S.b_base(cur);
    if constexpr (GATHER) { PG8_GATHER_OFFS(voffA, cur); }
    if constexpr (SP2) {
        PG8_STAGE_B(PG8_SB(0, 0), cB); PG8_STAGE_B(PG8_SB(0, 1), cB + hstepB); PG8_STAGE_A(PG8_SA(0, 0), cA, 0); PG8_STAGE_A(PG8_SA(0, 1), cA, 1);
        if (wr == 1) PG8_BAR;
        PG8_WAIT_V(2); PG8_BAR;
        PG8_STAGE_B(PG8_SB(1, 0), cB + kstep); PG8_STAGE_A(PG8_SA(1, 0), cA + kstep, 0); PG8_STAGE_B(PG8_SB(1, 1), cB + hstepB + kstep);
        PG8_WAIT_V(6); PG8_BAR;
    } else {
        PG8_STAGE_B(PG8_SB(0, 0), cB); PG8_STAGE_A(PG8_SA(0, 0), cA, 0); PG8_STAGE_B(PG8_SB(0, 1), cB + hstepB); PG8_STAGE_A(PG8_SA(0, 1), cA, 1);
        if (wr == 1) PG8_BAR;
        PG8_WAIT_V(4); PG8_BAR;
        PG8_STAGE_B(PG8_SB(1, 0), cB + kstep); PG8_STAGE_A(PG8_SA(1, 0), cA + kstep, 0); PG8_STAGE_B(PG8_SB(1, 1), cB + hstepB + kstep);
        PG8_WAIT_V(6); PG8_BAR;
    }
    for (;;) {
        const bool has_next = S.next(ui + 1, nxt);
        const char* nA = has_next ? S.a_base(nxt) : cA; const char* nB = has_next ? S.b_base(nxt) : cB;
#pragma unroll 1
        for (int t = 0; t < nt; t += 2) {
            const bool last = (t == nt - 2);
            const char* a1 = cA + (size_t)(t + 1) * kstep;
            const char* a2 = last ? nA : cA + (size_t)(t + 2) * kstep; const char* b2 = last ? nB : cB + (size_t)(t + 2) * kstep;
            const char* a3 = a2 + kstep; const char* b3 = b2 + kstep;
            if constexpr (GATHER) { if (last && has_next) { PG8_GATHER_OFFS(voffN, nxt); } }
            if constexpr (SP2) {
            PG8_LDB(B0, 0, 0); PG8_LDB(B1, 0, 1); PG8_SCHED; PG8_LDA(At, 0, 0); PG8_STAGE_A(PG8_SA(1, 1), a1, 1);
            PG8_WAIT_V(8); PG8_WAIT_L(0); PG8_BAR; PG8_MMA(0, 0, At, B0); PG8_MMA(0, 1, At, B1); PG8_BAR; PG8_SCHED;
            if constexpr (GATHER) { if (last && has_next) {
#pragma unroll
                for (int _h = 0; _h < 2; ++_h)
#pragma unroll
                    for (int _i = 0; _i < 2; ++_i) voffA[_h][_i] = voffN[_h][_i]; } }
            PG8_LDA(At, 0, 1); PG8_STAGE_B(PG8_SB(0, 0), b2); PG8_STAGE_B(PG8_SB(0, 1), b2 + hstepB); PG8_STAGE_A(PG8_SA(0, 0), a2, 0);
            PG8_WAIT_V(8); PG8_WAIT_L(0); PG8_BAR; PG8_MMA(1, 0, At, B0); PG8_MMA(1, 1, At, B1); PG8_BAR; PG8_SCHED;
            PG8_LDB(B0, 1, 0); PG8_LDB(B1, 1, 1); PG8_SCHED; PG8_LDA(At, 1, 0); PG8_STAGE_A(PG8_SA(0, 1), a2, 1);
            PG8_WAIT_V(8); PG8_WAIT_L(0); PG8_BAR; PG8_MMA(0, 0, At, B0); PG8_MMA(0, 1, At, B1); PG8_BAR; PG8_SCHED;
            PG8_LDA(At, 1, 1); PG8_STAGE_B(PG8_SB(1, 0), b3); PG8_STAGE_B(PG8_SB(1, 1), b3 + hstepB); PG8_STAGE_A(PG8_SA(1, 0), a3, 0);
            PG8_WAIT_V(8); PG8_WAIT_L(0); PG8_BAR; PG8_MMA(1, 0, At, B0); PG8_MMA(1, 1, At, B1); PG8_BAR; PG8_SCHED;
            } else {
            PG8_LDB(B0, 0, 0); PG8_SCHED; PG8_LDA(At, 0, 0); PG8_STAGE_A(PG8_SA(1, 1), a1, 1);
            PG8_WAIT_L(8); PG8_BAR; PG8_WAIT_L(0); PG8_MMA(0, 0, At, B0); PG8_BAR; PG8_SCHED;
            if constexpr (GATHER) { if (last && has_next) {
#pragma unroll
                for (int _h = 0; _h < 2; ++_h)
#pragma unroll
                    for (int _i = 0; _i < 2; ++_i) voffA[_h][_i] = voffN[_h][_i]; } }
            PG8_LDB(B1, 0, 1); PG8_STAGE_B(PG8_SB(0, 0), b2);
            PG8_BAR; PG8_WAIT_L(0); PG8_MMA(0, 1, At, B1); PG8_BAR;
            PG8_LDA(At, 0, 1); PG8_STAGE_A(PG8_SA(0, 0), a2, 0);
            PG8_BAR; PG8_WAIT_L(0); PG8_MMA(1, 0, At, B0); PG8_BAR; PG8_SCHED;
            PG8_STAGE_B(PG8_SB(0, 1), b2 + hstepB);
            PG8_WAIT_V(6); PG8_BAR; PG8_MMA(1, 1, At, B1); PG8_BAR;
            PG8_LDB(B0, 1, 0); PG8_SCHED; PG8_LDA(At, 1, 0); PG8_STAGE_A(PG8_SA(0, 1), a2, 1);
            PG8_WAIT_L(8); PG8_BAR; PG8_WAIT_L(0); PG8_MMA(0, 0, At, B0); PG8_BAR; PG8_SCHED;
            PG8_LDB(B1, 1, 1); PG8_STAGE_B(PG8_SB(1, 0), b3);
            PG8_BAR; PG8_WAIT_L(0); PG8_MMA(0, 1, At, B1); PG8_BAR;
            PG8_LDA(At, 1, 1); PG8_STAGE_A(PG8_SA(1, 0), a3, 0);
            PG8_BAR; PG8_WAIT_L(0); PG8_MMA(1, 0, At, B0); PG8_BAR; PG8_SCHED;
            PG8_STAGE_B(PG8_SB(1, 1), b3 + hstepB);
            PG8_WAIT_V(6); PG8_BAR; PG8_MMA(1, 1, At, B1); PG8_BAR;
            }
        }
        if constexpr (ALIGN_EPI) { if (wr == 0) PG8_BAR; }
        E(acc, cur, wr, wc, fr, fq);
        if (!has_next) break;
#pragma unroll
        for (int a = 0; a < 2; ++a)
#pragma unroll
            for (int b = 0; b < 2; ++b)
#pragma unroll
                for (int m = 0; m < 4; ++m)
#pragma unroll
                    for (int n = 0; n < 2; ++n) acc[a][b][m][n] = (f32x4){0.f, 0.f, 0.f, 0.f};
        cur = nxt; cA = nA; cB = nB; ++ui;
        if constexpr (ALIGN_EPI) { if (wr == 1) PG8_BAR; }
    }
    PG8_WAIT_V(0);
    if constexpr (!ALIGN_EPI) { if (wr == 0) PG8_BAR; }
    PG8_BAR;
#undef PG8_SA
#undef PG8_SB
#undef PG8_STAGE_A
#undef PG8_STAGE_B
#undef PG8_LDA
#undef PG8_LDB
#undef PG8_MMA
#undef PG8_CAT
#undef PG8_WAIT_V
#undef PG8_WAIT_L
#undef PG8_BAR
#undef PG8_SCHED
#undef PG8_GATHER_OFFS
}
}
namespace mk {
constexpr int NWAVES = 8;
constexpr int T = 16384, D = 1024, SEQ = 4096, NB = 4, NE = 32, NH = 32;
constexpr int DSSD = 2048, DCONV = 3072, NPROJ = 8224;
constexpr float EPS = 1e-5f;
constexpr size_t MiB = 1u << 20;
constexpr size_t WS_CTL = 0, CTL_ZERO_BYTES = 256 * 1024;
constexpr size_t WS_MOD = 128 * 1024;
constexpr size_t WS_CD = 1 * MiB;
constexpr size_t WS_GATE = 1 * MiB + 256 * 1024;
constexpr size_t WS_DT = 2 * MiB;
constexpr size_t WS_LIST = 4 * MiB;
constexpr size_t WS_WDT = 6 * MiB;
constexpr size_t WS_WPOOL = 6 * MiB + 512 * 1024;
constexpr size_t WS_WIN = 8 * MiB, WS_WSSD = 24 * MiB, WS_WPO = 28 * MiB, WS_WOUT = 30 * MiB, WS_WGU = 32 * MiB, WS_WDN = 160 * MiB;
constexpr size_t WS_H = 224 * MiB, WS_Z = 256 * MiB, WS_XBC = 320 * MiB, WS_U = 416 * MiB, WS_GATES = 448 * MiB, WS_STATES = 512 * MiB, WS_Y = 576 * MiB;
constexpr size_t WS_P = 640 * MiB, WS_P2 = 672 * MiB, WS_M1 = 704 * MiB, WS_MERGED = 736 * MiB, WS_END = 768 * MiB;
constexpr size_t WS_XC = 768 * MiB;
constexpr size_t WS_ACT = 256 * MiB, WS_YB = 416 * MiB;
constexpr int ACT_ROWS = 73728;
constexpr int CW_TMO = 0, CW_CODE = 1, CW_GCNT = 1024, CW_BAR = 4096;
constexpr int RING_BYTES = 143360;
constexpr int LDSCTL_OFF = RING_BYTES, MISC_OFF = LDSCTL_OFF + 64;
constexpr int LDS_BYTES = 147456;

#define GAS __attribute__((address_space(1)))
#define LAS __attribute__((address_space(3)))
typedef unsigned short bf16;
typedef unsigned v4u __attribute__((ext_vector_type(4)));
typedef unsigned v2u __attribute__((ext_vector_type(2)));
typedef float f32x4 __attribute__((ext_vector_type(4)));
typedef float f32x16 __attribute__((ext_vector_type(16)));
typedef short bf16x8 __attribute__((ext_vector_type(8)));
typedef GAS unsigned gu32;
#define RLX_AGENT __ATOMIC_RELAXED, __HIP_MEMORY_SCOPE_AGENT
#define LDS_WAIT() asm volatile("s_waitcnt lgkmcnt(0)" ::: "memory")
#define VM_WAIT() asm volatile("s_waitcnt vmcnt(0)" ::: "memory")
__device__ __forceinline__ unsigned f2bf(float f) { unsigned u = __builtin_bit_cast(unsigned, f); return (u + 0x7fffu + ((u >> 16) & 1u)) >> 16; }
typedef float f32x2_t __attribute__((ext_vector_type(2))); typedef __bf16 bf16x2_t __attribute__((ext_vector_type(2)));
__device__ __forceinline__ unsigned pk2(float lo, float hi) { const f32x2_t v = {lo, hi}; const bf16x2_t b = __builtin_convertvector(v, bf16x2_t); return __builtin_bit_cast(unsigned, b); }
__device__ __forceinline__ float bflo(unsigned w) { return __builtin_bit_cast(float, w << 16); }
__device__ __forceinline__ float bfhi(unsigned w) { return __builtin_bit_cast(float, w & 0xffff0000u); }
__device__ __forceinline__ float bf2f(bf16 h) { return __builtin_bit_cast(float, (unsigned)h << 16); }
__device__ __forceinline__ float sigm(float x) { return __builtin_amdgcn_rcpf(1.f + __builtin_amdgcn_exp2f(x * -1.4426950408889634f)); }
__device__ __forceinline__ float silu(float x) { return x * sigm(x); }
__device__ __forceinline__ float wave_sum(float v) {
#pragma unroll
    for (int o = 1; o < 64; o <<= 1) v += __shfl_xor(v, o);
    return v;
}

#define XB_TMO      128
#define XB_XCNT(j)  (256  + 64 * (j))
#define XB_XSUB(j)  (1280 + 64 * (j))
#define XB_XGEN(j)  (2304 + 64 * (j))
#define XB_TOP      3328
#define XB_TOPGEN   3392
#define XCD_BAR_WORDS 3456
#define XB_SPIN_CAP (1u << 18)
__device__ __forceinline__ unsigned xb_ld(unsigned* p)              { return __hip_atomic_load(p, __ATOMIC_RELAXED, __HIP_MEMORY_SCOPE_AGENT); }
__device__ __forceinline__ unsigned xb_add(unsigned* p, unsigned v) { return __hip_atomic_fetch_add(p, v, __ATOMIC_RELAXED, __HIP_MEMORY_SCOPE_AGENT); }
__device__ __forceinline__ unsigned xb_xcc_id() { return (unsigned)__builtin_amdgcn_s_getreg((3 << 11) | 20) & 0xFu; }
#define XB_SPIN(cond, bar) do { unsigned _sp = 0; while (cond) { __builtin_amdgcn_s_sleep(1); \
    if ((++_sp & 255u) == 0u) { if (xb_ld(&(bar)[XB_TMO])) break; if (_sp > XB_SPIN_CAP) { atomicAdd(&(bar)[XB_TMO], 1u); break; } } } } while (0)
struct XcdBarrier { unsigned* bar; unsigned x; volatile LAS unsigned* st; };
__device__ __forceinline__ XcdBarrier xcd_barrier_post(unsigned* bar, volatile LAS unsigned* st) {
    XcdBarrier b; b.bar = bar; b.x = xb_xcc_id(); b.st = st;
    if (threadIdx.x == 0) (void)xb_add(&bar[XB_XCNT(b.x)], 1u);
    return b;
}
__device__ __forceinline__ void xcd_barrier_complete(unsigned* bar, unsigned x, unsigned& nloc, unsigned& nx) {
    const unsigned G = gridDim.x * gridDim.y * gridDim.z;
    unsigned sum, cnt, mine, sp = 0u;
    for (;;) {
        sum = 0u; cnt = 0u; mine = 0u;
#pragma unroll
        for (unsigned j = 0; j < 16; ++j) { const unsigned c = xb_ld(&bar[XB_XCNT(j)]); sum += c; cnt += (c > 0u) ? 1u : 0u; mine = (j == x) ? c : mine; }
        if (sum == G) break;
        __builtin_amdgcn_s_sleep(1);
        if ((++sp & 255u) == 0u) { if (xb_ld(&bar[XB_TMO])) break; if (sp > XB_SPIN_CAP) { atomicAdd(&bar[XB_TMO], 1u); break; } }
    }
    nloc = mine > 0u ? mine : 1u; nx = cnt > 0u ? cnt : 1u;
}
__device__ __forceinline__ void xcd_barrier(const XcdBarrier& b) {
    asm volatile("s_waitcnt vmcnt(0)" ::: "memory");
    __syncthreads();
    if (threadIdx.x == 0) {
        unsigned* bar = b.bar;
        __builtin_amdgcn_s_waitcnt(0);
        unsigned nloc = b.st[0], nx = b.st[1];
        if (nloc == 0u) { xcd_barrier_complete(bar, b.x, nloc, nx); b.st[0] = nloc; b.st[1] = nx; }
        const unsigned old = xb_add(&bar[XB_XSUB(b.x)], 1u);
        const unsigned gen = old / nloc;
        if (old + 1u == (gen + 1u) * nloc) {
            __builtin_amdgcn_fence(__ATOMIC_RELEASE, "agent");
            asm volatile("s_waitcnt vmcnt(0)" ::: "memory");
            const unsigned og = xb_add(&bar[XB_TOP], 1u);
            const unsigned tg = og / nx;
            if (og + 1u == (tg + 1u) * nx) xb_add(&bar[XB_TOPGEN], 1u);
            else XB_SPIN(xb_ld(&bar[XB_TOPGEN]) == tg, bar);
            __builtin_amdgcn_fence(__ATOMIC_ACQUIRE, "agent");
            xb_add(&bar[XB_XGEN(b.x)], 1u);
            asm volatile("s_waitcnt vmcnt(0)" ::: "memory");
        } else {
            XB_SPIN(xb_ld(&bar[XB_XGEN(b.x)]) == gen, bar);
            __builtin_amdgcn_fence(__ATOMIC_ACQUIRE, "agent");
            asm volatile("s_waitcnt vmcnt(0)" ::: "memory");
        }
    }
    __syncthreads();
}
}
namespace mk {
struct Frame {
    LAS unsigned char* lds; volatile LAS unsigned* MISC; gu32* ctl; unsigned char* ws; float* out; const float* const* in;
    int tid, lane, wave, vcu, G;
};
enum { I_X = 0, I_C, I_WADA, I_BADA, I_NMW, I_WIN, I_CONVW, I_CONVB, I_DTB, I_ALOG, I_DSKIP, I_SNW, I_WSSD, I_WPOOL, I_PSCALE, I_WPO, I_WOUT, I_NFW, I_WR, I_BR, I_WGU, I_BGU, I_WDN, I_BDN, I_NFINAL };

__device__ __forceinline__ void p0_tile(const float* src, int ldsrc, int srccol0, int k0, bf16* dst, int lddst, int dstrow0, int nvalid, LAS float* scr, int lane) {
    const int col = (lane & 15) * 4;
#pragma unroll 4
    for (int i = 0; i < 16; ++i) { const int kk = 4 * i + (lane >> 4);
        f32x4 v = (f32x4){0.f, 0.f, 0.f, 0.f};
        if (col < nvalid) v = *(const f32x4*)(src + (size_t)(k0 + kk) * ldsrc + srccol0 + col);
        LAS float* s = scr + kk * 65 + col; s[0] = v.x; s[1] = v.y; s[2] = v.z; s[3] = v.w; }
    LDS_WAIT(); asm volatile("" ::: "memory");
    const int c = lane & 7;
#pragma unroll
    for (int j = 0; j < 8; ++j) { const int n = (lane >> 3) + 8 * j; const LAS float* s = scr + (8 * c) * 65 + n;
        v4u o; o.x = pk2(s[0 * 65], s[1 * 65]); o.y = pk2(s[2 * 65], s[3 * 65]); o.z = pk2(s[4 * 65], s[5 * 65]); o.w = pk2(s[6 * 65], s[7 * 65]);
        if (n < nvalid) *(v4u*)(dst + (size_t)(dstrow0 + n) * lddst + k0 + 8 * c) = o; }
    LDS_WAIT(); asm volatile("" ::: "memory");
}
__device__ __forceinline__ void p0_tile8(const float* src, int ldsrc, int srccol0, int k0, unsigned char* dst, int lddst, int dstrow0, float scale, LAS float* scr, int lane) {
    const int col = (lane & 15) * 4;
#pragma unroll 4
    for (int i = 0; i < 16; ++i) { const int kk = 4 * i + (lane >> 4);
        const f32x4 v = *(const f32x4*)(src + (size_t)(k0 + kk) * ldsrc + srccol0 + col);
        LAS float* s = scr + kk * 65 + col; s[0] = v.x; s[1] = v.y; s[2] = v.z; s[3] = v.w; }
    LDS_WAIT(); asm volatile("" ::: "memory");
    const int c = lane & 7;
#pragma unroll
    for (int j = 0; j < 8; ++j) { const int n = (lane >> 3) + 8 * j; const LAS float* s = scr + (8 * c) * 65 + n;
        int w0 = 0, w1 = 0; w0 = __builtin_amdgcn_cvt_pk_fp8_f32(s[0 * 65] * scale, s[1 * 65] * scale, w0, false); w0 = __builtin_amdgcn_cvt_pk_fp8_f32(s[2 * 65] * scale, s[3 * 65] * scale, w0, true);
        w1 = __builtin_amdgcn_cvt_pk_fp8_f32(s[4 * 65] * scale, s[5 * 65] * scale, w1, false); w1 = __builtin_amdgcn_cvt_pk_fp8_f32(s[6 * 65] * scale, s[7 * 65] * scale, w1, true);
        *(v2u*)(dst + (size_t)(dstrow0 + n) * lddst + k0 + 8 * c) = (v2u){(unsigned)w0, (unsigned)w1}; }
    LDS_WAIT(); asm volatile("" ::: "memory");
}
__device__ __forceinline__ void p0_prologue(Frame& F) {
    LAS float* scr = (LAS float*)(F.lds + F.wave * 16896);
    const int gw = F.vcu * NWAVES + F.wave, NGW = F.G * NWAVES;
    bf16* WIN_T = (bf16*)(F.ws + WS_WIN); bf16* WDT_T = (bf16*)(F.ws + WS_WDT); bf16* WSSD_T = (bf16*)(F.ws + WS_WSSD); bf16* WPO_T = (bf16*)(F.ws + WS_WPO);
    bf16* WOUT_T = (bf16*)(F.ws + WS_WOUT); bf16* WPOOL_T = (bf16*)(F.ws + WS_WPOOL); bf16* WGU_T = (bf16*)(F.ws + WS_WGU); bf16* WDN_T = (bf16*)(F.ws + WS_WDN);
    constexpr int N_IN = 2048, N_DT = 16, N_SSD = 512, N_PO = 256, N_OUT = 256, N_POOL = 64, N_GU = 16384, N_DN = 8192;
    constexpr int NITEMS = N_IN + N_DT + N_SSD + N_PO + N_OUT + N_POOL + N_GU + N_DN;
    for (int it = gw; it < NITEMS; it += NGW) {
        int r = it;
        if (r < N_GU) { const int e = r >> 9, q = r & 511, rb = q >> 4, kb = q & 15; const int rho = rb * 64, pn = rho >> 8, rr = rho & 255;
            const int sc = rr < 128 ? 128 * pn + rr : 1024 + 128 * pn + (rr - 128);
            p0_tile8(F.in[I_WGU] + (size_t)e * 1024 * 2048, 2048, sc, kb * 64, (unsigned char*)WGU_T + (size_t)e * 2048 * 1024, 1024, rho, 32.f, scr, F.lane); continue; } r -= N_GU;
        if (r < N_DN) { const int e = r >> 8, q = r & 255, rb = q >> 4, kb = q & 15;
            p0_tile8(F.in[I_WDN] + (size_t)e * 1024 * 1024, 1024, rb * 64, kb * 64, (unsigned char*)WDN_T + (size_t)e * 1024 * 1024, 1024, rb * 64, 32.f, scr, F.lane); continue; } r -= N_DN;
        if (r < N_IN) { const int rb = r >> 4, kb = r & 15; const int drow = rb * 64; const int sc = drow + (drow >= 5120 ? 32 : 0);
            p0_tile(F.in[I_WIN], NPROJ, sc, kb * 64, WIN_T, 1024, drow, 64, scr, F.lane); continue; } r -= N_IN;
        if (r < N_DT) { p0_tile(F.in[I_WIN], NPROJ, 5120, r * 64, WDT_T, 1024, 0, 32, scr, F.lane); continue; } r -= N_DT;
        if (r < N_SSD) { const int rb = r >> 5, kb = r & 31; p0_tile(F.in[I_WSSD], 1024, rb * 64, kb * 64, WSSD_T, 2048, rb * 64, 64, scr, F.lane); continue; } r -= N_SSD;
        if (r < N_PO) { const int rb = r >> 4, kb = r & 15; p0_tile(F.in[I_WPO], 1024, rb * 64, kb * 64, WPO_T, 1024, rb * 64, 64, scr, F.lane); continue; } r -= N_PO;
        if (r < N_OUT) { const int rb = r >> 4, kb = r & 15; p0_tile(F.in[I_WOUT], 1024, rb * 64, kb * 64, WOUT_T, 1024, rb * 64, 64, scr, F.lane); continue; } r -= N_OUT;
        { const int g = r >> 4, q = r & 15, rb = q >> 2, kb = q & 3; p0_tile(F.in[I_WPOOL] + (size_t)g * 65536, 256, rb * 64, kb * 64, WPOOL_T, 256, g * 256 + rb * 64, 64, scr, F.lane); }
    }
    __syncthreads();
    { float* mod = (float*)(F.ws + WS_MOD); LAS float* red = (LAS float*)F.lds;
      for (int jb = F.vcu; jb < 256; jb += F.G) {
        const int jj = F.tid & 31, sl = F.tid >> 5, j = jb * 24 + jj; float a0 = 0.f, a1 = 0.f, a2 = 0.f, a3 = 0.f; const float* cc = F.in[I_C];
        if (jj < 24) {
#pragma unroll 8
            for (int k = sl * 64; k < sl * 64 + 64; ++k) { const float w = F.in[I_WADA][(size_t)k * 6144 + j];
                a0 += silu(cc[k]) * w; a1 += silu(cc[1024 + k]) * w; a2 += silu(cc[2048 + k]) * w; a3 += silu(cc[3072 + k]) * w; } }
        red[(sl * 4 + 0) * 32 + jj] = a0; red[(sl * 4 + 1) * 32 + jj] = a1; red[(sl * 4 + 2) * 32 + jj] = a2; red[(sl * 4 + 3) * 32 + jj] = a3;
        __syncthreads();
        if (F.tid < 128) { const int b = F.tid >> 5, q = F.tid & 31; if (q < 24) { float s = F.in[I_BADA][jb * 24 + q];
#pragma unroll
                for (int i = 0; i < 16; ++i) s += red[(i * 4 + b) * 32 + q];
                mod[b * 6144 + jb * 24 + q] = s; } }
        __syncthreads();
      } }
}

__device__ __forceinline__ void p1_norm_dt(Frame& F) {
    constexpr int PITCH = 2064;
    LAS unsigned char* tile = F.lds + F.wave * (8 * PITCH);
    for (int grp = F.vcu * NWAVES + F.wave; grp < T / 8; grp += F.G * NWAVES) {
    const int t0 = grp * 8, b = t0 / SEQ;
    const float* mod = (const float*)(F.ws + WS_MOD) + b * 6144; bf16* H = (bf16*)(F.ws + WS_H);
    f32x4 wv[4], scv[4], shv[4];
#pragma unroll
    for (int j = 0; j < 4; ++j) { const int col = 4 * F.lane + 256 * j; wv[j] = *(const f32x4*)(F.in[I_NMW] + col); scv[j] = *(const f32x4*)(mod + 1024 + col); shv[j] = *(const f32x4*)(mod + col); }
#pragma unroll 1
    for (int r = 0; r < 8; ++r) {
        const float* xr = F.in[I_X] + (size_t)(t0 + r) * D; f32x4 v[4]; float s = 0.f;
#pragma unroll
        for (int j = 0; j < 4; ++j) { v[j] = *(const f32x4*)(xr + 4 * F.lane + 256 * j); s += (v[j].x * v[j].x + v[j].y * v[j].y) + (v[j].z * v[j].z + v[j].w * v[j].w); }
        const float rstd = rsqrtf(wave_sum(s) * (1.f / D) + EPS);
#pragma unroll
        for (int j = 0; j < 4; ++j) { const f32x4 hv = v[j] * rstd * wv[j] * (scv[j] + 1.f) + shv[j];
            v2u o; o.x = pk2(hv.x, hv.y); o.y = pk2(hv.z, hv.w);
            *(v2u*)(H + (size_t)(t0 + r) * D + 4 * F.lane + 256 * j) = o;
            *(LAS v2u*)(tile + r * PITCH + (4 * F.lane + 256 * j) * 2) = o; }
    }
    LDS_WAIT(); asm volatile("" ::: "memory");
    const bf16* WDT_T = (const bf16*)(F.ws + WS_WDT);
    f32x4 acc0 = (f32x4){0.f, 0.f, 0.f, 0.f}, acc1 = acc0; const int fr = F.lane & 15, fq = F.lane >> 4;
#pragma unroll 4
    for (int s = 0; s < 32; ++s) {
        const bf16x8 a = *(const LAS bf16x8*)(tile + (fr & 7) * PITCH + (32 * s + 8 * fq) * 2);
        const bf16x8 b0 = *(const bf16x8*)(WDT_T + (size_t)fr * 1024 + 32 * s + 8 * fq), b1 = *(const bf16x8*)(WDT_T + (size_t)(fr + 16) * 1024 + 32 * s + 8 * fq);
        acc0 = __builtin_amdgcn_mfma_f32_16x16x32_bf16(a, b0, acc0, 0, 0, 0); acc1 = __builtin_amdgcn_mfma_f32_16x16x32_bf16(a, b1, acc1, 0, 0, 0);
    }
    if (fq < 2) { float* DT = (float*)(F.ws + WS_DT); const float db0 = F.in[I_DTB][fr], db1 = F.in[I_DTB][fr + 16];
#pragma unroll
        for (int i = 0; i < 4; ++i) { const int row = t0 + 4 * fq + i; float x0 = acc0[i] + db0, x1 = acc1[i] + db1;
            DT[(size_t)row * 32 + fr] = x0 > 20.f ? x0 : log1pf(__expf(x0)); DT[(size_t)row * 32 + 16 + fr] = x1 > 20.f ? x1 : log1pf(__expf(x1)); } }
    LDS_WAIT();
    }
}

template <int W> __device__ __forceinline__ void pool_item(const bf16* U, bf16* P, int t0, int tt0, int cg) {
    v4u raw[W + 7];
#pragma unroll
    for (int r = 0; r < W + 7; ++r) { const int d = r - (W - 1); raw[r] = (tt0 + d >= 0) ? *(const v4u*)(U + (size_t)(t0 + d) * D + cg * 8) : (v4u){0u, 0u, 0u, 0u}; }
    float s[8];
#pragma unroll
    for (int q = 0; q < 8; ++q) s[q] = 0.f;
#pragma unroll
    for (int r = 0; r < W - 1; ++r) { const v4u v = raw[r]; s[0] += bflo(v.x); s[1] += bfhi(v.x); s[2] += bflo(v.y); s[3] += bfhi(v.y); s[4] += bflo(v.z); s[5] += bfhi(v.z); s[6] += bflo(v.w); s[7] += bfhi(v.w); }
#pragma unroll
    for (int i = 0; i < 8; ++i) { const v4u v = raw[W - 1 + i]; const float u[8] = {bflo(v.x), bfhi(v.x), bflo(v.y), bfhi(v.y), bflo(v.z), bfhi(v.z), bflo(v.w), bfhi(v.w)};
#pragma unroll
        for (int q = 0; q < 8; ++q) s[q] += u[q];
        const int tt = tt0 + i; const float inv = 1.f / (float)(tt + 1 < W ? tt + 1 : W);
        v4u o; o.x = pk2(s[0] * inv - u[0], s[1] * inv - u[1]); o.y = pk2(s[2] * inv - u[2], s[3] * inv - u[3]); o.z = pk2(s[4] * inv - u[4], s[5] * inv - u[5]); o.w = pk2(s[6] * inv - u[6], s[7] * inv - u[7]);
        *(v4u*)(P + (size_t)(t0 + i) * D + cg * 8) = o;
        const v4u z = raw[i]; s[0] -= bflo(z.x); s[1] -= bfhi(z.x); s[2] -= bflo(z.y); s[3] -= bfhi(z.y); s[4] -= bflo(z.z); s[5] -= bfhi(z.z); s[6] -= bflo(z.w); s[7] -= bfhi(z.w); }
}
__device__ __forceinline__ void pool_pass(Frame& F) {
    const bf16* U = (const bf16*)(F.ws + WS_U); bf16* P = (bf16*)(F.ws + WS_P);
    for (int it = F.vcu * 512 + F.tid; it < 2048 * 128; it += F.G * 512) {
        const int wsel = __builtin_amdgcn_readfirstlane((it >> 6) & 3), cg = wsel * 32 + (it & 31), strip = (it >> 8) * 2 + ((it >> 5) & 1); const int t0 = strip * 8, tt0 = t0 % SEQ;
        if (wsel == 0) pool_item<2>(U, P, t0, tt0, cg); else if (wsel == 1) pool_item<4>(U, P, t0, tt0, cg); else if (wsel == 2) pool_item<8>(U, P, t0, tt0, cg); else pool_item<16>(U, P, t0, tt0, cg);
    }
}

__device__ __forceinline__ int swz16(int row) { return (row ^ (row >> 4)) & 15; }
__device__ __forceinline__ void conv8x8(const bf16* XBC, const float* cw, const float* cb, int trow0, bool seq_start, int col, float (&out)[8][8]) {
    float u[11][8];
#pragma unroll
    for (int r = 0; r < 11; ++r) { v4u v = (v4u){0u, 0u, 0u, 0u}; if (!(r < 3 && seq_start)) v = *(const v4u*)(XBC + (size_t)(trow0 - 3 + r) * DCONV + col);
        u[r][0] = bflo(v.x); u[r][1] = bfhi(v.x); u[r][2] = bflo(v.y); u[r][3] = bfhi(v.y); u[r][4] = bflo(v.z); u[r][5] = bfhi(v.z); u[r][6] = bflo(v.w); u[r][7] = bfhi(v.w); }
    float w[4][8], bb[8];
#pragma unroll
    for (int k = 0; k < 4; ++k) { const f32x4 a = *(const f32x4*)(cw + k * DCONV + col), b = *(const f32x4*)(cw + k * DCONV + col + 4);
        w[k][0] = a.x; w[k][1] = a.y; w[k][2] = a.z; w[k][3] = a.w; w[k][4] = b.x; w[k][5] = b.y; w[k][6] = b.z; w[k][7] = b.w; }
    { const f32x4 a = *(const f32x4*)(cb + col), b = *(const f32x4*)(cb + col + 4); bb[0] = a.x; bb[1] = a.y; bb[2] = a.z; bb[3] = a.w; bb[4] = b.x; bb[5] = b.y; bb[6] = b.z; bb[7] = b.w; }
#pragma unroll
    for (int i = 0; i < 8; ++i)
#pragma unroll
        for (int q = 0; q < 8; ++q) { const float a = bb[q] + w[0][q] * u[i][q] + w[1][q] * u[i + 1][q] + w[2][q] * u[i + 2][q] + w[3][q] * u[i + 3][q]; out[i][q] = silu(a); }
}
__device__ __forceinline__ void conv_item(const bf16* XBC, const float* cw, const float* cb, int trow0, bool seq_start, int col, bf16* gdst, const bool do_g, LAS unsigned char* img, const bool do_img, int row0, int chunk, const LAS float* sc, const bool do_sc) {
    v4u raw[11];
#pragma unroll
    for (int r = 0; r < 11; ++r) { raw[r] = (v4u){0u, 0u, 0u, 0u}; if (!(r < 3 && seq_start)) raw[r] = *(const v4u*)(XBC + (size_t)(trow0 - 3 + r) * DCONV + col); }
    f32x4 wa[4], wb[4];
#pragma unroll
    for (int k = 0; k < 4; ++k) { wa[k] = *(const f32x4*)(cw + k * DCONV + col); wb[k] = *(const f32x4*)(cw + k * DCONV + col + 4); }
    const f32x4 ba = *(const f32x4*)(cb + col), bbv = *(const f32x4*)(cb + col + 4);
    unsigned la[8];
#pragma unroll
    for (int q = 0; q < 8; ++q) la[q] = (unsigned)((row0 + q) * 256 + ((chunk ^ swz16(row0 + q)) << 4));
#define CI_U(R, Q) (((Q) & 1) ? bfhi(((Q) >> 1) == 0 ? raw[R].x : ((Q) >> 1) == 1 ? raw[R].y : ((Q) >> 1) == 2 ? raw[R].z : raw[R].w) : bflo(((Q) >> 1) == 0 ? raw[R].x : ((Q) >> 1) == 1 ? raw[R].y : ((Q) >> 1) == 2 ? raw[R].z : raw[R].w))
#define CI_W(K, Q) ((Q) < 4 ? wa[K][(Q) & 3] : wb[K][(Q) & 3])
#pragma unroll
    for (int ip = 0; ip < 4; ++ip) {
        float a0[8], a1[8];
#pragma unroll
        for (int q = 0; q < 8; ++q) { const float bq = q < 4 ? ba[q & 3] : bbv[q & 3];
            a0[q] = silu(bq + CI_W(0, q) * CI_U(2 * ip, q) + CI_W(1, q) * CI_U(2 * ip + 1, q) + CI_W(2, q) * CI_U(2 * ip + 2, q) + CI_W(3, q) * CI_U(2 * ip + 3, q));
            a1[q] = silu(bq + CI_W(0, q) * CI_U(2 * ip + 1, q) + CI_W(1, q) * CI_U(2 * ip + 2, q) + CI_W(2, q) * CI_U(2 * ip + 3, q) + CI_W(3, q) * CI_U(2 * ip + 4, q)); }
        if (do_g) { *(v4u*)(gdst + (size_t)(2 * ip) * DCONV) = (v4u){pk2(a0[0], a0[1]), pk2(a0[2], a0[3]), pk2(a0[4], a0[5]), pk2(a0[6], a0[7])};
                    *(v4u*)(gdst + (size_t)(2 * ip + 1) * DCONV) = (v4u){pk2(a1[0], a1[1]), pk2(a1[2], a1[3]), pk2(a1[4], a1[5]), pk2(a1[6], a1[7])}; }
        if (do_img) { float s0 = 1.f, s1 = 1.f; if (do_sc) { s0 = sc[2 * ip]; s1 = sc[2 * ip + 1]; }
#pragma unroll
            for (int q = 0; q < 8; ++q) *(LAS unsigned*)(img + la[q] + 4 * ip) = pk2(a0[q] * s0, a1[q] * s1); }
    }
#undef CI_U
#undef CI_W
}
__device__ __forceinline__ void put_transposed(LAS unsigned char* img, int row0, int chunk, const float (&o)[8][8]) {
#pragma unroll
    for (int q = 0; q < 8; ++q) { const int row = row0 + q; v4u v; v.x = pk2(o[0][q], o[1][q]); v.y = pk2(o[2][q], o[3][q]); v.z = pk2(o[4][q], o[5][q]); v.w = pk2(o[6][q], o[7][q]);
        *(LAS v4u*)(img + row * 256 + ((chunk ^ swz16(row)) << 4)) = v; }
}
__device__ __forceinline__ void put_global(bf16* dst, const float (&o)[8][8]) {
#pragma unroll
    for (int i = 0; i < 8; ++i) { v4u v; v.x = pk2(o[i][0], o[i][1]); v.y = pk2(o[i][2], o[i][3]); v.z = pk2(o[i][4], o[i][5]); v.w = pk2(o[i][6], o[i][7]); *(v4u*)(dst + (size_t)i * DCONV) = v; }
}
__device__ __forceinline__ void put_natural(LAS unsigned char* img, int l0, int chunk, const float (&o)[8][8]) {
#pragma unroll
    for (int i = 0; i < 8; ++i) { const int row = l0 + i; v4u v; v.x = pk2(o[i][0], o[i][1]); v.y = pk2(o[i][2], o[i][3]); v.z = pk2(o[i][4], o[i][5]); v.w = pk2(o[i][6], o[i][7]);
        *(LAS v4u*)(img + row * 256 + ((chunk ^ swz16(row)) << 4)) = v; }
}
__device__ __forceinline__ bf16x8 ld_frag(const LAS unsigned char* img, int row, int chunk) { return *(const LAS bf16x8*)(img + row * 256 + ((chunk ^ swz16(row)) << 4)); }

__device__ __forceinline__ void ssd_states_unit(Frame& F, int unit) {
    const int hh = unit & 1, g = (unit >> 1) & 3, c = (unit >> 3) & 31, b = unit >> 8; const int t0 = b * SEQ + c * 128;
    LAS float* sx = (LAS float*)F.lds;
    LAS unsigned char* Bt = F.lds + 4096; LAS unsigned char* Xt = F.lds + 4096 + 32768;
    const float* DT = (const float*)(F.ws + WS_DT); const bf16* XBC = (const bf16*)(F.ws + WS_XBC); bf16* XC = (bf16*)(F.ws + WS_XC); float* CD = (float*)(F.ws + WS_CD);
    __syncthreads();
    if (F.wave < 4) {
        const int h = g * 8 + 4 * hh + F.wave; const float A = -__expf(F.in[I_ALOG][h]); const int l = 2 * F.lane;
        const float d0 = DT[(size_t)(t0 + l) * 32 + h], d1 = DT[(size_t)(t0 + l + 1) * 32 + h]; const float a0 = d0 * A, a1 = d1 * A, s = a0 + a1;
        float incl = s;
#pragma unroll
        for (int o = 1; o < 64; o <<= 1) { const float v = __shfl_up(incl, o); if (F.lane >= o) incl += v; }
        const float c0 = incl - s + a0, c1 = incl, total = __shfl(incl, 63);
        sx[F.wave * 128 + l] = d0 * __expf(total - c0); sx[F.wave * 128 + l + 1] = d1 * __expf(total - c1);
        if (F.lane == 0) CD[(b * 32 + c) * 32 + h] = __expf(total);
    }
    __syncthreads();
#pragma unroll 1
    for (int itx = 0; itx < 2; ++itx) {
        int kind, strip, grp, col;
        if (itx == 0) { kind = 0; strip = F.tid >> 5; grp = F.tid & 31; col = g * 512 + hh * 256 + grp * 8; }
        else if (F.tid < 256) { kind = 1; strip = F.tid >> 4; grp = F.tid & 15; col = 2048 + g * 128 + grp * 8; }
        else if (F.tid < 384) { kind = 2; strip = 8 * hh + ((F.tid - 256) >> 4); grp = F.tid & 15; col = 2560 + g * 128 + grp * 8; }
        else { kind = 3; strip = 0; grp = 0; col = 0; }
        if (kind < 3) { const int l0 = strip * 8;
            conv_item(XBC, F.in[I_CONVW], F.in[I_CONVB], t0 + l0, (c == 0 && l0 == 0), col, XC + (size_t)(t0 + l0) * DCONV + col, (kind != 1 || hh == 0),
                      kind ? Bt : Xt, kind < 2, grp * 8, strip, sx + (grp >> 3) * 128 + l0, kind == 0); }
    }
    __syncthreads();
    const int li = F.lane & 31, half = F.lane >> 5, hp = (F.wave >> 1) * 64 + (F.wave & 1) * 32 + li;
    f32x16 acc[4];
#pragma unroll
    for (int nt = 0; nt < 4; ++nt)
#pragma unroll
        for (int r = 0; r < 16; ++r) acc[nt][r] = 0.f;
#pragma unroll 2
    for (int ks = 0; ks < 8; ++ks) { const bf16x8 xb = ld_frag(Xt, hp, 2 * ks + half);
#pragma unroll
        for (int nt = 0; nt < 4; ++nt) { const bf16x8 ba = ld_frag(Bt, 32 * nt + li, 2 * ks + half); acc[nt] = __builtin_amdgcn_mfma_f32_32x32x16_bf16(ba, xb, acc[nt], 0, 0, 0); } }
    __syncthreads();
    LAS unsigned char* OUT = Xt;
#pragma unroll
    for (int nt = 0; nt < 4; ++nt)
#pragma unroll
        for (int rq = 0; rq < 4; ++rq) { const int ch8 = 8 * nt + 2 * rq + half; v2u v; v.x = pk2(acc[nt][4 * rq], acc[nt][4 * rq + 1]); v.y = pk2(acc[nt][4 * rq + 2], acc[nt][4 * rq + 3]);
            *(LAS v2u*)(OUT + hp * 256 + ((ch8 ^ (hp & 31)) << 3)) = v; }
    __syncthreads();
    bf16* ST = (bf16*)(F.ws + WS_STATES) + ((size_t)((b * 32 + c) * 32 + g * 8 + 4 * hh)) * 8192;
#pragma unroll
    for (int it = 0; it < 8; ++it) { const int idx = it * 512 + F.tid, row = idx >> 4, j = idx & 15, k = row & 31;
        v4u v = *(const LAS v4u*)(OUT + row * 256 + ((j ^ (k >> 1)) << 4)); if (k & 1) v = (v4u){v.z, v.w, v.x, v.y};
        *(v4u*)(ST + (size_t)row * 128 + j * 8) = v; }
}

__device__ __forceinline__ void ssd_scan(Frame& F) {
    bf16* ST = (bf16*)(F.ws + WS_STATES); const float* CD = (const float*)(F.ws + WS_CD);
    for (int gid = F.vcu * 512 + F.tid; gid < 131072; gid += F.G * 512) {
        const int bh = gid >> 10, b = bh >> 5, h = bh & 31, el = (gid & 1023) * 8;
        float st[8];
#pragma unroll
        for (int q = 0; q < 8; ++q) st[q] = 0.f;
#pragma unroll 4
        for (int c = 0; c < 32; ++c) { bf16* p = ST + ((size_t)((b * 32 + c) * 32 + h)) * 8192 + el; const v4u v = *(const v4u*)p; const float cd = CD[(b * 32 + c) * 32 + h];
            v4u o; o.x = pk2(st[0], st[1]); o.y = pk2(st[2], st[3]); o.z = pk2(st[4], st[5]); o.w = pk2(st[6], st[7]); *(v4u*)p = o;
            st[0] = st[0] * cd + bflo(v.x); st[1] = st[1] * cd + bfhi(v.x); st[2] = st[2] * cd + bflo(v.y); st[3] = st[3] * cd + bfhi(v.y);
            st[4] = st[4] * cd + bflo(v.z); st[5] = st[5] * cd + bfhi(v.z); st[6] = st[6] * cd + bflo(v.w); st[7] = st[7] * cd + bfhi(v.w); }
    }
}

__device__ __forceinline__ int off256(int row, int ch) { return 256 * row + 16 * (ch ^ (((row & 3) << 2) | ((row >> 2) & 3))); }
__device__ __forceinline__ int off512(int row, int ch) { return 512 * row + 16 * (ch ^ ((row & 3) << 2)); }
typedef short v4i16_t __attribute__((ext_vector_type(4)));
__device__ __forceinline__ v4i16_t tr_read(const LAS unsigned char* p) { return __builtin_amdgcn_ds_read_tr16_b64_v4i16((LAS v4i16_t*)p); }
__device__ __forceinline__ void ssd_out_unit(Frame& F, int unit, const int var, bf16* Y) {
    const int g = unit & 3, c = (unit >> 2) & 31, b = unit >> 7; const int t0 = b * SEQ + c * 128;
    LAS float* acum = (LAS float*)F.lds; LAS float* dtv = acum + 1024; LAS float* ssq = acum + 2048;
    LAS unsigned char* Bn = F.lds + 12288; LAS unsigned char* Cn = Bn + 32768; LAS unsigned char* Xn = Cn + 32768;
    const float* DT = (const float*)(F.ws + WS_DT); const bf16* XC = (const bf16*)(F.ws + WS_XC); const bf16* Z = (const bf16*)(F.ws + WS_Z);
    __syncthreads();
#pragma unroll
    for (int i = 0; i < 4; ++i) { const int k = F.wave * 4 + i, row = 4 * k + (F.lane >> 4), pc = F.lane & 15, lc = pc ^ (((row & 3) << 2) | ((row >> 2) & 3));
        const bf16* src = XC + (size_t)(t0 + row) * DCONV + 2048 + g * 128 + lc * 8;
        __builtin_amdgcn_global_load_lds((const unsigned*)src, (LAS unsigned*)(Bn + k * 1024), 16, 0, 0);
        __builtin_amdgcn_global_load_lds((const unsigned*)(src + 512), (LAS unsigned*)(Cn + k * 1024), 16, 0, 0); }
    { const int h = g * 8 + F.wave; const float A = -__expf(F.in[I_ALOG][h]); const int l = 2 * F.lane;
        const float d0 = DT[(size_t)(t0 + l) * 32 + h], d1 = DT[(size_t)(t0 + l + 1) * 32 + h]; const float a0 = d0 * A, a1 = d1 * A, s = a0 + a1;
        float incl = s;
#pragma unroll
        for (int o = 1; o < 64; o <<= 1) { const float v = __shfl_up(incl, o); if (F.lane >= o) incl += v; }
        acum[F.wave * 128 + l] = incl - s + a0; acum[F.wave * 128 + l + 1] = incl; dtv[F.wave * 128 + l] = d0; dtv[F.wave * 128 + l + 1] = d1; }
    const int li = F.lane & 31, half = F.lane >> 5, ew = F.wave >> 1, lsel = F.wave & 1;
    const int trq = (F.lane & 15) >> 2, trp = F.lane & 3, trblk = (F.lane >> 4) & 1;
#pragma unroll 1
    for (int ps = 0; ps < 2; ++ps) {
        if (ps) __syncthreads();
#pragma unroll
        for (int i = 0; i < 8; ++i) { const int k = F.wave * 8 + i, row = 2 * k + (F.lane >> 5), pc = F.lane & 31, lc = pc ^ ((row & 3) << 2);
            __builtin_amdgcn_global_load_lds((const unsigned*)(XC + (size_t)(t0 + row) * DCONV + g * 512 + ps * 256 + lc * 8), (LAS unsigned*)(Xn + k * 1024), 16, 0, 0); }
        const int e = 4 * ps + ew, h = 8 * g + e; const float Dk = F.in[I_DSKIP][h];
        const bf16* prev = (const bf16*)(F.ws + WS_STATES) + ((size_t)((b * 32 + c) * 32 + h)) * 8192;
        VM_WAIT(); __syncthreads();
        const LAS float* ac = acum + e * 128; const LAS float* dv = dtv + e * 128;
        f32x16 accs[2][2];
#pragma unroll
        for (int it = 0; it < 2; ++it) {
            const int i = lsel ? (1 + it) : (it ? 3 : 0); const int l = 32 * i + li; const float acl = ac[l];
            f32x16 acc[2];
#pragma unroll
            for (int pt = 0; pt < 2; ++pt)
#pragma unroll
                for (int r = 0; r < 16; ++r) acc[pt][r] = 0.f;
            if (var & 1) {
            bf16x8 pf[2][8];
#pragma unroll
            for (int pt = 0; pt < 2; ++pt)
#pragma unroll
                for (int ks = 0; ks < 8; ++ks) pf[pt][ks] = *(const bf16x8*)(prev + (size_t)(32 * pt + li) * 128 + 16 * ks + 8 * half);
#pragma unroll
            for (int ks = 0; ks < 8; ++ks) { const bf16x8 cf = *(const LAS bf16x8*)(Cn + off256(l, 2 * ks + half));
#pragma unroll
                for (int pt = 0; pt < 2; ++pt) acc[pt] = __builtin_amdgcn_mfma_f32_32x32x16_bf16(pf[pt][ks], cf, acc[pt], 0, 0, 0); }
            }
            { const float el = __expf(acl);
#pragma unroll
                for (int pt = 0; pt < 2; ++pt)
#pragma unroll
                    for (int r = 0; r < 16; ++r) acc[pt][r] *= el; }
#pragma unroll 1
            for (int j = 0; j <= ((var & 2) ? i : -1); ++j) {
                f32x16 gt;
#pragma unroll
                for (int r = 0; r < 16; ++r) gt[r] = 0.f;
#pragma unroll 4
                for (int ks = 0; ks < 8; ++ks) { const bf16x8 bfm = *(const LAS bf16x8*)(Bn + off256(32 * j + li, 2 * ks + half)); const bf16x8 cf = *(const LAS bf16x8*)(Cn + off256(l, 2 * ks + half)); gt = __builtin_amdgcn_mfma_f32_32x32x16_bf16(bfm, cf, gt, 0, 0, 0); }
                unsigned wp[8];
#pragma unroll
                for (int rq = 0; rq < 4; ++rq) { const int sb = 32 * j + 8 * rq + 4 * half; const f32x4 as4 = *(const LAS f32x4*)(ac + sb), dt4 = *(const LAS f32x4*)(dv + sb); float wv[4];
#pragma unroll
                    for (int x = 0; x < 4; ++x) { const int s = sb + x; float w = gt[4 * rq + x] * __expf(fminf(acl - as4[x], 0.f)) * dt4[x];
                        if (j == i) { if (s > l) w = 0.f; if (s == l) w += Dk; } wv[x] = w; }
                    wp[2 * rq] = pk2(wv[0], wv[1]); wp[2 * rq + 1] = pk2(wv[2], wv[3]); }
                const bf16x8 wf0 = __builtin_bit_cast(bf16x8, (v4u){wp[0], wp[1], wp[2], wp[3]}), wf1 = __builtin_bit_cast(bf16x8, (v4u){wp[4], wp[5], wp[6], wp[7]});
#pragma unroll
                for (int pt = 0; pt < 2; ++pt) { const int chunk = ew * 8 + 4 * pt + 2 * trblk + (trp >> 1);
#pragma unroll
                    for (int ksub = 0; ksub < 2; ++ksub) { const int r0 = 32 * j + 16 * ksub + 4 * half + trq;
                        const v4i16_t lo = tr_read(Xn + off512(r0, chunk) + 8 * (trp & 1)), hi = tr_read(Xn + off512(r0 + 8, chunk) + 8 * (trp & 1));
                        const bf16x8 xf = (bf16x8){lo[0], lo[1], lo[2], lo[3], hi[0], hi[1], hi[2], hi[3]};
                        acc[pt] = __builtin_amdgcn_mfma_f32_32x32x16_bf16(xf, ksub ? wf1 : wf0, acc[pt], 0, 0, 0); } }
            }
            accs[it][0] = acc[0]; accs[it][1] = acc[1];
            asm volatile("" ::: "memory"); __builtin_amdgcn_sched_barrier(0);
        }
        __syncthreads();
        LAS unsigned char* Tt = Xn;
        if (var & 4) {
#pragma unroll
        for (int it = 0; it < 2; ++it) { const int i = lsel ? (1 + it) : (it ? 3 : 0); const int l = 32 * i + li;
#pragma unroll
            for (int pt = 0; pt < 2; ++pt)
#pragma unroll
                for (int rq = 0; rq < 4; ++rq) { const int c8 = ew * 16 + 8 * pt + 2 * rq + half;
                    *(LAS v2u*)(Tt + l * 512 + ((c8 ^ (l & 31)) << 3)) = (v2u){pk2(accs[it][pt][4 * rq], accs[it][pt][4 * rq + 1]), pk2(accs[it][pt][4 * rq + 2], accs[it][pt][4 * rq + 3])}; } }
        }
        __syncthreads();
        if (var & 4)
        { v4u zq[8];
#pragma unroll
          for (int k = 0; k < 8; ++k) { const int idx = k * 512 + F.tid, l = idx >> 5, j = idx & 31; zq[k] = *(const v4u*)(Z + (size_t)(t0 + l) * DSSD + g * 512 + ps * 256 + j * 8); }
#pragma unroll
          for (int k = 0; k < 8; ++k) { const int idx = k * 512 + F.tid, l = idx >> 5, j = idx & 31, kk = l & 31;
            v4u tq = *(const LAS v4u*)(Tt + l * 512 + ((j ^ (kk >> 1)) << 4)); if (kk & 1) tq = (v4u){tq.z, tq.w, tq.x, tq.y};
            const v4u z4 = zq[k];
            const float y0 = bflo(tq.x) * silu(bflo(z4.x)), y1 = bfhi(tq.x) * silu(bfhi(z4.x)), y2 = bflo(tq.y) * silu(bflo(z4.y)), y3 = bfhi(tq.y) * silu(bfhi(z4.y));
            const float y4 = bflo(tq.z) * silu(bflo(z4.z)), y5 = bfhi(tq.z) * silu(bfhi(z4.z)), y6 = bflo(tq.w) * silu(bflo(z4.w)), y7 = bfhi(tq.w) * silu(bfhi(z4.w));
            float sq = ((y0 * y0 + y1 * y1) + (y2 * y2 + y3 * y3)) + ((y4 * y4 + y5 * y5) + (y6 * y6 + y7 * y7));
#pragma unroll
            for (int o = 1; o < 32; o <<= 1) sq += __shfl_xor(sq, o);
            if (j == 0) ssq[ps * 128 + l] = sq;
            *(v4u*)(Y + (size_t)(t0 + l) * DSSD + g * 512 + ps * 256 + j * 8) = (v4u){pk2(y0, y1), pk2(y2, y3), pk2(y4, y5), pk2(y6, y7)}; } }
    }
    VM_WAIT(); __syncthreads();
    if (var & 8)
#pragma unroll
    for (int hb = 0; hb < 2; ++hb) { v4u yq[8];
#pragma unroll
        for (int k = 0; k < 8; ++k) { const int idx = (hb * 8 + k) * 512 + F.tid, l = idx >> 6, j = idx & 63; yq[k] = *(const v4u*)(Y + (size_t)(t0 + l) * DSSD + g * 512 + j * 8); }
#pragma unroll
        for (int k = 0; k < 8; ++k) { const int idx = (hb * 8 + k) * 512 + F.tid, l = idx >> 6, j = idx & 63; const float rstd = rsqrtf((ssq[l] + ssq[128 + l]) * (1.f / 512.f) + EPS);
            const f32x4 w0 = *(const f32x4*)(F.in[I_SNW] + g * 512 + j * 8), w1 = *(const f32x4*)(F.in[I_SNW] + g * 512 + j * 8 + 4); const v4u v = yq[k];
            *(v4u*)(Y + (size_t)(t0 + l) * DSSD + g * 512 + j * 8) = (v4u){pk2(bflo(v.x) * rstd * w0.x, bfhi(v.x) * rstd * w0.y), pk2(bflo(v.y) * rstd * w0.z, bfhi(v.y) * rstd * w0.w),
                                                                         pk2(bflo(v.z) * rstd * w1.x, bfhi(v.z) * rstd * w1.y), pk2(bflo(v.w) * rstd * w1.z, bfhi(v.w) * rstd * w1.w)}; } }
}
}
namespace mk {
using pg8::Unit;
constexpr int MI_TSTART = 16, MI_CNT = 64;

struct Sched {
    int mode, nM, nN, nwg, G, c, lda, ldb, a_pn_off, npn;
    const bf16* A; const bf16* Bt; const int* list; const volatile LAS unsigned* misc;
    __device__ __forceinline__ void init_dense(int M, int N, int G_, int c_, const bf16* A_, int lda_, const bf16* Bt_, int ldb_, int a_pn_off_) {
        mode = 0; nM = M / 256; nN = N / 256; nwg = nM * nN; G = G_; c = c_; A = A_; Bt = Bt_; lda = lda_; ldb = ldb_; a_pn_off = a_pn_off_; npn = 0; list = nullptr; misc = nullptr; }
    __device__ __forceinline__ void init_moe(int mode_, int G_, int c_, const bf16* A_, const bf16* Bt_, const int* list_, const volatile LAS unsigned* misc_) {
        mode = mode_; G = G_; c = c_; A = A_; Bt = Bt_; lda = 512; ldb = 512; a_pn_off = 0; npn = (mode_ == 1) ? 8 : 4; list = list_; misc = misc_; nM = 0; nN = 0; nwg = __builtin_amdgcn_readfirstlane((int)misc_[MI_TSTART + 32]) * npn; }
    __device__ __forceinline__ bool next(int i, Unit& u) const {
        const long L = (long)i * G + c; if (L >= nwg) return false;
        if (mode == 0) {
            int wgid = (int)L; { const int q = nwg / 8, r = nwg % 8, xcd = wgid % 8, off = wgid / 8; wgid = (xcd < r ? xcd * (q + 1) : r * (q + 1) + (xcd - r) * q) + off; }
            const int nig = 8 * nN, gid = wgid / nig, fm = gid * 8, gsz = (nM - fm) < 8 ? (nM - fm) : 8;
            u.pm = fm + ((wgid % nig) % gsz); u.pn = (wgid % nig) / gsz; u.e = 0; u.i = 0; return true;
        }
        const int rt = (int)L / npn, pn = (int)L % npn; int e = 0;
        while (e < 31 && __builtin_amdgcn_readfirstlane((int)misc[MI_TSTART + e + 1]) <= rt) ++e;
        u.pm = rt; u.pn = pn; u.e = e; u.i = rt - __builtin_amdgcn_readfirstlane((int)misc[MI_TSTART + e]); return true;
    }
    __device__ __forceinline__ const char* a_base(const Unit& u) const {
        if (mode == 0) return (const char*)(A + (size_t)u.pm * 256 * lda + (size_t)u.pn * a_pn_off);
        if (mode == 1) return (const char*)A;
        return (const char*)(A + (size_t)u.pm * 256 * 512); }
    __device__ __forceinline__ const char* b_base(const Unit& u) const {
        if (mode == 0) return (const char*)(Bt + (size_t)u.pn * 256 * ldb);
        if (mode == 1) return (const char*)(Bt + (size_t)u.e * 2048 * 512 + (size_t)u.pn * 256 * 512);
        return (const char*)(Bt + (size_t)u.e * 1024 * 512 + (size_t)u.pn * 256 * 512); }
    __device__ __forceinline__ unsigned row_off(const Unit& u, int r) const {
        if (mode == 2) return (unsigned)r * 1024u;
        const int idx = u.i * 256 + r; const int cnt = (int)misc[MI_CNT + u.e];
        const int tok = idx < cnt ? (list[(size_t)u.e * T + idx] >> 2) : 0; return (unsigned)tok * 1024u; }
};

struct EpiAll {
    static constexpr bool PERM = true;
    int kind, pad; unsigned char* ws; const float* const* in; float* out; const volatile LAS unsigned* misc;
    __device__ __forceinline__ void operator()(const pg8::f32x4 (&acc)[2][2][4][2], const Unit& u, int wr, int wc, int fr, int fq) const {
        const int rl0 = wr * 64 + fr, row0 = u.pm * 256 + rl0, cl0 = wc * 32 + 8 * fq;
        if (kind == 0) {
            bf16* base; int ld, colt; bool sg = false;
            if (u.pn < 8) { base = (bf16*)(ws + WS_Z); ld = 2048; colt = u.pn * 256; }
            else if (u.pn < 20) { base = (bf16*)(ws + WS_XBC); ld = 3072; colt = (u.pn - 8) * 256; }
            else if (u.pn < 24) { base = (bf16*)(ws + WS_U); ld = 1024; colt = (u.pn - 20) * 256; }
            else { base = (bf16*)(ws + WS_GATES); ld = 2048; colt = (u.pn - 24) * 256; sg = true; }
#pragma unroll
            for (int ai = 0; ai < 2; ++ai)
#pragma unroll
                for (int m = 0; m < 4; ++m) { bf16* rowp = base + (size_t)(row0 + ai * 128 + m * 16) * ld + colt + cl0;
#pragma unroll
                    for (int bj = 0; bj < 2; ++bj) { pg8::f32x4 v0 = acc[ai][bj][m][0], v1 = acc[ai][bj][m][1];
                        if (sg) { v0 = (pg8::f32x4){sigm(v0[0]), sigm(v0[1]), sigm(v0[2]), sigm(v0[3])}; v1 = (pg8::f32x4){sigm(v1[0]), sigm(v1[1]), sigm(v1[2]), sigm(v1[3])}; }
                        v4u w; w.x = pk2(v0[0], v0[1]); w.y = pk2(v0[2], v0[3]); w.z = pk2(v1[0], v1[1]); w.w = pk2(v1[2], v1[3]);
                        *(v4u*)(rowp + bj * 128) = w; } }
        } else if (kind == 1) {
            bf16* base = (bf16*)(ws + WS_P2); const float* ps = in[I_PSCALE];
#pragma unroll
            for (int bj = 0; bj < 2; ++bj) { const int col = u.pn * 256 + bj * 128 + cl0; const f32x4 s0 = *(const f32x4*)(ps + col), s1 = *(const f32x4*)(ps + col + 4);
#pragma unroll
                for (int ai = 0; ai < 2; ++ai)
#pragma unroll
                    for (int m = 0; m < 4; ++m) { const pg8::f32x4 v0 = acc[ai][bj][m][0] * s0, v1 = acc[ai][bj][m][1] * s1;
                        v4u w; w.x = pk2(v0[0], v0[1]); w.y = pk2(v0[2], v0[3]); w.z = pk2(v1[0], v1[1]); w.w = pk2(v1[2], v1[3]);
                        *(v4u*)(base + (size_t)(row0 + ai * 128 + m * 16) * 1024 + col) = w; } }
        } else if (kind == 2 || kind == 3) {
            const bf16* gates = (const bf16*)(ws + WS_GATES) + (kind == 3 ? 1024 : 0); bf16* m1 = (bf16*)(ws + WS_M1); bf16* mg = (bf16*)(ws + WS_MERGED);
#pragma unroll
            for (int ai = 0; ai < 2; ++ai) { v4u gq[4][2], mq[4][2];
#pragma unroll
                for (int m = 0; m < 4; ++m)
#pragma unroll
                    for (int bj = 0; bj < 2; ++bj) { const size_t row = row0 + ai * 128 + m * 16; const int col = u.pn * 256 + bj * 128 + cl0; gq[m][bj] = *(const v4u*)(gates + row * 2048 + col);
                        if (kind == 3) mq[m][bj] = *(const v4u*)(m1 + row * 1024 + col); else mq[m][bj] = (v4u){0u, 0u, 0u, 0u}; }
#pragma unroll
                for (int m = 0; m < 4; ++m)
#pragma unroll
                    for (int bj = 0; bj < 2; ++bj) { const size_t row = row0 + ai * 128 + m * 16; const int col = u.pn * 256 + bj * 128 + cl0; const v4u g4 = gq[m][bj], m4 = mq[m][bj];
                        float r[8] = {acc[ai][bj][m][0][0] * bflo(g4.x), acc[ai][bj][m][0][1] * bfhi(g4.x), acc[ai][bj][m][0][2] * bflo(g4.y), acc[ai][bj][m][0][3] * bfhi(g4.y),
                                      acc[ai][bj][m][1][0] * bflo(g4.z), acc[ai][bj][m][1][1] * bfhi(g4.z), acc[ai][bj][m][1][2] * bflo(g4.w), acc[ai][bj][m][1][3] * bfhi(g4.w)};
                        if (kind == 3) { r[0] += bflo(m4.x); r[1] += bfhi(m4.x); r[2] += bflo(m4.y); r[3] += bfhi(m4.y); r[4] += bflo(m4.z); r[5] += bfhi(m4.z); r[6] += bflo(m4.w); r[7] += bfhi(m4.w); }
                        v4u w; w.x = pk2(r[0], r[1]); w.y = pk2(r[2], r[3]); w.z = pk2(r[4], r[5]); w.w = pk2(r[6], r[7]);
                        *(v4u*)((kind == 3 ? mg : m1) + row * 1024 + col) = w; } }
        } else if (kind == 4) {
            const int b = (u.pm * 256) / SEQ; const float* ga = (const float*)(ws + WS_MOD) + b * 6144 + 2048; const float* x = in[I_X];
            f32x4 g0[2], g1[2];
#pragma unroll
            for (int bj = 0; bj < 2; ++bj) { const int col = u.pn * 256 + bj * 128 + cl0; g0[bj] = *(const f32x4*)(ga + col); g1[bj] = *(const f32x4*)(ga + col + 4); }
#pragma unroll
            for (int ai = 0; ai < 2; ++ai) { f32x4 xa[4][2], xb[4][2];
#pragma unroll
                for (int m = 0; m < 4; ++m)
#pragma unroll
                    for (int bj = 0; bj < 2; ++bj) { const size_t off = (size_t)(row0 + ai * 128 + m * 16) * 1024 + u.pn * 256 + bj * 128 + cl0; xa[m][bj] = *(const f32x4*)(x + off); xb[m][bj] = *(const f32x4*)(x + off + 4); }
#pragma unroll
                for (int m = 0; m < 4; ++m)
#pragma unroll
                    for (int bj = 0; bj < 2; ++bj) { const size_t off = (size_t)(row0 + ai * 128 + m * 16) * 1024 + u.pn * 256 + bj * 128 + cl0;
                        *(f32x4*)(out + off) = xa[m][bj] + g0[bj] * acc[ai][bj][m][0]; *(f32x4*)(out + off + 4) = xb[m][bj] + g1[bj] * acc[ai][bj][m][1]; } }
        } else if (kind == 5) {
            unsigned char* act = (unsigned char*)(ws + WS_ACT); const float* bgu = in[I_BGU] + (size_t)u.e * 2048; const int col = u.pn * 128 + cl0;
            const f32x4 bg0 = *(const f32x4*)(bgu + col), bg1 = *(const f32x4*)(bgu + col + 4), bl0 = *(const f32x4*)(bgu + 1024 + col), bl1 = *(const f32x4*)(bgu + 1024 + col + 4);
#pragma unroll
            for (int ai = 0; ai < 2; ++ai)
#pragma unroll
                for (int m = 0; m < 4; ++m) { float r[8];
#pragma unroll
                    for (int n = 0; n < 2; ++n)
#pragma unroll
                        for (int x = 0; x < 4; ++x) { float gl = acc[ai][0][m][n][x] * 0.03125f + (n ? bg1[x] : bg0[x]), ln = acc[ai][1][m][n][x] * 0.03125f + (n ? bl1[x] : bl0[x]);
                            gl = fminf(gl, 7.f); ln = fminf(fmaxf(ln, -7.f), 7.f); r[4 * n + x] = gl * sigm(1.702f * gl) * (ln + 1.f); }
                    int w0 = 0, w1 = 0; w0 = __builtin_amdgcn_cvt_pk_fp8_f32(r[0], r[1], w0, false); w0 = __builtin_amdgcn_cvt_pk_fp8_f32(r[2], r[3], w0, true);
                    w1 = __builtin_amdgcn_cvt_pk_fp8_f32(r[4], r[5], w1, false); w1 = __builtin_amdgcn_cvt_pk_fp8_f32(r[6], r[7], w1, true);
                    *(v2u*)(act + (size_t)(row0 + ai * 128 + m * 16) * 1024 + col) = (v2u){(unsigned)w0, (unsigned)w1}; }
        } else {
            bf16* yb = (bf16*)(ws + WS_YB); const float* bdn = in[I_BDN] + (size_t)u.e * 1024; const int* list = (const int*)(ws + WS_LIST) + (size_t)u.e * T; const float* gate = (const float*)(ws + WS_GATE);
            const int cnt = (int)misc[MI_CNT + u.e]; int slot[2][4]; float gt[2][4];
#pragma unroll
            for (int ai = 0; ai < 2; ++ai)
#pragma unroll
                for (int m = 0; m < 4; ++m) { const int idx = u.i * 256 + rl0 + ai * 128 + m * 16; slot[ai][m] = idx < cnt ? list[idx] : -1; }
#pragma unroll
            for (int ai = 0; ai < 2; ++ai)
#pragma unroll
                for (int m = 0; m < 4; ++m) gt[ai][m] = slot[ai][m] >= 0 ? gate[slot[ai][m]] : 0.f;
            f32x4 b0[2], b1[2];
#pragma unroll
            for (int bj = 0; bj < 2; ++bj) { const int col = u.pn * 256 + bj * 128 + cl0; b0[bj] = *(const f32x4*)(bdn + col); b1[bj] = *(const f32x4*)(bdn + col + 4); }
#pragma unroll
            for (int ai = 0; ai < 2; ++ai)
#pragma unroll
                for (int m = 0; m < 4; ++m) {
                    if (slot[ai][m] >= 0) {
#pragma unroll
                        for (int bj = 0; bj < 2; ++bj) { const int col = u.pn * 256 + bj * 128 + cl0;
                            const pg8::f32x4 v0 = (acc[ai][bj][m][0] * 0.03125f + b0[bj]) * gt[ai][m], v1 = (acc[ai][bj][m][1] * 0.03125f + b1[bj]) * gt[ai][m];
                            v4u w; w.x = pk2(v0[0], v0[1]); w.y = pk2(v0[2], v0[3]); w.z = pk2(v1[0], v1[1]); w.w = pk2(v1[2], v1[3]);
                            *(v4u*)(yb + (size_t)slot[ai][m] * 1024 + col) = w; } } }
        }
    }
};

__device__ __forceinline__ void p6_router(Frame& F) {
    LAS float* wrT = (LAS float*)F.lds;
    LAS int* lcnt = (LAS int*)(F.lds + 131072); LAS int* lbase = lcnt + 32; LAS int* rec = lcnt + 64;
    const float* wr = F.in[I_WR];
    __syncthreads();
    for (int idx = F.tid; idx < 32768; idx += 512) { const int k = idx >> 5, e = idx & 31; wrT[e * 1024 + k] = wr[idx]; }
    for (int rb = F.vcu; rb < T / 64; rb += F.G) {
    __syncthreads();
    if (F.tid < 32) lcnt[F.tid] = 0;
    __syncthreads();
    const int rowblk = rb * 64, b = rowblk / SEQ; const float* mod = (const float*)(F.ws + WS_MOD) + b * 6144; unsigned char* H8 = (unsigned char*)(F.ws + WS_H);
    const float* x1 = F.out;
#pragma unroll 1
    for (int pr = 0; pr < 4; ++pr) {
        float hv[2][16]; const int rl0 = F.wave * 8 + pr * 2;
#pragma unroll
        for (int rr = 0; rr < 2; ++rr) { const size_t t = rowblk + rl0 + rr; f32x4 v[4]; float s = 0.f;
#pragma unroll
            for (int j = 0; j < 4; ++j) { v[j] = *(const f32x4*)(x1 + t * D + 4 * F.lane + 256 * j); s += (v[j].x * v[j].x + v[j].y * v[j].y) + (v[j].z * v[j].z + v[j].w * v[j].w); }
            const float rstd = rsqrtf(wave_sum(s) * (1.f / D) + EPS);
#pragma unroll
            for (int j = 0; j < 4; ++j) { const int col = 4 * F.lane + 256 * j; const f32x4 w = *(const f32x4*)(F.in[I_NFW] + col), sc = *(const f32x4*)(mod + 4096 + col), sh = *(const f32x4*)(mod + 3072 + col);
                const f32x4 h = v[j] * rstd * w * (sc + 1.f) + sh; hv[rr][4 * j] = h.x; hv[rr][4 * j + 1] = h.y; hv[rr][4 * j + 2] = h.z; hv[rr][4 * j + 3] = h.w;
                int w8 = 0; w8 = __builtin_amdgcn_cvt_pk_fp8_f32(h.x, h.y, w8, false); w8 = __builtin_amdgcn_cvt_pk_fp8_f32(h.z, h.w, w8, true); *(unsigned*)(H8 + t * D + col) = (unsigned)w8; } }
        float a[64];
#pragma unroll
        for (int e = 0; e < 32; ++e) { float s0 = 0.f, s1 = 0.f;
#pragma unroll
            for (int j = 0; j < 4; ++j) { const f32x4 w = *(const LAS f32x4*)(wrT + e * 1024 + 4 * F.lane + 256 * j);
                s0 += hv[0][4 * j] * w.x + hv[0][4 * j + 1] * w.y + hv[0][4 * j + 2] * w.z + hv[0][4 * j + 3] * w.w;
                s1 += hv[1][4 * j] * w.x + hv[1][4 * j + 1] * w.y + hv[1][4 * j + 2] * w.z + hv[1][4 * j + 3] * w.w; }
            a[2 * e] = s0; a[2 * e + 1] = s1; }
#define RED_STEP(N, M) { _Pragma("unroll") for (int i = 0; i < (N) / 2; ++i) { const bool up = (F.lane & (M)) != 0; const float keep = up ? a[i + (N) / 2] : a[i], send = up ? a[i] : a[i + (N) / 2]; a[i] = keep + __shfl_xor(send, (M)); } }
        RED_STEP(64, 32) RED_STEP(32, 16) RED_STEP(16, 8) RED_STEP(8, 4) RED_STEP(4, 2) RED_STEP(2, 1)
#undef RED_STEP
        const int e = F.lane >> 1, rr = F.lane & 1; float v = a[0] + F.in[I_BR][e];
        float tv[4]; int ti[4];
#pragma unroll
        for (int r = 0; r < 4; ++r) { float m = v; int mi = e;
#pragma unroll
            for (int o = 2; o < 64; o <<= 1) { const float om = __shfl_xor(m, o); const int oi = __shfl_xor(mi, o); if (om > m || (om == m && oi < mi)) { m = om; mi = oi; } }
            tv[r] = m; ti[r] = mi; if (e == mi) v = -INFINITY; }
        if (F.lane < 2) { const float e0 = 1.f, e1 = __expf(tv[1] - tv[0]), e2 = __expf(tv[2] - tv[0]), e3 = __expf(tv[3] - tv[0]); const float inv = 1.f / (e0 + e1 + e2 + e3);
            const float gt[4] = {e0 * inv, e1 * inv, e2 * inv, e3 * inv}; const int rl = rl0 + rr;
#pragma unroll
            for (int r = 0; r < 4; ++r) { const int pos = __hip_atomic_fetch_add(lcnt + ti[r], 1, __ATOMIC_RELAXED, __HIP_MEMORY_SCOPE_WORKGROUP);
                rec[(rl * 4 + r) * 3] = ti[r]; rec[(rl * 4 + r) * 3 + 1] = pos; rec[(rl * 4 + r) * 3 + 2] = __float_as_int(gt[r]); } }
    }
    __syncthreads();
    if (F.tid < 32) lbase[F.tid] = (int)__hip_atomic_fetch_add((unsigned*)(F.ctl + CW_GCNT) + F.tid, (unsigned)lcnt[F.tid], __ATOMIC_RELAXED, __HIP_MEMORY_SCOPE_AGENT);
    __syncthreads();
    if (F.tid < 256) { const int rl = F.tid >> 2, r = F.tid & 3; const int e = rec[F.tid * 3], pos = rec[F.tid * 3 + 1]; const int slot = (rowblk + rl) * 4 + r;
        ((int*)(F.ws + WS_LIST))[(size_t)e * T + lbase[e] + pos] = slot; ((float*)(F.ws + WS_GATE))[slot] = __int_as_float(rec[F.tid * 3 + 2]); }
    }
}

__device__ __forceinline__ void moe_setup(Frame& F) {
    __syncthreads();
    if (F.tid == 0) { int acc = 0; F.MISC[MI_TSTART] = 0;
        for (int e = 0; e < 32; ++e) { const unsigned cnt = __hip_atomic_load((unsigned*)(F.ctl + CW_GCNT) + e, RLX_AGENT); F.MISC[MI_CNT + e] = cnt; acc += (int)((cnt + 255u) >> 8); F.MISC[MI_TSTART + e + 1] = (unsigned)acc; } }
    __syncthreads();
}

__device__ __forceinline__ void p9_final(Frame& F, const float dscale) {
    const bf16* YB = (const bf16*)(F.ws + WS_YB);
#pragma unroll 1
    for (size_t t = F.vcu * NWAVES + F.wave; t < (size_t)T; t += F.G * NWAVES) { const int b = (int)(t / SEQ); const float* ga = (const float*)(F.ws + WS_MOD) + b * 6144 + 5120;
        f32x4 v[4]; float s = 0.f;
#pragma unroll
        for (int j = 0; j < 4; ++j) { const int col = 4 * F.lane + 256 * j; f32x4 m = (f32x4){0.f, 0.f, 0.f, 0.f};
#pragma unroll
            for (int k = 0; k < 4; ++k) { const v2u q = *(const v2u*)(YB + (t * 4 + k) * D + col); m += (f32x4){bflo(q.x), bfhi(q.x), bflo(q.y), bfhi(q.y)}; }
            v[j] = *(const f32x4*)(F.out + t * D + col) + *(const f32x4*)(ga + col) * m; s += (v[j].x * v[j].x + v[j].y * v[j].y) + (v[j].z * v[j].z + v[j].w * v[j].w); }
        const float rstd = rsqrtf(wave_sum(s) * (1.f / D) + EPS);
#pragma unroll
        for (int j = 0; j < 4; ++j) { const int col = 4 * F.lane + 256 * j; *(f32x4*)(F.out + t * D + col) = v[j] * (rstd * dscale) * *(const f32x4*)(F.in[I_NFINAL] + col); } }
}
}
namespace mk {
#ifndef MK_N_LAUNCHES
#define MK_N_LAUNCHES 1
#endif
constexpr int NPHASES = 12;
struct Args { const float* in[25]; float* out; unsigned char* ws; int ph_lo, ph_hi, li, pad; };

__global__ void __launch_bounds__(NWAVES * 64, 2) mk_fwd(Args args) {
    extern __shared__ __attribute__((aligned(16))) unsigned char lds[];
    Frame F;
    F.lds = (LAS unsigned char*)lds; F.MISC = (volatile LAS unsigned*)(F.lds + MISC_OFF);
    F.tid = threadIdx.x; F.lane = F.tid & 63; F.wave = __builtin_amdgcn_readfirstlane(F.tid >> 6);
    F.G = gridDim.x; { const int bx = blockIdx.x; F.vcu = (F.G % 8 == 0) ? (bx % 8) * (F.G / 8) + bx / 8 : bx; }
    F.ws = args.ws; F.out = args.out; F.in = args.in; F.ctl = (gu32*)(args.ws + WS_CTL);
    for (int u = F.tid; u < (LDS_BYTES - LDSCTL_OFF) / 4; u += NWAVES * 64) ((LAS unsigned*)(F.lds + LDSCTL_OFF))[u] = 0u;
    __syncthreads();
    XcdBarrier bar = xcd_barrier_post((unsigned*)(F.ctl + CW_BAR) + args.li * XCD_BAR_WORDS, F.MISC + 0);
    const int lo = args.ph_lo, hi = args.ph_hi;
#ifndef MK_PH_MASK
#define MK_PH_MASK 0xFFF
#endif
#define IN(k) (((MK_PH_MASK >> (k)) & 1) && lo <= (k) && (k) < hi)
#define SEAM(k) do { if (IN(k) && IN((k) + 1)) xcd_barrier(bar); } while (0)
    LAS unsigned char* ring = F.lds;
    const int cid = (int)blockIdx.x;

    if (IN(0)) { p0_prologue(F); } SEAM(0);
    if (IN(1)) { p1_norm_dt(F); } SEAM(1);
    if (IN(2)) {
        Sched S; S.init_dense(T, 8192, F.G, cid, (const bf16*)(F.ws + WS_H), 1024, (const bf16*)(F.ws + WS_WIN), 1024, 0);
        EpiAll E{0, 0, F.ws, F.in, F.out, F.MISC}; __syncthreads();
        pg8::gemm_phase<EpiAll, Sched, true, true, false, false>(ring, 1024, 1024, 1024, S, E);
    } SEAM(2);
    if (IN(3)) {
#ifndef MK_NOPOOL
        pool_pass(F);
#endif
        asm volatile("" ::: "memory"); __builtin_amdgcn_sched_barrier(0); for (int u = F.vcu; u < 1024; u += F.G) ssd_states_unit(F, u); } SEAM(3);
    if (IN(4)) { if (args.li != 1) ssd_scan(F);
        Sched S; S.init_dense(T, 1024, F.G, cid, (const bf16*)(F.ws + WS_P), 1024, (const bf16*)(F.ws + WS_WPOOL), 256, 256);
        EpiAll E{1, 0, F.ws, F.in, F.out, F.MISC};
        __syncthreads();
        pg8::gemm_phase<EpiAll, Sched, true, true, false, false>(ring, 256, 1024, 256, S, E);
    } SEAM(4);
    if (IN(5)) {
#ifdef MK_VAR
        const int var = (args.li == 1) ? (MK_VAR) : 15; bf16* ydst = (args.li == 1) ? (bf16*)(F.ws + 864 * MiB) : (bf16*)(F.ws + WS_Y);
#else
        const int var = 15; bf16* ydst = (bf16*)(F.ws + WS_Y);
#endif
        for (int u = F.vcu; u < 512; u += F.G) ssd_out_unit(F, u, var, ydst); } SEAM(5);
    if (IN(6)) {
        { Sched S; S.init_dense(T, 1024, F.G, cid, (const bf16*)(F.ws + WS_Y), 2048, (const bf16*)(F.ws + WS_WSSD), 2048, 0);
          EpiAll E{2, 0, F.ws, F.in, F.out, F.MISC}; __syncthreads();
          pg8::gemm_phase<EpiAll, Sched, true, true, false, false>(ring, 2048, 2048, 2048, S, E); }
        VM_WAIT(); __syncthreads();
        { Sched S; S.init_dense(T, 1024, F.G, cid, (const bf16*)(F.ws + WS_P2), 1024, (const bf16*)(F.ws + WS_WPO), 1024, 0);
          EpiAll E{3, 0, F.ws, F.in, F.out, F.MISC}; __syncthreads();
          pg8::gemm_phase<EpiAll, Sched, true, true, false, false>(ring, 1024, 1024, 1024, S, E); }
    } SEAM(6);
    if (IN(7)) { Sched S; S.init_dense(T, 1024, F.G, cid, (const bf16*)(F.ws + WS_MERGED), 1024, (const bf16*)(F.ws + WS_WOUT), 1024, 0);
        EpiAll E{4, 0, F.ws, F.in, F.out, F.MISC}; __syncthreads();
        pg8::gemm_phase<EpiAll, Sched, true, true, false, false>(ring, 1024, 1024, 1024, S, E);
    } SEAM(7);
    if (IN(8)) { p6_router(F); } SEAM(8);
    if (IN(9)) { moe_setup(F);
        Sched S; S.init_moe(1, F.G, cid, (const bf16*)(F.ws + WS_H), (const bf16*)(F.ws + WS_WGU), (const int*)(F.ws + WS_LIST), F.MISC);
        EpiAll E{5, 0, F.ws, F.in, F.out, F.MISC}; __syncthreads();
        pg8::gemm_phase<EpiAll, Sched, true, true, true, true>(ring, 512, 512, 512, S, E);
    } SEAM(9);
    if (IN(10)) { moe_setup(F);
        Sched S; S.init_moe(2, F.G, cid, (const bf16*)(F.ws + WS_ACT), (const bf16*)(F.ws + WS_WDN), (const int*)(F.ws + WS_LIST), F.MISC);
        EpiAll E{6, 0, F.ws, F.in, F.out, F.MISC}; __syncthreads();
        pg8::gemm_phase<EpiAll, Sched, true, true, true, true>(ring, 512, 512, 512, S, E);
    } SEAM(10);
    if (IN(11)) { p9_final(F, 1.f); }
#undef IN
#undef SEAM
}

static void run_mk(void* const* d_in, float* out, unsigned char* ws, hipStream_t stream) {
    static int grid = 0;
    if (grid == 0) {
        int dev = 0, cus = 0;
        if (hipGetDevice(&dev) != hipSuccess || hipDeviceGetAttribute(&cus, hipDeviceAttributeMultiprocessorCount, dev) != hipSuccess) { fprintf(stderr, "kernel_launch: device query failed\n"); grid = -1; return; }
        if (hipFuncSetAttribute((const void*)mk_fwd, hipFuncAttributeMaxDynamicSharedMemorySize, LDS_BYTES) != hipSuccess) { fprintf(stderr, "kernel_launch: hipFuncSetAttribute failed\n"); grid = -1; return; }
        (void)hipGetLastError();
        grid = cus;
    }
    if (grid < 0) return;
    (void)hipMemsetAsync(ws + WS_CTL, 0, CTL_ZERO_BYTES, stream);
    Args a{};
    for (int i = 0; i < 25; ++i) a.in[i] = (const float*)d_in[i];
    a.out = out; a.ws = ws;
#ifdef MK_DUP
    const int nl = 3, los[3] = {0, MK_DUP, MK_DUP + 1}, his[3] = {MK_DUP + 1, MK_DUP + 1, NPHASES};
#else
    const int nl = 1, los[1] = {0}, his[1] = {NPHASES};
#endif
    for (int li = 0; li < nl; ++li) {
        if (los[li] >= his[li]) continue;
        a.ph_lo = los[li]; a.ph_hi = his[li]; a.li = li;
        hipLaunchKernelGGL(mk_fwd, dim3(grid), dim3(NWAVES * 64), LDS_BYTES, stream, a);
    }
}
}
extern "C" void kernel_launch(void* const* d_in, const int* in_sizes, int n_in, void* d_out, int out_size, void* d_ws, size_t ws_size, hipStream_t stream) {
    mk::run_mk(d_in, (float*)d_out, (unsigned char*)d_ws, stream);
}
```

```cpp
#include <hip/hip_runtime.h>
#include <cstdio>
#include <cstdint>
#include <cmath>
namespace pg8 {
#define PG8_LAS __attribute__((address_space(3)))
typedef unsigned short bf16_t;
typedef short bf16x8 __attribute__((ext_vector_type(8)));
typedef float f32x4 __attribute__((ext_vector_type(4)));
typedef unsigned u32x4 __attribute__((ext_vector_type(4)));
typedef unsigned u32x2 __attribute__((ext_vector_type(2)));
constexpr int BM = 256, BK = 64, HALF = 128, HTB = HALF * BK * 2  , STAGE_BYTES = 8 * HTB, NXCD = 8, WGM = 8;

__host__ __device__ __forceinline__ int lds_byte(int r, int c) { const int st = (r >> 4) * 2 + (c >> 5), rr = r & 15, cc = c & 31, ob = rr * 64 + cc * 2; return st * 1024 + (ob ^ (((ob >> 9) & 1) << 5)); }
__host__ __device__ __forceinline__ void stage_rc(int b, int& R, int& C) { const int st = b / 1024, sb = b % 1024, swz = sb ^ (((sb >> 9) & 1) << 5); R = (st >> 1) * 16 + swz / 64; C = (st & 1) * 32 + (swz % 64) / 2; }
__host__ __device__ __forceinline__ int perm32(int rho) { const int n = rho >> 4, i = rho & 15; return 8 * (i >> 2) + 4 * n + (i & 3); }

struct Unit { int pm, pn, e, i; };

__device__ __forceinline__ unsigned cvt_pk_bf16(float lo, float hi) { unsigned r; asm volatile("v_cvt_pk_bf16_f32 %0, %1, %2" : "=v"(r) : "v"(lo), "v"(hi)); return r; }

struct StaticOrder {
    int nM, nN, nwg, G, c; const bf16_t* A; const bf16_t* Bt; int lda, ldb, a_pn_off, pad;
    __device__ void init(int M, int N, int G_, int c_, const bf16_t* A_, int lda_, const bf16_t* Bt_, int ldb_, int a_pn_off_) { nM = M / BM; nN = N / BM; nwg = nM * nN; G = G_; c = c_; A = A_; Bt = Bt_; lda = lda_; ldb = ldb_; a_pn_off = a_pn_off_; pad = 0; }
    __device__ bool next(int i, Unit& u) const {
        const long L = (long)i * G + c; if (L >= nwg) return false;
        int wgid = (int)L; { const int q = nwg / NXCD, r = nwg % NXCD, xcd = wgid % NXCD, off = wgid / NXCD; wgid = (xcd < r ? xcd * (q + 1) : r * (q + 1) + (xcd - r) * q) + off; }
        const int nig = WGM * nN, gid = wgid / nig, fm = gid * WGM, gsz = (nM - fm) < WGM ? (nM - fm) : WGM;
        u.pm = fm + ((wgid % nig) % gsz); u.pn = (wgid % nig) / gsz; u.e = 0; u.i = 0; return true;
    }
    __device__ __forceinline__ const char* a_base(const Unit& u) const { return (const char*)(A + (size_t)u.pm * BM * lda + (size_t)u.pn * a_pn_off); }
    __device__ __forceinline__ const char* b_base(const Unit& u) const { return (const char*)(Bt + (size_t)u.pn * BM * ldb); }
    __device__ __forceinline__ unsigned row_off(const Unit&, int) const { return 0u; }
};

typedef int v8i32 __attribute__((ext_vector_type(8))); typedef int i32x4 __attribute__((ext_vector_type(4)));
template <class Epi, class Sched, bool ALIGN_EPI, bool SP2, int GATHER  , bool FP8>
__device__ __forceinline__ void gemm_phase(PG8_LAS unsigned char* lds, const int wave_id, const int K, const int lda, const int ldb, const Sched& S, const Epi& E) {
    int lane_; asm volatile("v_mbcnt_lo_u32_b32 %0, -1, 0\n\tv_mbcnt_hi_u32_b32 %0, -1, %0" : "=v"(lane_));
    const int wid = wave_id, lane = lane_, tid = wid * 64 + lane, wr = wid >> 2, wc = wid & 3, fr = lane & 15, fq = lane >> 4;
    const int nt = K / BK;
    unsigned voffA[2][2], voffN[2][2], voffB[2];
#pragma unroll
    for (int i = 0; i < 2; ++i) { int R, C; stage_rc(tid * 16 + i * 8192, R, C); const int Rb = Epi::PERM ? ((R & ~31) + perm32(R & 31)) : R;
        voffA[0][i] = GATHER ? (unsigned)C * 2u : (unsigned)(R * lda + C) * 2u; voffA[1][i] = voffA[0][i]; voffN[0][i] = 0; voffN[1][i] = 0; voffB[i] = (unsigned)(Rb * ldb + C) * 2u; }
    const unsigned kstep = (unsigned)(BK * 2);
    const unsigned hstepA = GATHER ? 0u : (unsigned)(HALF * lda * 2);
    const unsigned hstepB = (unsigned)(HALF * ldb * 2);
    const __amdgpu_buffer_rsrc_t rsrcA = __builtin_amdgcn_make_buffer_rsrc((void*)S.a_root(), 0, 0xFFFFFFFF, 0x00020000), rsrcB = __builtin_amdgcn_make_buffer_rsrc((void*)S.b_root(), 0, 0xFFFFFFFF, 0x00020000);
    const unsigned ldsw = (unsigned)wid * 1024u;
    const int aoff = lds_byte(wr * 64 + fr, fq * 8), boff = lds_byte(wc * 32 + fr, fq * 8);
#define PG8_SA(b, h) (((b) * 2 + (h)) * HTB)
#define PG8_SB(b, h) ((4 + (b) * 2 + (h)) * HTB)
#define PG8_STAGE_B(bufoff, soff) do { _Pragma("unroll") for (int _i = 0; _i < 2; ++_i) \
        __builtin_amdgcn_raw_ptr_buffer_load_lds(rsrcB, (PG8_LAS unsigned*)(lds + (bufoff) + ldsw + _i * 8192), 16, voffB[_i], (soff), 0, 0); } while (0)
#define PG8_STAGE_A(bufoff, soff, h) do { _Pragma("unroll") for (int _i = 0; _i < 2; ++_i) \
        __builtin_amdgcn_raw_ptr_buffer_load_lds(rsrcA, (PG8_LAS unsigned*)(lds + (bufoff) + ldsw + _i * 8192), 16, voffA[GATHER ? (h) : 0][_i], (soff) + (h) * hstepA, 0, 0); } while (0)
#define PG8_LDA(dst, b, h) do { _Pragma("unroll") for (int m = 0; m < 4; ++m) _Pragma("unroll") for (int k = 0; k < 2; ++k) dst[m][k] = *(const PG8_LAS bf16x8*)(lds + PG8_SA(b, h) + aoff + m * 2048 + k * 1024); } while (0)
#define PG8_LDB(dst, b, h) do { _Pragma("unroll") for (int n = 0; n < 2; ++n) _Pragma("unroll") for (int k = 0; k < 2; ++k) dst[n][k] = *(const PG8_LAS bf16x8*)(lds + PG8_SB(b, h) + boff + n * 2048 + k * 1024); } while (0)
#define PG8_CAT(x) (__builtin_shufflevector(__builtin_bit_cast(i32x4, x[0]), __builtin_bit_cast(i32x4, x[1]), 0, 1, 2, 3, 4, 5, 6, 7))
#define PG8_MMA(ai, bj, At, Bt) do { __builtin_amdgcn_s_setprio(1); _Pragma("unroll") for (int m = 0; m < 4; ++m) _Pragma("unroll") for (int n = 0; n < 2; ++n) { \
        if constexpr (FP8) acc[ai][bj][m][n] = __builtin_amdgcn_mfma_scale_f32_16x16x128_f8f6f4(PG8_CAT(Bt[n]), PG8_CAT(At[m]), acc[ai][bj][m][n], 0, 0, 0, 0x7f7f7f7f, 0, 0x7f7f7f7f); \
        else { _Pragma("unroll") for (int k = 0; k < 2; ++k) acc[ai][bj][m][n] = __builtin_amdgcn_mfma_f32_16x16x32_bf16(Bt[n][k], At[m][k], acc[ai][bj][m][n], 0, 0, 0); } } __builtin_amdgcn_s_setprio(0); } while (0)
#define PG8_WAIT_V(n) asm volatile("s_waitcnt vmcnt(" #n ")" ::: "memory")
#define PG8_WAIT_L(n) asm volatile("s_waitcnt lgkmcnt(" #n ")" ::: "memory")
#define PG8_BAR __builtin_amdgcn_s_barrier()
#define PG8_SCHED __builtin_amdgcn_sched_barrier(0)
#define PG8_GATHER_OFFS(dst, u) do { _Pragma("unroll") for (int _i = 0; _i < 2; ++_i) { int R_, C_; stage_rc(tid * 16 + _i * 8192, R_, C_); _Pragma("unroll") for (int _h = 0; _h < 2; ++_h) dst[_h][_i] = S.row_off(u, _h * HALF + R_) + (unsigned)C_ * 2u; } } while (0)
    Unit cur, nxt; int ui = 0;
    if (!S.next(0, cur)) return;
    f32x4 acc[2][2][4][2];
#pragma unroll
    for (int a = 0; a < 2; ++a)
#pragma unroll
        for (int b = 0; b < 2; ++b)
#pragma unroll
            for (int m = 0; m < 4; ++m)
#pragma unroll
                for (int n = 0; n < 2; ++n) acc[a][b][m][n] = (f32x4){0.f, 0.f, 0.f, 0.f};
    bf16x8 At[4][2], B0[2][2], B1[2][2];
    unsigned cA = (unsigned)(S.a_base(cur) - (const char*)S.a_root()), cB = (unsigned)(S.b_base(cur) - (const char*)S.b_root());
    if constexpr (GATHER) { PG8_GATHER_OFFS(voffA, cur); }
    if constexpr (SP2) {
        PG8_STAGE_B(PG8_SB(0, 0), cB); PG8_STAGE_B(PG8_SB(0, 1), cB + hstepB); PG8_STAGE_A(PG8_SA(0, 0), cA, 0); PG8_STAGE_A(PG8_SA(0, 1), cA, 1);
        if (wr == 1) PG8_BAR;
        PG8_WAIT_V(2); PG8_BAR;
        PG8_STAGE_B(PG8_SB(1, 0), cB + kstep); PG8_STAGE_A(PG8_SA(1, 0), cA + kstep, 0); PG8_STAGE_B(PG8_SB(1, 1), cB + hstepB + kstep);
        PG8_WAIT_V(6); PG8_BAR;
    } else {
        PG8_STAGE_B(PG8_SB(0, 0), cB); PG8_STAGE_A(PG8_SA(0, 0), cA, 0); PG8_STAGE_B(PG8_SB(0, 1), cB + hstepB); PG8_STAGE_A(PG8_SA(0, 1), cA, 1);
        if (wr == 1) PG8_BAR;
        PG8_WAIT_V(4); PG8_BAR;
        PG8_STAGE_B(PG8_SB(1, 0), cB + kstep); PG8_STAGE_A(PG8_SA(1, 0), cA + kstep, 0); PG8_STAGE_B(PG8_SB(1, 1), cB + hstepB + kstep);
        PG8_WAIT_V(6); PG8_BAR;
    }
    for (;;) {
        const bool has_next = S.next(ui + 1, nxt);
        const unsigned nA = has_next ? (unsigned)(S.a_base(nxt) - (const char*)S.a_root()) : cA, nB = has_next ? (unsigned)(S.b_base(nxt) - (const char*)S.b_root()) : cB;
#pragma unroll 1
        for (int t = 0; t < nt; t += 2) {
            const bool last = (t == nt - 2);
            const unsigned a1 = cA + (unsigned)(t + 1) * kstep;
            const unsigned a2 = last ? nA : cA + (unsigned)(t + 2) * kstep, b2 = last ? nB : cB + (unsigned)(t + 2) * kstep;
            const unsigned a3 = a2 + kstep, b3 = b2 + kstep;
            if constexpr (GATHER == 1) { if (last && has_next) { PG8_GATHER_OFFS(voffN, nxt); } }
            if constexpr (SP2) {
            PG8_LDB(B0, 0, 0); PG8_LDB(B1, 0, 1); PG8_SCHED; PG8_LDA(At, 0, 0); PG8_STAGE_A(PG8_SA(1, 1), a1, 1);
            PG8_WAIT_V(8); PG8_WAIT_L(0); PG8_BAR; PG8_MMA(0, 0, At, B0); PG8_MMA(0, 1, At, B1); PG8_BAR; PG8_SCHED;
            if constexpr (GATHER == 1) { if (last && has_next) {
#pragma unroll
                for (int _h = 0; _h < 2; ++_h)
#pragma unroll
                    for (int _i = 0; _i < 2; ++_i) voffA[_h][_i] = voffN[_h][_i]; } }
            if constexpr (GATHER == 2) { if (last && has_next) { PG8_GATHER_OFFS(voffA, nxt); } }
            PG8_LDA(At, 0, 1); PG8_STAGE_B(PG8_SB(0, 0), b2); PG8_STAGE_B(PG8_SB(0, 1), b2 + hstepB); PG8_STAGE_A(PG8_SA(0, 0), a2, 0);
            PG8_WAIT_V(8); PG8_WAIT_L(0); PG8_BAR; PG8_MMA(1, 0, At, B0); PG8_MMA(1, 1, At, B1); PG8_BAR; PG8_SCHED;
            PG8_LDB(B0, 1, 0); PG8_LDB(B1, 1, 1); PG8_SCHED; PG8_LDA(At, 1, 0); PG8_STAGE_A(PG8_SA(0, 1), a2, 1);
            PG8_WAIT_V(8); PG8_WAIT_L(0); PG8_BAR; PG8_MMA(0, 0, At, B0); PG8_MMA(0, 1, At, B1); PG8_BAR; PG8_SCHED;
            PG8_LDA(At, 1, 1); PG8_STAGE_B(PG8_SB(1, 0), b3); PG8_STAGE_B(PG8_SB(1, 1), b3 + hstepB); PG8_STAGE_A(PG8_SA(1, 0), a3, 0);
            PG8_WAIT_V(8); PG8_WAIT_L(0); PG8_BAR; PG8_MMA(1, 0, At, B0); PG8_MMA(1, 1, At, B1); PG8_BAR; PG8_SCHED;
            } else {
            PG8_LDB(B0, 0, 0); PG8_SCHED; PG8_LDA(At, 0, 0); PG8_STAGE_A(PG8_SA(1, 1), a1, 1);
            PG8_WAIT_L(8); PG8_BAR; PG8_WAIT_L(0); PG8_MMA(0, 0, At, B0); PG8_BAR; PG8_SCHED;
            if constexpr (GATHER == 1) { if (last && has_next) {
#pragma unroll
                for (int _h = 0; _h < 2; ++_h)
#pragma unroll
                    for (int _i = 0; _i < 2; ++_i) voffA[_h][_i] = voffN[_h][_i]; } }
            if constexpr (GATHER == 2) { if (last && has_next) { PG8_GATHER_OFFS(voffA, nxt); } }
            PG8_LDB(B1, 0, 1); PG8_STAGE_B(PG8_SB(0, 0), b2);
            PG8_BAR; PG8_WAIT_L(0); PG8_MMA(0, 1, At, B1); PG8_BAR;
            PG8_LDA(At, 0, 1); PG8_STAGE_A(PG8_SA(0, 0), a2, 0);
            PG8_BAR; PG8_WAIT_L(0); PG8_MMA(1, 0, At, B0); PG8_BAR; PG8_SCHED;
            PG8_STAGE_B(PG8_SB(0, 1), b2 + hstepB);
            PG8_WAIT_V(6); PG8_BAR; PG8_MMA(1, 1, At, B1); PG8_BAR;
            PG8_LDB(B0, 1, 0); PG8_SCHED; PG8_LDA(At, 1, 0); PG8_STAGE_A(PG8_SA(0, 1), a2, 1);
            PG8_WAIT_L(8); PG8_BAR; PG8_WAIT_L(0); PG8_MMA(0, 0, At, B0); PG8_BAR; PG8_SCHED;
            PG8_LDB(B1, 1, 1); PG8_STAGE_B(PG8_SB(1, 0), b3);
            PG8_BAR; PG8_WAIT_L(0); PG8_MMA(0, 1, At, B1); PG8_BAR;
            PG8_LDA(At, 1, 1); PG8_STAGE_A(PG8_SA(1, 0), a3, 0);
            PG8_BAR; PG8_WAIT_L(0); PG8_MMA(1, 0, At, B0); PG8_BAR; PG8_SCHED;
            PG8_STAGE_B(PG8_SB(1, 1), b3 + hstepB);
            PG8_WAIT_V(6); PG8_BAR; PG8_MMA(1, 1, At, B1); PG8_BAR;
            }
        }
        if constexpr (ALIGN_EPI) { if (wr == 0) PG8_BAR; }
        E(acc, cur, wr, wc, fr, fq);
        if (!has_next) break;
#pragma unroll
        for (int a = 0; a < 2; ++a)
#pragma unroll
            for (int b = 0; b < 2; ++b)
#pragma unroll
                for (int m = 0; m < 4; ++m)
#pragma unroll
                    for (int n = 0; n < 2; ++n) acc[a][b][m][n] = (f32x4){0.f, 0.f, 0.f, 0.f};
        cur = nxt; cA = nA; cB = nB; ++ui;
        if constexpr (ALIGN_EPI) { if (wr == 1) PG8_BAR; }
    }
    PG8_WAIT_V(0);
    if constexpr (!ALIGN_EPI) { if (wr == 0) PG8_BAR; }
    PG8_BAR;
#undef PG8_SA
#undef PG8_SB
#undef PG8_STAGE_A
#undef PG8_STAGE_B
#undef PG8_LDA
#undef PG8_LDB
#undef PG8_MMA
#undef PG8_CAT
#undef PG8_WAIT_V
#undef PG8_WAIT_L
#undef PG8_BAR
#undef PG8_SCHED
#undef PG8_GATHER_OFFS
}
}
namespace mk {
constexpr int NWAVES = 8;
constexpr int T = 16384, D = 1024, SEQ = 4096, NB = 4, NE = 32, NH = 32;
constexpr int DSSD = 2048, DCONV = 3072, NPROJ = 8224;
constexpr float EPS = 1e-5f;
constexpr size_t MiB = 1u << 20;
constexpr size_t WS_CTL = 0, CTL_ZERO_BYTES = 256 * 1024;
constexpr size_t WS_MOD = 128 * 1024;
constexpr size_t WS_CD = 1 * MiB;
constexpr size_t WS_GATE = 1 * MiB + 256 * 1024;
constexpr size_t WS_DT = 2 * MiB;
constexpr size_t WS_LIST = 4 * MiB;
constexpr size_t WS_WDT = 6 * MiB;
constexpr size_t WS_WPOOL = 6 * MiB + 512 * 1024;
constexpr size_t WS_WIN = 8 * MiB, WS_WSSD = 24 * MiB, WS_WPO = 28 * MiB, WS_WOUT = 30 * MiB, WS_WGU = 32 * MiB, WS_WDN = 160 * MiB;
constexpr size_t WS_H = 224 * MiB, WS_Z = 256 * MiB, WS_XBC = 320 * MiB, WS_U = 416 * MiB, WS_GATES = 448 * MiB, WS_STATES = 512 * MiB, WS_Y = 576 * MiB;
constexpr size_t WS_P = 640 * MiB, WS_P2 = 672 * MiB, WS_M1 = 704 * MiB, WS_MERGED = 736 * MiB, WS_END = 768 * MiB;
constexpr size_t WS_XC = 768 * MiB;
constexpr size_t WS_ACT = 256 * MiB, WS_YB = 416 * MiB;
constexpr int ACT_ROWS = 73728;
constexpr int CW_TMO = 0, CW_CODE = 1, CW_GCNT = 1024, CW_BAR = 4096;
constexpr int RING_BYTES = 143360;
constexpr int LDSCTL_OFF = RING_BYTES, MISC_OFF = LDSCTL_OFF + 64;
constexpr int LDS_BYTES = 147456;

#define GAS __attribute__((address_space(1)))
#define LAS __attribute__((address_space(3)))
typedef unsigned short bf16;
typedef unsigned v4u __attribute__((ext_vector_type(4)));
typedef unsigned v2u __attribute__((ext_vector_type(2)));
typedef float f32x4 __attribute__((ext_vector_type(4)));
typedef float f32x16 __attribute__((ext_vector_type(16)));
typedef short bf16x8 __attribute__((ext_vector_type(8)));
typedef GAS unsigned gu32;
#define RLX_AGENT __ATOMIC_RELAXED, __HIP_MEMORY_SCOPE_AGENT
#define LDS_WAIT() asm volatile("s_waitcnt lgkmcnt(0)" ::: "memory")
#define VM_WAIT() asm volatile("s_waitcnt vmcnt(0)" ::: "memory")
__device__ __forceinline__ unsigned f2bf(float f) { unsigned u = __builtin_bit_cast(unsigned, f); return (u + 0x7fffu + ((u >> 16) & 1u)) >> 16; }
typedef float f32x2_t __attribute__((ext_vector_type(2))); typedef __bf16 bf16x2_t __attribute__((ext_vector_type(2)));
__device__ __forceinline__ unsigned pk2(float lo, float hi) { const f32x2_t v = {lo, hi}; const bf16x2_t b = __builtin_convertvector(v, bf16x2_t); return __builtin_bit_cast(unsigned, b); }
__device__ __forceinline__ float bflo(unsigned w) { return __builtin_bit_cast(float, w << 16); }
__device__ __forceinline__ float bfhi(unsigned w) { return __builtin_bit_cast(float, w & 0xffff0000u); }
__device__ __forceinline__ float bf2f(bf16 h) { return __builtin_bit_cast(float, (unsigned)h << 16); }
__device__ __forceinline__ float sigm(float x) { return __builtin_amdgcn_rcpf(1.f + __builtin_amdgcn_exp2f(x * -1.4426950408889634f)); }
__device__ __forceinline__ float silu(float x) { return x * sigm(x); }
__device__ __forceinline__ float wave_sum(float v) {
#pragma unroll
    for (int o = 1; o < 64; o <<= 1) v += __shfl_xor(v, o);
    return v;
}

#define XB_TMO      128
#define XB_XCNT(j)  (256  + 64 * (j))
#define XB_XSUB(j)  (1280 + 64 * (j))
#define XB_XGEN(j)  (2304 + 64 * (j))
#define XB_TOP      3328
#define XB_TOPGEN   3392
#define XCD_BAR_WORDS 3456
#define XB_SPIN_CAP (1u << 18)
__device__ __forceinline__ unsigned xb_ld(unsigned* p)              { return __hip_atomic_load(p, __ATOMIC_RELAXED, __HIP_MEMORY_SCOPE_AGENT); }
__device__ __forceinline__ unsigned xb_add(unsigned* p, unsigned v) { return __hip_atomic_fetch_add(p, v, __ATOMIC_RELAXED, __HIP_MEMORY_SCOPE_AGENT); }
__device__ __forceinline__ unsigned xb_xcc_id() { return (unsigned)__builtin_amdgcn_s_getreg((3 << 11) | 20) & 0xFu; }
#define XB_SPIN(cond, bar) do { unsigned _sp = 0; while (cond) { __builtin_amdgcn_s_sleep(1); \
    if ((++_sp & 255u) == 0u) { if (xb_ld(&(bar)[XB_TMO])) break; if (_sp > XB_SPIN_CAP) { atomicAdd(&(bar)[XB_TMO], 1u); break; } } } } while (0)
struct XcdBarrier { unsigned* bar; unsigned x; volatile LAS unsigned* st; };
__device__ __forceinline__ XcdBarrier xcd_barrier_post(unsigned* bar, volatile LAS unsigned* st) {
    XcdBarrier b; b.bar = bar; b.x = xb_xcc_id(); b.st = st;
    if (threadIdx.x == 0) (void)xb_add(&bar[XB_XCNT(b.x)], 1u);
    return b;
}
__device__ __forceinline__ void xcd_barrier_complete(unsigned* bar, unsigned x, unsigned& nloc, unsigned& nx) {
    const unsigned G = gridDim.x * gridDim.y * gridDim.z;
    unsigned sum, cnt, mine, sp = 0u;
    for (;;) {
        sum = 0u; cnt = 0u; mine = 0u;
#pragma unroll
        for (unsigned j = 0; j < 16; ++j) { const unsigned c = xb_ld(&bar[XB_XCNT(j)]); sum += c; cnt += (c > 0u) ? 1u : 0u; mine = (j == x) ? c : mine; }
        if (sum == G) break;
        __builtin_amdgcn_s_sleep(1);
        if ((++sp & 255u) == 0u) { if (xb_ld(&bar[XB_TMO])) break; if (sp > XB_SPIN_CAP) { atomicAdd(&bar[XB_TMO], 1u); break; } }
    }
    nloc = mine > 0u ? mine : 1u; nx = cnt > 0u ? cnt : 1u;
}
__device__ __forceinline__ void xcd_barrier(const XcdBarrier& b, const int wave) {
    asm volatile("s_waitcnt vmcnt(0)" ::: "memory");
    __syncthreads();
    int lane_; asm volatile("v_mbcnt_lo_u32_b32 %0, -1, 0\n\tv_mbcnt_hi_u32_b32 %0, -1, %0" : "=v"(lane_));
    if (wave == 0 && lane_ == 0) {
        unsigned* bar = b.bar;
        __builtin_amdgcn_s_waitcnt(0);
        unsigned nloc = b.st[0], nx = b.st[1];
        if (nloc == 0u) { xcd_barrier_complete(bar, b.x, nloc, nx); b.st[0] = nloc; b.st[1] = nx; }
        const unsigned old = xb_add(&bar[XB_XSUB(b.x)], 1u);
        const unsigned gen = old / nloc;
        if (old + 1u == (gen + 1u) * nloc) {
            __builtin_amdgcn_fence(__ATOMIC_RELEASE, "agent");
            asm volatile("s_waitcnt vmcnt(0)" ::: "memory");
            const unsigned og = xb_add(&bar[XB_TOP], 1u);
            const unsigned tg = og / nx;
            if (og + 1u == (tg + 1u) * nx) xb_add(&bar[XB_TOPGEN], 1u);
            else XB_SPIN(xb_ld(&bar[XB_TOPGEN]) == tg, bar);
            __builtin_amdgcn_fence(__ATOMIC_ACQUIRE, "agent");
            xb_add(&bar[XB_XGEN(b.x)], 1u);
            asm volatile("s_waitcnt vmcnt(0)" ::: "memory");
        } else {
            XB_SPIN(xb_ld(&bar[XB_XGEN(b.x)]) == gen, bar);
            __builtin_amdgcn_fence(__ATOMIC_ACQUIRE, "agent");
            asm volatile("s_waitcnt vmcnt(0)" ::: "memory");
        }
    }
    __syncthreads();
}
}
namespace mk {
struct Frame {
    LAS unsigned char* lds; volatile LAS unsigned* MISC; gu32* ctl; unsigned char* ws; float* out; const float* const* in;
    int tid, lane, wave, vcu, G;
};
__device__ __forceinline__ void refresh_ids(Frame& F) { int l; asm volatile("v_mbcnt_lo_u32_b32 %0, -1, 0\n\tv_mbcnt_hi_u32_b32 %0, -1, %0" : "=v"(l)); F.lane = l; F.tid = F.wave * 64 + l; }
enum { I_X = 0, I_C, I_WADA, I_BADA, I_NMW, I_WIN, I_CONVW, I_CONVB, I_DTB, I_ALOG, I_DSKIP, I_SNW, I_WSSD, I_WPOOL, I_PSCALE, I_WPO, I_WOUT, I_NFW, I_WR, I_BR, I_WGU, I_BGU, I_WDN, I_BDN, I_NFINAL };

__device__ __forceinline__ void p0_tile(const float* src, int ldsrc, int srccol0, int k0, bf16* dst, int lddst, int dstrow0, int nvalid, LAS float* scr, int lane) {
    const int col = (lane & 15) * 4;
    f32x4 tv[16];
#pragma unroll
    for (int i = 0; i < 16; ++i) { const int kk = 4 * i + (lane >> 4); tv[i] = (f32x4){0.f, 0.f, 0.f, 0.f}; if (col < nvalid) tv[i] = *(const f32x4*)(src + (size_t)(k0 + kk) * ldsrc + srccol0 + col); }
#pragma unroll
    for (int i = 0; i < 16; ++i) { const int kk = 4 * i + (lane >> 4); LAS float* s = scr + kk * 65 + col; s[0] = tv[i].x; s[1] = tv[i].y; s[2] = tv[i].z; s[3] = tv[i].w; }
    LDS_WAIT(); asm volatile("" ::: "memory");
    const int c = lane & 7;
#pragma unroll
    for (int j = 0; j < 8; ++j) { const int n = (lane >> 3) + 8 * j; const LAS float* s = scr + (8 * c) * 65 + n;
        v4u o; o.x = pk2(s[0 * 65], s[1 * 65]); o.y = pk2(s[2 * 65], s[3 * 65]); o.z = pk2(s[4 * 65], s[5 * 65]); o.w = pk2(s[6 * 65], s[7 * 65]);
        if (n < nvalid) *(v4u*)(dst + (size_t)(dstrow0 + n) * lddst + k0 + 8 * c) = o; }
    LDS_WAIT(); asm volatile("" ::: "memory");
}
__device__ __forceinline__ void p0_tile8(const float* src, int ldsrc, int srccol0, int k0, unsigned char* dst, int lddst, int dstrow0, float scale, LAS float* scr, int lane) {
    const int col = (lane & 15) * 4;
    f32x4 tv[16];
#pragma unroll
    for (int i = 0; i < 16; ++i) { const int kk = 4 * i + (lane >> 4); tv[i] = *(const f32x4*)(src + (size_t)(k0 + kk) * ldsrc + srccol0 + col); }
#pragma unroll
    for (int i = 0; i < 16; ++i) { const int kk = 4 * i + (lane >> 4); LAS float* s = scr + kk * 65 + col; s[0] = tv[i].x; s[1] = tv[i].y; s[2] = tv[i].z; s[3] = tv[i].w; }
    LDS_WAIT(); asm volatile("" ::: "memory");
    const int c = lane & 7;
#pragma unroll
    for (int j = 0; j < 8; ++j) { const int n = (lane >> 3) + 8 * j; const LAS float* s = scr + (8 * c) * 65 + n;
        int w0 = 0, w1 = 0; w0 = __builtin_amdgcn_cvt_pk_fp8_f32(s[0 * 65] * scale, s[1 * 65] * scale, w0, false); w0 = __builtin_amdgcn_cvt_pk_fp8_f32(s[2 * 65] * scale, s[3 * 65] * scale, w0, true);
        w1 = __builtin_amdgcn_cvt_pk_fp8_f32(s[4 * 65] * scale, s[5 * 65] * scale, w1, false); w1 = __builtin_amdgcn_cvt_pk_fp8_f32(s[6 * 65] * scale, s[7 * 65] * scale, w1, true);
        *(v2u*)(dst + (size_t)(dstrow0 + n) * lddst + k0 + 8 * c) = (v2u){(unsigned)w0, (unsigned)w1}; }
    LDS_WAIT(); asm volatile("" ::: "memory");
}
__device__ __forceinline__ void p0_prologue(Frame& F) {
    LAS float* scr = (LAS float*)(F.lds + F.wave * 16896);
    const int gw = F.vcu * NWAVES + F.wave, NGW = F.G * NWAVES;
    bf16* WIN_T = (bf16*)(F.ws + WS_WIN); bf16* WDT_T = (bf16*)(F.ws + WS_WDT); bf16* WSSD_T = (bf16*)(F.ws + WS_WSSD); bf16* WPO_T = (bf16*)(F.ws + WS_WPO);
    bf16* WOUT_T = (bf16*)(F.ws + WS_WOUT); bf16* WPOOL_T = (bf16*)(F.ws + WS_WPOOL); bf16* WGU_T = (bf16*)(F.ws + WS_WGU); bf16* WDN_T = (bf16*)(F.ws + WS_WDN);
    constexpr int N_IN = 2048, N_DT = 16, N_SSD = 512, N_PO = 256, N_OUT = 256, N_POOL = 64, N_GU = 16384, N_DN = 8192;
    constexpr int NITEMS = N_IN + N_DT + N_SSD + N_PO + N_OUT + N_POOL + N_GU + N_DN;
    for (int it = gw; it < NITEMS; it += NGW) {
        int r = it;
        if (r < N_GU) { const int e = r >> 9, q = r & 511, rb = q >> 4, kb = q & 15; const int rho = rb * 64, pn = rho >> 8, rr = rho & 255;
            const int sc = rr < 128 ? 128 * pn + rr : 1024 + 128 * pn + (rr - 128);
            p0_tile8(F.in[I_WGU] + (size_t)e * 1024 * 2048, 2048, sc, kb * 64, (unsigned char*)WGU_T + (size_t)e * 2048 * 1024, 1024, rho, 32.f, scr, F.lane); continue; } r -= N_GU;
        if (r < N_DN) { const int e = r >> 8, q = r & 255, rb = q >> 4, kb = q & 15;
            p0_tile8(F.in[I_WDN] + (size_t)e * 1024 * 1024, 1024, rb * 64, kb * 64, (unsigned char*)WDN_T + (size_t)e * 1024 * 1024, 1024, rb * 64, 32.f, scr, F.lane); continue; } r -= N_DN;
        if (r < N_IN) { const int rb = r >> 4, kb = r & 15; const int drow = rb * 64; const int sc = drow + (drow >= 5120 ? 32 : 0);
            p0_tile(F.in[I_WIN], NPROJ, sc, kb * 64, WIN_T, 1024, drow, 64, scr, F.lane); continue; } r -= N_IN;
        if (r < N_DT) { p0_tile(F.in[I_WIN], NPROJ, 5120, r * 64, WDT_T, 1024, 0, 32, scr, F.lane); continue; } r -= N_DT;
        if (r < N_SSD) { const int rb = r >> 5, kb = r & 31; p0_tile(F.in[I_WSSD], 1024, rb * 64, kb * 64, WSSD_T, 2048, rb * 64, 64, scr, F.lane); continue; } r -= N_SSD;
        if (r < N_PO) { const int rb = r >> 4, kb = r & 15; p0_tile(F.in[I_WPO], 1024, rb * 64, kb * 64, WPO_T, 1024, rb * 64, 64, scr, F.lane); continue; } r -= N_PO;
        if (r < N_OUT) { const int rb = r >> 4, kb = r & 15; p0_tile(F.in[I_WOUT], 1024, rb * 64, kb * 64, WOUT_T, 1024, rb * 64, 64, scr, F.lane); continue; } r -= N_OUT;
        { const int g = r >> 4, q = r & 15, rb = q >> 2, kb = q & 3; p0_tile(F.in[I_WPOOL] + (size_t)g * 65536, 256, rb * 64, kb * 64, WPOOL_T, 256, g * 256 + rb * 64, 64, scr, F.lane); }
    }
    __syncthreads();
    { float* mod = (float*)(F.ws + WS_MOD); LAS float* red = (LAS float*)F.lds;
      for (int jb = F.vcu; jb < 256; jb += F.G) {
        const int jj = F.tid & 31, sl = F.tid >> 5, j = jb * 24 + jj; float a0 = 0.f, a1 = 0.f, a2 = 0.f, a3 = 0.f; const float* cc = F.in[I_C];
        if (jj < 24) {
#pragma unroll 8
            for (int k = sl * 64; k < sl * 64 + 64; ++k) { const float w = F.in[I_WADA][(size_t)k * 6144 + j];
                a0 += silu(cc[k]) * w; a1 += silu(cc[1024 + k]) * w; a2 += silu(cc[2048 + k]) * w; a3 += silu(cc[3072 + k]) * w; } }
        red[(sl * 4 + 0) * 32 + jj] = a0; red[(sl * 4 + 1) * 32 + jj] = a1; red[(sl * 4 + 2) * 32 + jj] = a2; red[(sl * 4 + 3) * 32 + jj] = a3;
        __syncthreads();
        if (F.tid < 128) { const int b = F.tid >> 5, q = F.tid & 31; if (q < 24) { float s = F.in[I_BADA][jb * 24 + q];
#pragma unroll
                for (int i = 0; i < 16; ++i) s += red[(i * 4 + b) * 32 + q];
                mod[b * 6144 + jb * 24 + q] = s; } }
        __syncthreads();
      } }
}

__device__ __forceinline__ void p1_norm_dt(Frame& F) {
    constexpr int PITCH = 2064;
    LAS unsigned char* tile = F.lds + F.wave * (8 * PITCH);
    for (int grp = F.vcu * NWAVES + F.wave; grp < T / 8; grp += F.G * NWAVES) {
    const int t0 = grp * 8, b = t0 / SEQ;
    const float* mod = (const float*)(F.ws + WS_MOD) + b * 6144; bf16* H = (bf16*)(F.ws + WS_H);
    f32x4 wv[4], scv[4], shv[4];
#pragma unroll
    for (int j = 0; j < 4; ++j) { const int col = 4 * F.lane + 256 * j; wv[j] = *(const f32x4*)(F.in[I_NMW] + col); scv[j] = *(const f32x4*)(mod + 1024 + col); shv[j] = *(const f32x4*)(mod + col); }
#pragma unroll 1
    for (int r4 = 0; r4 < 8; r4 += 4) {
      f32x4 xv[4][4];
#pragma unroll
      for (int rr = 0; rr < 4; ++rr)
#pragma unroll
        for (int j = 0; j < 4; ++j) xv[rr][j] = *(const f32x4*)(F.in[I_X] + (size_t)(t0 + r4 + rr) * D + 4 * F.lane + 256 * j);
#pragma unroll
      for (int rr = 0; rr < 4; ++rr) { const int r = r4 + rr;
        f32x4 v[4]; float s = 0.f;
#pragma unroll
        for (int j = 0; j < 4; ++j) { v[j] = xv[rr][j]; s += (v[j].x * v[j].x + v[j].y * v[j].y) + (v[j].z * v[j].z + v[j].w * v[j].w); }
        const float rstd = rsqrtf(wave_sum(s) * (1.f / D) + EPS);
#pragma unroll
        for (int j = 0; j < 4; ++j) { const f32x4 hv = v[j] * rstd * wv[j] * (scv[j] + 1.f) + shv[j];
            v2u o; o.x = pk2(hv.x, hv.y); o.y = pk2(hv.z, hv.w);
            *(v2u*)(H + (size_t)(t0 + r) * D + 4 * F.lane + 256 * j) = o;
            *(LAS v2u*)(tile + r * PITCH + (4 * F.lane + 256 * j) * 2) = o; }
      }
    }
    LDS_WAIT(); asm volatile("" ::: "memory");
    const bf16* WDT_T = (const bf16*)(F.ws + WS_WDT);
    f32x4 acc0 = (f32x4){0.f, 0.f, 0.f, 0.f}, acc1 = acc0; const int fr = F.lane & 15, fq = F.lane >> 4;
#pragma unroll 8
    for (int s = 0; s < 32; ++s) {
        const bf16x8 a = *(const LAS bf16x8*)(tile + (fr & 7) * PITCH + (32 * s + 8 * fq) * 2);
        const bf16x8 b0 = *(const bf16x8*)(WDT_T + (size_t)fr * 1024 + 32 * s + 8 * fq), b1 = *(const bf16x8*)(WDT_T + (size_t)(fr + 16) * 1024 + 32 * s + 8 * fq);
        acc0 = __builtin_amdgcn_mfma_f32_16x16x32_bf16(a, b0, acc0, 0, 0, 0); acc1 = __builtin_amdgcn_mfma_f32_16x16x32_bf16(a, b1, acc1, 0, 0, 0);
    }
    if (fq < 2) { float* DT = (float*)(F.ws + WS_DT); const float db0 = F.in[I_DTB][fr], db1 = F.in[I_DTB][fr + 16];
#pragma unroll
        for (int i = 0; i < 4; ++i) { const int row = t0 + 4 * fq + i; float x0 = acc0[i] + db0, x1 = acc1[i] + db1;
            DT[(size_t)row * 32 + fr] = x0 > 20.f ? x0 : log1pf(__expf(x0)); DT[(size_t)row * 32 + 16 + fr] = x1 > 20.f ? x1 : log1pf(__expf(x1)); } }
    LDS_WAIT();
    }
}

template <int W> __device__ __forceinline__ void pool_item(const bf16* U, bf16* P, int t0, int tt0, int cg) {
    v4u raw[W + 7];
#pragma unroll
    for (int r = 0; r < W + 7; ++r) { const int d = r - (W - 1); raw[r] = (tt0 + d >= 0) ? *(const v4u*)(U + (size_t)(t0 + d) * D + cg * 8) : (v4u){0u, 0u, 0u, 0u}; }
    float s[8];
#pragma unroll
    for (int q = 0; q < 8; ++q) s[q] = 0.f;
#pragma unroll
    for (int r = 0; r < W - 1; ++r) { const v4u v = raw[r]; s[0] += bflo(v.x); s[1] += bfhi(v.x); s[2] += bflo(v.y); s[3] += bfhi(v.y); s[4] += bflo(v.z); s[5] += bfhi(v.z); s[6] += bflo(v.w); s[7] += bfhi(v.w); }
#pragma unroll
    for (int i = 0; i < 8; ++i) { const v4u v = raw[W - 1 + i]; const float u[8] = {bflo(v.x), bfhi(v.x), bflo(v.y), bfhi(v.y), bflo(v.z), bfhi(v.z), bflo(v.w), bfhi(v.w)};
#pragma unroll
        for (int q = 0; q < 8; ++q) s[q] += u[q];
        const int tt = tt0 + i; const float inv = 1.f / (float)(tt + 1 < W ? tt + 1 : W);
        v4u o; o.x = pk2(s[0] * inv - u[0], s[1] * inv - u[1]); o.y = pk2(s[2] * inv - u[2], s[3] * inv - u[3]); o.z = pk2(s[4] * inv - u[4], s[5] * inv - u[5]); o.w = pk2(s[6] * inv - u[6], s[7] * inv - u[7]);
        *(v4u*)(P + (size_t)(t0 + i) * D + cg * 8) = o;
        const v4u z = raw[i]; s[0] -= bflo(z.x); s[1] -= bfhi(z.x); s[2] -= bflo(z.y); s[3] -= bfhi(z.y); s[4] -= bflo(z.z); s[5] -= bfhi(z.z); s[6] -= bflo(z.w); s[7] -= bfhi(z.w); }
}
__device__ __forceinline__ void pool_pass(Frame& F) {
    const bf16* U = (const bf16*)(F.ws + WS_U); bf16* P = (bf16*)(F.ws + WS_P);
    for (int it = F.vcu * 512 + F.tid; it < 2048 * 128; it += F.G * 512) {
        const int wsel = __builtin_amdgcn_readfirstlane((it >> 6) & 3), cg = wsel * 32 + (it & 31), strip = (it >> 8) * 2 + ((it >> 5) & 1); const int t0 = strip * 8, tt0 = t0 % SEQ;
        if (wsel == 0) pool_item<2>(U, P, t0, tt0, cg); else if (wsel == 1) pool_item<4>(U, P, t0, tt0, cg); else if (wsel == 2) pool_item<8>(U, P, t0, tt0, cg); else pool_item<16>(U, P, t0, tt0, cg);
    }
}

__device__ __forceinline__ int swz16(int row) { return (row ^ (row >> 4)) & 15; }
__device__ __forceinline__ void conv8x8(const bf16* XBC, const float* cw, const float* cb, int trow0, bool seq_start, int col, float (&out)[8][8]) {
    float u[11][8];
#pragma unroll
    for (int r = 0; r < 11; ++r) { v4u v = (v4u){0u, 0u, 0u, 0u}; if (!(r < 3 && seq_start)) v = *(const v4u*)(XBC + (size_t)(trow0 - 3 + r) * DCONV + col);
        u[r][0] = bflo(v.x); u[r][1] = bfhi(v.x); u[r][2] = bflo(v.y); u[r][3] = bfhi(v.y); u[r][4] = bflo(v.z); u[r][5] = bfhi(v.z); u[r][6] = bflo(v.w); u[r][7] = bfhi(v.w); }
    float w[4][8], bb[8];
#pragma unroll
    for (int k = 0; k < 4; ++k) { const f32x4 a = *(const f32x4*)(cw + k * DCONV + col), b = *(const f32x4*)(cw + k * DCONV + col + 4);
        w[k][0] = a.x; w[k][1] = a.y; w[k][2] = a.z; w[k][3] = a.w; w[k][4] = b.x; w[k][5] = b.y; w[k][6] = b.z; w[k][7] = b.w; }
    { const f32x4 a = *(const f32x4*)(cb + col), b = *(const f32x4*)(cb + col + 4); bb[0] = a.x; bb[1] = a.y; bb[2] = a.z; bb[3] = a.w; bb[4] = b.x; bb[5] = b.y; bb[6] = b.z; bb[7] = b.w; }
#pragma unroll
    for (int i = 0; i < 8; ++i)
#pragma unroll
        for (int q = 0; q < 8; ++q) { const float a = bb[q] + w[0][q] * u[i][q] + w[1][q] * u[i + 1][q] + w[2][q] * u[i + 2][q] + w[3][q] * u[i + 3][q]; out[i][q] = silu(a); }
}
__device__ __forceinline__ void conv_item(const bf16* XBC, const float* cw, const float* cb, int trow0, bool seq_start, int col, bf16* gdst, const bool do_g, LAS unsigned char* img, const bool do_img, int row0, int chunk, const LAS float* sc, const bool do_sc) {
    v4u raw[11];
#pragma unroll
    for (int r = 0; r < 11; ++r) { raw[r] = (v4u){0u, 0u, 0u, 0u}; if (!(r < 3 && seq_start)) raw[r] = *(const v4u*)(XBC + (size_t)(trow0 - 3 + r) * DCONV + col); }
    f32x4 wa[4], wb[4];
#pragma unroll
    for (int k = 0; k < 4; ++k) { wa[k] = *(const f32x4*)(cw + k * DCONV + col); wb[k] = *(const f32x4*)(cw + k * DCONV + col + 4); }
    const f32x4 ba = *(const f32x4*)(cb + col), bbv = *(const f32x4*)(cb + col + 4);
    unsigned la[8];
#pragma unroll
    for (int q = 0; q < 8; ++q) la[q] = (unsigned)((row0 + q) * 256 + ((chunk ^ swz16(row0 + q)) << 4));
#define CI_U(R, Q) (((Q) & 1) ? bfhi(((Q) >> 1) == 0 ? raw[R].x : ((Q) >> 1) == 1 ? raw[R].y : ((Q) >> 1) == 2 ? raw[R].z : raw[R].w) : bflo(((Q) >> 1) == 0 ? raw[R].x : ((Q) >> 1) == 1 ? raw[R].y : ((Q) >> 1) == 2 ? raw[R].z : raw[R].w))
#define CI_W(K, Q) ((Q) < 4 ? wa[K][(Q) & 3] : wb[K][(Q) & 3])
#pragma unroll
    for (int ip = 0; ip < 4; ++ip) {
        float a0[8], a1[8];
#pragma unroll
        for (int q = 0; q < 8; ++q) { const float bq = q < 4 ? ba[q & 3] : bbv[q & 3];
            a0[q] = silu(bq + CI_W(0, q) * CI_U(2 * ip, q) + CI_W(1, q) * CI_U(2 * ip + 1, q) + CI_W(2, q) * CI_U(2 * ip + 2, q) + CI_W(3, q) * CI_U(2 * ip + 3, q));
            a1[q] = silu(bq + CI_W(0, q) * CI_U(2 * ip + 1, q) + CI_W(1, q) * CI_U(2 * ip + 2, q) + CI_W(2, q) * CI_U(2 * ip + 3, q) + CI_W(3, q) * CI_U(2 * ip + 4, q)); }
        if (do_g) { *(v4u*)(gdst + (size_t)(2 * ip) * DCONV) = (v4u){pk2(a0[0], a0[1]), pk2(a0[2], a0[3]), pk2(a0[4], a0[5]), pk2(a0[6], a0[7])};
                    *(v4u*)(gdst + (size_t)(2 * ip + 1) * DCONV) = (v4u){pk2(a1[0], a1[1]), pk2(a1[2], a1[3]), pk2(a1[4], a1[5]), pk2(a1[6], a1[7])}; }
        if (do_img) { float s0 = 1.f, s1 = 1.f; if (do_sc) { s0 = sc[2 * ip]; s1 = sc[2 * ip + 1]; }
#pragma unroll
            for (int q = 0; q < 8; ++q) *(LAS unsigned*)(img + la[q] + 4 * ip) = pk2(a0[q] * s0, a1[q] * s1); }
    }
#undef CI_U
#undef CI_W
}
__device__ __forceinline__ void put_transposed(LAS unsigned char* img, int row0, int chunk, const float (&o)[8][8]) {
#pragma unroll
    for (int q = 0; q < 8; ++q) { const int row = row0 + q; v4u v; v.x = pk2(o[0][q], o[1][q]); v.y = pk2(o[2][q], o[3][q]); v.z = pk2(o[4][q], o[5][q]); v.w = pk2(o[6][q], o[7][q]);
        *(LAS v4u*)(img + row * 256 + ((chunk ^ swz16(row)) << 4)) = v; }
}
__device__ __forceinline__ void put_global(bf16* dst, const float (&o)[8][8]) {
#pragma unroll
    for (int i = 0; i < 8; ++i) { v4u v; v.x = pk2(o[i][0], o[i][1]); v.y = pk2(o[i][2], o[i][3]); v.z = pk2(o[i][4], o[i][5]); v.w = pk2(o[i][6], o[i][7]); *(v4u*)(dst + (size_t)i * DCONV) = v; }
}
__device__ __forceinline__ void put_natural(LAS unsigned char* img, int l0, int chunk, const float (&o)[8][8]) {
#pragma unroll
    for (int i = 0; i < 8; ++i) { const int row = l0 + i; v4u v; v.x = pk2(o[i][0], o[i][1]); v.y = pk2(o[i][2], o[i][3]); v.z = pk2(o[i][4], o[i][5]); v.w = pk2(o[i][6], o[i][7]);
        *(LAS v4u*)(img + row * 256 + ((chunk ^ swz16(row)) << 4)) = v; }
}
__device__ __forceinline__ bf16x8 ld_frag(const LAS unsigned char* img, int row, int chunk) { return *(const LAS bf16x8*)(img + row * 256 + ((chunk ^ swz16(row)) << 4)); }

__device__ __forceinline__ void ssd_states_unit(Frame& F, int unit) {
    const int hh = unit & 1, g = (unit >> 1) & 3, c = (unit >> 3) & 31, b = unit >> 8; const int t0 = b * SEQ + c * 128;
    LAS float* sx = (LAS float*)F.lds;
    LAS unsigned char* Bt = F.lds + 4096; LAS unsigned char* Xt = F.lds + 4096 + 32768;
    const float* DT = (const float*)(F.ws + WS_DT); const bf16* XBC = (const bf16*)(F.ws + WS_XBC); bf16* XC = (bf16*)(F.ws + WS_XC); float* CD = (float*)(F.ws + WS_CD);
    __syncthreads();
    if (F.wave < 4) {
        const int h = g * 8 + 4 * hh + F.wave; const float A = -__expf(F.in[I_ALOG][h]); const int l = 2 * F.lane;
        const float d0 = DT[(size_t)(t0 + l) * 32 + h], d1 = DT[(size_t)(t0 + l + 1) * 32 + h]; const float a0 = d0 * A, a1 = d1 * A, s = a0 + a1;
        float incl = s;
#pragma unroll
        for (int o = 1; o < 64; o <<= 1) { const float v = __shfl_up(incl, o); if (F.lane >= o) incl += v; }
        const float c0 = incl - s + a0, c1 = incl, total = __shfl(incl, 63);
        sx[F.wave * 128 + l] = d0 * __expf(total - c0); sx[F.wave * 128 + l + 1] = d1 * __expf(total - c1);
        if (F.lane == 0) CD[(b * 32 + c) * 32 + h] = __expf(total);
    }
    __syncthreads();
#pragma unroll 1
    for (int itx = 0; itx < 2; ++itx) {
        int kind, strip, grp, col;
        if (itx == 0) { kind = 0; strip = F.tid >> 5; grp = F.tid & 31; col = g * 512 + hh * 256 + grp * 8; }
        else if (F.tid < 256) { kind = 1; strip = F.tid >> 4; grp = F.tid & 15; col = 2048 + g * 128 + grp * 8; }
        else if (F.tid < 384) { kind = 2; strip = 8 * hh + ((F.tid - 256) >> 4); grp = F.tid & 15; col = 2560 + g * 128 + grp * 8; }
        else { kind = 3; strip = 0; grp = 0; col = 0; }
        if (kind < 3) { const int l0 = strip * 8;
            conv_item(XBC, F.in[I_CONVW], F.in[I_CONVB], t0 + l0, (c == 0 && l0 == 0), col, XC + (size_t)(t0 + l0) * DCONV + col, (kind != 1 || hh == 0),
                      kind ? Bt : Xt, kind < 2, grp * 8, strip, sx + (grp >> 3) * 128 + l0, kind == 0); }
    }
    __syncthreads();
    const int li = F.lane & 31, half = F.lane >> 5, hp = (F.wave >> 1) * 64 + (F.wave & 1) * 32 + li;
    f32x16 acc[4];
#pragma unroll
    for (int nt = 0; nt < 4; ++nt)
#pragma unroll
        for (int r = 0; r < 16; ++r) acc[nt][r] = 0.f;
#pragma unroll 2
    for (int ks = 0; ks < 8; ++ks) { const bf16x8 xb = ld_frag(Xt, hp, 2 * ks + half);
#pragma unroll
        for (int nt = 0; nt < 4; ++nt) { const bf16x8 ba = ld_frag(Bt, 32 * nt + li, 2 * ks + half); acc[nt] = __builtin_amdgcn_mfma_f32_32x32x16_bf16(ba, xb, acc[nt], 0, 0, 0); } }
    __syncthreads();
    LAS unsigned char* OUT = Xt;
#pragma unroll
    for (int nt = 0; nt < 4; ++nt)
#pragma unroll
        for (int rq = 0; rq < 4; ++rq) { const int ch8 = 8 * nt + 2 * rq + half; v2u v; v.x = pk2(acc[nt][4 * rq], acc[nt][4 * rq + 1]); v.y = pk2(acc[nt][4 * rq + 2], acc[nt][4 * rq + 3]);
            *(LAS v2u*)(OUT + hp * 256 + ((ch8 ^ (hp & 31)) << 3)) = v; }
    __syncthreads();
    bf16* ST = (bf16*)(F.ws + WS_STATES) + ((size_t)((b * 32 + c) * 32 + g * 8 + 4 * hh)) * 8192;
#pragma unroll
    for (int it = 0; it < 8; ++it) { const int idx = it * 512 + F.tid, row = idx >> 4, j = idx & 15, k = row & 31;
        v4u v = *(const LAS v4u*)(OUT + row * 256 + ((j ^ (k >> 1)) << 4)); if (k & 1) v = (v4u){v.z, v.w, v.x, v.y};
        *(v4u*)(ST + (size_t)row * 128 + j * 8) = v; }
}

__device__ __forceinline__ void ssd_scan(Frame& F, const bool dry) {
    bf16* ST = (bf16*)(F.ws + WS_STATES); const size_t dofs = dry ? (size_t)(864 * MiB - WS_STATES) / 2 : 0; const float* CD = (const float*)(F.ws + WS_CD);
    for (int gid = F.vcu * 512 + F.tid; gid < 131072; gid += F.G * 512) {
        const int bh = gid >> 10, b = bh >> 5, h = bh & 31, el = (gid & 1023) * 8;
        float st[8];
#pragma unroll
        for (int q = 0; q < 8; ++q) st[q] = 0.f;
#pragma unroll 4
        for (int c = 0; c < 32; ++c) { bf16* p = ST + ((size_t)((b * 32 + c) * 32 + h)) * 8192 + el; const v4u v = *(const v4u*)p; const float cd = CD[(b * 32 + c) * 32 + h];
            v4u o; o.x = pk2(st[0], st[1]); o.y = pk2(st[2], st[3]); o.z = pk2(st[4], st[5]); o.w = pk2(st[6], st[7]); *(v4u*)(p + dofs) = o;
            st[0] = st[0] * cd + bflo(v.x); st[1] = st[1] * cd + bfhi(v.x); st[2] = st[2] * cd + bflo(v.y); st[3] = st[3] * cd + bfhi(v.y);
            st[4] = st[4] * cd + bflo(v.z); st[5] = st[5] * cd + bfhi(v.z); st[6] = st[6] * cd + bflo(v.w); st[7] = st[7] * cd + bfhi(v.w); }
    }
}

__device__ __forceinline__ int off256(int row, int ch) { return 256 * row + 16 * (ch ^ (((row & 3) << 2) | ((row >> 2) & 3))); }
__device__ __forceinline__ int off512(int row, int ch) { return 512 * row + 16 * (ch ^ ((row & 3) << 2)); }
typedef short v4i16_t __attribute__((ext_vector_type(4)));
__device__ __forceinline__ v4i16_t tr_read(const LAS unsigned char* p) { return __builtin_amdgcn_ds_read_tr16_b64_v4i16((LAS v4i16_t*)p); }
__device__ __forceinline__ void ssd_out_unit(Frame& F, int unit, const int var, bf16* Y) {
    const int g = unit & 3, c = (unit >> 2) & 31, b = unit >> 7; const int t0 = b * SEQ + c * 128;
    LAS float* acum = (LAS float*)F.lds; LAS float* dtv = acum + 1024; LAS float* ssq = acum + 2048;
    LAS unsigned char* Bn = F.lds + 12288; LAS unsigned char* Cn = Bn + 32768; LAS unsigned char* Xn = Cn + 32768;
    const float* DT = (const float*)(F.ws + WS_DT); const bf16* XC = (const bf16*)(F.ws + WS_XC); const bf16* Z = (const bf16*)(F.ws + WS_Z);
    __syncthreads();
#pragma unroll
    for (int i = 0; i < 4; ++i) { const int k = F.wave * 4 + i, row = 4 * k + (F.lane >> 4), pc = F.lane & 15, lc = pc ^ (((row & 3) << 2) | ((row >> 2) & 3));
        const bf16* src = XC + (size_t)(t0 + row) * DCONV + 2048 + g * 128 + lc * 8;
        __builtin_amdgcn_global_load_lds((const unsigned*)src, (LAS unsigned*)(Bn + k * 1024), 16, 0, 0);
        __builtin_amdgcn_global_load_lds((const unsigned*)(src + 512), (LAS unsigned*)(Cn + k * 1024), 16, 0, 0); }
    { const int h = g * 8 + F.wave; const float A = -__expf(F.in[I_ALOG][h]); const int l = 2 * F.lane;
        const float d0 = DT[(size_t)(t0 + l) * 32 + h], d1 = DT[(size_t)(t0 + l + 1) * 32 + h]; const float a0 = d0 * A, a1 = d1 * A, s = a0 + a1;
        float incl = s;
#pragma unroll
        for (int o = 1; o < 64; o <<= 1) { const float v = __shfl_up(incl, o); if (F.lane >= o) incl += v; }
        acum[F.wave * 128 + l] = incl - s + a0; acum[F.wave * 128 + l + 1] = incl; dtv[F.wave * 128 + l] = d0; dtv[F.wave * 128 + l + 1] = d1; }
    const int li = F.lane & 31, half = F.lane >> 5, ew = F.wave >> 1, lsel = F.wave & 1;
    const int trq = (F.lane & 15) >> 2, trp = F.lane & 3, trblk = (F.lane >> 4) & 1;
#pragma unroll 1
    for (int ps = 0; ps < 2; ++ps) {
        if (ps) __syncthreads();
#pragma unroll
        for (int i = 0; i < 8; ++i) { const int k = F.wave * 8 + i, row = 2 * k + (F.lane >> 5), pc = F.lane & 31, lc = pc ^ ((row & 3) << 2);
            __builtin_amdgcn_global_load_lds((const unsigned*)(XC + (size_t)(t0 + row) * DCONV + g * 512 + ps * 256 + lc * 8), (LAS unsigned*)(Xn + k * 1024), 16, 0, 0); }
        const int e = 4 * ps + ew, h = 8 * g + e; const float Dk = F.in[I_DSKIP][h];
        const bf16* prev = (const bf16*)(F.ws + WS_STATES) + ((size_t)((b * 32 + c) * 32 + h)) * 8192;
        VM_WAIT(); __syncthreads();
        const LAS float* ac = acum + e * 128; const LAS float* dv = dtv + e * 128;
        f32x16 accs[2][2];
#pragma unroll
        for (int it = 0; it < 2; ++it) {
            const int i = lsel ? (1 + it) : (it ? 3 : 0); const int l = 32 * i + li; const float acl = ac[l];
            f32x16 acc[2];
#pragma unroll
            for (int pt = 0; pt < 2; ++pt)
#pragma unroll
                for (int r = 0; r < 16; ++r) acc[pt][r] = 0.f;
            if (var & 1) {
            bf16x8 pf[2][8];
#pragma unroll
            for (int pt = 0; pt < 2; ++pt)
#pragma unroll
                for (int ks = 0; ks < 8; ++ks) pf[pt][ks] = *(const bf16x8*)(prev + (size_t)(32 * pt + li) * 128 + 16 * ks + 8 * half);
#pragma unroll
            for (int ks = 0; ks < 8; ++ks) { const bf16x8 cf = *(const LAS bf16x8*)(Cn + off256(l, 2 * ks + half));
#pragma unroll
                for (int pt = 0; pt < 2; ++pt) acc[pt] = __builtin_amdgcn_mfma_f32_32x32x16_bf16(pf[pt][ks], cf, acc[pt], 0, 0, 0); }
            }
            { const float el = __expf(acl);
#pragma unroll
                for (int pt = 0; pt < 2; ++pt)
#pragma unroll
                    for (int r = 0; r < 16; ++r) acc[pt][r] *= el; }
#pragma unroll 1
            for (int j = 0; j <= ((var & 2) ? i : -1); ++j) {
                f32x16 gt;
#pragma unroll
                for (int r = 0; r < 16; ++r) gt[r] = 0.f;
#pragma unroll 4
                for (int ks = 0; ks < 8; ++ks) { const bf16x8 bfm = *(const LAS bf16x8*)(Bn + off256(32 * j + li, 2 * ks + half)); const bf16x8 cf = *(const LAS bf16x8*)(Cn + off256(l, 2 * ks + half)); gt = __builtin_amdgcn_mfma_f32_32x32x16_bf16(bfm, cf, gt, 0, 0, 0); }
                unsigned wp[8];
#pragma unroll
                for (int rq = 0; rq < 4; ++rq) { const int sb = 32 * j + 8 * rq + 4 * half; const f32x4 as4 = *(const LAS f32x4*)(ac + sb), dt4 = *(const LAS f32x4*)(dv + sb); float wv[4];
#pragma unroll
                    for (int x = 0; x < 4; ++x) { const int s = sb + x; float w = gt[4 * rq + x] * __expf(fminf(acl - as4[x], 0.f)) * dt4[x];
                        if (j == i) { if (s > l) w = 0.f; if (s == l) w += Dk; } wv[x] = w; }
                    wp[2 * rq] = pk2(wv[0], wv[1]); wp[2 * rq + 1] = pk2(wv[2], wv[3]); }
                const bf16x8 wf0 = __builtin_bit_cast(bf16x8, (v4u){wp[0], wp[1], wp[2], wp[3]}), wf1 = __builtin_bit_cast(bf16x8, (v4u){wp[4], wp[5], wp[6], wp[7]});
#pragma unroll
                for (int pt = 0; pt < 2; ++pt) { const int chunk = ew * 8 + 4 * pt + 2 * trblk + (trp >> 1);
#pragma unroll
                    for (int ksub = 0; ksub < 2; ++ksub) { const int r0 = 32 * j + 16 * ksub + 4 * half + trq;
                        const v4i16_t lo = tr_read(Xn + off512(r0, chunk) + 8 * (trp & 1)), hi = tr_read(Xn + off512(r0 + 8, chunk) + 8 * (trp & 1));
                        const bf16x8 xf = (bf16x8){lo[0], lo[1], lo[2], lo[3], hi[0], hi[1], hi[2], hi[3]};
                        acc[pt] = __builtin_amdgcn_mfma_f32_32x32x16_bf16(xf, ksub ? wf1 : wf0, acc[pt], 0, 0, 0); } }
            }
            accs[it][0] = acc[0]; accs[it][1] = acc[1];
            asm volatile("" ::: "memory"); __builtin_amdgcn_sched_barrier(0);
        }
        __syncthreads();
        LAS unsigned char* Tt = Xn;
        if (var & 4) {
#pragma unroll
        for (int it = 0; it < 2; ++it) { const int i = lsel ? (1 + it) : (it ? 3 : 0); const int l = 32 * i + li;
#pragma unroll
            for (int pt = 0; pt < 2; ++pt)
#pragma unroll
                for (int rq = 0; rq < 4; ++rq) { const int c8 = ew * 16 + 8 * pt + 2 * rq + half;
                    *(LAS v2u*)(Tt + l * 512 + ((c8 ^ (l & 31)) << 3)) = (v2u){pk2(accs[it][pt][4 * rq], accs[it][pt][4 * rq + 1]), pk2(accs[it][pt][4 * rq + 2], accs[it][pt][4 * rq + 3])}; } }
        }
        __syncthreads();
        if (var & 4)
        { v4u zq[8];
#pragma unroll
          for (int k = 0; k < 8; ++k) { const int idx = k * 512 + F.tid, l = idx >> 5, j = idx & 31; zq[k] = *(const v4u*)(Z + (size_t)(t0 + l) * DSSD + g * 512 + ps * 256 + j * 8); }
#pragma unroll
          for (int k = 0; k < 8; ++k) { const int idx = k * 512 + F.tid, l = idx >> 5, j = idx & 31, kk = l & 31;
            v4u tq = *(const LAS v4u*)(Tt + l * 512 + ((j ^ (kk >> 1)) << 4)); if (kk & 1) tq = (v4u){tq.z, tq.w, tq.x, tq.y};
            const v4u z4 = zq[k];
            const float y0 = bflo(tq.x) * silu(bflo(z4.x)), y1 = bfhi(tq.x) * silu(bfhi(z4.x)), y2 = bflo(tq.y) * silu(bflo(z4.y)), y3 = bfhi(tq.y) * silu(bfhi(z4.y));
            const float y4 = bflo(tq.z) * silu(bflo(z4.z)), y5 = bfhi(tq.z) * silu(bfhi(z4.z)), y6 = bflo(tq.w) * silu(bflo(z4.w)), y7 = bfhi(tq.w) * silu(bfhi(z4.w));
            float sq = ((y0 * y0 + y1 * y1) + (y2 * y2 + y3 * y3)) + ((y4 * y4 + y5 * y5) + (y6 * y6 + y7 * y7));
#pragma unroll
            for (int o = 1; o < 32; o <<= 1) sq += __shfl_xor(sq, o);
            if (j == 0) ssq[ps * 128 + l] = sq;
            *(v4u*)(Y + (size_t)(t0 + l) * DSSD + g * 512 + ps * 256 + j * 8) = (v4u){pk2(y0, y1), pk2(y2, y3), pk2(y4, y5), pk2(y6, y7)}; } }
    }
    VM_WAIT(); __syncthreads();
    if (var & 8)
#pragma unroll
    for (int hb = 0; hb < 2; ++hb) { v4u yq[8];
#pragma unroll
        for (int k = 0; k < 8; ++k) { const int idx = (hb * 8 + k) * 512 + F.tid, l = idx >> 6, j = idx & 63; yq[k] = *(const v4u*)(Y + (size_t)(t0 + l) * DSSD + g * 512 + j * 8); }
#pragma unroll
        for (int k = 0; k < 8; ++k) { const int idx = (hb * 8 + k) * 512 + F.tid, l = idx >> 6, j = idx & 63; const float rstd = rsqrtf((ssq[l] + ssq[128 + l]) * (1.f / 512.f) + EPS);
            const f32x4 w0 = *(const f32x4*)(F.in[I_SNW] + g * 512 + j * 8), w1 = *(const f32x4*)(F.in[I_SNW] + g * 512 + j * 8 + 4); const v4u v = yq[k];
            *(v4u*)(Y + (size_t)(t0 + l) * DSSD + g * 512 + j * 8) = (v4u){pk2(bflo(v.x) * rstd * w0.x, bfhi(v.x) * rstd * w0.y), pk2(bflo(v.y) * rstd * w0.z, bfhi(v.y) * rstd * w0.w),
                                                                         pk2(bflo(v.z) * rstd * w1.x, bfhi(v.z) * rstd * w1.y), pk2(bflo(v.w) * rstd * w1.z, bfhi(v.w) * rstd * w1.w)}; } }
}
}
namespace mk {
using pg8::Unit;
constexpr int MI_TSTART = 16, MI_CNT = 64;

struct Sched {
    int mode, nM, nN, nwg, G, c, lda, ldb, a_pn_off, npn;
    const bf16* A; const bf16* Bt; const int* list; const volatile LAS unsigned* misc;
    __device__ __forceinline__ void init_dense(int M, int N, int G_, int c_, const bf16* A_, int lda_, const bf16* Bt_, int ldb_, int a_pn_off_) {
        mode = 0; nM = M / 256; nN = N / 256; nwg = nM * nN; G = G_; c = c_; A = A_; Bt = Bt_; lda = lda_; ldb = ldb_; a_pn_off = a_pn_off_; npn = 0; list = nullptr; misc = nullptr; }
    __device__ __forceinline__ void init_moe(int mode_, int G_, int c_, const bf16* A_, const bf16* Bt_, const int* list_, const volatile LAS unsigned* misc_) {
        mode = mode_; G = G_; c = c_; A = A_; Bt = Bt_; lda = 512; ldb = 512; a_pn_off = 0; npn = (mode_ == 1) ? 8 : 4; list = list_; misc = misc_; nM = 0; nN = 0; nwg = __builtin_amdgcn_readfirstlane((int)misc_[MI_TSTART + 32]) * npn; }
    __device__ __forceinline__ bool next(int i, Unit& u) const {
        const long L = (long)i * G + c; if (L >= nwg) return false;
        if (mode == 0) {
            int wgid = (int)L; { const int q = nwg / 8, r = nwg % 8, xcd = wgid % 8, off = wgid / 8; wgid = (xcd < r ? xcd * (q + 1) : r * (q + 1) + (xcd - r) * q) + off; }
            const int nig = 8 * nN, gid = wgid / nig, fm = gid * 8, gsz = (nM - fm) < 8 ? (nM - fm) : 8;
            u.pm = fm + ((wgid % nig) % gsz); u.pn = (wgid % nig) / gsz; u.e = 0; u.i = 0; return true;
        }
        const int rt = (int)L / npn, pn = (int)L % npn; int e = 0;
        while (e < 31 && __builtin_amdgcn_readfirstlane((int)misc[MI_TSTART + e + 1]) <= rt) ++e;
        u.pm = rt; u.pn = pn; u.e = e; u.i = rt - __builtin_amdgcn_readfirstlane((int)misc[MI_TSTART + e]); return true;
    }
    __device__ __forceinline__ const bf16* a_root() const { return A; }
    __device__ __forceinline__ const bf16* b_root() const { return Bt; }
    __device__ __forceinline__ const char* a_base(const Unit& u) const {
        if (mode == 0) return (const char*)(A + (size_t)u.pm * 256 * lda + (size_t)u.pn * a_pn_off);
        if (mode == 1) return (const char*)A;
        return (const char*)(A + (size_t)u.pm * 256 * 512); }
    __device__ __forceinline__ const char* b_base(const Unit& u) const {
        if (mode == 0) return (const char*)(Bt + (size_t)u.pn * 256 * ldb);
        if (mode == 1) return (const char*)(Bt + (size_t)u.e * 2048 * 512 + (size_t)u.pn * 256 * 512);
        return (const char*)(Bt + (size_t)u.e * 1024 * 512 + (size_t)u.pn * 256 * 512); }
    __device__ __forceinline__ unsigned row_off(const Unit& u, int r) const {
        if (mode == 2) return (unsigned)r * 1024u;
        if (mode == 0) return (unsigned)r * (unsigned)lda * 2u;
        const int idx = u.i * 256 + r; const int cnt = (int)misc[MI_CNT + u.e];
        const int tok = idx < cnt ? (list[(size_t)u.e * T + idx] >> 2) : 0; return (unsigned)tok * 1024u; }
};

struct EpiAll {
    static constexpr bool PERM = true;
    int kind, pad; unsigned char* ws; const float* const* in; float* out; const volatile LAS unsigned* misc;
    __device__ __forceinline__ void operator()(const pg8::f32x4 (&acc)[2][2][4][2], const Unit& u, int wr, int wc, int fr, int fq) const {
        const int rl0 = wr * 64 + fr, row0 = u.pm * 256 + rl0, cl0 = wc * 32 + 8 * fq;
        if (kind == 0) {
            bf16* base; int ld, colt; bool sg = false;
            if (u.pn < 8) { base = (bf16*)(ws + WS_Z); ld = 2048; colt = u.pn * 256; }
            else if (u.pn < 20) { base = (bf16*)(ws + WS_XBC); ld = 3072; colt = (u.pn - 8) * 256; }
            else if (u.pn < 24) { base = (bf16*)(ws + WS_U); ld = 1024; colt = (u.pn - 20) * 256; }
            else { base = (bf16*)(ws + WS_GATES); ld = 2048; colt = (u.pn - 24) * 256; sg = true; }
#pragma unroll
            for (int ai = 0; ai < 2; ++ai)
#pragma unroll
                for (int m = 0; m < 4; ++m) { bf16* rowp = base + (size_t)(row0 + ai * 128 + m * 16) * ld + colt + cl0;
#pragma unroll
                    for (int bj = 0; bj < 2; ++bj) { pg8::f32x4 v0 = acc[ai][bj][m][0], v1 = acc[ai][bj][m][1];
                        if (sg) { v0 = (pg8::f32x4){sigm(v0[0]), sigm(v0[1]), sigm(v0[2]), sigm(v0[3])}; v1 = (pg8::f32x4){sigm(v1[0]), sigm(v1[1]), sigm(v1[2]), sigm(v1[3])}; }
                        v4u w; w.x = pk2(v0[0], v0[1]); w.y = pk2(v0[2], v0[3]); w.z = pk2(v1[0], v1[1]); w.w = pk2(v1[2], v1[3]);
                        *(v4u*)(rowp + bj * 128) = w; } }
        } else if (kind == 1) {
            bf16* base = (bf16*)(ws + WS_P2); const float* ps = in[I_PSCALE];
#pragma unroll
            for (int bj = 0; bj < 2; ++bj) { const int col = u.pn * 256 + bj * 128 + cl0; const f32x4 s0 = *(const f32x4*)(ps + col), s1 = *(const f32x4*)(ps + col + 4);
#pragma unroll
                for (int ai = 0; ai < 2; ++ai)
#pragma unroll
                    for (int m = 0; m < 4; ++m) { const pg8::f32x4 v0 = acc[ai][bj][m][0] * s0, v1 = acc[ai][bj][m][1] * s1;
                        v4u w; w.x = pk2(v0[0], v0[1]); w.y = pk2(v0[2], v0[3]); w.z = pk2(v1[0], v1[1]); w.w = pk2(v1[2], v1[3]);
                        *(v4u*)(base + (size_t)(row0 + ai * 128 + m * 16) * 1024 + col) = w; } }
        } else if (kind == 2 || kind == 3) {
            const bf16* gates = (const bf16*)(ws + WS_GATES) + (kind == 3 ? 1024 : 0); bf16* m1 = (bf16*)(ws + WS_M1); bf16* mg = (bf16*)(ws + WS_MERGED);
#pragma unroll
            for (int ai = 0; ai < 2; ++ai) { v4u gq[4][2], mq[4][2];
#pragma unroll
                for (int m = 0; m < 4; ++m)
#pragma unroll
                    for (int bj = 0; bj < 2; ++bj) { const size_t row = row0 + ai * 128 + m * 16; const int col = u.pn * 256 + bj * 128 + cl0; gq[m][bj] = *(const v4u*)(gates + row * 2048 + col);
                        if (kind == 3) mq[m][bj] = *(const v4u*)(m1 + row * 1024 + col); else mq[m][bj] = (v4u){0u, 0u, 0u, 0u}; }
#pragma unroll
                for (int m = 0; m < 4; ++m)
#pragma unroll
                    for (int bj = 0; bj < 2; ++bj) { const size_t row = row0 + ai * 128 + m * 16; const int col = u.pn * 256 + bj * 128 + cl0; const v4u g4 = gq[m][bj], m4 = mq[m][bj];
                        float r[8] = {acc[ai][bj][m][0][0] * bflo(g4.x), acc[ai][bj][m][0][1] * bfhi(g4.x), acc[ai][bj][m][0][2] * bflo(g4.y), acc[ai][bj][m][0][3] * bfhi(g4.y),
                                      acc[ai][bj][m][1][0] * bflo(g4.z), acc[ai][bj][m][1][1] * bfhi(g4.z), acc[ai][bj][m][1][2] * bflo(g4.w), acc[ai][bj][m][1][3] * bfhi(g4.w)};
                        if (kind == 3) { r[0] += bflo(m4.x); r[1] += bfhi(m4.x); r[2] += bflo(m4.y); r[3] += bfhi(m4.y); r[4] += bflo(m4.z); r[5] += bfhi(m4.z); r[6] += bflo(m4.w); r[7] += bfhi(m4.w); }
                        v4u w; w.x = pk2(r[0], r[1]); w.y = pk2(r[2], r[3]); w.z = pk2(r[4], r[5]); w.w = pk2(r[6], r[7]);
                        *(v4u*)((kind == 3 ? mg : m1) + row * 1024 + col) = w; } }
        } else if (kind == 4) {
            const int b = (u.pm * 256) / SEQ; const float* ga = (const float*)(ws + WS_MOD) + b * 6144 + 2048; const float* x = in[I_X];
            f32x4 g0[2], g1[2];
#pragma unroll
            for (int bj = 0; bj < 2; ++bj) { const int col = u.pn * 256 + bj * 128 + cl0; g0[bj] = *(const f32x4*)(ga + col); g1[bj] = *(const f32x4*)(ga + col + 4); }
#pragma unroll
            for (int ai = 0; ai < 2; ++ai)
#pragma unroll
              for (int m = 0; m < 4; ++m) { f32x4 xa[2], xb[2];
#pragma unroll
                for (int bj = 0; bj < 2; ++bj) { const size_t off = (size_t)(row0 + ai * 128 + m * 16) * 1024 + u.pn * 256 + bj * 128 + cl0; xa[bj] = *(const f32x4*)(x + off); xb[bj] = *(const f32x4*)(x + off + 4); }
#pragma unroll
                for (int bj = 0; bj < 2; ++bj) { const size_t off = (size_t)(row0 + ai * 128 + m * 16) * 1024 + u.pn * 256 + bj * 128 + cl0;
                    *(f32x4*)(out + off) = xa[bj] + g0[bj] * acc[ai][bj][m][0]; *(f32x4*)(out + off + 4) = xb[bj] + g1[bj] * acc[ai][bj][m][1]; } }
        } else if (kind == 5) {
            unsigned char* act = (unsigned char*)(ws + WS_ACT); const float* bgu = in[I_BGU] + (size_t)u.e * 2048; const int col = u.pn * 128 + cl0;
            const f32x4 bg0 = *(const f32x4*)(bgu + col), bg1 = *(const f32x4*)(bgu + col + 4), bl0 = *(const f32x4*)(bgu + 1024 + col), bl1 = *(const f32x4*)(bgu + 1024 + col + 4);
#pragma unroll
            for (int ai = 0; ai < 2; ++ai)
#pragma unroll
                for (int m = 0; m < 4; ++m) { float r[8];
#pragma unroll
                    for (int n = 0; n < 2; ++n)
#pragma unroll
                        for (int x = 0; x < 4; ++x) { float gl = acc[ai][0][m][n][x] * 0.03125f + (n ? bg1[x] : bg0[x]), ln = acc[ai][1][m][n][x] * 0.03125f + (n ? bl1[x] : bl0[x]);
                            gl = fminf(gl, 7.f); ln = fminf(fmaxf(ln, -7.f), 7.f); r[4 * n + x] = gl * sigm(1.702f * gl) * (ln + 1.f); }
                    int w0 = 0, w1 = 0; w0 = __builtin_amdgcn_cvt_pk_fp8_f32(r[0], r[1], w0, false); w0 = __builtin_amdgcn_cvt_pk_fp8_f32(r[2], r[3], w0, true);
                    w1 = __builtin_amdgcn_cvt_pk_fp8_f32(r[4], r[5], w1, false); w1 = __builtin_amdgcn_cvt_pk_fp8_f32(r[6], r[7], w1, true);
                    *(v2u*)(act + (size_t)(row0 + ai * 128 + m * 16) * 1024 + col) = (v2u){(unsigned)w0, (unsigned)w1}; }
        } else {
            bf16* yb = (bf16*)(ws + WS_YB); const float* bdn = in[I_BDN] + (size_t)u.e * 1024; const int* list = (const int*)(ws + WS_LIST) + (size_t)u.e * T; const float* gate = (const float*)(ws + WS_GATE);
            const int cnt = (int)misc[MI_CNT + u.e];
#pragma unroll
            for (int ai = 0; ai < 2; ++ai) { int slot[4]; float gt[4];
#pragma unroll
                for (int m = 0; m < 4; ++m) { const int idx = u.i * 256 + rl0 + ai * 128 + m * 16; slot[m] = idx < cnt ? list[idx] : -1; }
#pragma unroll
                for (int m = 0; m < 4; ++m) gt[m] = slot[m] >= 0 ? gate[slot[m]] : 0.f;
#pragma unroll
                for (int bj = 0; bj < 2; ++bj) { const int col = u.pn * 256 + bj * 128 + cl0; const f32x4 b0 = *(const f32x4*)(bdn + col), b1 = *(const f32x4*)(bdn + col + 4);
#pragma unroll
                    for (int m = 0; m < 4; ++m) {
                        if (slot[m] >= 0) {
                            const pg8::f32x4 v0 = (acc[ai][bj][m][0] * 0.03125f + b0) * gt[m], v1 = (acc[ai][bj][m][1] * 0.03125f + b1) * gt[m];
                            v4u w; w.x = pk2(v0[0], v0[1]); w.y = pk2(v0[2], v0[3]); w.z = pk2(v1[0], v1[1]); w.w = pk2(v1[2], v1[3]);
                            *(v4u*)(yb + (size_t)slot[m] * 1024 + col) = w; } } } }
        }
    }
};

__device__ __forceinline__ void p6_router(Frame& F, const bool dry, const int var) {
    LAS float* wrT = (LAS float*)F.lds;
    LAS int* lcnt = (LAS int*)(F.lds + 131072); LAS int* lbase = lcnt + 32; LAS int* rec = lcnt + 64;
    const float* wr = F.in[I_WR];
    __syncthreads();
    if (var & 1) { f32x4 wv[16];
#pragma unroll
      for (int i = 0; i < 16; ++i) wv[i] = *(const f32x4*)(wr + (size_t)(i * 512 + F.tid) * 4);
#pragma unroll
      for (int i = 0; i < 16; ++i) { const int idx = (i * 512 + F.tid) * 4, k = idx >> 5, e = idx & 31; wrT[e * 1024 + k] = wv[i].x; wrT[(e + 1) * 1024 + k] = wv[i].y; wrT[(e + 2) * 1024 + k] = wv[i].z; wrT[(e + 3) * 1024 + k] = wv[i].w; } }
    for (int rb = F.vcu; rb < T / 64; rb += F.G) {
    __syncthreads();
    if (F.tid < 32) lcnt[F.tid] = 0;
    __syncthreads();
    const int rowblk = rb * 64, b = rowblk / SEQ; const float* mod = (const float*)(F.ws + WS_MOD) + b * 6144; unsigned char* H8 = (unsigned char*)(F.ws + WS_H);
    const float* x1 = F.out;
    f32x4 xn[2][4];
#pragma unroll
    for (int rr = 0; rr < 2; ++rr)
#pragma unroll
        for (int j = 0; j < 4; ++j) xn[rr][j] = *(const f32x4*)(x1 + (size_t)(rowblk + F.wave * 8 + rr) * D + 4 * F.lane + 256 * j);
#pragma unroll 1
    for (int pr = 0; pr < ((var & 2) ? 4 : 0); ++pr) {
        float hv[2][16]; const int rl0 = F.wave * 8 + pr * 2;
        f32x4 xc[2][4];
#pragma unroll
        for (int rr = 0; rr < 2; ++rr)
#pragma unroll
            for (int j = 0; j < 4; ++j) xc[rr][j] = xn[rr][j];
        if (pr < 3) {
#pragma unroll
            for (int rr = 0; rr < 2; ++rr)
#pragma unroll
                for (int j = 0; j < 4; ++j) xn[rr][j] = *(const f32x4*)(x1 + (size_t)(rowblk + rl0 + 2 + rr) * D + 4 * F.lane + 256 * j); }
#pragma unroll
        for (int rr = 0; rr < 2; ++rr) { const size_t t = rowblk + rl0 + rr; f32x4 v[4]; float s = 0.f;
#pragma unroll
            for (int j = 0; j < 4; ++j) { v[j] = xc[rr][j]; s += (v[j].x * v[j].x + v[j].y * v[j].y) + (v[j].z * v[j].z + v[j].w * v[j].w); }
            const float rstd = rsqrtf(wave_sum(s) * (1.f / D) + EPS);
#pragma unroll
            for (int j = 0; j < 4; ++j) { const int col = 4 * F.lane + 256 * j; const f32x4 w = *(const f32x4*)(F.in[I_NFW] + col), sc = *(const f32x4*)(mod + 4096 + col), sh = *(const f32x4*)(mod + 3072 + col);
                const f32x4 h = v[j] * rstd * w * (sc + 1.f) + sh; hv[rr][4 * j] = h.x; hv[rr][4 * j + 1] = h.y; hv[rr][4 * j + 2] = h.z; hv[rr][4 * j + 3] = h.w;
                int w8 = 0; w8 = __builtin_amdgcn_cvt_pk_fp8_f32(h.x, h.y, w8, false); w8 = __builtin_amdgcn_cvt_pk_fp8_f32(h.z, h.w, w8, true); *(unsigned*)(H8 + t * D + col) = (unsigned)w8; } }
        float a[64];
        { typedef float f32x2v __attribute__((ext_vector_type(2)));
          f32x2v h2v[16];
#pragma unroll
          for (int k = 0; k < 16; ++k) h2v[k] = (f32x2v){hv[0][k], hv[1][k]};
#pragma unroll
          for (int eg = 0; eg < 8; ++eg) { f32x4 w[4][4];
#pragma unroll
            for (int ee = 0; ee < 4; ++ee)
#pragma unroll
              for (int j = 0; j < 4; ++j) w[ee][j] = *(const LAS f32x4*)(wrT + (4 * eg + ee) * 1024 + 4 * F.lane + 256 * j);
            __builtin_amdgcn_sched_barrier(0);
#pragma unroll
            for (int ee = 0; ee < 4; ++ee) { f32x2v s = (f32x2v){0.f, 0.f};
#pragma unroll
              for (int j = 0; j < 4; ++j) {
                s = __builtin_elementwise_fma(h2v[4 * j], (f32x2v){w[ee][j].x, w[ee][j].x}, s); s = __builtin_elementwise_fma(h2v[4 * j + 1], (f32x2v){w[ee][j].y, w[ee][j].y}, s);
                s = __builtin_elementwise_fma(h2v[4 * j + 2], (f32x2v){w[ee][j].z, w[ee][j].z}, s); s = __builtin_elementwise_fma(h2v[4 * j + 3], (f32x2v){w[ee][j].w, w[ee][j].w}, s); }
              a[2 * (4 * eg + ee)] = s.x; a[2 * (4 * eg + ee) + 1] = s.y; }
            __builtin_amdgcn_sched_barrier(0); } }
#define RED_STEP(N, M) { _Pragma("unroll") for (int i = 0; i < (N) / 2; ++i) { const bool up = (F.lane & (M)) != 0; const float keep = up ? a[i + (N) / 2] : a[i], send = up ? a[i] : a[i + (N) / 2]; a[i] = keep + __shfl_xor(send, (M)); } }
        RED_STEP(64, 32) RED_STEP(32, 16) RED_STEP(16, 8) RED_STEP(8, 4) RED_STEP(4, 2) RED_STEP(2, 1)
#undef RED_STEP
        const int e = F.lane >> 1, rr = F.lane & 1; float v = a[0] + F.in[I_BR][e];
        float tv[4]; int ti[4];
#pragma unroll
        for (int r = 0; r < 4; ++r) { float m = v; int mi = e;
#pragma unroll
            for (int o = 2; o < 64; o <<= 1) { const float om = __shfl_xor(m, o); const int oi = __shfl_xor(mi, o); if (om > m || (om == m && oi < mi)) { m = om; mi = oi; } }
            tv[r] = m; ti[r] = mi; if (e == mi) v = -INFINITY; }
        if (F.lane < 2) { const float e0 = 1.f, e1 = __expf(tv[1] - tv[0]), e2 = __expf(tv[2] - tv[0]), e3 = __expf(tv[3] - tv[0]); const float inv = 1.f / (e0 + e1 + e2 + e3);
            const float gt[4] = {e0 * inv, e1 * inv, e2 * inv, e3 * inv}; const int rl = rl0 + rr;
#pragma unroll
            for (int r = 0; r < 4; ++r) { const int pos = __hip_atomic_fetch_add(lcnt + ti[r], 1, __ATOMIC_RELAXED, __HIP_MEMORY_SCOPE_WORKGROUP);
                rec[(rl * 4 + r) * 3] = ti[r]; rec[(rl * 4 + r) * 3 + 1] = pos; rec[(rl * 4 + r) * 3 + 2] = __float_as_int(gt[r]); } }
    }
    __syncthreads();
    if (var & 4) {
    if (F.tid < 32) lbase[F.tid] = (int)__hip_atomic_fetch_add((unsigned*)(F.ctl + CW_GCNT) + (dry ? 32 : 0) + 64 * F.tid, (unsigned)lcnt[F.tid], __ATOMIC_RELAXED, __HIP_MEMORY_SCOPE_AGENT);
    __syncthreads();
    if (F.tid < 256) { const int rl = F.tid >> 2, r = F.tid & 3; const int e = rec[F.tid * 3], pos = rec[F.tid * 3 + 1]; const int slot = (rowblk + rl) * 4 + r;
        ((int*)(F.ws + (dry ? 900 * MiB : WS_LIST)))[(size_t)e * T + lbase[e] + pos] = slot; ((float*)(F.ws + (dry ? 910 * MiB : WS_GATE)))[slot] = __int_as_float(rec[F.tid * 3 + 2]); }
    }
    }
}

__device__ __forceinline__ void moe_setup(Frame& F) {
    __syncthreads();
    if (F.tid == 0) { int acc = 0; F.MISC[MI_TSTART] = 0;
        for (int e = 0; e < 32; ++e) { const unsigned cnt = __hip_atomic_load((unsigned*)(F.ctl + CW_GCNT) + 64 * e, RLX_AGENT); F.MISC[MI_CNT + e] = cnt; acc += (int)((cnt + 255u) >> 8); F.MISC[MI_TSTART + e + 1] = (unsigned)acc; } }
    __syncthreads();
}

__device__ __forceinline__ void p9_final(Frame& F, const float dscale, float* dst) {
    const bf16* YB = (const bf16*)(F.ws + WS_YB);
#pragma unroll 1
    for (size_t t = F.vcu * NWAVES + F.wave; t < (size_t)T; t += F.G * NWAVES) { const int b = (int)(t / SEQ); const float* ga = (const float*)(F.ws + WS_MOD) + b * 6144 + 5120;
        f32x4 v[4]; float s = 0.f;
#pragma unroll
        for (int j = 0; j < 4; ++j) { const int col = 4 * F.lane + 256 * j; f32x4 m = (f32x4){0.f, 0.f, 0.f, 0.f};
#pragma unroll
            for (int k = 0; k < 4; ++k) { const v2u q = *(const v2u*)(YB + (t * 4 + k) * D + col); m += (f32x4){bflo(q.x), bfhi(q.x), bflo(q.y), bfhi(q.y)}; }
            v[j] = *(const f32x4*)(F.out + t * D + col) + *(const f32x4*)(ga + col) * m; s += (v[j].x * v[j].x + v[j].y * v[j].y) + (v[j].z * v[j].z + v[j].w * v[j].w); }
        const float rstd = rsqrtf(wave_sum(s) * (1.f / D) + EPS);
#pragma unroll
        for (int j = 0; j < 4; ++j) { const int col = 4 * F.lane + 256 * j; *(f32x4*)(dst + t * D + col) = v[j] * (rstd * dscale) * *(const f32x4*)(F.in[I_NFINAL] + col); } }
}
}
namespace mk {
#ifndef MK_N_LAUNCHES
#define MK_N_LAUNCHES 1
#endif
constexpr int NPHASES = 12;
struct Args { const float* in[25]; float* out; unsigned char* ws; int ph_lo, ph_hi, li, pad; };

__global__ void __launch_bounds__(NWAVES * 64, 2) mk_fwd(Args args) {
    extern __shared__ __attribute__((aligned(16))) unsigned char lds[];
    Frame F;
    F.lds = (LAS unsigned char*)lds; F.MISC = (volatile LAS unsigned*)(F.lds + MISC_OFF);
    F.tid = threadIdx.x; F.lane = F.tid & 63; F.wave = __builtin_amdgcn_readfirstlane(F.tid >> 6);
    F.G = gridDim.x; { const int bx = blockIdx.x; F.vcu = (F.G % 8 == 0) ? (bx % 8) * (F.G / 8) + bx / 8 : bx; }
    F.ws = args.ws; F.out = args.out; F.in = args.in; F.ctl = (gu32*)(args.ws + WS_CTL);
    for (int u = F.tid; u < (LDS_BYTES - LDSCTL_OFF) / 4; u += NWAVES * 64) ((LAS unsigned*)(F.lds + LDSCTL_OFF))[u] = 0u;
    __syncthreads();
    XcdBarrier bar = xcd_barrier_post((unsigned*)(F.ctl + CW_BAR) + args.li * XCD_BAR_WORDS, F.MISC + 0);
    const int lo = args.ph_lo, hi = args.ph_hi;
#ifndef MK_PH_MASK
#define MK_PH_MASK 0xFFF
#endif
#define IN(k) (((MK_PH_MASK >> (k)) & 1) && lo <= (k) && (k) < hi)
#define SEAM(k) do { if (IN(k) && IN((k) + 1)) xcd_barrier(bar, F.wave); } while (0)
    LAS unsigned char* ring = F.lds;
    const int cid = (int)blockIdx.x;

    if (IN(0)) { refresh_ids(F); p0_prologue(F); } SEAM(0);
    if (IN(1)) { refresh_ids(F); p1_norm_dt(F); } SEAM(1);
    if (IN(2)) { refresh_ids(F);
        Sched S; S.init_dense(T, 8192, F.G, cid, (const bf16*)(F.ws + WS_H), 1024, (const bf16*)(F.ws + WS_WIN), 1024, 0);
        EpiAll E{0, 0, F.ws, F.in, F.out, F.MISC}; __syncthreads();
        pg8::gemm_phase<EpiAll, Sched, true, true, 0, false>(ring, F.wave, 1024, 1024, 1024, S, E);
    } SEAM(2);
    if (IN(3)) { refresh_ids(F);
#ifndef MK_NOPOOL
        pool_pass(F);
#endif
        asm volatile("" ::: "memory"); __builtin_amdgcn_sched_barrier(0); for (int u = F.vcu; u < 1024; u += F.G) ssd_states_unit(F, u); } SEAM(3);
    if (IN(4)) { refresh_ids(F);
#ifdef MK_DUPSCAN
        ssd_scan(F, args.li == 1);
#else
        if (args.li != 1) ssd_scan(F, false);
#endif

        Sched S; S.init_dense(T, 1024, F.G, cid, (const bf16*)(F.ws + WS_P), 1024, (const bf16*)(F.ws + WS_WPOOL), 256, 256);
        EpiAll E{1, 0, F.ws, F.in, F.out, F.MISC};
        __syncthreads();
        pg8::gemm_phase<EpiAll, Sched, true, true, 0, false>(ring, F.wave, 256, 1024, 256, S, E);
    } SEAM(4);
    if (IN(5)) { refresh_ids(F);
#ifdef MK_VAR
        const int var = (args.li == 1) ? (MK_VAR) : 15; bf16* ydst = (args.li == 1) ? (bf16*)(F.ws + 864 * MiB) : (bf16*)(F.ws + WS_Y);
#else
        const int var = 15; bf16* ydst = (bf16*)(F.ws + WS_Y);
#endif
        for (int u = F.vcu; u < 512; u += F.G) ssd_out_unit(F, u, var, ydst); } SEAM(5);
    if (IN(6)) { refresh_ids(F);
        { Sched S; S.init_dense(T, 1024, F.G, cid, (const bf16*)(F.ws + WS_Y), 2048, (const bf16*)(F.ws + WS_WSSD), 2048, 0);
          EpiAll E{2, 0, F.ws, F.in, F.out, F.MISC}; __syncthreads();
          pg8::gemm_phase<EpiAll, Sched, true, true, 0, false>(ring, F.wave, 2048, 2048, 2048, S, E); }
        VM_WAIT(); __syncthreads();
        { Sched S; S.init_dense(T, 1024, F.G, cid, (const bf16*)(F.ws + WS_P2), 1024, (const bf16*)(F.ws + WS_WPO), 1024, 0);
          EpiAll E{3, 0, F.ws, F.in, F.out, F.MISC}; __syncthreads();
          pg8::gemm_phase<EpiAll, Sched, true, true, 0, false>(ring, F.wave, 1024, 1024, 1024, S, E); }
    } SEAM(6);
    if (IN(7)) { refresh_ids(F); Sched S; S.init_dense(T, 1024, F.G, cid, (const bf16*)(F.ws + WS_MERGED), 1024, (const bf16*)(F.ws + WS_WOUT), 1024, 0);
        EpiAll E{4, 0, F.ws, F.in, F.out, F.MISC}; __syncthreads();
        pg8::gemm_phase<EpiAll, Sched, true, true, 0, false>(ring, F.wave, 1024, 1024, 1024, S, E);
    } SEAM(7);
    #ifndef MK_RVAR
#define MK_RVAR 7
#endif
    if (IN(8)) { refresh_ids(F); p6_router(F, args.li == 1, args.li == 1 ? (MK_RVAR) : 7); } SEAM(8);
    if (IN(9)) { refresh_ids(F); moe_setup(F);
        Sched S; S.init_moe(1, F.G, cid, (const bf16*)(F.ws + WS_H), (const bf16*)(F.ws + WS_WGU), (const int*)(F.ws + WS_LIST), F.MISC);
        EpiAll E{5, 0, F.ws, F.in, F.out, F.MISC}; __syncthreads();
        pg8::gemm_phase<EpiAll, Sched, true, true, 1, true>(ring, F.wave, 512, 512, 512, S, E);
    } SEAM(9);
    if (IN(10)) { refresh_ids(F); moe_setup(F);
        Sched S; S.init_moe(2, F.G, cid, (const bf16*)(F.ws + WS_ACT), (const bf16*)(F.ws + WS_WDN), (const int*)(F.ws + WS_LIST), F.MISC);
        EpiAll E{6, 0, F.ws, F.in, F.out, F.MISC}; __syncthreads();
        pg8::gemm_phase<EpiAll, Sched, true, true, 1, true>(ring, F.wave, 512, 512, 512, S, E);
    } SEAM(10);
    if (IN(11)) { refresh_ids(F); p9_final(F, 1.f, args.li == 1 ? (float*)(F.ws + 864 * MiB) : F.out); }
#undef IN
#undef SEAM
}

static void run_mk(void* const* d_in, float* out, unsigned char* ws, hipStream_t stream) {
    static int grid = 0;
    if (grid == 0) {
        int dev = 0, cus = 0;
        if (hipGetDevice(&dev) != hipSuccess || hipDeviceGetAttribute(&cus, hipDeviceAttributeMultiprocessorCount, dev) != hipSuccess) { fprintf(stderr, "kernel_launch: device query failed\n"); grid = -1; return; }
        if (hipFuncSetAttribute((const void*)mk_fwd, hipFuncAttributeMaxDynamicSharedMemorySize, LDS_BYTES) != hipSuccess) { fprintf(stderr, "kernel_launch: hipFuncSetAttribute failed\n"); grid = -1; return; }
        (void)hipGetLastError();
        grid = cus;
    }
    if (grid < 0) return;
    (void)hipMemsetAsync(ws + WS_CTL, 0, CTL_ZERO_BYTES, stream);
    Args a{};
    for (int i = 0; i < 25; ++i) a.in[i] = (const float*)d_in[i];
    a.out = out; a.ws = ws;
#ifdef MK_DUP
    const int nl = 3, los[3] = {0, MK_DUP, MK_DUP + 1}, his[3] = {MK_DUP + 1, MK_DUP + 1, NPHASES};
#else
    const int nl = 1, los[1] = {0}, his[1] = {NPHASES};
#endif
    for (int li = 0; li < nl; ++li) {
        if (los[li] >= his[li]) continue;
        a.ph_lo = los[li]; a.ph_hi = his[li]; a.li = li;
        hipLaunchKernelGGL(mk_fwd, dim3(grid), dim3(NWAVES * 64), LDS_BYTES, stream, a);
    }
}
}
extern "C" void kernel_launch(void* const* d_in, const int* in_sizes, int n_in, void* d_out, int out_size, void* d_ws, size_t ws_size, hipStream_t stream) {
    mk::run_mk(d_in, (float*)d_out, (unsigned char*)d_ws, stream);
}
```

```cpp
#include <hip/hip_runtime.h>
#include <cstdio>
#include <cstdint>
#include <cmath>
namespace pg8 {
#define PG8_LAS __attribute__((address_space(3)))
typedef unsigned short bf16_t;
typedef short bf16x8 __attribute__((ext_vector_type(8)));
typedef float f32x4 __attribute__((ext_vector_type(4)));
typedef unsigned u32x4 __attribute__((ext_vector_type(4)));
typedef unsigned u32x2 __attribute__((ext_vector_type(2)));
constexpr int BM = 256, BK = 64, HALF = 128, HTB = HALF * BK * 2  , STAGE_BYTES = 8 * HTB, NXCD = 8, WGM = 8;

__host__ __device__ __forceinline__ int lds_byte(int r, int c) { const int st = (r >> 4) * 2 + (c >> 5), rr = r & 15, cc = c & 31, ob = rr * 64 + cc * 2; return st * 1024 + (ob ^ (((ob >> 9) & 1) << 5)); }
__host__ __device__ __forceinline__ void stage_rc(int b, int& R, int& C) { const int st = b / 1024, sb = b % 1024, swz = sb ^ (((sb >> 9) & 1) << 5); R = (st >> 1) * 16 + swz / 64; C = (st & 1) * 32 + (swz % 64) / 2; }
__host__ __device__ __forceinline__ int perm32(int rho) { const int n = rho >> 4, i = rho & 15; return 8 * (i >> 2) + 4 * n + (i & 3); }

struct Unit { int pm, pn, e, i; };

__device__ __forceinline__ unsigned cvt_pk_bf16(float lo, float hi) { unsigned r; asm volatile("v_cvt_pk_bf16_f32 %0, %1, %2" : "=v"(r) : "v"(lo), "v"(hi)); return r; }

struct StaticOrder {
    int nM, nN, nwg, G, c; const bf16_t* A; const bf16_t* Bt; int lda, ldb, a_pn_off, pad;
    __device__ void init(int M, int N, int G_, int c_, const bf16_t* A_, int lda_, const bf16_t* Bt_, int ldb_, int a_pn_off_) { nM = M / BM; nN = N / BM; nwg = nM * nN; G = G_; c = c_; A = A_; Bt = Bt_; lda = lda_; ldb = ldb_; a_pn_off = a_pn_off_; pad = 0; }
    __device__ bool next(int i, Unit& u) const {
        const long L = (long)i * G + c; if (L >= nwg) return false;
        int wgid = (int)L; { const int q = nwg / NXCD, r = nwg % NXCD, xcd = wgid % NXCD, off = wgid / NXCD; wgid = (xcd < r ? xcd * (q + 1) : r * (q + 1) + (xcd - r) * q) + off; }
        const int nig = WGM * nN, gid = wgid / nig, fm = gid * WGM, gsz = (nM - fm) < WGM ? (nM - fm) : WGM;
        u.pm = fm + ((wgid % nig) % gsz); u.pn = (wgid % nig) / gsz; u.e = 0; u.i = 0; return true;
    }
    __device__ __forceinline__ const char* a_base(const Unit& u) const { return (const char*)(A + (size_t)u.pm * BM * lda + (size_t)u.pn * a_pn_off); }
    __device__ __forceinline__ const char* b_base(const Unit& u) const { return (const char*)(Bt + (size_t)u.pn * BM * ldb); }
    __device__ __forceinline__ unsigned row_off(const Unit&, int) const { return 0u; }
};

typedef int v8i32 __attribute__((ext_vector_type(8))); typedef int i32x4 __attribute__((ext_vector_type(4)));
template <class Epi, class Sched, bool ALIGN_EPI, bool SP2, int GATHER  , bool FP8>
__device__ __forceinline__ void gemm_phase(PG8_LAS unsigned char* lds, const int wave_id, const int K, const int lda, const int ldb, const Sched& S, const Epi& E) {
    int lane_; asm volatile("v_mbcnt_lo_u32_b32 %0, -1, 0\n\tv_mbcnt_hi_u32_b32 %0, -1, %0" : "=v"(lane_));
    const int wid = wave_id, lane = lane_, tid = wid * 64 + lane, wr = wid >> 2, wc = wid & 3, fr = lane & 15, fq = lane >> 4;
    const int nt = K / BK;
    unsigned voffA[2][2], voffN[2][2], voffB[2];
#pragma unroll
    for (int i = 0; i < 2; ++i) { int R, C; stage_rc(tid * 16 + i * 8192, R, C); const int Rb = Epi::PERM ? ((R & ~31) + perm32(R & 31)) : R;
        voffA[0][i] = GATHER ? (unsigned)C * 2u : (unsigned)(R * lda + C) * 2u; voffA[1][i] = voffA[0][i]; voffN[0][i] = 0; voffN[1][i] = 0; voffB[i] = (unsigned)(Rb * ldb + C) * 2u; }
    const unsigned kstep = (unsigned)(BK * 2);
    const unsigned hstepA = GATHER ? 0u : (unsigned)(HALF * lda * 2);
    const unsigned hstepB = (unsigned)(HALF * ldb * 2);
    const __amdgpu_buffer_rsrc_t rsrcA = __builtin_amdgcn_make_buffer_rsrc((void*)S.a_root(), 0, 0xFFFFFFFF, 0x00020000), rsrcB = __builtin_amdgcn_make_buffer_rsrc((void*)S.b_root(), 0, 0xFFFFFFFF, 0x00020000);
    const unsigned ldsw = (unsigned)wid * 1024u;
    const int aoff = lds_byte(wr * 64 + fr, fq * 8), boff = lds_byte(wc * 32 + fr, fq * 8);
#define PG8_SA(b, h) (((b) * 2 + (h)) * HTB)
#define PG8_SB(b, h) ((4 + (b) * 2 + (h)) * HTB)
#define PG8_STAGE_B(bufoff, soff) do { _Pragma("unroll") for (int _i = 0; _i < 2; ++_i) \
        __builtin_amdgcn_raw_ptr_buffer_load_lds(rsrcB, (PG8_LAS unsigned*)(lds + (bufoff) + ldsw + _i * 8192), 16, voffB[_i], (soff), 0, 0); } while (0)
#define PG8_STAGE_A(bufoff, soff, h) do { _Pragma("unroll") for (int _i = 0; _i < 2; ++_i) \
        __builtin_amdgcn_raw_ptr_buffer_load_lds(rsrcA, (PG8_LAS unsigned*)(lds + (bufoff) + ldsw + _i * 8192), 16, voffA[GATHER ? (h) : 0][_i], (soff) + (h) * hstepA, 0, 0); } while (0)
#define PG8_LDA(dst, b, h) do { _Pragma("unroll") for (int m = 0; m < 4; ++m) _Pragma("unroll") for (int k = 0; k < 2; ++k) dst[m][k] = *(const PG8_LAS bf16x8*)(lds + PG8_SA(b, h) + aoff + m * 2048 + k * 1024); } while (0)
#define PG8_LDB(dst, b, h) do { _Pragma("unroll") for (int n = 0; n < 2; ++n) _Pragma("unroll") for (int k = 0; k < 2; ++k) dst[n][k] = *(const PG8_LAS bf16x8*)(lds + PG8_SB(b, h) + boff + n * 2048 + k * 1024); } while (0)
#define PG8_CAT(x) (__builtin_shufflevector(__builtin_bit_cast(i32x4, x[0]), __builtin_bit_cast(i32x4, x[1]), 0, 1, 2, 3, 4, 5, 6, 7))
#define PG8_MMA(ai, bj, At, Bt) do { __builtin_amdgcn_s_setprio(1); _Pragma("unroll") for (int m = 0; m < 4; ++m) _Pragma("unroll") for (int n = 0; n < 2; ++n) { \
        if constexpr (FP8) acc[ai][bj][m][n] = __builtin_amdgcn_mfma_scale_f32_16x16x128_f8f6f4(PG8_CAT(Bt[n]), PG8_CAT(At[m]), acc[ai][bj][m][n], 0, 0, 0, 0x7a7a7a7a  , 0, 0x7f7f7f7f); \
        else { _Pragma("unroll") for (int k = 0; k < 2; ++k) acc[ai][bj][m][n] = __builtin_amdgcn_mfma_f32_16x16x32_bf16(Bt[n][k], At[m][k], acc[ai][bj][m][n], 0, 0, 0); } } __builtin_amdgcn_s_setprio(0); } while (0)
#define PG8_WAIT_V(n) asm volatile("s_waitcnt vmcnt(" #n ")" ::: "memory")
#define PG8_WAIT_L(n) asm volatile("s_waitcnt lgkmcnt(" #n ")" ::: "memory")
#define PG8_BAR __builtin_amdgcn_s_barrier()
#define PG8_SCHED __builtin_amdgcn_sched_barrier(0)
#define PG8_GATHER_OFFS(dst, u) do { _Pragma("unroll") for (int _i = 0; _i < 2; ++_i) { int R_, C_; stage_rc(tid * 16 + _i * 8192, R_, C_); _Pragma("unroll") for (int _h = 0; _h < 2; ++_h) dst[_h][_i] = S.row_off(u, _h * HALF + R_) + (unsigned)C_ * 2u; } } while (0)
    Unit cur, nxt; int ui = 0;
    if (!S.next(0, cur)) return;
    f32x4 acc[2][2][4][2];
#pragma unroll
    for (int a = 0; a < 2; ++a)
#pragma unroll
        for (int b = 0; b < 2; ++b)
#pragma unroll
            for (int m = 0; m < 4; ++m)
#pragma unroll
                for (int n = 0; n < 2; ++n) acc[a][b][m][n] = (f32x4){0.f, 0.f, 0.f, 0.f};
    bf16x8 At[4][2], B0[2][2], B1[2][2];
    unsigned cA = (unsigned)(S.a_base(cur) - (const char*)S.a_root()), cB = (unsigned)(S.b_base(cur) - (const char*)S.b_root());
    if constexpr (GATHER) { PG8_GATHER_OFFS(voffA, cur); }
    if constexpr (SP2) {
        PG8_STAGE_B(PG8_SB(0, 0), cB); PG8_STAGE_B(PG8_SB(0, 1), cB + hstepB); PG8_STAGE_A(PG8_SA(0, 0), cA, 0); PG8_STAGE_A(PG8_SA(0, 1), cA, 1);
        if (wr == 1) PG8_BAR;
        PG8_WAIT_V(2); PG8_BAR;
        PG8_STAGE_B(PG8_SB(1, 0), cB + kstep); PG8_STAGE_A(PG8_SA(1, 0), cA + kstep, 0); PG8_STAGE_B(PG8_SB(1, 1), cB + hstepB + kstep);
        PG8_WAIT_V(6); PG8_BAR;
    } else {
        PG8_STAGE_B(PG8_SB(0, 0), cB); PG8_STAGE_A(PG8_SA(0, 0), cA, 0); PG8_STAGE_B(PG8_SB(0, 1), cB + hstepB); PG8_STAGE_A(PG8_SA(0, 1), cA, 1);
        if (wr == 1) PG8_BAR;
        PG8_WAIT_V(4); PG8_BAR;
        PG8_STAGE_B(PG8_SB(1, 0), cB + kstep); PG8_STAGE_A(PG8_SA(1, 0), cA + kstep, 0); PG8_STAGE_B(PG8_SB(1, 1), cB + hstepB + kstep);
        PG8_WAIT_V(6); PG8_BAR;
    }
    for (;;) {
        const bool has_next = S.next(ui + 1, nxt);
        const unsigned nA = has_next ? (unsigned)(S.a_base(nxt) - (const char*)S.a_root()) : cA, nB = has_next ? (unsigned)(S.b_base(nxt) - (const char*)S.b_root()) : cB;
#pragma unroll 1
        for (int t = 0; t < nt; t += 2) {
            const bool last = (t == nt - 2);
            const unsigned a1 = cA + (unsigned)(t + 1) * kstep;
            const unsigned a2 = last ? nA : cA + (unsigned)(t + 2) * kstep, b2 = last ? nB : cB + (unsigned)(t + 2) * kstep;
            const unsigned a3 = a2 + kstep, b3 = b2 + kstep;
            if constexpr (GATHER == 1) { if (last && has_next) { PG8_GATHER_OFFS(voffN, nxt); } }
            if constexpr (SP2) {
            PG8_LDB(B0, 0, 0); PG8_LDB(B1, 0, 1); PG8_SCHED; PG8_LDA(At, 0, 0); PG8_STAGE_A(PG8_SA(1, 1), a1, 1);
            PG8_WAIT_V(8); PG8_WAIT_L(0); PG8_BAR; PG8_MMA(0, 0, At, B0); PG8_MMA(0, 1, At, B1); PG8_BAR; PG8_SCHED;
            if constexpr (GATHER == 1) { if (last && has_next) {
#pragma unroll
                for (int _h = 0; _h < 2; ++_h)
#pragma unroll
                    for (int _i = 0; _i < 2; ++_i) voffA[_h][_i] = voffN[_h][_i]; } }
            if constexpr (GATHER == 2) { if (last && has_next) { PG8_GATHER_OFFS(voffA, nxt); } }
            PG8_LDA(At, 0, 1); PG8_STAGE_B(PG8_SB(0, 0), b2); PG8_STAGE_B(PG8_SB(0, 1), b2 + hstepB); PG8_STAGE_A(PG8_SA(0, 0), a2, 0);
            PG8_WAIT_V(8); PG8_WAIT_L(0); PG8_BAR; PG8_MMA(1, 0, At, B0); PG8_MMA(1, 1, At, B1); PG8_BAR; PG8_SCHED;
            PG8_LDB(B0, 1, 0); PG8_LDB(B1, 1, 1); PG8_SCHED; PG8_LDA(At, 1, 0); PG8_STAGE_A(PG8_SA(0, 1), a2, 1);
            PG8_WAIT_V(8); PG8_WAIT_L(0); PG8_BAR; PG8_MMA(0, 0, At, B0); PG8_MMA(0, 1, At, B1); PG8_BAR; PG8_SCHED;
            PG8_LDA(At, 1, 1); PG8_STAGE_B(PG8_SB(1, 0), b3); PG8_STAGE_B(PG8_SB(1, 1), b3 + hstepB); PG8_STAGE_A(PG8_SA(1, 0), a3, 0);
            PG8_WAIT_V(8); PG8_WAIT_L(0); PG8_BAR; PG8_MMA(1, 0, At, B0); PG8_MMA(1, 1, At, B1); PG8_BAR; PG8_SCHED;
            } else {
            PG8_LDB(B0, 0, 0); PG8_SCHED; PG8_LDA(At, 0, 0); PG8_STAGE_A(PG8_SA(1, 1), a1, 1);
            PG8_WAIT_L(8); PG8_BAR; PG8_WAIT_L(0); PG8_MMA(0, 0, At, B0); PG8_BAR; PG8_SCHED;
            if constexpr (GATHER == 1) { if (last && has_next) {
#pragma unroll
                for (int _h = 0; _h < 2; ++_h)
#pragma unroll
                    for (int _i = 0; _i < 2; ++_i) voffA[_h][_i] = voffN[_h][_i]; } }
            if constexpr (GATHER == 2) { if (last && has_next) { PG8_GATHER_OFFS(voffA, nxt); } }
            PG8_LDB(B1, 0, 1); PG8_STAGE_B(PG8_SB(0, 0), b2);
            PG8_BAR; PG8_WAIT_L(0); PG8_MMA(0, 1, At, B1); PG8_BAR;
            PG8_LDA(At, 0, 1); PG8_STAGE_A(PG8_SA(0, 0), a2, 0);
            PG8_BAR; PG8_WAIT_L(0); PG8_MMA(1, 0, At, B0); PG8_BAR; PG8_SCHED;
            PG8_STAGE_B(PG8_SB(0, 1), b2 + hstepB);
            PG8_WAIT_V(6); PG8_BAR; PG8_MMA(1, 1, At, B1); PG8_BAR;
            PG8_LDB(B0, 1, 0); PG8_SCHED; PG8_LDA(At, 1, 0); PG8_STAGE_A(PG8_SA(0, 1), a2, 1);
            PG8_WAIT_L(8); PG8_BAR; PG8_WAIT_L(0); PG8_MMA(0, 0, At, B0); PG8_BAR; PG8_SCHED;
            PG8_LDB(B1, 1, 1); PG8_STAGE_B(PG8_SB(1, 0), b3);
            PG8_BAR; PG8_WAIT_L(0); PG8_MMA(0, 1, At, B1); PG8_BAR;
            PG8_LDA(At, 1, 1); PG8_STAGE_A(PG8_SA(1, 0), a3, 0);
            PG8_BAR; PG8_WAIT_L(0); PG8_MMA(1, 0, At, B0); PG8_BAR; PG8_SCHED;
            PG8_STAGE_B(PG8_SB(1, 1), b3 + hstepB);
            PG8_WAIT_V(6); PG8_BAR; PG8_MMA(1, 1, At, B1); PG8_BAR;
            }
        }
        if constexpr (ALIGN_EPI) { if (wr == 0) PG8_BAR; }
        E(acc, cur, wr, wc, fr, fq);
        if (!has_next) break;
#pragma unroll
        for (int a = 0; a < 2; ++a)
#pragma unroll
            for (int b = 0; b < 2; ++b)
#pragma unroll
                for (int m = 0; m < 4; ++m)
#pragma unroll
                    for (int n = 0; n < 2; ++n) acc[a][b][m][n] = (f32x4){0.f, 0.f, 0.f, 0.f};
        cur = nxt; cA = nA; cB = nB; ++ui;
        if constexpr (ALIGN_EPI) { if (wr == 1) PG8_BAR; }
    }
    PG8_WAIT_V(0);
    if constexpr (!ALIGN_EPI) { if (wr == 0) PG8_BAR; }
    PG8_BAR;
#undef PG8_SA
#undef PG8_SB
#undef PG8_STAGE_A
#undef PG8_STAGE_B
#undef PG8_LDA
#undef PG8_LDB
#undef PG8_MMA
#undef PG8_CAT
#undef PG8_WAIT_V
#undef PG8_WAIT_L
#undef PG8_BAR
#undef PG8_SCHED
#undef PG8_GATHER_OFFS
}
}
namespace mk {
constexpr int NWAVES = 8;
constexpr int T = 16384, D = 1024, SEQ = 4096, NB = 4, NE = 32, NH = 32;
constexpr int DSSD = 2048, DCONV = 3072, NPROJ = 8224;
constexpr float EPS = 1e-5f;
constexpr size_t MiB = 1u << 20;
constexpr size_t WS_CTL = 0, CTL_ZERO_BYTES = 256 * 1024;
constexpr size_t WS_MOD = 128 * 1024;
constexpr size_t WS_CD = 1 * MiB;
constexpr size_t WS_GATE = 1 * MiB + 256 * 1024;
constexpr size_t WS_DT = 2 * MiB;
constexpr size_t WS_LIST = 4 * MiB;
constexpr size_t WS_WDT = 6 * MiB;
constexpr size_t WS_WPOOL = 6 * MiB + 512 * 1024;
constexpr size_t WS_WIN = 8 * MiB, WS_WSSD = 24 * MiB, WS_WPO = 28 * MiB, WS_WOUT = 30 * MiB, WS_WGU = 32 * MiB, WS_WDN = 160 * MiB;
constexpr size_t WS_H = 224 * MiB, WS_Z = 256 * MiB, WS_XBC = 320 * MiB, WS_U = 416 * MiB, WS_GATES = 448 * MiB, WS_STATES = 512 * MiB, WS_Y = 576 * MiB;
constexpr size_t WS_P = 640 * MiB, WS_P2 = 672 * MiB, WS_M1 = 704 * MiB, WS_MERGED = 736 * MiB, WS_END = 768 * MiB;
constexpr size_t WS_XC = 768 * MiB;
constexpr size_t WS_ACT = 256 * MiB, WS_YB = 416 * MiB;
constexpr int ACT_ROWS = 73728;
constexpr int CW_TMO = 0, CW_CODE = 1, CW_GCNT = 1024, CW_BAR = 4096;
constexpr int RING_BYTES = 143360;
constexpr int LDSCTL_OFF = RING_BYTES, MISC_OFF = LDSCTL_OFF + 64;
constexpr int LDS_BYTES = 147456;

#define GAS __attribute__((address_space(1)))
#define LAS __attribute__((address_space(3)))
typedef unsigned short bf16;
typedef unsigned v4u __attribute__((ext_vector_type(4)));
typedef unsigned v2u __attribute__((ext_vector_type(2)));
typedef float f32x4 __attribute__((ext_vector_type(4)));
typedef float f32x16 __attribute__((ext_vector_type(16)));
typedef short bf16x8 __attribute__((ext_vector_type(8)));
typedef GAS unsigned gu32;
#define RLX_AGENT __ATOMIC_RELAXED, __HIP_MEMORY_SCOPE_AGENT
#define LDS_WAIT() asm volatile("s_waitcnt lgkmcnt(0)" ::: "memory")
#define VM_WAIT() asm volatile("s_waitcnt vmcnt(0)" ::: "memory")
__device__ __forceinline__ unsigned f2bf(float f) { unsigned u = __builtin_bit_cast(unsigned, f); return (u + 0x7fffu + ((u >> 16) & 1u)) >> 16; }
typedef float f32x2_t __attribute__((ext_vector_type(2))); typedef __bf16 bf16x2_t __attribute__((ext_vector_type(2)));
__device__ __forceinline__ unsigned pk2(float lo, float hi) { const f32x2_t v = {lo, hi}; const bf16x2_t b = __builtin_convertvector(v, bf16x2_t); return __builtin_bit_cast(unsigned, b); }
__device__ __forceinline__ float bflo(unsigned w) { return __builtin_bit_cast(float, w << 16); }
__device__ __forceinline__ float bfhi(unsigned w) { return __builtin_bit_cast(float, w & 0xffff0000u); }
__device__ __forceinline__ float bf2f(bf16 h) { return __builtin_bit_cast(float, (unsigned)h << 16); }
__device__ __forceinline__ float sigm(float x) { return __builtin_amdgcn_rcpf(1.f + __builtin_amdgcn_exp2f(x * -1.4426950408889634f)); }
__device__ __forceinline__ float silu(float x) { return x * sigm(x); }
__device__ __forceinline__ float wave_sum(float v) {
#pragma unroll
    for (int o = 1; o < 64; o <<= 1) v += __shfl_xor(v, o);
    return v;
}

#define XB_TMO      128
#define XB_XCNT(j)  (256  + 64 * (j))
#define XB_XSUB(j)  (1280 + 64 * (j))
#define XB_XGEN(j)  (2304 + 64 * (j))
#define XB_TOP      3328
#define XB_TOPGEN   3392
#define XCD_BAR_WORDS 3456
#define XB_SPIN_CAP (1u << 18)
__device__ __forceinline__ unsigned xb_ld(unsigned* p)              { return __hip_atomic_load(p, __ATOMIC_RELAXED, __HIP_MEMORY_SCOPE_AGENT); }
__device__ __forceinline__ unsigned xb_add(unsigned* p, unsigned v) { return __hip_atomic_fetch_add(p, v, __ATOMIC_RELAXED, __HIP_MEMORY_SCOPE_AGENT); }
__device__ __forceinline__ unsigned xb_xcc_id() { return (unsigned)__builtin_amdgcn_s_getreg((3 << 11) | 20) & 0xFu; }
#define XB_SPIN(cond, bar) do { unsigned _sp = 0; while (cond) { __builtin_amdgcn_s_sleep(1); \
    if ((++_sp & 255u) == 0u) { if (xb_ld(&(bar)[XB_TMO])) break; if (_sp > XB_SPIN_CAP) { atomicAdd(&(bar)[XB_TMO], 1u); break; } } } } while (0)
struct XcdBarrier { unsigned* bar; unsigned x; volatile LAS unsigned* st; };
__device__ __forceinline__ XcdBarrier xcd_barrier_post(unsigned* bar, volatile LAS unsigned* st) {
    XcdBarrier b; b.bar = bar; b.x = xb_xcc_id(); b.st = st;
    if (threadIdx.x == 0) (void)xb_add(&bar[XB_XCNT(b.x)], 1u);
    return b;
}
__device__ __forceinline__ void xcd_barrier_complete(unsigned* bar, unsigned x, unsigned& nloc, unsigned& nx) {
    const unsigned G = gridDim.x * gridDim.y * gridDim.z;
    unsigned sum, cnt, mine, sp = 0u;
    for (;;) {
        sum = 0u; cnt = 0u; mine = 0u;
#pragma unroll
        for (unsigned j = 0; j < 16; ++j) { const unsigned c = xb_ld(&bar[XB_XCNT(j)]); sum += c; cnt += (c > 0u) ? 1u : 0u; mine = (j == x) ? c : mine; }
        if (sum == G) break;
        __builtin_amdgcn_s_sleep(1);
        if ((++sp & 255u) == 0u) { if (xb_ld(&bar[XB_TMO])) break; if (sp > XB_SPIN_CAP) { atomicAdd(&bar[XB_TMO], 1u); break; } }
    }
    nloc = mine > 0u ? mine : 1u; nx = cnt > 0u ? cnt : 1u;
}
__device__ __forceinline__ void xcd_barrier(const XcdBarrier& b, const int wave) {
    asm volatile("s_waitcnt vmcnt(0)" ::: "memory");
    __syncthreads();
    int lane_; asm volatile("v_mbcnt_lo_u32_b32 %0, -1, 0\n\tv_mbcnt_hi_u32_b32 %0, -1, %0" : "=v"(lane_));
    if (wave == 0 && lane_ == 0) {
        unsigned* bar = b.bar;
        __builtin_amdgcn_s_waitcnt(0);
        unsigned nloc = b.st[0], nx = b.st[1];
        if (nloc == 0u) { xcd_barrier_complete(bar, b.x, nloc, nx); b.st[0] = nloc; b.st[1] = nx; }
        const unsigned old = xb_add(&bar[XB_XSUB(b.x)], 1u);
        const unsigned gen = old / nloc;
        if (old + 1u == (gen + 1u) * nloc) {
            __builtin_amdgcn_fence(__ATOMIC_RELEASE, "agent");
            asm volatile("s_waitcnt vmcnt(0)" ::: "memory");
            const unsigned og = xb_add(&bar[XB_TOP], 1u);
            const unsigned tg = og / nx;
            if (og + 1u == (tg + 1u) * nx) xb_add(&bar[XB_TOPGEN], 1u);
            else XB_SPIN(xb_ld(&bar[XB_TOPGEN]) == tg, bar);
            __builtin_amdgcn_fence(__ATOMIC_ACQUIRE, "agent");
            xb_add(&bar[XB_XGEN(b.x)], 1u);
            asm volatile("s_waitcnt vmcnt(0)" ::: "memory");
        } else {
            XB_SPIN(xb_ld(&bar[XB_XGEN(b.x)]) == gen, bar);
            __builtin_amdgcn_fence(__ATOMIC_ACQUIRE, "agent");
            asm volatile("s_waitcnt vmcnt(0)" ::: "memory");
        }
    }
    __syncthreads();
}
}
namespace mk {
struct Frame {
    LAS unsigned char* lds; volatile LAS unsigned* MISC; gu32* ctl; unsigned char* ws; float* out; const float* const* in;
    int tid, lane, wave, vcu, G;
};
__device__ __forceinline__ void refresh_ids(Frame& F) { int l; asm volatile("v_mbcnt_lo_u32_b32 %0, -1, 0\n\tv_mbcnt_hi_u32_b32 %0, -1, %0" : "=v"(l)); F.lane = l; F.tid = F.wave * 64 + l; }
enum { I_X = 0, I_C, I_WADA, I_BADA, I_NMW, I_WIN, I_CONVW, I_CONVB, I_DTB, I_ALOG, I_DSKIP, I_SNW, I_WSSD, I_WPOOL, I_PSCALE, I_WPO, I_WOUT, I_NFW, I_WR, I_BR, I_WGU, I_BGU, I_WDN, I_BDN, I_NFINAL };

__device__ __forceinline__ void p0_tile(const float* src, int ldsrc, int srccol0, int k0, bf16* dst, int lddst, int dstrow0, int nvalid, LAS float* scr, int lane) {
    const int col = (lane & 15) * 4;
    f32x4 tv[16];
#pragma unroll
    for (int i = 0; i < 16; ++i) { const int kk = 4 * i + (lane >> 4); tv[i] = (f32x4){0.f, 0.f, 0.f, 0.f}; if (col < nvalid) tv[i] = *(const f32x4*)(src + (size_t)(k0 + kk) * ldsrc + srccol0 + col); }
#pragma unroll
    for (int i = 0; i < 16; ++i) { const int kk = 4 * i + (lane >> 4); LAS float* s = scr + kk * 65 + col; s[0] = tv[i].x; s[1] = tv[i].y; s[2] = tv[i].z; s[3] = tv[i].w; }
    LDS_WAIT(); asm volatile("" ::: "memory");
    const int c = lane & 7;
#pragma unroll
    for (int j = 0; j < 8; ++j) { const int n = (lane >> 3) + 8 * j; const LAS float* s = scr + (8 * c) * 65 + n;
        v4u o; o.x = pk2(s[0 * 65], s[1 * 65]); o.y = pk2(s[2 * 65], s[3 * 65]); o.z = pk2(s[4 * 65], s[5 * 65]); o.w = pk2(s[6 * 65], s[7 * 65]);
        if (n < nvalid) *(v4u*)(dst + (size_t)(dstrow0 + n) * lddst + k0 + 8 * c) = o; }
    LDS_WAIT(); asm volatile("" ::: "memory");
}
__device__ __forceinline__ void p0_tile8(const float* src, int ldsrc, int srccol0, int k0, unsigned char* dst, int lddst, int dstrow0, float scale, LAS float* scr, int lane) {
    const int col = (lane & 15) * 4;
    f32x4 tv[16];
#pragma unroll
    for (int i = 0; i < 16; ++i) { const int kk = 4 * i + (lane >> 4); tv[i] = *(const f32x4*)(src + (size_t)(k0 + kk) * ldsrc + srccol0 + col); }
#pragma unroll
    for (int i = 0; i < 16; ++i) { const int kk = 4 * i + (lane >> 4); LAS float* s = scr + kk * 65 + col; s[0] = tv[i].x; s[1] = tv[i].y; s[2] = tv[i].z; s[3] = tv[i].w; }
    LDS_WAIT(); asm volatile("" ::: "memory");
    const int c = lane & 7;
#pragma unroll
    for (int j = 0; j < 8; ++j) { const int n = (lane >> 3) + 8 * j; const LAS float* s = scr + (8 * c) * 65 + n;
        int w0 = 0, w1 = 0; w0 = __builtin_amdgcn_cvt_pk_fp8_f32(s[0 * 65] * scale, s[1 * 65] * scale, w0, false); w0 = __builtin_amdgcn_cvt_pk_fp8_f32(s[2 * 65] * scale, s[3 * 65] * scale, w0, true);
        w1 = __builtin_amdgcn_cvt_pk_fp8_f32(s[4 * 65] * scale, s[5 * 65] * scale, w1, false); w1 = __builtin_amdgcn_cvt_pk_fp8_f32(s[6 * 65] * scale, s[7 * 65] * scale, w1, true);
        *(v2u*)(dst + (size_t)(dstrow0 + n) * lddst + k0 + 8 * c) = (v2u){(unsigned)w0, (unsigned)w1}; }
    LDS_WAIT(); asm volatile("" ::: "memory");
}
__device__ __forceinline__ void p0_prologue(Frame& F) {
    LAS float* scr = (LAS float*)(F.lds + F.wave * 16896);
    const int gw = F.vcu * NWAVES + F.wave, NGW = F.G * NWAVES;
    bf16* WIN_T = (bf16*)(F.ws + WS_WIN); bf16* WDT_T = (bf16*)(F.ws + WS_WDT); bf16* WSSD_T = (bf16*)(F.ws + WS_WSSD); bf16* WPO_T = (bf16*)(F.ws + WS_WPO);
    bf16* WOUT_T = (bf16*)(F.ws + WS_WOUT); bf16* WPOOL_T = (bf16*)(F.ws + WS_WPOOL); bf16* WGU_T = (bf16*)(F.ws + WS_WGU); bf16* WDN_T = (bf16*)(F.ws + WS_WDN);
    constexpr int N_IN = 2048, N_DT = 16, N_SSD = 512, N_PO = 256, N_OUT = 256, N_POOL = 64, N_GU = 16384, N_DN = 8192;
    constexpr int NITEMS = N_IN + N_DT + N_SSD + N_PO + N_OUT + N_POOL + N_GU + N_DN;
    for (int it = gw; it < NITEMS; it += NGW) {
        int r = it;
        if (r < N_GU) { const int e = r >> 9, q = r & 511, rb = q >> 4, kb = q & 15; const int rho = rb * 64, pn = rho >> 8, rr = rho & 255;
            const int sc = rr < 128 ? 128 * pn + rr : 1024 + 128 * pn + (rr - 128);
            p0_tile8(F.in[I_WGU] + (size_t)e * 1024 * 2048, 2048, sc, kb * 64, (unsigned char*)WGU_T + (size_t)e * 2048 * 1024, 1024, rho, 32.f, scr, F.lane); continue; } r -= N_GU;
        if (r < N_DN) { const int e = r >> 8, q = r & 255, rb = q >> 4, kb = q & 15;
            p0_tile8(F.in[I_WDN] + (size_t)e * 1024 * 1024, 1024, rb * 64, kb * 64, (unsigned char*)WDN_T + (size_t)e * 1024 * 1024, 1024, rb * 64, 32.f, scr, F.lane); continue; } r -= N_DN;
        if (r < N_IN) { const int rb = r >> 4, kb = r & 15; const int drow = rb * 64; const int sc = drow + (drow >= 5120 ? 32 : 0);
            p0_tile(F.in[I_WIN], NPROJ, sc, kb * 64, WIN_T, 1024, drow, 64, scr, F.lane); continue; } r -= N_IN;
        if (r < N_DT) { p0_tile(F.in[I_WIN], NPROJ, 5120, r * 64, WDT_T, 1024, 0, 32, scr, F.lane); continue; } r -= N_DT;
        if (r < N_SSD) { const int rb = r >> 5, kb = r & 31; p0_tile(F.in[I_WSSD], 1024, rb * 64, kb * 64, WSSD_T, 2048, rb * 64, 64, scr, F.lane); continue; } r -= N_SSD;
        if (r < N_PO) { const int rb = r >> 4, kb = r & 15; p0_tile(F.in[I_WPO], 1024, rb * 64, kb * 64, WPO_T, 1024, rb * 64, 64, scr, F.lane); continue; } r -= N_PO;
        if (r < N_OUT) { const int rb = r >> 4, kb = r & 15; p0_tile(F.in[I_WOUT], 1024, rb * 64, kb * 64, WOUT_T, 1024, rb * 64, 64, scr, F.lane); continue; } r -= N_OUT;
        { const int g = r >> 4, q = r & 15, rb = q >> 2, kb = q & 3; p0_tile(F.in[I_WPOOL] + (size_t)g * 65536, 256, rb * 64, kb * 64, WPOOL_T, 256, g * 256 + rb * 64, 64, scr, F.lane); }
    }
    __syncthreads();
    { float* mod = (float*)(F.ws + WS_MOD); LAS float* red = (LAS float*)F.lds;
      for (int jb = F.vcu; jb < 256; jb += F.G) {
        const int jj = F.tid & 31, sl = F.tid >> 5, j = jb * 24 + jj; float a0 = 0.f, a1 = 0.f, a2 = 0.f, a3 = 0.f; const float* cc = F.in[I_C];
        if (jj < 24) {
#pragma unroll 8
            for (int k = sl * 64; k < sl * 64 + 64; ++k) { const float w = F.in[I_WADA][(size_t)k * 6144 + j];
                a0 += silu(cc[k]) * w; a1 += silu(cc[1024 + k]) * w; a2 += silu(cc[2048 + k]) * w; a3 += silu(cc[3072 + k]) * w; } }
        red[(sl * 4 + 0) * 32 + jj] = a0; red[(sl * 4 + 1) * 32 + jj] = a1; red[(sl * 4 + 2) * 32 + jj] = a2; red[(sl * 4 + 3) * 32 + jj] = a3;
        __syncthreads();
        if (F.tid < 128) { const int b = F.tid >> 5, q = F.tid & 31; if (q < 24) { float s = F.in[I_BADA][jb * 24 + q];
#pragma unroll
                for (int i = 0; i < 16; ++i) s += red[(i * 4 + b) * 32 + q];
                mod[b * 6144 + jb * 24 + q] = s; } }
        __syncthreads();
      } }
}

__device__ __forceinline__ void p1_norm_dt(Frame& F) {
    constexpr int PITCH = 2064;
    LAS unsigned char* tile = F.lds + F.wave * (8 * PITCH);
    for (int grp = F.vcu * NWAVES + F.wave; grp < T / 8; grp += F.G * NWAVES) {
    const int t0 = grp * 8, b = t0 / SEQ;
    const float* mod = (const float*)(F.ws + WS_MOD) + b * 6144; bf16* H = (bf16*)(F.ws + WS_H);
    f32x4 wv[4], scv[4], shv[4];
#pragma unroll
    for (int j = 0; j < 4; ++j) { const int col = 4 * F.lane + 256 * j; wv[j] = *(const f32x4*)(F.in[I_NMW] + col); scv[j] = *(const f32x4*)(mod + 1024 + col); shv[j] = *(const f32x4*)(mod + col); }
#pragma unroll 1
    for (int r4 = 0; r4 < 8; r4 += 4) {
      f32x4 xv[4][4];
#pragma unroll
      for (int rr = 0; rr < 4; ++rr)
#pragma unroll
        for (int j = 0; j < 4; ++j) xv[rr][j] = *(const f32x4*)(F.in[I_X] + (size_t)(t0 + r4 + rr) * D + 4 * F.lane + 256 * j);
#pragma unroll
      for (int rr = 0; rr < 4; ++rr) { const int r = r4 + rr;
        f32x4 v[4]; float s = 0.f;
#pragma unroll
        for (int j = 0; j < 4; ++j) { v[j] = xv[rr][j]; s += (v[j].x * v[j].x + v[j].y * v[j].y) + (v[j].z * v[j].z + v[j].w * v[j].w); }
        const float rstd = rsqrtf(wave_sum(s) * (1.f / D) + EPS);
#pragma unroll
        for (int j = 0; j < 4; ++j) { const f32x4 hv = v[j] * rstd * wv[j] * (scv[j] + 1.f) + shv[j];
            v2u o; o.x = pk2(hv.x, hv.y); o.y = pk2(hv.z, hv.w);
            *(v2u*)(H + (size_t)(t0 + r) * D + 4 * F.lane + 256 * j) = o;
            *(LAS v2u*)(tile + r * PITCH + (4 * F.lane + 256 * j) * 2) = o; }
      }
    }
    LDS_WAIT(); asm volatile("" ::: "memory");
    const bf16* WDT_T = (const bf16*)(F.ws + WS_WDT);
    f32x4 acc0 = (f32x4){0.f, 0.f, 0.f, 0.f}, acc1 = acc0; const int fr = F.lane & 15, fq = F.lane >> 4;
#pragma unroll 8
    for (int s = 0; s < 32; ++s) {
        const bf16x8 a = *(const LAS bf16x8*)(tile + (fr & 7) * PITCH + (32 * s + 8 * fq) * 2);
        const bf16x8 b0 = *(const bf16x8*)(WDT_T + (size_t)fr * 1024 + 32 * s + 8 * fq), b1 = *(const bf16x8*)(WDT_T + (size_t)(fr + 16) * 1024 + 32 * s + 8 * fq);
        acc0 = __builtin_amdgcn_mfma_f32_16x16x32_bf16(a, b0, acc0, 0, 0, 0); acc1 = __builtin_amdgcn_mfma_f32_16x16x32_bf16(a, b1, acc1, 0, 0, 0);
    }
    if (fq < 2) { float* DT = (float*)(F.ws + WS_DT); const float db0 = F.in[I_DTB][fr], db1 = F.in[I_DTB][fr + 16];
#pragma unroll
        for (int i = 0; i < 4; ++i) { const int row = t0 + 4 * fq + i; float x0 = acc0[i] + db0, x1 = acc1[i] + db1;
            DT[(size_t)row * 32 + fr] = x0 > 20.f ? x0 : log1pf(__expf(x0)); DT[(size_t)row * 32 + 16 + fr] = x1 > 20.f ? x1 : log1pf(__expf(x1)); } }
    LDS_WAIT();
    }
}

template <int W> __device__ __forceinline__ void pool_item(const bf16* U, bf16* P, int t0, int tt0, int cg) {
    v4u raw[W + 7];
#pragma unroll
    for (int r = 0; r < W + 7; ++r) { const int d = r - (W - 1); raw[r] = (tt0 + d >= 0) ? *(const v4u*)(U + (size_t)(t0 + d) * D + cg * 8) : (v4u){0u, 0u, 0u, 0u}; }
    float s[8];
#pragma unroll
    for (int q = 0; q < 8; ++q) s[q] = 0.f;
#pragma unroll
    for (int r = 0; r < W - 1; ++r) { const v4u v = raw[r]; s[0] += bflo(v.x); s[1] += bfhi(v.x); s[2] += bflo(v.y); s[3] += bfhi(v.y); s[4] += bflo(v.z); s[5] += bfhi(v.z); s[6] += bflo(v.w); s[7] += bfhi(v.w); }
#pragma unroll
    for (int i = 0; i < 8; ++i) { const v4u v = raw[W - 1 + i]; const float u[8] = {bflo(v.x), bfhi(v.x), bflo(v.y), bfhi(v.y), bflo(v.z), bfhi(v.z), bflo(v.w), bfhi(v.w)};
#pragma unroll
        for (int q = 0; q < 8; ++q) s[q] += u[q];
        const int tt = tt0 + i; const float inv = 1.f / (float)(tt + 1 < W ? tt + 1 : W);
        v4u o; o.x = pk2(s[0] * inv - u[0], s[1] * inv - u[1]); o.y = pk2(s[2] * inv - u[2], s[3] * inv - u[3]); o.z = pk2(s[4] * inv - u[4], s[5] * inv - u[5]); o.w = pk2(s[6] * inv - u[6], s[7] * inv - u[7]);
        *(v4u*)(P + (size_t)(t0 + i) * D + cg * 8) = o;
        const v4u z = raw[i]; s[0] -= bflo(z.x); s[1] -= bfhi(z.x); s[2] -= bflo(z.y); s[3] -= bfhi(z.y); s[4] -= bflo(z.z); s[5] -= bfhi(z.z); s[6] -= bflo(z.w); s[7] -= bfhi(z.w); }
}
__device__ __forceinline__ void pool_pass(Frame& F) {
    const bf16* U = (const bf16*)(F.ws + WS_U); bf16* P = (bf16*)(F.ws + WS_P);
    for (int it = F.vcu * 512 + F.tid; it < 2048 * 128; it += F.G * 512) {
        const int wsel = __builtin_amdgcn_readfirstlane((it >> 6) & 3), cg = wsel * 32 + (it & 31), strip = (it >> 8) * 2 + ((it >> 5) & 1); const int t0 = strip * 8, tt0 = t0 % SEQ;
        if (wsel == 0) pool_item<2>(U, P, t0, tt0, cg); else if (wsel == 1) pool_item<4>(U, P, t0, tt0, cg); else if (wsel == 2) pool_item<8>(U, P, t0, tt0, cg); else pool_item<16>(U, P, t0, tt0, cg);
    }
}

__device__ __forceinline__ int swz16(int row) { return (row ^ (row >> 4)) & 15; }
__device__ __forceinline__ void conv8x8(const bf16* XBC, const float* cw, const float* cb, int trow0, bool seq_start, int col, float (&out)[8][8]) {
    float u[11][8];
#pragma unroll
    for (int r = 0; r < 11; ++r) { v4u v = (v4u){0u, 0u, 0u, 0u}; if (!(r < 3 && seq_start)) v = *(const v4u*)(XBC + (size_t)(trow0 - 3 + r) * DCONV + col);
        u[r][0] = bflo(v.x); u[r][1] = bfhi(v.x); u[r][2] = bflo(v.y); u[r][3] = bfhi(v.y); u[r][4] = bflo(v.z); u[r][5] = bfhi(v.z); u[r][6] = bflo(v.w); u[r][7] = bfhi(v.w); }
    float w[4][8], bb[8];
#pragma unroll
    for (int k = 0; k < 4; ++k) { const f32x4 a = *(const f32x4*)(cw + k * DCONV + col), b = *(const f32x4*)(cw + k * DCONV + col + 4);
        w[k][0] = a.x; w[k][1] = a.y; w[k][2] = a.z; w[k][3] = a.w; w[k][4] = b.x; w[k][5] = b.y; w[k][6] = b.z; w[k][7] = b.w; }
    { const f32x4 a = *(const f32x4*)(cb + col), b = *(const f32x4*)(cb + col + 4); bb[0] = a.x; bb[1] = a.y; bb[2] = a.z; bb[3] = a.w; bb[4] = b.x; bb[5] = b.y; bb[6] = b.z; bb[7] = b.w; }
#pragma unroll
    for (int i = 0; i < 8; ++i)
#pragma unroll
        for (int q = 0; q < 8; ++q) { const float a = bb[q] + w[0][q] * u[i][q] + w[1][q] * u[i + 1][q] + w[2][q] * u[i + 2][q] + w[3][q] * u[i + 3][q]; out[i][q] = silu(a); }
}
__device__ __forceinline__ void conv_item(const bf16* XBC, const float* cw, const float* cb, int trow0, bool seq_start, int col, bf16* gdst, const bool do_g, LAS unsigned char* img, const bool do_img, int row0, int chunk, const LAS float* sc, const bool do_sc) {
    v4u raw[11];
#pragma unroll
    for (int r = 0; r < 11; ++r) { raw[r] = (v4u){0u, 0u, 0u, 0u}; if (!(r < 3 && seq_start)) raw[r] = *(const v4u*)(XBC + (size_t)(trow0 - 3 + r) * DCONV + col); }
    f32x4 wa[4], wb[4];
#pragma unroll
    for (int k = 0; k < 4; ++k) { wa[k] = *(const f32x4*)(cw + k * DCONV + col); wb[k] = *(const f32x4*)(cw + k * DCONV + col + 4); }
    const f32x4 ba = *(const f32x4*)(cb + col), bbv = *(const f32x4*)(cb + col + 4);
    unsigned la[8];
#pragma unroll
    for (int q = 0; q < 8; ++q) la[q] = (unsigned)((row0 + q) * 256 + ((chunk ^ swz16(row0 + q)) << 4));
#define CI_U(R, Q) (((Q) & 1) ? bfhi(((Q) >> 1) == 0 ? raw[R].x : ((Q) >> 1) == 1 ? raw[R].y : ((Q) >> 1) == 2 ? raw[R].z : raw[R].w) : bflo(((Q) >> 1) == 0 ? raw[R].x : ((Q) >> 1) == 1 ? raw[R].y : ((Q) >> 1) == 2 ? raw[R].z : raw[R].w))
#define CI_W(K, Q) ((Q) < 4 ? wa[K][(Q) & 3] : wb[K][(Q) & 3])
#pragma unroll
    for (int ip = 0; ip < 4; ++ip) {
        float a0[8], a1[8];
#pragma unroll
        for (int q = 0; q < 8; ++q) { const float bq = q < 4 ? ba[q & 3] : bbv[q & 3];
            a0[q] = silu(bq + CI_W(0, q) * CI_U(2 * ip, q) + CI_W(1, q) * CI_U(2 * ip + 1, q) + CI_W(2, q) * CI_U(2 * ip + 2, q) + CI_W(3, q) * CI_U(2 * ip + 3, q));
            a1[q] = silu(bq + CI_W(0, q) * CI_U(2 * ip + 1, q) + CI_W(1, q) * CI_U(2 * ip + 2, q) + CI_W(2, q) * CI_U(2 * ip + 3, q) + CI_W(3, q) * CI_U(2 * ip + 4, q)); }
        if (do_g) { *(v4u*)(gdst + (size_t)(2 * ip) * DCONV) = (v4u){pk2(a0[0], a0[1]), pk2(a0[2], a0[3]), pk2(a0[4], a0[5]), pk2(a0[6], a0[7])};
                    *(v4u*)(gdst + (size_t)(2 * ip + 1) * DCONV) = (v4u){pk2(a1[0], a1[1]), pk2(a1[2], a1[3]), pk2(a1[4], a1[5]), pk2(a1[6], a1[7])}; }
        if (do_img) { float s0 = 1.f, s1 = 1.f; if (do_sc) { s0 = sc[2 * ip]; s1 = sc[2 * ip + 1]; }
#pragma unroll
            for (int q = 0; q < 8; ++q) *(LAS unsigned*)(img + la[q] + 4 * ip) = pk2(a0[q] * s0, a1[q] * s1); }
    }
#undef CI_U
#undef CI_W
}
__device__ __forceinline__ void put_transposed(LAS unsigned char* img, int row0, int chunk, const float (&o)[8][8]) {
#pragma unroll
    for (int q = 0; q < 8; ++q) { const int row = row0 + q; v4u v; v.x = pk2(o[0][q], o[1][q]); v.y = pk2(o[2][q], o[3][q]); v.z = pk2(o[4][q], o[5][q]); v.w = pk2(o[6][q], o[7][q]);
        *(LAS v4u*)(img + row * 256 + ((chunk ^ swz16(row)) << 4)) = v; }
}
__device__ __forceinline__ void put_global(bf16* dst, const float (&o)[8][8]) {
#pragma unroll
    for (int i = 0; i < 8; ++i) { v4u v; v.x = pk2(o[i][0], o[i][1]); v.y = pk2(o[i][2], o[i][3]); v.z = pk2(o[i][4], o[i][5]); v.w = pk2(o[i][6], o[i][7]); *(v4u*)(dst + (size_t)i * DCONV) = v; }
}
__device__ __forceinline__ void put_natural(LAS unsigned char* img, int l0, int chunk, const float (&o)[8][8]) {
#pragma unroll
    for (int i = 0; i < 8; ++i) { const int row = l0 + i; v4u v; v.x = pk2(o[i][0], o[i][1]); v.y = pk2(o[i][2], o[i][3]); v.z = pk2(o[i][4], o[i][5]); v.w = pk2(o[i][6], o[i][7]);
        *(LAS v4u*)(img + row * 256 + ((chunk ^ swz16(row)) << 4)) = v; }
}
__device__ __forceinline__ bf16x8 ld_frag(const LAS unsigned char* img, int row, int chunk) { return *(const LAS bf16x8*)(img + row * 256 + ((chunk ^ swz16(row)) << 4)); }

__device__ __forceinline__ void ssd_states_unit(Frame& F, int unit) {
    const int hh = unit & 1, g = (unit >> 1) & 3, c = (unit >> 3) & 31, b = unit >> 8; const int t0 = b * SEQ + c * 128;
    LAS float* sx = (LAS float*)F.lds;
    LAS unsigned char* Bt = F.lds + 4096; LAS unsigned char* Xt = F.lds + 4096 + 32768;
    const float* DT = (const float*)(F.ws + WS_DT); const bf16* XBC = (const bf16*)(F.ws + WS_XBC); bf16* XC = (bf16*)(F.ws + WS_XC); float* CD = (float*)(F.ws + WS_CD);
    __syncthreads();
    if (F.wave < 4) {
        const int h = g * 8 + 4 * hh + F.wave; const float A = -__expf(F.in[I_ALOG][h]); const int l = 2 * F.lane;
        const float d0 = DT[(size_t)(t0 + l) * 32 + h], d1 = DT[(size_t)(t0 + l + 1) * 32 + h]; const float a0 = d0 * A, a1 = d1 * A, s = a0 + a1;
        float incl = s;
#pragma unroll
        for (int o = 1; o < 64; o <<= 1) { const float v = __shfl_up(incl, o); if (F.lane >= o) incl += v; }
        const float c0 = incl - s + a0, c1 = incl, total = __shfl(incl, 63);
        sx[F.wave * 128 + l] = d0 * __expf(total - c0); sx[F.wave * 128 + l + 1] = d1 * __expf(total - c1);
        if (F.lane == 0) CD[(b * 32 + c) * 32 + h] = __expf(total);
    }
    __syncthreads();
#pragma unroll 1
    for (int itx = 0; itx < 2; ++itx) {
        int kind, strip, grp, col;
        if (itx == 0) { kind = 0; strip = F.tid >> 5; grp = F.tid & 31; col = g * 512 + hh * 256 + grp * 8; }
        else if (F.tid < 256) { kind = 1; strip = F.tid >> 4; grp = F.tid & 15; col = 2048 + g * 128 + grp * 8; }
        else if (F.tid < 384) { kind = 2; strip = 8 * hh + ((F.tid - 256) >> 4); grp = F.tid & 15; col = 2560 + g * 128 + grp * 8; }
        else { kind = 3; strip = 0; grp = 0; col = 0; }
        if (kind < 3) { const int l0 = strip * 8;
            conv_item(XBC, F.in[I_CONVW], F.in[I_CONVB], t0 + l0, (c == 0 && l0 == 0), col, XC + (size_t)(t0 + l0) * DCONV + col, (kind != 1 || hh == 0),
                      kind ? Bt : Xt, kind < 2, grp * 8, strip, sx + (grp >> 3) * 128 + l0, kind == 0); }
    }
    __syncthreads();
    const int li = F.lane & 31, half = F.lane >> 5, hp = (F.wave >> 1) * 64 + (F.wave & 1) * 32 + li;
    f32x16 acc[4];
#pragma unroll
    for (int nt = 0; nt < 4; ++nt)
#pragma unroll
        for (int r = 0; r < 16; ++r) acc[nt][r] = 0.f;
#pragma unroll 2
    for (int ks = 0; ks < 8; ++ks) { const bf16x8 xb = ld_frag(Xt, hp, 2 * ks + half);
#pragma unroll
        for (int nt = 0; nt < 4; ++nt) { const bf16x8 ba = ld_frag(Bt, 32 * nt + li, 2 * ks + half); acc[nt] = __builtin_amdgcn_mfma_f32_32x32x16_bf16(ba, xb, acc[nt], 0, 0, 0); } }
    __syncthreads();
    LAS unsigned char* OUT = Xt;
#pragma unroll
    for (int nt = 0; nt < 4; ++nt)
#pragma unroll
        for (int rq = 0; rq < 4; ++rq) { const int ch8 = 8 * nt + 2 * rq + half; v2u v; v.x = pk2(acc[nt][4 * rq], acc[nt][4 * rq + 1]); v.y = pk2(acc[nt][4 * rq + 2], acc[nt][4 * rq + 3]);
            *(LAS v2u*)(OUT + hp * 256 + ((ch8 ^ (hp & 31)) << 3)) = v; }
    __syncthreads();
    bf16* ST = (bf16*)(F.ws + WS_STATES) + ((size_t)((b * 32 + c) * 32 + g * 8 + 4 * hh)) * 8192;
#pragma unroll
    for (int it = 0; it < 8; ++it) { const int idx = it * 512 + F.tid, row = idx >> 4, j = idx & 15, k = row & 31;
        v4u v = *(const LAS v4u*)(OUT + row * 256 + ((j ^ (k >> 1)) << 4)); if (k & 1) v = (v4u){v.z, v.w, v.x, v.y};
        *(v4u*)(ST + (size_t)row * 128 + j * 8) = v; }
}

__device__ __forceinline__ void ssd_scan(Frame& F, const bool dry) {
    bf16* ST = (bf16*)(F.ws + WS_STATES); const size_t dofs = dry ? (size_t)(864 * MiB - WS_STATES) / 2 : 0; const float* CD = (const float*)(F.ws + WS_CD);
    for (int gid = F.vcu * 512 + F.tid; gid < 131072; gid += F.G * 512) {
        const int bh = gid >> 10, b = bh >> 5, h = bh & 31, el = (gid & 1023) * 8;
        float st[8];
#pragma unroll
        for (int q = 0; q < 8; ++q) st[q] = 0.f;
#pragma unroll 4
        for (int c = 0; c < 32; ++c) { bf16* p = ST + ((size_t)((b * 32 + c) * 32 + h)) * 8192 + el; const v4u v = *(const v4u*)p; const float cd = CD[(b * 32 + c) * 32 + h];
            v4u o; o.x = pk2(st[0], st[1]); o.y = pk2(st[2], st[3]); o.z = pk2(st[4], st[5]); o.w = pk2(st[6], st[7]); *(v4u*)(p + dofs) = o;
            st[0] = st[0] * cd + bflo(v.x); st[1] = st[1] * cd + bfhi(v.x); st[2] = st[2] * cd + bflo(v.y); st[3] = st[3] * cd + bfhi(v.y);
            st[4] = st[4] * cd + bflo(v.z); st[5] = st[5] * cd + bfhi(v.z); st[6] = st[6] * cd + bflo(v.w); st[7] = st[7] * cd + bfhi(v.w); }
    }
}

__device__ __forceinline__ int off256(int row, int ch) { return 256 * row + 16 * (ch ^ (((row & 3) << 2) | ((row >> 2) & 3))); }
__device__ __forceinline__ int off512(int row, int ch) { return 512 * row + 16 * (ch ^ ((row & 3) << 2)); }
typedef short v4i16_t __attribute__((ext_vector_type(4)));
__device__ __forceinline__ v4i16_t tr_read(const LAS unsigned char* p) { return __builtin_amdgcn_ds_read_tr16_b64_v4i16((LAS v4i16_t*)p); }
__device__ __forceinline__ void ssd_out_unit(Frame& F, int unit, const int var, bf16* Y) {
    const int g = unit & 3, c = (unit >> 2) & 31, b = unit >> 7; const int t0 = b * SEQ + c * 128;
    LAS float* acum = (LAS float*)F.lds; LAS float* dtv = acum + 1024; LAS float* ssq = acum + 2048;
    LAS unsigned char* Bn = F.lds + 12288; LAS unsigned char* Cn = Bn + 32768; LAS unsigned char* Xn = Cn + 32768;
    const float* DT = (const float*)(F.ws + WS_DT); const bf16* XC = (const bf16*)(F.ws + WS_XC); const bf16* Z = (const bf16*)(F.ws + WS_Z);
    __syncthreads();
#pragma unroll
    for (int i = 0; i < 4; ++i) { const int k = F.wave * 4 + i, row = 4 * k + (F.lane >> 4), pc = F.lane & 15, lc = pc ^ (((row & 3) << 2) | ((row >> 2) & 3));
        const bf16* src = XC + (size_t)(t0 + row) * DCONV + 2048 + g * 128 + lc * 8;
        __builtin_amdgcn_global_load_lds((const unsigned*)src, (LAS unsigned*)(Bn + k * 1024), 16, 0, 0);
        __builtin_amdgcn_global_load_lds((const unsigned*)(src + 512), (LAS unsigned*)(Cn + k * 1024), 16, 0, 0); }
    { const int h = g * 8 + F.wave; const float A = -__expf(F.in[I_ALOG][h]); const int l = 2 * F.lane;
        const float d0 = DT[(size_t)(t0 + l) * 32 + h], d1 = DT[(size_t)(t0 + l + 1) * 32 + h]; const float a0 = d0 * A, a1 = d1 * A, s = a0 + a1;
        float incl = s;
#pragma unroll
        for (int o = 1; o < 64; o <<= 1) { const float v = __shfl_up(incl, o); if (F.lane >= o) incl += v; }
        acum[F.wave * 128 + l] = incl - s + a0; acum[F.wave * 128 + l + 1] = incl; dtv[F.wave * 128 + l] = d0; dtv[F.wave * 128 + l + 1] = d1; }
    const int li = F.lane & 31, half = F.lane >> 5, ew = F.wave >> 1, lsel = F.wave & 1;
    const int trq = (F.lane & 15) >> 2, trp = F.lane & 3, trblk = (F.lane >> 4) & 1;
#pragma unroll 1
    for (int ps = 0; ps < 2; ++ps) {
        if (ps) __syncthreads();
#pragma unroll
        for (int i = 0; i < 8; ++i) { const int k = F.wave * 8 + i, row = 2 * k + (F.lane >> 5), pc = F.lane & 31, lc = pc ^ ((row & 3) << 2);
            __builtin_amdgcn_global_load_lds((const unsigned*)(XC + (size_t)(t0 + row) * DCONV + g * 512 + ps * 256 + lc * 8), (LAS unsigned*)(Xn + k * 1024), 16, 0, 0); }
        const int e = 4 * ps + ew, h = 8 * g + e; const float Dk = F.in[I_DSKIP][h];
        const bf16* prev = (const bf16*)(F.ws + WS_STATES) + ((size_t)((b * 32 + c) * 32 + h)) * 8192;
        VM_WAIT(); __syncthreads();
        const LAS float* ac = acum + e * 128; const LAS float* dv = dtv + e * 128;
        f32x16 accs[2][2];
#pragma unroll
        for (int it = 0; it < 2; ++it) {
            const int i = lsel ? (1 + it) : (it ? 3 : 0); const int l = 32 * i + li; const float acl = ac[l];
            f32x16 acc[2];
#pragma unroll
            for (int pt = 0; pt < 2; ++pt)
#pragma unroll
                for (int r = 0; r < 16; ++r) acc[pt][r] = 0.f;
            if (var & 1) {
            bf16x8 pf[2][8];
#pragma unroll
            for (int pt = 0; pt < 2; ++pt)
#pragma unroll
                for (int ks = 0; ks < 8; ++ks) pf[pt][ks] = *(const bf16x8*)(prev + (size_t)(32 * pt + li) * 128 + 16 * ks + 8 * half);
#pragma unroll
            for (int ks = 0; ks < 8; ++ks) { const bf16x8 cf = *(const LAS bf16x8*)(Cn + off256(l, 2 * ks + half));
#pragma unroll
                for (int pt = 0; pt < 2; ++pt) acc[pt] = __builtin_amdgcn_mfma_f32_32x32x16_bf16(pf[pt][ks], cf, acc[pt], 0, 0, 0); }
            }
            { const float el = __expf(acl);
#pragma unroll
                for (int pt = 0; pt < 2; ++pt)
#pragma unroll
                    for (int r = 0; r < 16; ++r) acc[pt][r] *= el; }
#pragma unroll 1
            for (int j = 0; j <= ((var & 2) ? i : -1); ++j) {
                f32x16 gt;
#pragma unroll
                for (int r = 0; r < 16; ++r) gt[r] = 0.f;
#pragma unroll 4
                for (int ks = 0; ks < 8; ++ks) { const bf16x8 bfm = *(const LAS bf16x8*)(Bn + off256(32 * j + li, 2 * ks + half)); const bf16x8 cf = *(const LAS bf16x8*)(Cn + off256(l, 2 * ks + half)); gt = __builtin_amdgcn_mfma_f32_32x32x16_bf16(bfm, cf, gt, 0, 0, 0); }
                unsigned wp[8];
#pragma unroll
                for (int rq = 0; rq < 4; ++rq) { const int sb = 32 * j + 8 * rq + 4 * half; const f32x4 as4 = *(const LAS f32x4*)(ac + sb), dt4 = *(const LAS f32x4*)(dv + sb); float wv[4];
#pragma unroll
                    for (int x = 0; x < 4; ++x) { const int s = sb + x; float w = gt[4 * rq + x] * __expf(fminf(acl - as4[x], 0.f)) * dt4[x];
                        if (j == i) { if (s > l) w = 0.f; if (s == l) w += Dk; } wv[x] = w; }
                    wp[2 * rq] = pk2(wv[0], wv[1]); wp[2 * rq + 1] = pk2(wv[2], wv[3]); }
                const bf16x8 wf0 = __builtin_bit_cast(bf16x8, (v4u){wp[0], wp[1], wp[2], wp[3]}), wf1 = __builtin_bit_cast(bf16x8, (v4u){wp[4], wp[5], wp[6], wp[7]});
#pragma unroll
                for (int pt = 0; pt < 2; ++pt) { const int chunk = ew * 8 + 4 * pt + 2 * trblk + (trp >> 1);
#pragma unroll
                    for (int ksub = 0; ksub < 2; ++ksub) { const int r0 = 32 * j + 16 * ksub + 4 * half + trq;
                        const v4i16_t lo = tr_read(Xn + off512(r0, chunk) + 8 * (trp & 1)), hi = tr_read(Xn + off512(r0 + 8, chunk) + 8 * (trp & 1));
                        const bf16x8 xf = (bf16x8){lo[0], lo[1], lo[2], lo[3], hi[0], hi[1], hi[2], hi[3]};
                        acc[pt] = __builtin_amdgcn_mfma_f32_32x32x16_bf16(xf, ksub ? wf1 : wf0, acc[pt], 0, 0, 0); } }
            }
            accs[it][0] = acc[0]; accs[it][1] = acc[1];
            asm volatile("" ::: "memory"); __builtin_amdgcn_sched_barrier(0);
        }
        __syncthreads();
        LAS unsigned char* Tt = Xn;
        if (var & 4) {
#pragma unroll
        for (int it = 0; it < 2; ++it) { const int i = lsel ? (1 + it) : (it ? 3 : 0); const int l = 32 * i + li;
#pragma unroll
            for (int pt = 0; pt < 2; ++pt)
#pragma unroll
                for (int rq = 0; rq < 4; ++rq) { const int c8 = ew * 16 + 8 * pt + 2 * rq + half;
                    *(LAS v2u*)(Tt + l * 512 + ((c8 ^ (l & 31)) << 3)) = (v2u){pk2(accs[it][pt][4 * rq], accs[it][pt][4 * rq + 1]), pk2(accs[it][pt][4 * rq + 2], accs[it][pt][4 * rq + 3])}; } }
        }
        __syncthreads();
        if (var & 4)
        { v4u zq[8];
#pragma unroll
          for (int k = 0; k < 8; ++k) { const int idx = k * 512 + F.tid, l = idx >> 5, j = idx & 31; zq[k] = *(const v4u*)(Z + (size_t)(t0 + l) * DSSD + g * 512 + ps * 256 + j * 8); }
#pragma unroll
          for (int k = 0; k < 8; ++k) { const int idx = k * 512 + F.tid, l = idx >> 5, j = idx & 31, kk = l & 31;
            v4u tq = *(const LAS v4u*)(Tt + l * 512 + ((j ^ (kk >> 1)) << 4)); if (kk & 1) tq = (v4u){tq.z, tq.w, tq.x, tq.y};
            const v4u z4 = zq[k];
            const float y0 = bflo(tq.x) * silu(bflo(z4.x)), y1 = bfhi(tq.x) * silu(bfhi(z4.x)), y2 = bflo(tq.y) * silu(bflo(z4.y)), y3 = bfhi(tq.y) * silu(bfhi(z4.y));
            const float y4 = bflo(tq.z) * silu(bflo(z4.z)), y5 = bfhi(tq.z) * silu(bfhi(z4.z)), y6 = bflo(tq.w) * silu(bflo(z4.w)), y7 = bfhi(tq.w) * silu(bfhi(z4.w));
            float sq = ((y0 * y0 + y1 * y1) + (y2 * y2 + y3 * y3)) + ((y4 * y4 + y5 * y5) + (y6 * y6 + y7 * y7));
#pragma unroll
            for (int o = 1; o < 32; o <<= 1) sq += __shfl_xor(sq, o);
            if (j == 0) ssq[ps * 128 + l] = sq;
            *(v4u*)(Y + (size_t)(t0 + l) * DSSD + g * 512 + ps * 256 + j * 8) = (v4u){pk2(y0, y1), pk2(y2, y3), pk2(y4, y5), pk2(y6, y7)}; } }
    }
    VM_WAIT(); __syncthreads();
    if (var & 8)
#pragma unroll
    for (int hb = 0; hb < 2; ++hb) { v4u yq[8];
#pragma unroll
        for (int k = 0; k < 8; ++k) { const int idx = (hb * 8 + k) * 512 + F.tid, l = idx >> 6, j = idx & 63; yq[k] = *(const v4u*)(Y + (size_t)(t0 + l) * DSSD + g * 512 + j * 8); }
#pragma unroll
        for (int k = 0; k < 8; ++k) { const int idx = (hb * 8 + k) * 512 + F.tid, l = idx >> 6, j = idx & 63; const float rstd = rsqrtf((ssq[l] + ssq[128 + l]) * (1.f / 512.f) + EPS);
            const f32x4 w0 = *(const f32x4*)(F.in[I_SNW] + g * 512 + j * 8), w1 = *(const f32x4*)(F.in[I_SNW] + g * 512 + j * 8 + 4); const v4u v = yq[k];
            *(v4u*)(Y + (size_t)(t0 + l) * DSSD + g * 512 + j * 8) = (v4u){pk2(bflo(v.x) * rstd * w0.x, bfhi(v.x) * rstd * w0.y), pk2(bflo(v.y) * rstd * w0.z, bfhi(v.y) * rstd * w0.w),
                                                                         pk2(bflo(v.z) * rstd * w1.x, bfhi(v.z) * rstd * w1.y), pk2(bflo(v.w) * rstd * w1.z, bfhi(v.w) * rstd * w1.w)}; } }
}
}
namespace mk {
using pg8::Unit;
constexpr int MI_TSTART = 16, MI_CNT = 64, MI_RT2E = 128;

struct Sched {
    int mode, nM, nN, nwg, G, c, lda, ldb, a_pn_off, npn;
    const bf16* A; const bf16* Bt; const int* list; const volatile LAS unsigned* misc;
    __device__ __forceinline__ void init_dense(int M, int N, int G_, int c_, const bf16* A_, int lda_, const bf16* Bt_, int ldb_, int a_pn_off_) {
        mode = 0; nM = M / 256; nN = N / 256; nwg = nM * nN; G = G_; c = c_; A = A_; Bt = Bt_; lda = lda_; ldb = ldb_; a_pn_off = a_pn_off_; npn = 0; list = nullptr; misc = nullptr; }
    __device__ __forceinline__ void init_moe(int mode_, int G_, int c_, const bf16* A_, const bf16* Bt_, const int* list_, const volatile LAS unsigned* misc_) {
        mode = mode_; G = G_; c = c_; A = A_; Bt = Bt_; lda = 512; ldb = 512; a_pn_off = 0; npn = (mode_ == 1) ? 8 : 4; list = list_; misc = misc_; nM = 0; nN = 0; nwg = __builtin_amdgcn_readfirstlane((int)misc_[MI_TSTART + 32]) * npn; }
    __device__ __forceinline__ bool next(int i, Unit& u) const {
        const long L = (long)i * G + c; if (L >= nwg) return false;
        if (mode == 0) {
            int wgid = (int)L; { const int q = nwg / 8, r = nwg % 8, xcd = wgid % 8, off = wgid / 8; wgid = (xcd < r ? xcd * (q + 1) : r * (q + 1) + (xcd - r) * q) + off; }
            const int nig = 8 * nN, gid = wgid / nig, fm = gid * 8, gsz = (nM - fm) < 8 ? (nM - fm) : 8;
            u.pm = fm + ((wgid % nig) % gsz); u.pn = (wgid % nig) / gsz; u.e = 0; u.i = 0; return true;
        }
        const int rt = (int)L / npn, pn = (int)L % npn; const int e = __builtin_amdgcn_readfirstlane((int)misc[MI_RT2E + rt]);
        u.pm = rt; u.pn = pn; u.e = e; u.i = rt - __builtin_amdgcn_readfirstlane((int)misc[MI_TSTART + e]); return true;
    }
    __device__ __forceinline__ const bf16* a_root() const { return A; }
    __device__ __forceinline__ const bf16* b_root() const { return Bt; }
    __device__ __forceinline__ const char* a_base(const Unit& u) const {
        if (mode == 0) return (const char*)(A + (size_t)u.pm * 256 * lda + (size_t)u.pn * a_pn_off);
        if (mode == 1) return (const char*)A;
        return (const char*)(A + (size_t)u.pm * 256 * 512); }
    __device__ __forceinline__ const char* b_base(const Unit& u) const {
        if (mode == 0) return (const char*)(Bt + (size_t)u.pn * 256 * ldb);
        if (mode == 1) return (const char*)(Bt + (size_t)u.e * 2048 * 512 + (size_t)u.pn * 256 * 512);
        return (const char*)(Bt + (size_t)u.e * 1024 * 512 + (size_t)u.pn * 256 * 512); }
    __device__ __forceinline__ unsigned row_off(const Unit& u, int r) const {
        if (mode == 2) return (unsigned)r * 1024u;
        if (mode == 0) return (unsigned)r * (unsigned)lda * 2u;
        const int idx = u.i * 256 + r; const int cnt = (int)misc[MI_CNT + u.e];
        const int tok = idx < cnt ? (list[(size_t)u.e * T + idx] >> 2) : 0; return (unsigned)tok * 1024u; }
};

struct EpiNone { static constexpr bool PERM = true; __device__ __forceinline__ void operator()(const pg8::f32x4 (&acc)[2][2][4][2], const Unit&, int, int, int, int) const { asm volatile("" :: "v"(acc[0][0][0][0]), "v"(acc[1][1][3][1])); } };
struct EpiAll {
    static constexpr bool PERM = true;
    int kind, pad; unsigned char* ws; const float* const* in; float* out; const volatile LAS unsigned* misc;
    __device__ __forceinline__ void operator()(const pg8::f32x4 (&acc)[2][2][4][2], const Unit& u, int wr, int wc, int fr, int fq) const {
        const int rl0 = wr * 64 + fr, row0 = u.pm * 256 + rl0, cl0 = wc * 32 + 8 * fq;
        if (kind == 0) {
            bf16* base; int ld, colt; bool sg = false;
            if (u.pn < 8) { base = (bf16*)(ws + WS_Z); ld = 2048; colt = u.pn * 256; }
            else if (u.pn < 20) { base = (bf16*)(ws + WS_XBC); ld = 3072; colt = (u.pn - 8) * 256; }
            else if (u.pn < 24) { base = (bf16*)(ws + WS_U); ld = 1024; colt = (u.pn - 20) * 256; }
            else { base = (bf16*)(ws + WS_GATES); ld = 2048; colt = (u.pn - 24) * 256; sg = true; }
#pragma unroll
            for (int ai = 0; ai < 2; ++ai)
#pragma unroll
                for (int m = 0; m < 4; ++m) { bf16* rowp = base + (size_t)(row0 + ai * 128 + m * 16) * ld + colt + cl0;
#pragma unroll
                    for (int bj = 0; bj < 2; ++bj) { pg8::f32x4 v0 = acc[ai][bj][m][0], v1 = acc[ai][bj][m][1];
                        if (sg) { v0 = (pg8::f32x4){sigm(v0[0]), sigm(v0[1]), sigm(v0[2]), sigm(v0[3])}; v1 = (pg8::f32x4){sigm(v1[0]), sigm(v1[1]), sigm(v1[2]), sigm(v1[3])}; }
                        v4u w; w.x = pk2(v0[0], v0[1]); w.y = pk2(v0[2], v0[3]); w.z = pk2(v1[0], v1[1]); w.w = pk2(v1[2], v1[3]);
                        *(v4u*)(rowp + bj * 128) = w; } }
        } else if (kind == 1) {
            bf16* base = (bf16*)(ws + WS_P2); const float* ps = in[I_PSCALE];
#pragma unroll
            for (int bj = 0; bj < 2; ++bj) { const int col = u.pn * 256 + bj * 128 + cl0; const f32x4 s0 = *(const f32x4*)(ps + col), s1 = *(const f32x4*)(ps + col + 4);
#pragma unroll
                for (int ai = 0; ai < 2; ++ai)
#pragma unroll
                    for (int m = 0; m < 4; ++m) { const pg8::f32x4 v0 = acc[ai][bj][m][0] * s0, v1 = acc[ai][bj][m][1] * s1;
                        v4u w; w.x = pk2(v0[0], v0[1]); w.y = pk2(v0[2], v0[3]); w.z = pk2(v1[0], v1[1]); w.w = pk2(v1[2], v1[3]);
                        *(v4u*)(base + (size_t)(row0 + ai * 128 + m * 16) * 1024 + col) = w; } }
        } else if (kind == 2 || kind == 3) {
            const bf16* gates = (const bf16*)(ws + WS_GATES) + (kind == 3 ? 1024 : 0); bf16* m1 = (bf16*)(ws + WS_M1); bf16* mg = (bf16*)(ws + WS_MERGED);
#pragma unroll
            for (int ai = 0; ai < 2; ++ai) { v4u gq[4][2], mq[4][2];
#pragma unroll
                for (int m = 0; m < 4; ++m)
#pragma unroll
                    for (int bj = 0; bj < 2; ++bj) { const size_t row = row0 + ai * 128 + m * 16; const int col = u.pn * 256 + bj * 128 + cl0; gq[m][bj] = *(const v4u*)(gates + row * 2048 + col);
                        if (kind == 3) mq[m][bj] = *(const v4u*)(m1 + row * 1024 + col); else mq[m][bj] = (v4u){0u, 0u, 0u, 0u}; }
#pragma unroll
                for (int m = 0; m < 4; ++m)
#pragma unroll
                    for (int bj = 0; bj < 2; ++bj) { const size_t row = row0 + ai * 128 + m * 16; const int col = u.pn * 256 + bj * 128 + cl0; const v4u g4 = gq[m][bj], m4 = mq[m][bj];
                        float r[8] = {acc[ai][bj][m][0][0] * bflo(g4.x), acc[ai][bj][m][0][1] * bfhi(g4.x), acc[ai][bj][m][0][2] * bflo(g4.y), acc[ai][bj][m][0][3] * bfhi(g4.y),
                                      acc[ai][bj][m][1][0] * bflo(g4.z), acc[ai][bj][m][1][1] * bfhi(g4.z), acc[ai][bj][m][1][2] * bflo(g4.w), acc[ai][bj][m][1][3] * bfhi(g4.w)};
                        if (kind == 3) { r[0] += bflo(m4.x); r[1] += bfhi(m4.x); r[2] += bflo(m4.y); r[3] += bfhi(m4.y); r[4] += bflo(m4.z); r[5] += bfhi(m4.z); r[6] += bflo(m4.w); r[7] += bfhi(m4.w); }
                        v4u w; w.x = pk2(r[0], r[1]); w.y = pk2(r[2], r[3]); w.z = pk2(r[4], r[5]); w.w = pk2(r[6], r[7]);
                        *(v4u*)((kind == 3 ? mg : m1) + row * 1024 + col) = w; } }
        } else if (kind == 4) {
            const int b = (u.pm * 256) / SEQ; const float* ga = (const float*)(ws + WS_MOD) + b * 6144 + 2048; const float* x = in[I_X];
            f32x4 g0[2], g1[2];
#pragma unroll
            for (int bj = 0; bj < 2; ++bj) { const int col = u.pn * 256 + bj * 128 + cl0; g0[bj] = *(const f32x4*)(ga + col); g1[bj] = *(const f32x4*)(ga + col + 4); }
#pragma unroll
            for (int ai = 0; ai < 2; ++ai)
#pragma unroll
              for (int m = 0; m < 4; ++m) { f32x4 xa[2], xb[2];
#pragma unroll
                for (int bj = 0; bj < 2; ++bj) { const size_t off = (size_t)(row0 + ai * 128 + m * 16) * 1024 + u.pn * 256 + bj * 128 + cl0; xa[bj] = *(const f32x4*)(x + off); xb[bj] = *(const f32x4*)(x + off + 4); }
#pragma unroll
                for (int bj = 0; bj < 2; ++bj) { const size_t off = (size_t)(row0 + ai * 128 + m * 16) * 1024 + u.pn * 256 + bj * 128 + cl0;
                    *(f32x4*)(out + off) = xa[bj] + g0[bj] * acc[ai][bj][m][0]; *(f32x4*)(out + off + 4) = xb[bj] + g1[bj] * acc[ai][bj][m][1]; } }
        } else if (kind == 5) {
            typedef float f2 __attribute__((ext_vector_type(2)));
            unsigned char* act = (unsigned char*)(ws + WS_ACT); const float* bgu = in[I_BGU] + (size_t)u.e * 2048; const int col = u.pn * 128 + cl0;
            const f32x4 bg0 = *(const f32x4*)(bgu + col), bg1 = *(const f32x4*)(bgu + col + 4), bl0 = *(const f32x4*)(bgu + 1024 + col) + 1.f, bl1 = *(const f32x4*)(bgu + 1024 + col + 4) + 1.f;
            const f2 bgp[4] = {(f2){bg0.x, bg0.y}, (f2){bg0.z, bg0.w}, (f2){bg1.x, bg1.y}, (f2){bg1.z, bg1.w}}, blp[4] = {(f2){bl0.x, bl0.y}, (f2){bl0.z, bl0.w}, (f2){bl1.x, bl1.y}, (f2){bl1.z, bl1.w}};
#pragma unroll
            for (int ai = 0; ai < 2; ++ai)
#pragma unroll
                for (int m = 0; m < 4; ++m) { int w[2] = {0, 0};
#pragma unroll
                    for (int hp = 0; hp < 4; ++hp) { const int n = hp >> 1, x = (hp & 1) * 2;
                        f2 gl = (f2){acc[ai][0][m][n][x], acc[ai][0][m][n][x + 1]} + bgp[hp], ln = (f2){acc[ai][1][m][n][x], acc[ai][1][m][n][x + 1]} + blp[hp];
                        gl.x = fminf(gl.x, 7.f); gl.y = fminf(gl.y, 7.f); ln.x = __builtin_amdgcn_fmed3f(ln.x, -6.f, 8.f); ln.y = __builtin_amdgcn_fmed3f(ln.y, -6.f, 8.f);
                        f2 t = gl * -2.4554669595930155f;
                        t.x = __builtin_amdgcn_exp2f(t.x); t.y = __builtin_amdgcn_exp2f(t.y); t = t + 1.f; t.x = __builtin_amdgcn_rcpf(t.x); t.y = __builtin_amdgcn_rcpf(t.y);
                        const f2 r = (gl * t) * ln;
                        if (hp & 1) w[n] = __builtin_amdgcn_cvt_pk_fp8_f32(r.x, r.y, w[n], true); else w[n] = __builtin_amdgcn_cvt_pk_fp8_f32(r.x, r.y, w[n], false); }
                    *(v2u*)(act + (size_t)(row0 + ai * 128 + m * 16) * 1024 + col) = (v2u){(unsigned)w[0], (unsigned)w[1]}; }
        } else {
            bf16* yb = (bf16*)(ws + WS_YB); const float* bdn = in[I_BDN] + (size_t)u.e * 1024; const int* list = (const int*)(ws + WS_LIST) + (size_t)u.e * T; const float* gate = (const float*)(ws + WS_GATE);
            const int cnt = (int)misc[MI_CNT + u.e];
#pragma unroll
            for (int ai = 0; ai < 2; ++ai) { int slot[4]; float gt[4];
#pragma unroll
                for (int m = 0; m < 4; ++m) { const int idx = u.i * 256 + rl0 + ai * 128 + m * 16; slot[m] = idx < cnt ? list[idx] : -1; }
#pragma unroll
                for (int m = 0; m < 4; ++m) gt[m] = slot[m] >= 0 ? gate[slot[m]] : 0.f;
#pragma unroll
                for (int bj = 0; bj < 2; ++bj) { const int col = u.pn * 256 + bj * 128 + cl0; const f32x4 b0 = *(const f32x4*)(bdn + col), b1 = *(const f32x4*)(bdn + col + 4);
#pragma unroll
                    for (int m = 0; m < 4; ++m) {
                        if (slot[m] >= 0) {
                            const pg8::f32x4 v0 = (acc[ai][bj][m][0] + b0) * gt[m], v1 = (acc[ai][bj][m][1] + b1) * gt[m];
                            v4u w; w.x = pk2(v0[0], v0[1]); w.y = pk2(v0[2], v0[3]); w.z = pk2(v1[0], v1[1]); w.w = pk2(v1[2], v1[3]);
                            *(v4u*)(yb + (size_t)slot[m] * 1024 + col) = w; } } } }
        }
    }
};

__device__ __forceinline__ void p6_router(Frame& F, const bool dry, const int var) {
    LAS float* wrT = (LAS float*)F.lds;
    LAS int* lcnt = (LAS int*)(F.lds + 131072); LAS int* lbase = lcnt + 32; LAS int* rec = lcnt + 64;
    const float* wr = F.in[I_WR];
    __syncthreads();
    if (var & 1) { f32x4 wv[16];
#pragma unroll
      for (int i = 0; i < 16; ++i) wv[i] = *(const f32x4*)(wr + (size_t)(i * 512 + F.tid) * 4);
#pragma unroll
      for (int i = 0; i < 16; ++i) { const int idx = (i * 512 + F.tid) * 4, k = idx >> 5, e = idx & 31; wrT[e * 1024 + k] = wv[i].x; wrT[(e + 1) * 1024 + k] = wv[i].y; wrT[(e + 2) * 1024 + k] = wv[i].z; wrT[(e + 3) * 1024 + k] = wv[i].w; } }
    for (int rb = F.vcu; rb < T / 64; rb += F.G) {
    __syncthreads();
    if (F.tid < 32) lcnt[F.tid] = 0;
    __syncthreads();
    const int rowblk = rb * 64, b = rowblk / SEQ; const float* mod = (const float*)(F.ws + WS_MOD) + b * 6144; unsigned char* H8 = (unsigned char*)(F.ws + WS_H);
    const float* x1 = F.out;
    f32x4 xn[2][4];
#pragma unroll
    for (int rr = 0; rr < 2; ++rr)
#pragma unroll
        for (int j = 0; j < 4; ++j) xn[rr][j] = *(const f32x4*)(x1 + (size_t)(rowblk + F.wave * 8 + rr) * D + 4 * F.lane + 256 * j);
#pragma unroll 1
    for (int pr = 0; pr < ((var & 2) ? 4 : 0); ++pr) {
        float hv[2][16]; const int rl0 = F.wave * 8 + pr * 2;
        f32x4 xc[2][4];
#pragma unroll
        for (int rr = 0; rr < 2; ++rr)
#pragma unroll
            for (int j = 0; j < 4; ++j) xc[rr][j] = xn[rr][j];
        if (pr < 3) {
#pragma unroll
            for (int rr = 0; rr < 2; ++rr)
#pragma unroll
                for (int j = 0; j < 4; ++j) xn[rr][j] = *(const f32x4*)(x1 + (size_t)(rowblk + rl0 + 2 + rr) * D + 4 * F.lane + 256 * j); }
#pragma unroll
        for (int rr = 0; rr < 2; ++rr) { const size_t t = rowblk + rl0 + rr; f32x4 v[4]; float s = 0.f;
#pragma unroll
            for (int j = 0; j < 4; ++j) { v[j] = xc[rr][j]; s += (v[j].x * v[j].x + v[j].y * v[j].y) + (v[j].z * v[j].z + v[j].w * v[j].w); }
            const float rstd = rsqrtf(wave_sum(s) * (1.f / D) + EPS);
#pragma unroll
            for (int j = 0; j < 4; ++j) { const int col = 4 * F.lane + 256 * j; const f32x4 w = *(const f32x4*)(F.in[I_NFW] + col), sc = *(const f32x4*)(mod + 4096 + col), sh = *(const f32x4*)(mod + 3072 + col);
                const f32x4 h = v[j] * rstd * w * (sc + 1.f) + sh; hv[rr][4 * j] = h.x; hv[rr][4 * j + 1] = h.y; hv[rr][4 * j + 2] = h.z; hv[rr][4 * j + 3] = h.w;
                int w8 = 0; w8 = __builtin_amdgcn_cvt_pk_fp8_f32(h.x, h.y, w8, false); w8 = __builtin_amdgcn_cvt_pk_fp8_f32(h.z, h.w, w8, true); *(unsigned*)(H8 + t * D + col) = (unsigned)w8; } }
        float a[64];
        { typedef float f32x2v __attribute__((ext_vector_type(2)));
          f32x2v h2v[16];
#pragma unroll
          for (int k = 0; k < 16; ++k) h2v[k] = (f32x2v){hv[0][k], hv[1][k]};
#pragma unroll
          for (int eg = 0; eg < 8; ++eg) { f32x4 w[4][4];
#pragma unroll
            for (int ee = 0; ee < 4; ++ee)
#pragma unroll
              for (int j = 0; j < 4; ++j) w[ee][j] = *(const LAS f32x4*)(wrT + (4 * eg + ee) * 1024 + 4 * F.lane + 256 * j);
            __builtin_amdgcn_sched_barrier(0);
#pragma unroll
            for (int ee = 0; ee < 4; ++ee) { f32x2v s = (f32x2v){0.f, 0.f};
#pragma unroll
              for (int j = 0; j < 4; ++j) {
                s = __builtin_elementwise_fma(h2v[4 * j], (f32x2v){w[ee][j].x, w[ee][j].x}, s); s = __builtin_elementwise_fma(h2v[4 * j + 1], (f32x2v){w[ee][j].y, w[ee][j].y}, s);
                s = __builtin_elementwise_fma(h2v[4 * j + 2], (f32x2v){w[ee][j].z, w[ee][j].z}, s); s = __builtin_elementwise_fma(h2v[4 * j + 3], (f32x2v){w[ee][j].w, w[ee][j].w}, s); }
              a[2 * (4 * eg + ee)] = s.x; a[2 * (4 * eg + ee) + 1] = s.y; }
            __builtin_amdgcn_sched_barrier(0); } }
#define RED_STEP(N, M) { _Pragma("unroll") for (int i = 0; i < (N) / 2; ++i) { const bool up = (F.lane & (M)) != 0; const float keep = up ? a[i + (N) / 2] : a[i], send = up ? a[i] : a[i + (N) / 2]; a[i] = keep + __shfl_xor(send, (M)); } }
        RED_STEP(64, 32) RED_STEP(32, 16) RED_STEP(16, 8) RED_STEP(8, 4) RED_STEP(4, 2) RED_STEP(2, 1)
#undef RED_STEP
        const int e = F.lane >> 1, rr = F.lane & 1; float v = a[0] + F.in[I_BR][e];
        float tv[4]; int ti[4];
#pragma unroll
        for (int r = 0; r < 4; ++r) { float m = v; int mi = e;
#pragma unroll
            for (int o = 2; o < 64; o <<= 1) { const float om = __shfl_xor(m, o); const int oi = __shfl_xor(mi, o); if (om > m || (om == m && oi < mi)) { m = om; mi = oi; } }
            tv[r] = m; ti[r] = mi; if (e == mi) v = -INFINITY; }
        if (F.lane < 2) { const float e0 = 1.f, e1 = __expf(tv[1] - tv[0]), e2 = __expf(tv[2] - tv[0]), e3 = __expf(tv[3] - tv[0]); const float inv = 1.f / (e0 + e1 + e2 + e3);
            const float gt[4] = {e0 * inv, e1 * inv, e2 * inv, e3 * inv}; const int rl = rl0 + rr;
#pragma unroll
            for (int r = 0; r < 4; ++r) { const int pos = __hip_atomic_fetch_add(lcnt + ti[r], 1, __ATOMIC_RELAXED, __HIP_MEMORY_SCOPE_WORKGROUP);
                rec[(rl * 4 + r) * 3] = ti[r]; rec[(rl * 4 + r) * 3 + 1] = pos; rec[(rl * 4 + r) * 3 + 2] = __float_as_int(gt[r]); } }
    }
    __syncthreads();
    if (var & 4) {
    if (F.tid < 32) lbase[F.tid] = (int)__hip_atomic_fetch_add((unsigned*)(F.ctl + CW_GCNT) + (dry ? 32 : 0) + 64 * F.tid, (unsigned)lcnt[F.tid], __ATOMIC_RELAXED, __HIP_MEMORY_SCOPE_AGENT);
    __syncthreads();
    if (F.tid < 256) { const int rl = F.tid >> 2, r = F.tid & 3; const int e = rec[F.tid * 3], pos = rec[F.tid * 3 + 1]; const int slot = (rowblk + rl) * 4 + r;
        ((int*)(F.ws + (dry ? 900 * MiB : WS_LIST)))[(size_t)e * T + lbase[e] + pos] = slot; ((float*)(F.ws + (dry ? 910 * MiB : WS_GATE)))[slot] = __int_as_float(rec[F.tid * 3 + 2]); }
    }
    }
}

__device__ __forceinline__ void moe_setup(Frame& F) {
    __syncthreads();
    if (F.tid == 0) { int acc = 0; F.MISC[MI_TSTART] = 0;
        for (int e = 0; e < 32; ++e) { const unsigned cnt = __hip_atomic_load((unsigned*)(F.ctl + CW_GCNT) + 64 * e, RLX_AGENT); F.MISC[MI_CNT + e] = cnt; acc += (int)((cnt + 255u) >> 8); F.MISC[MI_TSTART + e + 1] = (unsigned)acc; } }
    __syncthreads();
    if (F.tid < 320) { int e = 0; while (e < 31 && (int)F.MISC[MI_TSTART + e + 1] <= F.tid) ++e; F.MISC[MI_RT2E + F.tid] = (unsigned)e; }
    __syncthreads();
}

__device__ __forceinline__ void p9_final(Frame& F, const float dscale, float* dst) {
    const bf16* YB = (const bf16*)(F.ws + WS_YB);
#pragma unroll 1
    for (size_t t = F.vcu * NWAVES + F.wave; t < (size_t)T; t += F.G * NWAVES) { const int b = (int)(t / SEQ); const float* ga = (const float*)(F.ws + WS_MOD) + b * 6144 + 5120;
        f32x4 v[4]; float s = 0.f;
#pragma unroll
        for (int j = 0; j < 4; ++j) { const int col = 4 * F.lane + 256 * j; f32x4 m = (f32x4){0.f, 0.f, 0.f, 0.f};
#pragma unroll
            for (int k = 0; k < 4; ++k) { const v2u q = *(const v2u*)(YB + (t * 4 + k) * D + col); m += (f32x4){bflo(q.x), bfhi(q.x), bflo(q.y), bfhi(q.y)}; }
            v[j] = *(const f32x4*)(F.out + t * D + col) + *(const f32x4*)(ga + col) * m; s += (v[j].x * v[j].x + v[j].y * v[j].y) + (v[j].z * v[j].z + v[j].w * v[j].w); }
        const float rstd = rsqrtf(wave_sum(s) * (1.f / D) + EPS);
#pragma unroll
        for (int j = 0; j < 4; ++j) { const int col = 4 * F.lane + 256 * j; *(f32x4*)(dst + t * D + col) = v[j] * (rstd * dscale) * *(const f32x4*)(F.in[I_NFINAL] + col); } }
}
}
namespace mk {
#ifndef MK_N_LAUNCHES
#define MK_N_LAUNCHES 1
#endif
constexpr int NPHASES = 12;
struct Args { const float* in[25]; float* out; unsigned char* ws; int ph_lo, ph_hi, li, pad; };

__global__ void __launch_bounds__(NWAVES * 64, 2) mk_fwd(Args args) {
    extern __shared__ __attribute__((aligned(16))) unsigned char lds[];
    Frame F;
    F.lds = (LAS unsigned char*)lds; F.MISC = (volatile LAS unsigned*)(F.lds + MISC_OFF);
    F.tid = threadIdx.x; F.lane = F.tid & 63; F.wave = __builtin_amdgcn_readfirstlane(F.tid >> 6);
    F.G = gridDim.x; { const int bx = blockIdx.x; F.vcu = (F.G % 8 == 0) ? (bx % 8) * (F.G / 8) + bx / 8 : bx; }
    F.ws = args.ws; F.out = args.out; F.in = args.in; F.ctl = (gu32*)(args.ws + WS_CTL);
    for (int u = F.tid; u < (LDS_BYTES - LDSCTL_OFF) / 4; u += NWAVES * 64) ((LAS unsigned*)(F.lds + LDSCTL_OFF))[u] = 0u;
    __syncthreads();
    XcdBarrier bar = xcd_barrier_post((unsigned*)(F.ctl + CW_BAR) + args.li * XCD_BAR_WORDS, F.MISC + 0);
    const int lo = args.ph_lo, hi = args.ph_hi;
#ifndef MK_PH_MASK
#define MK_PH_MASK 0xFFF
#endif
#define IN(k) (((MK_PH_MASK >> (k)) & 1) && lo <= (k) && (k) < hi)
#define SEAM(k) do { if (IN(k) && IN((k) + 1)) xcd_barrier(bar, F.wave); } while (0)
    LAS unsigned char* ring = F.lds;
    const int cid = (int)blockIdx.x;

    if (IN(0)) { refresh_ids(F); p0_prologue(F); } SEAM(0);
    if (IN(1)) { refresh_ids(F); p1_norm_dt(F); } SEAM(1);
    if (IN(2)) { refresh_ids(F);
        Sched S; S.init_dense(T, 8192, F.G, cid, (const bf16*)(F.ws + WS_H), 1024, (const bf16*)(F.ws + WS_WIN), 1024, 0);
        EpiAll E{0, 0, F.ws, F.in, F.out, F.MISC}; __syncthreads();
        pg8::gemm_phase<EpiAll, Sched, true, true, 0, false>(ring, F.wave, 1024, 1024, 1024, S, E);
    } SEAM(2);
    if (IN(3)) { refresh_ids(F);
#ifndef MK_NOPOOL
        pool_pass(F);
#endif
        asm volatile("" ::: "memory"); __builtin_amdgcn_sched_barrier(0); for (int u = F.vcu; u < 1024; u += F.G) ssd_states_unit(F, u); } SEAM(3);
    if (IN(4)) { refresh_ids(F);
#ifdef MK_DUPSCAN
        ssd_scan(F, args.li == 1);
#else
        if (args.li != 1) ssd_scan(F, false);
#endif

        Sched S; S.init_dense(T, 1024, F.G, cid, (const bf16*)(F.ws + WS_P), 1024, (const bf16*)(F.ws + WS_WPOOL), 256, 256);
        EpiAll E{1, 0, F.ws, F.in, F.out, F.MISC};
        __syncthreads();
        pg8::gemm_phase<EpiAll, Sched, true, true, 0, false>(ring, F.wave, 256, 1024, 256, S, E);
    } SEAM(4);
    if (IN(5)) { refresh_ids(F);
#ifdef MK_VAR
        const int var = (args.li == 1) ? (MK_VAR) : 15; bf16* ydst = (args.li == 1) ? (bf16*)(F.ws + 864 * MiB) : (bf16*)(F.ws + WS_Y);
#else
        const int var = 15; bf16* ydst = (bf16*)(F.ws + WS_Y);
#endif
        for (int u = F.vcu; u < 512; u += F.G) ssd_out_unit(F, u, var, ydst); } SEAM(5);
    if (IN(6)) { refresh_ids(F);
        { Sched S; S.init_dense(T, 1024, F.G, cid, (const bf16*)(F.ws + WS_Y), 2048, (const bf16*)(F.ws + WS_WSSD), 2048, 0);
          EpiAll E{2, 0, F.ws, F.in, F.out, F.MISC}; __syncthreads();
          pg8::gemm_phase<EpiAll, Sched, true, true, 0, false>(ring, F.wave, 2048, 2048, 2048, S, E); }
        VM_WAIT(); __syncthreads();
        { Sched S; S.init_dense(T, 1024, F.G, cid, (const bf16*)(F.ws + WS_P2), 1024, (const bf16*)(F.ws + WS_WPO), 1024, 0);
          EpiAll E{3, 0, F.ws, F.in, F.out, F.MISC}; __syncthreads();
          pg8::gemm_phase<EpiAll, Sched, true, true, 0, false>(ring, F.wave, 1024, 1024, 1024, S, E); }
    } SEAM(6);
    if (IN(7)) { refresh_ids(F); Sched S; S.init_dense(T, 1024, F.G, cid, (const bf16*)(F.ws + WS_MERGED), 1024, (const bf16*)(F.ws + WS_WOUT), 1024, 0);
        EpiAll E{4, 0, F.ws, F.in, F.out, F.MISC}; __syncthreads();
        pg8::gemm_phase<EpiAll, Sched, true, true, 0, false>(ring, F.wave, 1024, 1024, 1024, S, E);
    } SEAM(7);
    #ifndef MK_RVAR
#define MK_RVAR 7
#endif
    if (IN(8)) { refresh_ids(F); p6_router(F, args.li == 1, args.li == 1 ? (MK_RVAR) : 7); } SEAM(8);
    if (IN(9)) { refresh_ids(F); moe_setup(F);
        Sched S; S.init_moe(1, F.G, cid, (const bf16*)(F.ws + WS_H), (const bf16*)(F.ws + WS_WGU), (const int*)(F.ws + WS_LIST), F.MISC);
        EpiAll E{5, 0, F.ws, F.in, F.out, F.MISC}; __syncthreads();
#ifdef MK_KLOOP_ONLY
        if (args.li == 1) { EpiNone EN; pg8::gemm_phase<EpiNone, Sched, true, true, 1, true>(ring, F.wave, 512, 512, 512, S, EN); } else
#endif
        pg8::gemm_phase<EpiAll, Sched, true, true, 1, true>(ring, F.wave, 512, 512, 512, S, E);
    } SEAM(9);
    if (IN(10)) { refresh_ids(F); moe_setup(F);
        Sched S; S.init_moe(2, F.G, cid, (const bf16*)(F.ws + WS_ACT), (const bf16*)(F.ws + WS_WDN), (const int*)(F.ws + WS_LIST), F.MISC);
        EpiAll E{6, 0, F.ws, F.in, F.out, F.MISC}; __syncthreads();
        pg8::gemm_phase<EpiAll, Sched, true, true, 1, true>(ring, F.wave, 512, 512, 512, S, E);
    } SEAM(10);
    if (IN(11)) { refresh_ids(F); p9_final(F, 1.f, args.li == 1 ? (float*)(F.ws + 864 * MiB) : F.out); }
#undef IN
#undef SEAM
}

static void run_mk(void* const* d_in, float* out, unsigned char* ws, hipStream_t stream) {
    static int grid = 0;
    if (grid == 0) {
        int dev = 0, cus = 0;
        if (hipGetDevice(&dev) != hipSuccess || hipDeviceGetAttribute(&cus, hipDeviceAttributeMultiprocessorCount, dev) != hipSuccess) { fprintf(stderr, "kernel_launch: device query failed\n"); grid = -1; return; }
        if (hipFuncSetAttribute((const void*)mk_fwd, hipFuncAttributeMaxDynamicSharedMemorySize, LDS_BYTES) != hipSuccess) { fprintf(stderr, "kernel_launch: hipFuncSetAttribute failed\n"); grid = -1; return; }
        (void)hipGetLastError();
        grid = cus;
    }
    if (grid < 0) return;
    (void)hipMemsetAsync(ws + WS_CTL, 0, CTL_ZERO_BYTES, stream);
    Args a{};
    for (int i = 0; i < 25; ++i) a.in[i] = (const float*)d_in[i];
    a.out = out; a.ws = ws;
#ifdef MK_DUP
    const int nl = 3, los[3] = {0, MK_DUP, MK_DUP + 1}, his[3] = {MK_DUP + 1, MK_DUP + 1, NPHASES};
#else
    const int nl = 1, los[1] = {0}, his[1] = {NPHASES};
#endif
    for (int li = 0; li < nl; ++li) {
        if (los[li] >= his[li]) continue;
        a.ph_lo = los[li]; a.ph_hi = his[li]; a.li = li;
        hipLaunchKernelGGL(mk_fwd, dim3(grid), dim3(NWAVES * 64), LDS_BYTES, stream, a);
    }
}
}
extern "C" void kernel_launch(void* const* d_in, const int* in_sizes, int n_in, void* d_out, int out_size, void* d_ws, size_t ws_size, hipStream_t stream) {
    mk::run_mk(d_in, (float*)d_out, (unsigned char*)d_ws, stream);
}
```

```cpp
#include <hip/hip_runtime.h>
#include <cstdio>
#include <cstdint>
#include <cmath>
namespace pg8 {
#define PG8_LAS __attribute__((address_space(3)))
typedef unsigned short bf16_t;
typedef short bf16x8 __attribute__((ext_vector_type(8)));
typedef float f32x4 __attribute__((ext_vector_type(4)));
typedef unsigned u32x4 __attribute__((ext_vector_type(4)));
typedef unsigned u32x2 __attribute__((ext_vector_type(2)));
constexpr int BM = 256, BK = 64, HALF = 128, HTB = HALF * BK * 2  , STAGE_BYTES = 8 * HTB, NXCD = 8, WGM = 8;

__host__ __device__ __forceinline__ int lds_byte(int r, int c) { const int st = (r >> 4) * 2 + (c >> 5), rr = r & 15, cc = c & 31, ob = rr * 64 + cc * 2; return st * 1024 + (ob ^ (((ob >> 9) & 1) << 5)); }
__host__ __device__ __forceinline__ void stage_rc(int b, int& R, int& C) { const int st = b / 1024, sb = b % 1024, swz = sb ^ (((sb >> 9) & 1) << 5); R = (st >> 1) * 16 + swz / 64; C = (st & 1) * 32 + (swz % 64) / 2; }
__host__ __device__ __forceinline__ int perm32(int rho) { const int n = rho >> 4, i = rho & 15; return 8 * (i >> 2) + 4 * n + (i & 3); }

struct Unit { int pm, pn, e, i; };

__device__ __forceinline__ unsigned cvt_pk_bf16(float lo, float hi) { unsigned r; asm volatile("v_cvt_pk_bf16_f32 %0, %1, %2" : "=v"(r) : "v"(lo), "v"(hi)); return r; }

struct StaticOrder {
    int nM, nN, nwg, G, c; const bf16_t* A; const bf16_t* Bt; int lda, ldb, a_pn_off, pad;
    __device__ void init(int M, int N, int G_, int c_, const bf16_t* A_, int lda_, const bf16_t* Bt_, int ldb_, int a_pn_off_) { nM = M / BM; nN = N / BM; nwg = nM * nN; G = G_; c = c_; A = A_; Bt = Bt_; lda = lda_; ldb = ldb_; a_pn_off = a_pn_off_; pad = 0; }
    __device__ bool next(int i, Unit& u) const {
        const long L = (long)i * G + c; if (L >= nwg) return false;
        int wgid = (int)L; { const int q = nwg / NXCD, r = nwg % NXCD, xcd = wgid % NXCD, off = wgid / NXCD; wgid = (xcd < r ? xcd * (q + 1) : r * (q + 1) + (xcd - r) * q) + off; }
        const int nig = WGM * nN, gid = wgid / nig, fm = gid * WGM, gsz = (nM - fm) < WGM ? (nM - fm) : WGM;
        u.pm = fm + ((wgid % nig) % gsz); u.pn = (wgid % nig) / gsz; u.e = 0; u.i = 0; return true;
    }
    __device__ __forceinline__ const char* a_base(const Unit& u) const { return (const char*)(A + (size_t)u.pm * BM * lda + (size_t)u.pn * a_pn_off); }
    __device__ __forceinline__ const char* b_base(const Unit& u) const { return (const char*)(Bt + (size_t)u.pn * BM * ldb); }
    __device__ __forceinline__ unsigned row_off(const Unit&, int) const { return 0u; }
};

typedef int v8i32 __attribute__((ext_vector_type(8))); typedef int i32x4 __attribute__((ext_vector_type(4)));
template <class Epi, class Sched, bool ALIGN_EPI, bool SP2, int GATHER  , bool FP8>
__device__ __forceinline__ void gemm_phase(PG8_LAS unsigned char* lds, const int wave_id, const int K, const int lda, const int ldb, const Sched& S, const Epi& E) {
    int lane_; asm volatile("v_mbcnt_lo_u32_b32 %0, -1, 0\n\tv_mbcnt_hi_u32_b32 %0, -1, %0" : "=v"(lane_));
    const int wid = wave_id, lane = lane_, tid = wid * 64 + lane, wr = wid >> 2, wc = wid & 3, fr = lane & 15, fq = lane >> 4;
    const int nt = K / BK;
    unsigned voffA[2][2], voffN[2][2], voffB[2];
#pragma unroll
    for (int i = 0; i < 2; ++i) { int R, C; stage_rc(tid * 16 + i * 8192, R, C); const int Rb = Epi::PERM ? ((R & ~31) + perm32(R & 31)) : R;
        voffA[0][i] = GATHER ? (unsigned)C * 2u : (unsigned)(R * lda + C) * 2u; voffA[1][i] = voffA[0][i]; voffN[0][i] = 0; voffN[1][i] = 0; voffB[i] = (unsigned)(Rb * ldb + C) * 2u; }
    const unsigned kstep = (unsigned)(BK * 2);
    const unsigned hstepA = GATHER ? 0u : (unsigned)(HALF * lda * 2);
    const unsigned hstepB = (unsigned)(HALF * ldb * 2);
    const __amdgpu_buffer_rsrc_t rsrcA = __builtin_amdgcn_make_buffer_rsrc((void*)S.a_root(), 0, 0xFFFFFFFF, 0x00020000), rsrcB = __builtin_amdgcn_make_buffer_rsrc((void*)S.b_root(), 0, 0xFFFFFFFF, 0x00020000);
    const unsigned ldsw = (unsigned)wid * 1024u;
    const int aoff = lds_byte(wr * 64 + fr, fq * 8), boff = lds_byte(wc * 32 + fr, fq * 8);
#define PG8_SA(b, h) (((b) * 2 + (h)) * HTB)
#define PG8_SB(b, h) ((4 + (b) * 2 + (h)) * HTB)
#define PG8_STAGE_B(bufoff, soff) do { _Pragma("unroll") for (int _i = 0; _i < 2; ++_i) \
        __builtin_amdgcn_raw_ptr_buffer_load_lds(rsrcB, (PG8_LAS unsigned*)(lds + (bufoff) + ldsw + _i * 8192), 16, voffB[_i], (soff), 0, 0); } while (0)
#define PG8_STAGE_A(bufoff, soff, h) do { _Pragma("unroll") for (int _i = 0; _i < 2; ++_i) \
        __builtin_amdgcn_raw_ptr_buffer_load_lds(rsrcA, (PG8_LAS unsigned*)(lds + (bufoff) + ldsw + _i * 8192), 16, voffA[GATHER ? (h) : 0][_i], (soff) + (h) * hstepA, 0, 0); } while (0)
#define PG8_LDA(dst, b, h) do { _Pragma("unroll") for (int m = 0; m < 4; ++m) _Pragma("unroll") for (int k = 0; k < 2; ++k) dst[m][k] = *(const PG8_LAS bf16x8*)(lds + PG8_SA(b, h) + aoff + m * 2048 + k * 1024); } while (0)
#define PG8_LDB(dst, b, h) do { _Pragma("unroll") for (int n = 0; n < 2; ++n) _Pragma("unroll") for (int k = 0; k < 2; ++k) dst[n][k] = *(const PG8_LAS bf16x8*)(lds + PG8_SB(b, h) + boff + n * 2048 + k * 1024); } while (0)
#define PG8_CAT(x) (__builtin_shufflevector(__builtin_bit_cast(i32x4, x[0]), __builtin_bit_cast(i32x4, x[1]), 0, 1, 2, 3, 4, 5, 6, 7))
#define PG8_MMA(ai, bj, At, Bt) do { __builtin_amdgcn_s_setprio(1); _Pragma("unroll") for (int m = 0; m < 4; ++m) _Pragma("unroll") for (int n = 0; n < 2; ++n) { \
        if constexpr (FP8) acc[ai][bj][m][n] = __builtin_amdgcn_mfma_scale_f32_16x16x128_f8f6f4(PG8_CAT(Bt[n]), PG8_CAT(At[m]), acc[ai][bj][m][n], 0, 0, 0, 0x7a7a7a7a  , 0, 0x7f7f7f7f); \
        else { _Pragma("unroll") for (int k = 0; k < 2; ++k) acc[ai][bj][m][n] = __builtin_amdgcn_mfma_f32_16x16x32_bf16(Bt[n][k], At[m][k], acc[ai][bj][m][n], 0, 0, 0); } } __builtin_amdgcn_s_setprio(0); } while (0)
#define PG8_WAIT_V(n) asm volatile("s_waitcnt vmcnt(" #n ")" ::: "memory")
#define PG8_WAIT_L(n) asm volatile("s_waitcnt lgkmcnt(" #n ")" ::: "memory")
#define PG8_BAR __builtin_amdgcn_s_barrier()
#define PG8_SCHED __builtin_amdgcn_sched_barrier(0)
#define PG8_GATHER_OFFS(dst, u) do { _Pragma("unroll") for (int _i = 0; _i < 2; ++_i) { int R_, C_; stage_rc(tid * 16 + _i * 8192, R_, C_); _Pragma("unroll") for (int _h = 0; _h < 2; ++_h) dst[_h][_i] = S.row_off(u, _h * HALF + R_) + (unsigned)C_ * 2u; } } while (0)
    Unit cur, nxt; int ui = 0;
    if (!S.next(0, cur)) return;
    f32x4 acc[2][2][4][2];
#pragma unroll
    for (int a = 0; a < 2; ++a)
#pragma unroll
        for (int b = 0; b < 2; ++b)
#pragma unroll
            for (int m = 0; m < 4; ++m)
#pragma unroll
                for (int n = 0; n < 2; ++n) acc[a][b][m][n] = (f32x4){0.f, 0.f, 0.f, 0.f};
    bf16x8 At[4][2], B0[2][2], B1[2][2];
    unsigned cA = (unsigned)(S.a_base(cur) - (const char*)S.a_root()), cB = (unsigned)(S.b_base(cur) - (const char*)S.b_root());
    if constexpr (GATHER) { PG8_GATHER_OFFS(voffA, cur); }
    if constexpr (SP2) {
        PG8_STAGE_B(PG8_SB(0, 0), cB); PG8_STAGE_B(PG8_SB(0, 1), cB + hstepB); PG8_STAGE_A(PG8_SA(0, 0), cA, 0); PG8_STAGE_A(PG8_SA(0, 1), cA, 1);
        if (wr == 1) PG8_BAR;
        PG8_WAIT_V(2); PG8_BAR;
        PG8_STAGE_B(PG8_SB(1, 0), cB + kstep); PG8_STAGE_A(PG8_SA(1, 0), cA + kstep, 0); PG8_STAGE_B(PG8_SB(1, 1), cB + hstepB + kstep);
        PG8_WAIT_V(6); PG8_BAR;
    } else {
        PG8_STAGE_B(PG8_SB(0, 0), cB); PG8_STAGE_A(PG8_SA(0, 0), cA, 0); PG8_STAGE_B(PG8_SB(0, 1), cB + hstepB); PG8_STAGE_A(PG8_SA(0, 1), cA, 1);
        if (wr == 1) PG8_BAR;
        PG8_WAIT_V(4); PG8_BAR;
        PG8_STAGE_B(PG8_SB(1, 0), cB + kstep); PG8_STAGE_A(PG8_SA(1, 0), cA + kstep, 0); PG8_STAGE_B(PG8_SB(1, 1), cB + hstepB + kstep);
        PG8_WAIT_V(6); PG8_BAR;
    }
    for (;;) {
        const bool has_next = S.next(ui + 1, nxt);
        const unsigned nA = has_next ? (unsigned)(S.a_base(nxt) - (const char*)S.a_root()) : cA, nB = has_next ? (unsigned)(S.b_base(nxt) - (const char*)S.b_root()) : cB;
#pragma unroll 1
        for (int t = 0; t < nt; t += 2) {
            const bool last = (t == nt - 2);
            const unsigned a1 = cA + (unsigned)(t + 1) * kstep;
            const unsigned a2 = last ? nA : cA + (unsigned)(t + 2) * kstep, b2 = last ? nB : cB + (unsigned)(t + 2) * kstep;
            const unsigned a3 = a2 + kstep, b3 = b2 + kstep;
            if constexpr (GATHER == 1) { if (last && has_next) { PG8_GATHER_OFFS(voffN, nxt); } }
            if constexpr (SP2) {
            PG8_LDB(B0, 0, 0); PG8_LDB(B1, 0, 1); PG8_SCHED; PG8_LDA(At, 0, 0); PG8_STAGE_A(PG8_SA(1, 1), a1, 1);
            PG8_WAIT_V(8); PG8_WAIT_L(0); PG8_BAR; PG8_MMA(0, 0, At, B0); PG8_MMA(0, 1, At, B1); PG8_BAR; PG8_SCHED;
            if constexpr (GATHER == 1) { if (last && has_next) {
#pragma unroll
                for (int _h = 0; _h < 2; ++_h)
#pragma unroll
                    for (int _i = 0; _i < 2; ++_i) voffA[_h][_i] = voffN[_h][_i]; } }
            if constexpr (GATHER == 2) { if (last && has_next) { PG8_GATHER_OFFS(voffA, nxt); } }
            PG8_LDA(At, 0, 1); PG8_STAGE_B(PG8_SB(0, 0), b2); PG8_STAGE_B(PG8_SB(0, 1), b2 + hstepB); PG8_STAGE_A(PG8_SA(0, 0), a2, 0);
            PG8_WAIT_V(8); PG8_WAIT_L(0); PG8_BAR; PG8_MMA(1, 0, At, B0); PG8_MMA(1, 1, At, B1); PG8_BAR; PG8_SCHED;
            PG8_LDB(B0, 1, 0); PG8_LDB(B1, 1, 1); PG8_SCHED; PG8_LDA(At, 1, 0); PG8_STAGE_A(PG8_SA(0, 1), a2, 1);
            PG8_WAIT_V(8); PG8_WAIT_L(0); PG8_BAR; PG8_MMA(0, 0, At, B0); PG8_MMA(0, 1, At, B1); PG8_BAR; PG8_SCHED;
            PG8_LDA(At, 1, 1); PG8_STAGE_B(PG8_SB(1, 0), b3); PG8_STAGE_B(PG8_SB(1, 1), b3 + hstepB); PG8_STAGE_A(PG8_SA(1, 0), a3, 0);
            PG8_WAIT_V(8); PG8_WAIT_L(0); PG8_BAR; PG8_MMA(1, 0, At, B0); PG8_MMA(1, 1, At, B1); PG8_BAR; PG8_SCHED;
            } else {
            PG8_LDB(B0, 0, 0); PG8_SCHED; PG8_LDA(At, 0, 0); PG8_STAGE_A(PG8_SA(1, 1), a1, 1);
            PG8_WAIT_L(8); PG8_BAR; PG8_WAIT_L(0); PG8_MMA(0, 0, At, B0); PG8_BAR; PG8_SCHED;
            if constexpr (GATHER == 1) { if (last && has_next) {
#pragma unroll
                for (int _h = 0; _h < 2; ++_h)
#pragma unroll
                    for (int _i = 0; _i < 2; ++_i) voffA[_h][_i] = voffN[_h][_i]; } }
            if constexpr (GATHER == 2) { if (last && has_next) { PG8_GATHER_OFFS(voffA, nxt); } }
            PG8_LDB(B1, 0, 1); PG8_STAGE_B(PG8_SB(0, 0), b2);
            PG8_BAR; PG8_WAIT_L(0); PG8_MMA(0, 1, At, B1); PG8_BAR;
            PG8_LDA(At, 0, 1); PG8_STAGE_A(PG8_SA(0, 0), a2, 0);
            PG8_BAR; PG8_WAIT_L(0); PG8_MMA(1, 0, At, B0); PG8_BAR; PG8_SCHED;
            PG8_STAGE_B(PG8_SB(0, 1), b2 + hstepB);
            PG8_WAIT_V(6); PG8_BAR; PG8_MMA(1, 1, At, B1); PG8_BAR;
            PG8_LDB(B0, 1, 0); PG8_SCHED; PG8_LDA(At, 1, 0); PG8_STAGE_A(PG8_SA(0, 1), a2, 1);
            PG8_WAIT_L(8); PG8_BAR; PG8_WAIT_L(0); PG8_MMA(0, 0, At, B0); PG8_BAR; PG8_SCHED;
            PG8_LDB(B1, 1, 1); PG8_STAGE_B(PG8_SB(1, 0), b3);
            PG8_BAR; PG8_WAIT_L(0); PG8_MMA(0, 1, At, B1); PG8_BAR;
            PG8_LDA(At, 1, 1); PG8_STAGE_A(PG8_SA(1, 0), a3, 0);
            PG8_BAR; PG8_WAIT_L(0); PG8_MMA(1, 0, At, B0); PG8_BAR; PG8_SCHED;
            PG8_STAGE_B(PG8_SB(1, 1), b3 + hstepB);
            PG8_WAIT_V(6); PG8_BAR; PG8_MMA(1, 1, At, B1); PG8_BAR;
            }
        }
        if constexpr (ALIGN_EPI) { if (wr == 0) PG8_BAR; }
        E(acc, cur, wr, wc, fr, fq);
        if (!has_next) break;
#pragma unroll
        for (int a = 0; a < 2; ++a)
#pragma unroll
            for (int b = 0; b < 2; ++b)
#pragma unroll
                for (int m = 0; m < 4; ++m)
#pragma unroll
                    for (int n = 0; n < 2; ++n) acc[a][b][m][n] = (f32x4){0.f, 0.f, 0.f, 0.f};
        cur = nxt; cA = nA; cB = nB; ++ui;
        if constexpr (ALIGN_EPI) { if (wr == 1) PG8_BAR; }
    }
    PG8_WAIT_V(0);
    if constexpr (!ALIGN_EPI) { if (wr == 0) PG8_BAR; }
    PG8_BAR;
#undef PG8_SA
#undef PG8_SB
#undef PG8_STAGE_A
#undef PG8_STAGE_B
#undef PG8_LDA
#undef PG8_LDB
#undef PG8_MMA
#undef PG8_CAT
#undef PG8_WAIT_V
#undef PG8_WAIT_L
#undef PG8_BAR
#undef PG8_SCHED
#undef PG8_GATHER_OFFS
}
}
namespace mk {
constexpr int NWAVES = 8;
constexpr int T = 16384, D = 1024, SEQ = 4096, NB = 4, NE = 32, NH = 32;
constexpr int DSSD = 2048, DCONV = 3072, NPROJ = 8224;
constexpr float EPS = 1e-5f;
constexpr size_t MiB = 1u << 20;
constexpr size_t WS_CTL = 0, CTL_ZERO_BYTES = 256 * 1024;
constexpr size_t WS_MOD = 128 * 1024;
constexpr size_t WS_CD = 1 * MiB;
constexpr size_t WS_GATE = 1 * MiB + 256 * 1024;
constexpr size_t WS_DT = 2 * MiB;
constexpr size_t WS_LIST = 4 * MiB;
constexpr size_t WS_WDT = 6 * MiB;
constexpr size_t WS_WPOOL = 6 * MiB + 512 * 1024;
constexpr size_t WS_WIN = 8 * MiB, WS_WSSD = 24 * MiB, WS_WPO = 28 * MiB, WS_WOUT = 30 * MiB, WS_WGU = 32 * MiB, WS_WDN = 160 * MiB;
constexpr size_t WS_H = 224 * MiB, WS_Z = 256 * MiB, WS_XBC = 320 * MiB, WS_U = 416 * MiB, WS_GATES = 448 * MiB, WS_STATES = 512 * MiB, WS_Y = 576 * MiB;
constexpr size_t WS_P = 640 * MiB, WS_P2 = 672 * MiB, WS_M1 = 704 * MiB, WS_MERGED = 736 * MiB, WS_END = 768 * MiB;
constexpr size_t WS_XC = 768 * MiB;
constexpr size_t WS_ACT = 256 * MiB, WS_YB = 416 * MiB;
constexpr int ACT_ROWS = 73728;
constexpr int CW_TMO = 0, CW_CODE = 1, CW_GCNT = 1024, CW_BAR = 4096;
constexpr int RING_BYTES = 143360;
constexpr int LDSCTL_OFF = RING_BYTES, MISC_OFF = LDSCTL_OFF + 64;
constexpr int LDS_BYTES = 147456;

#define GAS __attribute__((address_space(1)))
#define LAS __attribute__((address_space(3)))
typedef unsigned short bf16;
typedef unsigned v4u __attribute__((ext_vector_type(4)));
typedef unsigned v2u __attribute__((ext_vector_type(2)));
typedef float f32x4 __attribute__((ext_vector_type(4)));
typedef float f32x16 __attribute__((ext_vector_type(16)));
typedef short bf16x8 __attribute__((ext_vector_type(8)));
typedef GAS unsigned gu32;
#define RLX_AGENT __ATOMIC_RELAXED, __HIP_MEMORY_SCOPE_AGENT
#define LDS_WAIT() asm volatile("s_waitcnt lgkmcnt(0)" ::: "memory")
#define VM_WAIT() asm volatile("s_waitcnt vmcnt(0)" ::: "memory")
__device__ __forceinline__ unsigned f2bf(float f) { unsigned u = __builtin_bit_cast(unsigned, f); return (u + 0x7fffu + ((u >> 16) & 1u)) >> 16; }
typedef float f32x2_t __attribute__((ext_vector_type(2))); typedef __bf16 bf16x2_t __attribute__((ext_vector_type(2)));
__device__ __forceinline__ unsigned pk2(float lo, float hi) { const f32x2_t v = {lo, hi}; const bf16x2_t b = __builtin_convertvector(v, bf16x2_t); return __builtin_bit_cast(unsigned, b); }
__device__ __forceinline__ float bflo(unsigned w) { return __builtin_bit_cast(float, w << 16); }
__device__ __forceinline__ float bfhi(unsigned w) { return __builtin_bit_cast(float, w & 0xffff0000u); }
__device__ __forceinline__ float bf2f(bf16 h) { return __builtin_bit_cast(float, (unsigned)h << 16); }
__device__ __forceinline__ float sigm(float x) { return __builtin_amdgcn_rcpf(1.f + __builtin_amdgcn_exp2f(x * -1.4426950408889634f)); }
__device__ __forceinline__ float silu(float x) { return x * sigm(x); }
__device__ __forceinline__ float wave_sum(float v) {
#pragma unroll
    for (int o = 1; o < 64; o <<= 1) v += __shfl_xor(v, o);
    return v;
}

#define XB_TMO      128
#define XB_XCNT(j)  (256  + 64 * (j))
#define XB_XSUB(j)  (1280 + 64 * (j))
#define XB_XGEN(j)  (2304 + 64 * (j))
#define XB_TOP      3328
#define XB_TOPGEN   3392
#define XCD_BAR_WORDS 3456
#define XB_SPIN_CAP (1u << 18)
__device__ __forceinline__ unsigned xb_ld(unsigned* p)              { return __hip_atomic_load(p, __ATOMIC_RELAXED, __HIP_MEMORY_SCOPE_AGENT); }
__device__ __forceinline__ unsigned xb_add(unsigned* p, unsigned v) { return __hip_atomic_fetch_add(p, v, __ATOMIC_RELAXED, __HIP_MEMORY_SCOPE_AGENT); }
__device__ __forceinline__ unsigned xb_xcc_id() { return (unsigned)__builtin_amdgcn_s_getreg((3 << 11) | 20) & 0xFu; }
#define XB_SPIN(cond, bar) do { unsigned _sp = 0; while (cond) { __builtin_amdgcn_s_sleep(1); \
    if ((++_sp & 255u) == 0u) { if (xb_ld(&(bar)[XB_TMO])) break; if (_sp > XB_SPIN_CAP) { atomicAdd(&(bar)[XB_TMO], 1u); break; } } } } while (0)
struct XcdBarrier { unsigned* bar; unsigned x; volatile LAS unsigned* st; };
__device__ __forceinline__ XcdBarrier xcd_barrier_post(unsigned* bar, volatile LAS unsigned* st) {
    XcdBarrier b; b.bar = bar; b.x = xb_xcc_id(); b.st = st;
    if (threadIdx.x == 0) (void)xb_add(&bar[XB_XCNT(b.x)], 1u);
    return b;
}
__device__ __forceinline__ void xcd_barrier_complete(unsigned* bar, unsigned x, unsigned& nloc, unsigned& nx) {
    const unsigned G = gridDim.x * gridDim.y * gridDim.z;
    unsigned sum, cnt, mine, sp = 0u;
    for (;;) {
        sum = 0u; cnt = 0u; mine = 0u;
#pragma unroll
        for (unsigned j = 0; j < 16; ++j) { const unsigned c = xb_ld(&bar[XB_XCNT(j)]); sum += c; cnt += (c > 0u) ? 1u : 0u; mine = (j == x) ? c : mine; }
        if (sum == G) break;
        __builtin_amdgcn_s_sleep(1);
        if ((++sp & 255u) == 0u) { if (xb_ld(&bar[XB_TMO])) break; if (sp > XB_SPIN_CAP) { atomicAdd(&bar[XB_TMO], 1u); break; } }
    }
    nloc = mine > 0u ? mine : 1u; nx = cnt > 0u ? cnt : 1u;
}
__device__ __forceinline__ void xcd_barrier(const XcdBarrier& b, const int wave) {
    asm volatile("s_waitcnt vmcnt(0)" ::: "memory");
    __syncthreads();
    int lane_; asm volatile("v_mbcnt_lo_u32_b32 %0, -1, 0\n\tv_mbcnt_hi_u32_b32 %0, -1, %0" : "=v"(lane_));
    if (wave == 0 && lane_ == 0) {
        unsigned* bar = b.bar;
        __builtin_amdgcn_s_waitcnt(0);
        unsigned nloc = b.st[0], nx = b.st[1];
        if (nloc == 0u) { xcd_barrier_complete(bar, b.x, nloc, nx); b.st[0] = nloc; b.st[1] = nx; }
        const unsigned old = xb_add(&bar[XB_XSUB(b.x)], 1u);
        const unsigned gen = old / nloc;
        if (old + 1u == (gen + 1u) * nloc) {
            __builtin_amdgcn_fence(__ATOMIC_RELEASE, "agent");
            asm volatile("s_waitcnt vmcnt(0)" ::: "memory");
            const unsigned og = xb_add(&bar[XB_TOP], 1u);
            const unsigned tg = og / nx;
            if (og + 1u == (tg + 1u) * nx) xb_add(&bar[XB_TOPGEN], 1u);
            else XB_SPIN(xb_ld(&bar[XB_TOPGEN]) == tg, bar);
            __builtin_amdgcn_fence(__ATOMIC_ACQUIRE, "agent");
            xb_add(&bar[XB_XGEN(b.x)], 1u);
            asm volatile("s_waitcnt vmcnt(0)" ::: "memory");
        } else {
            XB_SPIN(xb_ld(&bar[XB_XGEN(b.x)]) == gen, bar);
            __builtin_amdgcn_fence(__ATOMIC_ACQUIRE, "agent");
            asm volatile("s_waitcnt vmcnt(0)" ::: "memory");
        }
    }
    __syncthreads();
}
}
namespace mk {
struct Frame {
    LAS unsigned char* lds; volatile LAS unsigned* MISC; gu32* ctl; unsigned char* ws; float* out; const float* const* in;
    int tid, lane, wave, vcu, G;
};
__device__ __forceinline__ void refresh_ids(Frame& F) { int l; asm volatile("v_mbcnt_lo_u32_b32 %0, -1, 0\n\tv_mbcnt_hi_u32_b32 %0, -1, %0" : "=v"(l)); F.lane = l; F.tid = F.wave * 64 + l; }
enum { I_X = 0, I_C, I_WADA, I_BADA, I_NMW, I_WIN, I_CONVW, I_CONVB, I_DTB, I_ALOG, I_DSKIP, I_SNW, I_WSSD, I_WPOOL, I_PSCALE, I_WPO, I_WOUT, I_NFW, I_WR, I_BR, I_WGU, I_BGU, I_WDN, I_BDN, I_NFINAL };

__device__ __forceinline__ void p0_tile(const float* src, int ldsrc, int srccol0, int k0, bf16* dst, int lddst, int dstrow0, int nvalid, LAS float* scr, int lane) {
    const int col = (lane & 15) * 4;
    f32x4 tv[16];
#pragma unroll
    for (int i = 0; i < 16; ++i) { const int kk = 4 * i + (lane >> 4); tv[i] = (f32x4){0.f, 0.f, 0.f, 0.f}; if (col < nvalid) tv[i] = *(const f32x4*)(src + (size_t)(k0 + kk) * ldsrc + srccol0 + col); }
#pragma unroll
    for (int i = 0; i < 16; ++i) { const int kk = 4 * i + (lane >> 4); LAS float* s = scr + kk * 65 + col; s[0] = tv[i].x; s[1] = tv[i].y; s[2] = tv[i].z; s[3] = tv[i].w; }
    LDS_WAIT(); asm volatile("" ::: "memory");
    const int c = lane & 7;
#pragma unroll
    for (int j = 0; j < 8; ++j) { const int n = (lane >> 3) + 8 * j; const LAS float* s = scr + (8 * c) * 65 + n;
        v4u o; o.x = pk2(s[0 * 65], s[1 * 65]); o.y = pk2(s[2 * 65], s[3 * 65]); o.z = pk2(s[4 * 65], s[5 * 65]); o.w = pk2(s[6 * 65], s[7 * 65]);
        if (n < nvalid) *(v4u*)(dst + (size_t)(dstrow0 + n) * lddst + k0 + 8 * c) = o; }
    LDS_WAIT(); asm volatile("" ::: "memory");
}
__device__ __forceinline__ void p0_tile8(const float* src, int ldsrc, int srccol0, int k0, unsigned char* dst, int lddst, int dstrow0, float scale, LAS float* scr, int lane) {
    const int col = (lane & 15) * 4;
    f32x4 tv[16];
#pragma unroll
    for (int i = 0; i < 16; ++i) { const int kk = 4 * i + (lane >> 4); tv[i] = *(const f32x4*)(src + (size_t)(k0 + kk) * ldsrc + srccol0 + col); }
#pragma unroll
    for (int i = 0; i < 16; ++i) { const int kk = 4 * i + (lane >> 4); LAS float* s = scr + kk * 65 + col; s[0] = tv[i].x; s[1] = tv[i].y; s[2] = tv[i].z; s[3] = tv[i].w; }
    LDS_WAIT(); asm volatile("" ::: "memory");
    const int c = lane & 7;
#pragma unroll
    for (int j = 0; j < 8; ++j) { const int n = (lane >> 3) + 8 * j; const LAS float* s = scr + (8 * c) * 65 + n;
        int w0 = 0, w1 = 0; w0 = __builtin_amdgcn_cvt_pk_fp8_f32(s[0 * 65] * scale, s[1 * 65] * scale, w0, false); w0 = __builtin_amdgcn_cvt_pk_fp8_f32(s[2 * 65] * scale, s[3 * 65] * scale, w0, true);
        w1 = __builtin_amdgcn_cvt_pk_fp8_f32(s[4 * 65] * scale, s[5 * 65] * scale, w1, false); w1 = __builtin_amdgcn_cvt_pk_fp8_f32(s[6 * 65] * scale, s[7 * 65] * scale, w1, true);
        *(v2u*)(dst + (size_t)(dstrow0 + n) * lddst + k0 + 8 * c) = (v2u){(unsigned)w0, (unsigned)w1}; }
    LDS_WAIT(); asm volatile("" ::: "memory");
}
__device__ __forceinline__ void p0_prologue(Frame& F) {
    LAS float* scr = (LAS float*)(F.lds + F.wave * 16896);
    const int gw = F.vcu * NWAVES + F.wave, NGW = F.G * NWAVES;
    bf16* WIN_T = (bf16*)(F.ws + WS_WIN); bf16* WDT_T = (bf16*)(F.ws + WS_WDT); bf16* WSSD_T = (bf16*)(F.ws + WS_WSSD); bf16* WPO_T = (bf16*)(F.ws + WS_WPO);
    bf16* WOUT_T = (bf16*)(F.ws + WS_WOUT); bf16* WPOOL_T = (bf16*)(F.ws + WS_WPOOL); bf16* WGU_T = (bf16*)(F.ws + WS_WGU); bf16* WDN_T = (bf16*)(F.ws + WS_WDN);
    constexpr int N_IN = 2048, N_DT = 16, N_SSD = 512, N_PO = 256, N_OUT = 256, N_POOL = 64, N_GU = 16384, N_DN = 8192;
    constexpr int NITEMS = N_IN + N_DT + N_SSD + N_PO + N_OUT + N_POOL + N_GU + N_DN;
    for (int it = gw; it < NITEMS; it += NGW) {
        int r = it;
        if (r < N_GU) { const int e = r >> 9, q = r & 511, rb = q >> 4, kb = q & 15; const int rho = rb * 64, pn = rho >> 8, rr = rho & 255;
            const int sc = rr < 128 ? 128 * pn + rr : 1024 + 128 * pn + (rr - 128);
            p0_tile8(F.in[I_WGU] + (size_t)e * 1024 * 2048, 2048, sc, kb * 64, (unsigned char*)WGU_T + (size_t)e * 2048 * 1024, 1024, rho, 32.f, scr, F.lane); continue; } r -= N_GU;
        if (r < N_DN) { const int e = r >> 8, q = r & 255, rb = q >> 4, kb = q & 15;
            p0_tile8(F.in[I_WDN] + (size_t)e * 1024 * 1024, 1024, rb * 64, kb * 64, (unsigned char*)WDN_T + (size_t)e * 1024 * 1024, 1024, rb * 64, 32.f, scr, F.lane); continue; } r -= N_DN;
        if (r < N_IN) { const int rb = r >> 4, kb = r & 15; const int drow = rb * 64; const int sc = drow + (drow >= 5120 ? 32 : 0);
            p0_tile(F.in[I_WIN], NPROJ, sc, kb * 64, WIN_T, 1024, drow, 64, scr, F.lane); continue; } r -= N_IN;
        if (r < N_DT) { p0_tile(F.in[I_WIN], NPROJ, 5120, r * 64, WDT_T, 1024, 0, 32, scr, F.lane); continue; } r -= N_DT;
        if (r < N_SSD) { const int rb = r >> 5, kb = r & 31; p0_tile(F.in[I_WSSD], 1024, rb * 64, kb * 64, WSSD_T, 2048, rb * 64, 64, scr, F.lane); continue; } r -= N_SSD;
        if (r < N_PO) { const int rb = r >> 4, kb = r & 15; p0_tile(F.in[I_WPO], 1024, rb * 64, kb * 64, WPO_T, 1024, rb * 64, 64, scr, F.lane); continue; } r -= N_PO;
        if (r < N_OUT) { const int rb = r >> 4, kb = r & 15; p0_tile(F.in[I_WOUT], 1024, rb * 64, kb * 64, WOUT_T, 1024, rb * 64, 64, scr, F.lane); continue; } r -= N_OUT;
        { const int g = r >> 4, q = r & 15, rb = q >> 2, kb = q & 3; p0_tile(F.in[I_WPOOL] + (size_t)g * 65536, 256, rb * 64, kb * 64, WPOOL_T, 256, g * 256 + rb * 64, 64, scr, F.lane); }
    }
    __syncthreads();
    { float* mod = (float*)(F.ws + WS_MOD); LAS float* red = (LAS float*)F.lds;
      for (int jb = F.vcu; jb < 256; jb += F.G) {
        const int jj = F.tid & 31, sl = F.tid >> 5, j = jb * 24 + jj; float a0 = 0.f, a1 = 0.f, a2 = 0.f, a3 = 0.f; const float* cc = F.in[I_C];
        if (jj < 24) {
#pragma unroll 8
            for (int k = sl * 64; k < sl * 64 + 64; ++k) { const float w = F.in[I_WADA][(size_t)k * 6144 + j];
                a0 += silu(cc[k]) * w; a1 += silu(cc[1024 + k]) * w; a2 += silu(cc[2048 + k]) * w; a3 += silu(cc[3072 + k]) * w; } }
        red[(sl * 4 + 0) * 32 + jj] = a0; red[(sl * 4 + 1) * 32 + jj] = a1; red[(sl * 4 + 2) * 32 + jj] = a2; red[(sl * 4 + 3) * 32 + jj] = a3;
        __syncthreads();
        if (F.tid < 128) { const int b = F.tid >> 5, q = F.tid & 31; if (q < 24) { float s = F.in[I_BADA][jb * 24 + q];
#pragma unroll
                for (int i = 0; i < 16; ++i) s += red[(i * 4 + b) * 32 + q];
                mod[b * 6144 + jb * 24 + q] = s; } }
        __syncthreads();
      } }
}

__device__ __forceinline__ void p1_norm_dt(Frame& F) {
    constexpr int PITCH = 2064;
    LAS unsigned char* tile = F.lds + F.wave * (8 * PITCH);
    for (int grp = F.vcu * NWAVES + F.wave; grp < T / 8; grp += F.G * NWAVES) {
    const int t0 = grp * 8, b = t0 / SEQ;
    const float* mod = (const float*)(F.ws + WS_MOD) + b * 6144; bf16* H = (bf16*)(F.ws + WS_H);
    f32x4 wv[4], scv[4], shv[4];
#pragma unroll
    for (int j = 0; j < 4; ++j) { const int col = 4 * F.lane + 256 * j; wv[j] = *(const f32x4*)(F.in[I_NMW] + col); scv[j] = *(const f32x4*)(mod + 1024 + col); shv[j] = *(const f32x4*)(mod + col); }
#pragma unroll 1
    for (int r4 = 0; r4 < 8; r4 += 4) {
      f32x4 xv[4][4];
#pragma unroll
      for (int rr = 0; rr < 4; ++rr)
#pragma unroll
        for (int j = 0; j < 4; ++j) xv[rr][j] = *(const f32x4*)(F.in[I_X] + (size_t)(t0 + r4 + rr) * D + 4 * F.lane + 256 * j);
#pragma unroll
      for (int rr = 0; rr < 4; ++rr) { const int r = r4 + rr;
        f32x4 v[4]; float s = 0.f;
#pragma unroll
        for (int j = 0; j < 4; ++j) { v[j] = xv[rr][j]; s += (v[j].x * v[j].x + v[j].y * v[j].y) + (v[j].z * v[j].z + v[j].w * v[j].w); }
        const float rstd = rsqrtf(wave_sum(s) * (1.f / D) + EPS);
#pragma unroll
        for (int j = 0; j < 4; ++j) { const f32x4 hv = v[j] * rstd * wv[j] * (scv[j] + 1.f) + shv[j];
            v2u o; o.x = pk2(hv.x, hv.y); o.y = pk2(hv.z, hv.w);
            *(v2u*)(H + (size_t)(t0 + r) * D + 4 * F.lane + 256 * j) = o;
            *(LAS v2u*)(tile + r * PITCH + (4 * F.lane + 256 * j) * 2) = o; }
      }
    }
    LDS_WAIT(); asm volatile("" ::: "memory");
    const bf16* WDT_T = (const bf16*)(F.ws + WS_WDT);
    f32x4 acc0 = (f32x4){0.f, 0.f, 0.f, 0.f}, acc1 = acc0; const int fr = F.lane & 15, fq = F.lane >> 4;
#pragma unroll 8
    for (int s = 0; s < 32; ++s) {
        const bf16x8 a = *(const LAS bf16x8*)(tile + (fr & 7) * PITCH + (32 * s + 8 * fq) * 2);
        const bf16x8 b0 = *(const bf16x8*)(WDT_T + (size_t)fr * 1024 + 32 * s + 8 * fq), b1 = *(const bf16x8*)(WDT_T + (size_t)(fr + 16) * 1024 + 32 * s + 8 * fq);
        acc0 = __builtin_amdgcn_mfma_f32_16x16x32_bf16(a, b0, acc0, 0, 0, 0); acc1 = __builtin_amdgcn_mfma_f32_16x16x32_bf16(a, b1, acc1, 0, 0, 0);
    }
    if (fq < 2) { float* DT = (float*)(F.ws + WS_DT); const float db0 = F.in[I_DTB][fr], db1 = F.in[I_DTB][fr + 16];
#pragma unroll
        for (int i = 0; i < 4; ++i) { const int row = t0 + 4 * fq + i; float x0 = acc0[i] + db0, x1 = acc1[i] + db1;
            DT[(size_t)row * 32 + fr] = x0 > 20.f ? x0 : log1pf(__expf(x0)); DT[(size_t)row * 32 + 16 + fr] = x1 > 20.f ? x1 : log1pf(__expf(x1)); } }
    LDS_WAIT();
    }
}

template <int W> __device__ __forceinline__ void pool_item(const bf16* U, bf16* P, int t0, int tt0, int cg) {
    v4u raw[W + 7];
    const __amdgpu_buffer_rsrc_t ru = __builtin_amdgcn_make_buffer_rsrc((void*)U, 0, 0xFFFFFFFF, 0x00020000), rp = __builtin_amdgcn_make_buffer_rsrc((void*)P, 0, 0xFFFFFFFF, 0x00020000);
    const unsigned vo = (unsigned)(t0 * D + cg * 8) * 2u;
#pragma unroll
    for (int r = 0; r < W + 7; ++r) { const int d = r - (W - 1); raw[r] = (v4u){0u, 0u, 0u, 0u}; if (tt0 + d >= 0) raw[r] = __builtin_amdgcn_raw_buffer_load_b128(ru, vo + (unsigned)(d * D * 2), 0, 0); }
    float s[8];
#pragma unroll
    for (int q = 0; q < 8; ++q) s[q] = 0.f;
#pragma unroll
    for (int r = 0; r < W - 1; ++r) { const v4u v = raw[r]; s[0] += bflo(v.x); s[1] += bfhi(v.x); s[2] += bflo(v.y); s[3] += bfhi(v.y); s[4] += bflo(v.z); s[5] += bfhi(v.z); s[6] += bflo(v.w); s[7] += bfhi(v.w); }
#pragma unroll
    for (int i = 0; i < 8; ++i) { const v4u v = raw[W - 1 + i]; const float u[8] = {bflo(v.x), bfhi(v.x), bflo(v.y), bfhi(v.y), bflo(v.z), bfhi(v.z), bflo(v.w), bfhi(v.w)};
#pragma unroll
        for (int q = 0; q < 8; ++q) s[q] += u[q];
        const int tt = tt0 + i; const float inv = 1.f / (float)(tt + 1 < W ? tt + 1 : W);
        v4u o; o.x = pk2(s[0] * inv - u[0], s[1] * inv - u[1]); o.y = pk2(s[2] * inv - u[2], s[3] * inv - u[3]); o.z = pk2(s[4] * inv - u[4], s[5] * inv - u[5]); o.w = pk2(s[6] * inv - u[6], s[7] * inv - u[7]);
        __builtin_amdgcn_raw_buffer_store_b128(o, rp, vo, i * D * 2, 0);
        const v4u z = raw[i]; s[0] -= bflo(z.x); s[1] -= bfhi(z.x); s[2] -= bflo(z.y); s[3] -= bfhi(z.y); s[4] -= bflo(z.z); s[5] -= bfhi(z.z); s[6] -= bflo(z.w); s[7] -= bfhi(z.w); }
}
__device__ __forceinline__ void pool_pass(Frame& F, const bool dry) {
    const bf16* U = (const bf16*)(F.ws + WS_U); bf16* P = (bf16*)(F.ws + (dry ? 864 * MiB : WS_P));
    for (int it = F.vcu * 512 + F.tid; it < 2048 * 128; it += F.G * 512) {
        const int wsel = __builtin_amdgcn_readfirstlane((it >> 6) & 3), cg = wsel * 32 + (it & 31), strip = (it >> 8) * 2 + ((it >> 5) & 1); const int t0 = strip * 8, tt0 = t0 % SEQ;
        if (wsel == 0) pool_item<2>(U, P, t0, tt0, cg); else if (wsel == 1) pool_item<4>(U, P, t0, tt0, cg); else if (wsel == 2) pool_item<8>(U, P, t0, tt0, cg); else pool_item<16>(U, P, t0, tt0, cg);
    }
}

__device__ __forceinline__ int swz16(int row) { return (row ^ (row >> 4)) & 15; }
__device__ __forceinline__ void conv8x8(const bf16* XBC, const float* cw, const float* cb, int trow0, bool seq_start, int col, float (&out)[8][8]) {
    float u[11][8];
#pragma unroll
    for (int r = 0; r < 11; ++r) { v4u v = (v4u){0u, 0u, 0u, 0u}; if (!(r < 3 && seq_start)) v = *(const v4u*)(XBC + (size_t)(trow0 - 3 + r) * DCONV + col);
        u[r][0] = bflo(v.x); u[r][1] = bfhi(v.x); u[r][2] = bflo(v.y); u[r][3] = bfhi(v.y); u[r][4] = bflo(v.z); u[r][5] = bfhi(v.z); u[r][6] = bflo(v.w); u[r][7] = bfhi(v.w); }
    float w[4][8], bb[8];
#pragma unroll
    for (int k = 0; k < 4; ++k) { const f32x4 a = *(const f32x4*)(cw + k * DCONV + col), b = *(const f32x4*)(cw + k * DCONV + col + 4);
        w[k][0] = a.x; w[k][1] = a.y; w[k][2] = a.z; w[k][3] = a.w; w[k][4] = b.x; w[k][5] = b.y; w[k][6] = b.z; w[k][7] = b.w; }
    { const f32x4 a = *(const f32x4*)(cb + col), b = *(const f32x4*)(cb + col + 4); bb[0] = a.x; bb[1] = a.y; bb[2] = a.z; bb[3] = a.w; bb[4] = b.x; bb[5] = b.y; bb[6] = b.z; bb[7] = b.w; }
#pragma unroll
    for (int i = 0; i < 8; ++i)
#pragma unroll
        for (int q = 0; q < 8; ++q) { const float a = bb[q] + w[0][q] * u[i][q] + w[1][q] * u[i + 1][q] + w[2][q] * u[i + 2][q] + w[3][q] * u[i + 3][q]; out[i][q] = silu(a); }
}
__device__ __forceinline__ void conv_load(const bf16* XBC, int trow0, bool seq_start, int col, bool active, v4u (&raw)[11]) {
    const __amdgpu_buffer_rsrc_t rs = __builtin_amdgcn_make_buffer_rsrc((void*)XBC, 0, 0xFFFFFFFF, 0x00020000);
    const unsigned voff = (unsigned)(trow0 * DCONV + col) * 2u;
#pragma unroll
    for (int r = 0; r < 11; ++r) { raw[r] = (v4u){0u, 0u, 0u, 0u}; if (active && !(r < 3 && seq_start)) raw[r] = __builtin_amdgcn_raw_buffer_load_b128(rs, voff + (unsigned)((r - 3) * DCONV * 2), 0, 0); }
}
__device__ __forceinline__ void st_item(int unit, int itx, int tid, int& kind, int& strip, int& grp, int& col, int& trow0, bool& seqs) {
    const int hh = unit & 1, g = (unit >> 1) & 3, c = (unit >> 3) & 31, b = unit >> 8;
    if (itx == 0) { kind = 0; strip = tid >> 5; grp = tid & 31; col = g * 512 + hh * 256 + grp * 8; }
    else if (tid < 256) { kind = 1; strip = tid >> 4; grp = tid & 15; col = 2048 + g * 128 + grp * 8; }
    else if (tid < 384) { kind = 2; strip = 8 * hh + ((tid - 256) >> 4); grp = tid & 15; col = 2560 + g * 128 + grp * 8; }
    else { kind = 3; strip = 0; grp = 0; col = 0; }
    trow0 = b * SEQ + c * 128 + strip * 8; seqs = (c == 0 && strip == 0);
}
__device__ __forceinline__ void conv_item(const bf16* XBC, const float* cw, const float* cb, int trow0, bool seq_start, int col, bf16* gdst, const unsigned gvo, const bool do_g, LAS unsigned char* img, const bool do_img, int row0, int chunk, const LAS float* sc, const bool do_sc, const v4u (&raw)[11]) {
    f32x4 wa[4], wb[4];
    const __amdgpu_buffer_rsrc_t rw = __builtin_amdgcn_make_buffer_rsrc((void*)cw, 0, 0xFFFFFFFF, 0x00020000), rb = __builtin_amdgcn_make_buffer_rsrc((void*)cb, 0, 0xFFFFFFFF, 0x00020000);
    const __amdgpu_buffer_rsrc_t rg = __builtin_amdgcn_make_buffer_rsrc((void*)gdst, 0, 0xFFFFFFFF, 0x00020000);
    const unsigned cvo = (unsigned)col * 4u;
#pragma unroll
    for (int k = 0; k < 4; ++k) { wa[k] = __builtin_bit_cast(f32x4, __builtin_amdgcn_raw_buffer_load_b128(rw, cvo, k * DCONV * 4, 0)); wb[k] = __builtin_bit_cast(f32x4, __builtin_amdgcn_raw_buffer_load_b128(rw, cvo + 16u, k * DCONV * 4, 0)); }
    const f32x4 ba = __builtin_bit_cast(f32x4, __builtin_amdgcn_raw_buffer_load_b128(rb, cvo, 0, 0)), bbv = __builtin_bit_cast(f32x4, __builtin_amdgcn_raw_buffer_load_b128(rb, cvo + 16u, 0, 0));
    unsigned la[8];
#pragma unroll
    for (int q = 0; q < 8; ++q) la[q] = (unsigned)((row0 + q) * 256 + ((chunk ^ swz16(row0 + q)) << 4));
#define CI_U(R, Q) (((Q) & 1) ? bfhi(((Q) >> 1) == 0 ? raw[R].x : ((Q) >> 1) == 1 ? raw[R].y : ((Q) >> 1) == 2 ? raw[R].z : raw[R].w) : bflo(((Q) >> 1) == 0 ? raw[R].x : ((Q) >> 1) == 1 ? raw[R].y : ((Q) >> 1) == 2 ? raw[R].z : raw[R].w))
#define CI_W(K, Q) ((Q) < 4 ? wa[K][(Q) & 3] : wb[K][(Q) & 3])
#pragma unroll
    for (int ip = 0; ip < 4; ++ip) {
        float a0[8], a1[8];
#pragma unroll
        for (int q = 0; q < 8; ++q) { const float bq = q < 4 ? ba[q & 3] : bbv[q & 3];
            a0[q] = silu(bq + CI_W(0, q) * CI_U(2 * ip, q) + CI_W(1, q) * CI_U(2 * ip + 1, q) + CI_W(2, q) * CI_U(2 * ip + 2, q) + CI_W(3, q) * CI_U(2 * ip + 3, q));
            a1[q] = silu(bq + CI_W(0, q) * CI_U(2 * ip + 1, q) + CI_W(1, q) * CI_U(2 * ip + 2, q) + CI_W(2, q) * CI_U(2 * ip + 3, q) + CI_W(3, q) * CI_U(2 * ip + 4, q)); }
        if (do_g) { __builtin_amdgcn_raw_buffer_store_b128((v4u){pk2(a0[0], a0[1]), pk2(a0[2], a0[3]), pk2(a0[4], a0[5]), pk2(a0[6], a0[7])}, rg, gvo, (2 * ip) * DCONV * 2, 0);
                    __builtin_amdgcn_raw_buffer_store_b128((v4u){pk2(a1[0], a1[1]), pk2(a1[2], a1[3]), pk2(a1[4], a1[5]), pk2(a1[6], a1[7])}, rg, gvo, (2 * ip + 1) * DCONV * 2, 0); }
        if (do_img) { float s0 = 1.f, s1 = 1.f; if (do_sc) { s0 = sc[2 * ip]; s1 = sc[2 * ip + 1]; }
#pragma unroll
            for (int q = 0; q < 8; ++q) *(LAS unsigned*)(img + la[q] + 4 * ip) = pk2(a0[q] * s0, a1[q] * s1); }
    }
#undef CI_U
#undef CI_W
}
__device__ __forceinline__ void put_transposed(LAS unsigned char* img, int row0, int chunk, const float (&o)[8][8]) {
#pragma unroll
    for (int q = 0; q < 8; ++q) { const int row = row0 + q; v4u v; v.x = pk2(o[0][q], o[1][q]); v.y = pk2(o[2][q], o[3][q]); v.z = pk2(o[4][q], o[5][q]); v.w = pk2(o[6][q], o[7][q]);
        *(LAS v4u*)(img + row * 256 + ((chunk ^ swz16(row)) << 4)) = v; }
}
__device__ __forceinline__ void put_global(bf16* dst, const float (&o)[8][8]) {
#pragma unroll
    for (int i = 0; i < 8; ++i) { v4u v; v.x = pk2(o[i][0], o[i][1]); v.y = pk2(o[i][2], o[i][3]); v.z = pk2(o[i][4], o[i][5]); v.w = pk2(o[i][6], o[i][7]); *(v4u*)(dst + (size_t)i * DCONV) = v; }
}
__device__ __forceinline__ void put_natural(LAS unsigned char* img, int l0, int chunk, const float (&o)[8][8]) {
#pragma unroll
    for (int i = 0; i < 8; ++i) { const int row = l0 + i; v4u v; v.x = pk2(o[i][0], o[i][1]); v.y = pk2(o[i][2], o[i][3]); v.z = pk2(o[i][4], o[i][5]); v.w = pk2(o[i][6], o[i][7]);
        *(LAS v4u*)(img + row * 256 + ((chunk ^ swz16(row)) << 4)) = v; }
}
__device__ __forceinline__ bf16x8 ld_frag(const LAS unsigned char* img, int row, int chunk) { return *(const LAS bf16x8*)(img + row * 256 + ((chunk ^ swz16(row)) << 4)); }

__device__ __forceinline__ void ssd_states_unit(Frame& F, int unit, const bool dry, const int var) {
    const int hh = unit & 1, g = (unit >> 1) & 3, c = (unit >> 3) & 31, b = unit >> 8; const int t0 = b * SEQ + c * 128;
    LAS float* sx = (LAS float*)F.lds;
    LAS unsigned char* Bt = F.lds + 4096; LAS unsigned char* Xt = F.lds + 4096 + 32768;
    const float* DT = (const float*)(F.ws + WS_DT); const bf16* XBC = (const bf16*)(F.ws + WS_XBC); bf16* XC = (bf16*)(F.ws + (dry ? 900 * MiB : WS_XC)); float* CD = (float*)(F.ws + (dry ? 1000 * MiB : WS_CD));
    __syncthreads();
    if (F.wave < 4) {
        const int h = g * 8 + 4 * hh + F.wave; const float A = -__expf(F.in[I_ALOG][h]); const int l = 2 * F.lane;
        const float d0 = DT[(size_t)(t0 + l) * 32 + h], d1 = DT[(size_t)(t0 + l + 1) * 32 + h]; const float a0 = d0 * A, a1 = d1 * A, s = a0 + a1;
        float incl = s;
#pragma unroll
        for (int o = 1; o < 64; o <<= 1) { const float v = __shfl_up(incl, o); if (F.lane >= o) incl += v; }
        const float c0 = incl - s + a0, c1 = incl, total = __shfl(incl, 63);
        sx[F.wave * 128 + l] = d0 * __expf(total - c0); sx[F.wave * 128 + l + 1] = d1 * __expf(total - c1);
        if (F.lane == 0) CD[(b * 32 + c) * 32 + h] = __expf(total);
    }
    __syncthreads();
#pragma unroll 1
    for (int itx = 0; itx < ((var & 2) ? 2 : 0); ++itx) {
        int kind, strip, grp, col, trow0; bool seqs; st_item(unit, itx, F.tid, kind, strip, grp, col, trow0, seqs);
        if (kind < 3) { const int l0 = strip * 8; v4u rawc[11]; conv_load(XBC, trow0, seqs, col, true, rawc);
            conv_item(XBC, F.in[I_CONVW], F.in[I_CONVB], t0 + l0, seqs, col, XC, (unsigned)((t0 + l0) * DCONV + col) * 2u, (kind != 1 || hh == 0),
                      kind ? Bt : Xt, kind < 2, grp * 8, strip, sx + (grp >> 3) * 128 + l0, kind == 0, rawc); }
    }
    __syncthreads();
    if (!(var & 4)) return;
    const int li = F.lane & 31, half = F.lane >> 5, hp = (F.wave >> 1) * 64 + (F.wave & 1) * 32 + li;
    f32x16 acc[4];
#pragma unroll
    for (int nt = 0; nt < 4; ++nt)
#pragma unroll
        for (int r = 0; r < 16; ++r) acc[nt][r] = 0.f;
#pragma unroll 2
    for (int ks = 0; ks < 8; ++ks) { const bf16x8 xb = ld_frag(Xt, hp, 2 * ks + half);
#pragma unroll
        for (int nt = 0; nt < 4; ++nt) { const bf16x8 ba = ld_frag(Bt, 32 * nt + li, 2 * ks + half); acc[nt] = __builtin_amdgcn_mfma_f32_32x32x16_bf16(ba, xb, acc[nt], 0, 0, 0); } }
    __syncthreads();
    LAS unsigned char* OUT = Xt;
#pragma unroll
    for (int nt = 0; nt < 4; ++nt)
#pragma unroll
        for (int rq = 0; rq < 4; ++rq) { const int ch8 = 8 * nt + 2 * rq + half; v2u v; v.x = pk2(acc[nt][4 * rq], acc[nt][4 * rq + 1]); v.y = pk2(acc[nt][4 * rq + 2], acc[nt][4 * rq + 3]);
            *(LAS v2u*)(OUT + hp * 256 + ((ch8 ^ (hp & 31)) << 3)) = v; }
    __syncthreads();
    bf16* ST = (bf16*)(F.ws + (dry ? 928 * MiB : WS_STATES)) + ((size_t)((b * 32 + c) * 32 + g * 8 + 4 * hh)) * 8192;
#pragma unroll
    for (int it = 0; it < 8; ++it) { const int idx = it * 512 + F.tid, row = idx >> 4, j = idx & 15, k = row & 31;
        v4u v = *(const LAS v4u*)(OUT + row * 256 + ((j ^ (k >> 1)) << 4)); if (k & 1) v = (v4u){v.z, v.w, v.x, v.y};
        *(v4u*)(ST + (size_t)row * 128 + j * 8) = v; }
}

__device__ __forceinline__ void ssd_scan(Frame& F, const bool dry) {
    bf16* ST = (bf16*)(F.ws + WS_STATES); const size_t dofs = dry ? (size_t)(864 * MiB - WS_STATES) / 2 : 0; const float* CD = (const float*)(F.ws + WS_CD);
    for (int gid = F.vcu * 512 + F.tid; gid < 131072; gid += F.G * 512) {
        const int bh = gid >> 10, b = bh >> 5, h = bh & 31, el = (gid & 1023) * 8;
        float st[8];
#pragma unroll
        for (int q = 0; q < 8; ++q) st[q] = 0.f;
#pragma unroll 4
        for (int c = 0; c < 32; ++c) { bf16* p = ST + ((size_t)((b * 32 + c) * 32 + h)) * 8192 + el; const v4u v = *(const v4u*)p; const float cd = CD[(b * 32 + c) * 32 + h];
            v4u o; o.x = pk2(st[0], st[1]); o.y = pk2(st[2], st[3]); o.z = pk2(st[4], st[5]); o.w = pk2(st[6], st[7]); *(v4u*)(p + dofs) = o;
            st[0] = st[0] * cd + bflo(v.x); st[1] = st[1] * cd + bfhi(v.x); st[2] = st[2] * cd + bflo(v.y); st[3] = st[3] * cd + bfhi(v.y);
            st[4] = st[4] * cd + bflo(v.z); st[5] = st[5] * cd + bfhi(v.z); st[6] = st[6] * cd + bflo(v.w); st[7] = st[7] * cd + bfhi(v.w); }
    }
}

__device__ __forceinline__ int off256(int row, int ch) { return 256 * row + 16 * (ch ^ (((row & 3) << 2) | ((row >> 2) & 3))); }
__device__ __forceinline__ int off512(int row, int ch) { return 512 * row + 16 * (ch ^ ((row & 3) << 2)); }
typedef short v4i16_t __attribute__((ext_vector_type(4)));
__device__ __forceinline__ v4i16_t tr_read(const LAS unsigned char* p) { return __builtin_amdgcn_ds_read_tr16_b64_v4i16((LAS v4i16_t*)p); }
__device__ __forceinline__ void ssd_out_stage_dma(Frame& F, int unit) {
    const int g = unit & 3, c = (unit >> 2) & 31, b = unit >> 7; const int t0 = b * SEQ + c * 128;
    LAS unsigned char* Bn = F.lds + 12288; LAS unsigned char* Cn = Bn + 32768; LAS unsigned char* Xn = Cn + 32768;
    const __amdgpu_buffer_rsrc_t rs = __builtin_amdgcn_make_buffer_rsrc((void*)(F.ws + WS_XC), 0, 0xFFFFFFFF, 0x00020000);
    const unsigned rowbase = (unsigned)t0 * (DCONV * 2);
#pragma unroll
    for (int i = 0; i < 4; ++i) { const int k = F.wave * 4 + i, rl = (F.lane >> 4), row = 4 * k + rl, pc = F.lane & 15, lc = pc ^ (((row & 3) << 2) | ((row >> 2) & 3));
        const unsigned voff = (unsigned)rl * (DCONV * 2) + (unsigned)lc * 16u, soff = rowbase + (unsigned)(4 * k) * (DCONV * 2) + (unsigned)(2048 + g * 128) * 2u;
        __builtin_amdgcn_raw_ptr_buffer_load_lds(rs, (LAS unsigned*)(Bn + k * 1024), 16, voff, soff, 0, 0);
        __builtin_amdgcn_raw_ptr_buffer_load_lds(rs, (LAS unsigned*)(Cn + k * 1024), 16, voff, soff + 1024u, 0, 0); }
#pragma unroll
    for (int i = 0; i < 8; ++i) { const int k = F.wave * 8 + i, rl = (F.lane >> 5), row = 2 * k + rl, pc = F.lane & 31, lc = pc ^ ((row & 3) << 2);
        const unsigned voff = (unsigned)rl * (DCONV * 2) + (unsigned)lc * 16u, soff = rowbase + (unsigned)(2 * k) * (DCONV * 2) + (unsigned)(g * 512) * 2u;
        __builtin_amdgcn_raw_ptr_buffer_load_lds(rs, (LAS unsigned*)(Xn + k * 1024), 16, voff, soff, 0, 0); }
}
__device__ __forceinline__ void ssd_out_stage_acum(Frame& F, int unit) {
    const int g = unit & 3, c = (unit >> 2) & 31, b = unit >> 7; const int t0 = b * SEQ + c * 128;
    LAS float* acum = (LAS float*)F.lds; LAS float* dtv = acum + 1024; const float* DT = (const float*)(F.ws + WS_DT);
    const int h = g * 8 + F.wave; const float A = -__expf(F.in[I_ALOG][h]); const int l = 2 * F.lane;
    const float d0 = DT[(size_t)(t0 + l) * 32 + h], d1 = DT[(size_t)(t0 + l + 1) * 32 + h]; const float a0 = d0 * A, a1 = d1 * A, s = a0 + a1;
    float incl = s;
#pragma unroll
    for (int o = 1; o < 64; o <<= 1) { const float v = __shfl_up(incl, o); if (F.lane >= o) incl += v; }
    acum[F.wave * 128 + l] = incl - s + a0; acum[F.wave * 128 + l + 1] = incl; dtv[F.wave * 128 + l] = d0; dtv[F.wave * 128 + l + 1] = d1;
}
__device__ __forceinline__ void ssd_out_unit(Frame& F, int unit, const int var, bf16* Y, const bool first, const int next_unit) {
    const int g = unit & 3, c = (unit >> 2) & 31, b = unit >> 7; const int t0 = b * SEQ + c * 128;
    LAS float* acum = (LAS float*)F.lds; LAS float* dtv = acum + 1024; LAS float* ssq = acum + 2048;
    LAS unsigned char* Bn = F.lds + 12288; LAS unsigned char* Cn = Bn + 32768; LAS unsigned char* Xn = Cn + 32768;
    const bf16* Z = (const bf16*)(F.ws + WS_Z);
    const __amdgpu_buffer_rsrc_t rsx = __builtin_amdgcn_make_buffer_rsrc((void*)(F.ws + WS_XC), 0, 0xFFFFFFFF, 0x00020000);
    if (first) { __syncthreads(); ssd_out_stage_dma(F, unit); ssd_out_stage_acum(F, unit); }
    const int li = F.lane & 31, half = F.lane >> 5, ew = F.wave >> 1, lsel = F.wave & 1;
    const int trq = (F.lane & 15) >> 2, trp = F.lane & 3, trblk = (F.lane >> 4) & 1;
#pragma unroll 1
    for (int ps = 0; ps < 2; ++ps) {
        if (ps) { __syncthreads();
#pragma unroll
          for (int i = 0; i < 8; ++i) { const int k = F.wave * 8 + i, rl = (F.lane >> 5), row = 2 * k + rl, pc = F.lane & 31, lc = pc ^ ((row & 3) << 2);
            const unsigned voff = (unsigned)rl * (DCONV * 2) + (unsigned)lc * 16u, soff = (unsigned)t0 * (DCONV * 2) + (unsigned)(2 * k) * (DCONV * 2) + (unsigned)(g * 512 + 256) * 2u;
            __builtin_amdgcn_raw_ptr_buffer_load_lds(rsx, (LAS unsigned*)(Xn + k * 1024), 16, voff, soff, 0, 0); } }
        const int e = 4 * ps + ew, h = 8 * g + e; const float Dk = F.in[I_DSKIP][h];
        const bf16* prev = (const bf16*)(F.ws + WS_STATES) + ((size_t)((b * 32 + c) * 32 + h)) * 8192;
        bf16x8 pf[2][8];
#pragma unroll
        for (int pt = 0; pt < 2; ++pt)
#pragma unroll
            for (int ks = 0; ks < 8; ++ks) pf[pt][ks] = *(const bf16x8*)(prev + (size_t)(32 * pt + li) * 128 + 16 * ks + 8 * half);
        VM_WAIT(); __syncthreads();
        const LAS float* ac = acum + e * 128; const LAS float* dv = dtv + e * 128;
        f32x16 accs[2][2];
#pragma unroll
        for (int it = 0; it < 2; ++it) {
            const int i = lsel ? (1 + it) : (it ? 3 : 0); const int l = 32 * i + li; const float acl = ac[l];
            f32x16 acc[2];
#pragma unroll
            for (int pt = 0; pt < 2; ++pt)
#pragma unroll
                for (int r = 0; r < 16; ++r) acc[pt][r] = 0.f;
            if (var & 1) {
#pragma unroll
            for (int ks = 0; ks < 8; ++ks) { const bf16x8 cf = *(const LAS bf16x8*)(Cn + off256(l, 2 * ks + half));
#pragma unroll
                for (int pt = 0; pt < 2; ++pt) acc[pt] = __builtin_amdgcn_mfma_f32_32x32x16_bf16(pf[pt][ks], cf, acc[pt], 0, 0, 0); }
            }
            { const float el = __expf(acl);
#pragma unroll
                for (int pt = 0; pt < 2; ++pt)
#pragma unroll
                    for (int r = 0; r < 16; ++r) acc[pt][r] *= el; }
#pragma unroll 1
            for (int j = 0; j <= ((var & 2) ? i : -1); ++j) {
                f32x16 gt;
#pragma unroll
                for (int r = 0; r < 16; ++r) gt[r] = 0.f;
#pragma unroll 4
                for (int ks = 0; ks < 8; ++ks) { const bf16x8 bfm = *(const LAS bf16x8*)(Bn + off256(32 * j + li, 2 * ks + half)); const bf16x8 cf = *(const LAS bf16x8*)(Cn + off256(l, 2 * ks + half)); gt = __builtin_amdgcn_mfma_f32_32x32x16_bf16(bfm, cf, gt, 0, 0, 0); }
                unsigned wp[8];
#pragma unroll
                for (int rq = 0; rq < 4; ++rq) { const int sb = 32 * j + 8 * rq + 4 * half; const f32x4 as4 = *(const LAS f32x4*)(ac + sb), dt4 = *(const LAS f32x4*)(dv + sb); float wv[4];
#pragma unroll
                    for (int x = 0; x < 4; ++x) { const int s = sb + x; float w = gt[4 * rq + x] * __expf(fminf(acl - as4[x], 0.f)) * dt4[x];
                        if (j == i) { if (s > l) w = 0.f; if (s == l) w += Dk; } wv[x] = w; }
                    wp[2 * rq] = pk2(wv[0], wv[1]); wp[2 * rq + 1] = pk2(wv[2], wv[3]); }
                const bf16x8 wf0 = __builtin_bit_cast(bf16x8, (v4u){wp[0], wp[1], wp[2], wp[3]}), wf1 = __builtin_bit_cast(bf16x8, (v4u){wp[4], wp[5], wp[6], wp[7]});
#pragma unroll
                for (int pt = 0; pt < 2; ++pt) { const int chunk = ew * 8 + 4 * pt + 2 * trblk + (trp >> 1);
#pragma unroll
                    for (int ksub = 0; ksub < 2; ++ksub) { const int r0 = 32 * j + 16 * ksub + 4 * half + trq;
                        const v4i16_t lo = tr_read(Xn + off512(r0, chunk) + 8 * (trp & 1)), hi = tr_read(Xn + off512(r0 + 8, chunk) + 8 * (trp & 1));
                        const bf16x8 xf = (bf16x8){lo[0], lo[1], lo[2], lo[3], hi[0], hi[1], hi[2], hi[3]};
                        acc[pt] = __builtin_amdgcn_mfma_f32_32x32x16_bf16(xf, ksub ? wf1 : wf0, acc[pt], 0, 0, 0); } }
            }
            accs[it][0] = acc[0]; accs[it][1] = acc[1];
            asm volatile("" ::: "memory"); __builtin_amdgcn_sched_barrier(0);
        }
        v4u zq[8];
        if (var & 4) {
#pragma unroll
          for (int k = 0; k < 8; ++k) { const int idx = k * 512 + F.tid, l = idx >> 5, j = idx & 31; zq[k] = *(const v4u*)(Z + (size_t)(t0 + l) * DSSD + g * 512 + ps * 256 + j * 8); } }
        __syncthreads();
        LAS unsigned char* Tt = Xn;
        if (var & 4) {
#pragma unroll
        for (int it = 0; it < 2; ++it) { const int i = lsel ? (1 + it) : (it ? 3 : 0); const int l = 32 * i + li;
#pragma unroll
            for (int pt = 0; pt < 2; ++pt)
#pragma unroll
                for (int rq = 0; rq < 4; ++rq) { const int c8 = ew * 16 + 8 * pt + 2 * rq + half;
                    *(LAS v2u*)(Tt + l * 512 + ((c8 ^ (l & 31)) << 3)) = (v2u){pk2(accs[it][pt][4 * rq], accs[it][pt][4 * rq + 1]), pk2(accs[it][pt][4 * rq + 2], accs[it][pt][4 * rq + 3])}; } }
        }
        __syncthreads();
        if (var & 4)
        {
#pragma unroll
          for (int k = 0; k < 8; ++k) { const int idx = k * 512 + F.tid, l = idx >> 5, j = idx & 31, kk = l & 31;
            v4u tq = *(const LAS v4u*)(Tt + l * 512 + ((j ^ (kk >> 1)) << 4)); if (kk & 1) tq = (v4u){tq.z, tq.w, tq.x, tq.y};
            const v4u z4 = zq[k];
            const float y0 = bflo(tq.x) * silu(bflo(z4.x)), y1 = bfhi(tq.x) * silu(bfhi(z4.x)), y2 = bflo(tq.y) * silu(bflo(z4.y)), y3 = bfhi(tq.y) * silu(bfhi(z4.y));
            const float y4 = bflo(tq.z) * silu(bflo(z4.z)), y5 = bfhi(tq.z) * silu(bfhi(z4.z)), y6 = bflo(tq.w) * silu(bflo(z4.w)), y7 = bfhi(tq.w) * silu(bfhi(z4.w));
            float sq = ((y0 * y0 + y1 * y1) + (y2 * y2 + y3 * y3)) + ((y4 * y4 + y5 * y5) + (y6 * y6 + y7 * y7));
#pragma unroll
            for (int o = 1; o < 32; o <<= 1) sq += __shfl_xor(sq, o);
            if (j == 0) ssq[ps * 128 + l] = sq;
            *(v4u*)(Y + (size_t)(t0 + l) * DSSD + g * 512 + ps * 256 + j * 8) = (v4u){pk2(y0, y1), pk2(y2, y3), pk2(y4, y5), pk2(y6, y7)}; } }
    }
    VM_WAIT(); __syncthreads();
    if (var & 8) { v4u yq[16];
#pragma unroll
        for (int k = 0; k < 16; ++k) { const int idx = k * 512 + F.tid, l = idx >> 6, j = idx & 63; yq[k] = *(const v4u*)(Y + (size_t)(t0 + l) * DSSD + g * 512 + j * 8); }
        const f32x4 w0 = *(const f32x4*)(F.in[I_SNW] + g * 512 + (F.tid & 63) * 8), w1 = *(const f32x4*)(F.in[I_SNW] + g * 512 + (F.tid & 63) * 8 + 4);
        asm volatile("" ::: "memory"); __builtin_amdgcn_sched_barrier(0);
        if (next_unit >= 0) ssd_out_stage_dma(F, next_unit);
        asm volatile("" ::: "memory"); __builtin_amdgcn_sched_barrier(0);
#pragma unroll
        for (int k = 0; k < 16; ++k) { const int idx = k * 512 + F.tid, l = idx >> 6, j = idx & 63; const float rstd = rsqrtf((ssq[l] + ssq[128 + l]) * (1.f / 512.f) + EPS); const v4u v = yq[k];
            *(v4u*)(Y + (size_t)(t0 + l) * DSSD + g * 512 + j * 8) = (v4u){pk2(bflo(v.x) * rstd * w0.x, bfhi(v.x) * rstd * w0.y), pk2(bflo(v.y) * rstd * w0.z, bfhi(v.y) * rstd * w0.w),
                                                                         pk2(bflo(v.z) * rstd * w1.x, bfhi(v.z) * rstd * w1.y), pk2(bflo(v.w) * rstd * w1.z, bfhi(v.w) * rstd * w1.w)}; } }
    else if (next_unit >= 0) ssd_out_stage_dma(F, next_unit);
    if (next_unit >= 0) ssd_out_stage_acum(F, next_unit);
}
}
namespace mk {
using pg8::Unit;
constexpr int MI_TSTART = 16, MI_CNT = 64, MI_RT2E = 128;

struct Sched {
    int mode, nM, nN, nwg, G, c, lda, ldb, a_pn_off, npn;
    const bf16* A; const bf16* Bt; const int* list; const volatile LAS unsigned* misc;
    __device__ __forceinline__ void init_dense(int M, int N, int G_, int c_, const bf16* A_, int lda_, const bf16* Bt_, int ldb_, int a_pn_off_) {
        mode = 0; nM = M / 256; nN = N / 256; nwg = nM * nN; G = G_; c = c_; A = A_; Bt = Bt_; lda = lda_; ldb = ldb_; a_pn_off = a_pn_off_; npn = 0; list = nullptr; misc = nullptr; }
    __device__ __forceinline__ void init_moe(int mode_, int G_, int c_, const bf16* A_, const bf16* Bt_, const int* list_, const volatile LAS unsigned* misc_) {
        mode = mode_; G = G_; c = c_; A = A_; Bt = Bt_; lda = 512; ldb = 512; a_pn_off = 0; npn = (mode_ == 1) ? 8 : 4; list = list_; misc = misc_; nM = 0; nN = 0; nwg = __builtin_amdgcn_readfirstlane((int)misc_[MI_TSTART + 32]) * npn; }
    __device__ __forceinline__ bool next(int i, Unit& u) const {
        const long L = (long)i * G + c; if (L >= nwg) return false;
        if (mode == 0) {
            int wgid = (int)L; { const int q = nwg / 8, r = nwg % 8, xcd = wgid % 8, off = wgid / 8; wgid = (xcd < r ? xcd * (q + 1) : r * (q + 1) + (xcd - r) * q) + off; }
            const int nig = 8 * nN, gid = wgid / nig, fm = gid * 8, gsz = (nM - fm) < 8 ? (nM - fm) : 8;
            u.pm = fm + ((wgid % nig) % gsz); u.pn = (wgid % nig) / gsz; u.e = 0; u.i = 0; return true;
        }
        const int rt = (int)L / npn, pn = (int)L % npn; const int e = __builtin_amdgcn_readfirstlane((int)misc[MI_RT2E + rt]);
        u.pm = rt; u.pn = pn; u.e = e; u.i = rt - __builtin_amdgcn_readfirstlane((int)misc[MI_TSTART + e]); return true;
    }
    __device__ __forceinline__ const bf16* a_root() const { return A; }
    __device__ __forceinline__ const bf16* b_root() const { return Bt; }
    __device__ __forceinline__ const char* a_base(const Unit& u) const {
        if (mode == 0) return (const char*)(A + (size_t)u.pm * 256 * lda + (size_t)u.pn * a_pn_off);
        if (mode == 1) return (const char*)A;
        return (const char*)(A + (size_t)u.pm * 256 * 512); }
    __device__ __forceinline__ const char* b_base(const Unit& u) const {
        if (mode == 0) return (const char*)(Bt + (size_t)u.pn * 256 * ldb);
        if (mode == 1) return (const char*)(Bt + (size_t)u.e * 2048 * 512 + (size_t)u.pn * 256 * 512);
        return (const char*)(Bt + (size_t)u.e * 1024 * 512 + (size_t)u.pn * 256 * 512); }
    __device__ __forceinline__ unsigned row_off(const Unit& u, int r) const {
        if (mode == 2) return (unsigned)r * 1024u;
        if (mode == 0) return (unsigned)r * (unsigned)lda * 2u;
        const int idx = u.i * 256 + r; const int cnt = (int)misc[MI_CNT + u.e];
        const int tok = idx < cnt ? (list[(size_t)u.e * T + idx] >> 2) : 0; return (unsigned)tok * 1024u; }
};

struct EpiNone { static constexpr bool PERM = true; __device__ __forceinline__ void operator()(const pg8::f32x4 (&acc)[2][2][4][2], const Unit&, int, int, int, int) const { asm volatile("" :: "v"(acc[0][0][0][0]), "v"(acc[1][1][3][1])); } };
struct EpiAll {
    static constexpr bool PERM = true;
    int kind, pad; unsigned char* ws; const float* const* in; float* out; const volatile LAS unsigned* misc;
    __device__ __forceinline__ void operator()(const pg8::f32x4 (&acc)[2][2][4][2], const Unit& u, int wr, int wc, int fr, int fq) const {
        const int rl0 = wr * 64 + fr, row0 = u.pm * 256 + rl0, cl0 = wc * 32 + 8 * fq;
        if (kind == 0) {
            bf16* base; int ld, colt; bool sg = false;
            if (u.pn < 8) { base = (bf16*)(ws + WS_Z); ld = 2048; colt = u.pn * 256; }
            else if (u.pn < 20) { base = (bf16*)(ws + WS_XBC); ld = 3072; colt = (u.pn - 8) * 256; }
            else if (u.pn < 24) { base = (bf16*)(ws + WS_U); ld = 1024; colt = (u.pn - 20) * 256; }
            else { base = (bf16*)(ws + WS_GATES); ld = 2048; colt = (u.pn - 24) * 256; sg = true; }
#pragma unroll
            for (int ai = 0; ai < 2; ++ai)
#pragma unroll
                for (int m = 0; m < 4; ++m) { bf16* rowp = base + (size_t)(row0 + ai * 128 + m * 16) * ld + colt + cl0;
#pragma unroll
                    for (int bj = 0; bj < 2; ++bj) { pg8::f32x4 v0 = acc[ai][bj][m][0], v1 = acc[ai][bj][m][1];
                        if (sg) { v0 = (pg8::f32x4){sigm(v0[0]), sigm(v0[1]), sigm(v0[2]), sigm(v0[3])}; v1 = (pg8::f32x4){sigm(v1[0]), sigm(v1[1]), sigm(v1[2]), sigm(v1[3])}; }
                        v4u w; w.x = pk2(v0[0], v0[1]); w.y = pk2(v0[2], v0[3]); w.z = pk2(v1[0], v1[1]); w.w = pk2(v1[2], v1[3]);
                        *(v4u*)(rowp + bj * 128) = w; } }
        } else if (kind == 1) {
            bf16* base = (bf16*)(ws + WS_P2); const float* ps = in[I_PSCALE];
#pragma unroll
            for (int bj = 0; bj < 2; ++bj) { const int col = u.pn * 256 + bj * 128 + cl0; const f32x4 s0 = *(const f32x4*)(ps + col), s1 = *(const f32x4*)(ps + col + 4);
#pragma unroll
                for (int ai = 0; ai < 2; ++ai)
#pragma unroll
                    for (int m = 0; m < 4; ++m) { const pg8::f32x4 v0 = acc[ai][bj][m][0] * s0, v1 = acc[ai][bj][m][1] * s1;
                        v4u w; w.x = pk2(v0[0], v0[1]); w.y = pk2(v0[2], v0[3]); w.z = pk2(v1[0], v1[1]); w.w = pk2(v1[2], v1[3]);
                        *(v4u*)(base + (size_t)(row0 + ai * 128 + m * 16) * 1024 + col) = w; } }
        } else if (kind == 2 || kind == 3) {
            const bf16* gates = (const bf16*)(ws + WS_GATES) + (kind == 3 ? 1024 : 0); bf16* m1 = (bf16*)(ws + WS_M1); bf16* mg = (bf16*)(ws + WS_MERGED);
#pragma unroll
            for (int ai = 0; ai < 2; ++ai) { v4u gq[4][2], mq[4][2];
#pragma unroll
                for (int m = 0; m < 4; ++m)
#pragma unroll
                    for (int bj = 0; bj < 2; ++bj) { const size_t row = row0 + ai * 128 + m * 16; const int col = u.pn * 256 + bj * 128 + cl0; gq[m][bj] = *(const v4u*)(gates + row * 2048 + col);
                        if (kind == 3) mq[m][bj] = *(const v4u*)(m1 + row * 1024 + col); else mq[m][bj] = (v4u){0u, 0u, 0u, 0u}; }
#pragma unroll
                for (int m = 0; m < 4; ++m)
#pragma unroll
                    for (int bj = 0; bj < 2; ++bj) { const size_t row = row0 + ai * 128 + m * 16; const int col = u.pn * 256 + bj * 128 + cl0; const v4u g4 = gq[m][bj], m4 = mq[m][bj];
                        float r[8] = {acc[ai][bj][m][0][0] * bflo(g4.x), acc[ai][bj][m][0][1] * bfhi(g4.x), acc[ai][bj][m][0][2] * bflo(g4.y), acc[ai][bj][m][0][3] * bfhi(g4.y),
                                      acc[ai][bj][m][1][0] * bflo(g4.z), acc[ai][bj][m][1][1] * bfhi(g4.z), acc[ai][bj][m][1][2] * bflo(g4.w), acc[ai][bj][m][1][3] * bfhi(g4.w)};
                        if (kind == 3) { r[0] += bflo(m4.x); r[1] += bfhi(m4.x); r[2] += bflo(m4.y); r[3] += bfhi(m4.y); r[4] += bflo(m4.z); r[5] += bfhi(m4.z); r[6] += bflo(m4.w); r[7] += bfhi(m4.w); }
                        v4u w; w.x = pk2(r[0], r[1]); w.y = pk2(r[2], r[3]); w.z = pk2(r[4], r[5]); w.w = pk2(r[6], r[7]);
                        *(v4u*)((kind == 3 ? mg : m1) + row * 1024 + col) = w; } }
        } else if (kind == 4) {
            const int b = (u.pm * 256) / SEQ; const float* ga = (const float*)(ws + WS_MOD) + b * 6144 + 2048; const float* x = in[I_X];
            f32x4 g0[2], g1[2];
#pragma unroll
            for (int bj = 0; bj < 2; ++bj) { const int col = u.pn * 256 + bj * 128 + cl0; g0[bj] = *(const f32x4*)(ga + col); g1[bj] = *(const f32x4*)(ga + col + 4); }
#pragma unroll
            for (int ai = 0; ai < 2; ++ai)
#pragma unroll
              for (int m = 0; m < 4; ++m) { f32x4 xa[2], xb[2];
#pragma unroll
                for (int bj = 0; bj < 2; ++bj) { const size_t off = (size_t)(row0 + ai * 128 + m * 16) * 1024 + u.pn * 256 + bj * 128 + cl0; xa[bj] = *(const f32x4*)(x + off); xb[bj] = *(const f32x4*)(x + off + 4); }
#pragma unroll
                for (int bj = 0; bj < 2; ++bj) { const size_t off = (size_t)(row0 + ai * 128 + m * 16) * 1024 + u.pn * 256 + bj * 128 + cl0;
                    *(f32x4*)(out + off) = xa[bj] + g0[bj] * acc[ai][bj][m][0]; *(f32x4*)(out + off + 4) = xb[bj] + g1[bj] * acc[ai][bj][m][1]; } }
        } else if (kind == 5) {
            typedef float f2 __attribute__((ext_vector_type(2)));
            unsigned char* act = (unsigned char*)(ws + WS_ACT); const float* bgu = in[I_BGU] + (size_t)u.e * 2048; const int col = u.pn * 128 + cl0;
            const f32x4 bg0 = *(const f32x4*)(bgu + col), bg1 = *(const f32x4*)(bgu + col + 4), bl0 = *(const f32x4*)(bgu + 1024 + col) + 1.f, bl1 = *(const f32x4*)(bgu + 1024 + col + 4) + 1.f;
            const f2 bgp[4] = {(f2){bg0.x, bg0.y}, (f2){bg0.z, bg0.w}, (f2){bg1.x, bg1.y}, (f2){bg1.z, bg1.w}}, blp[4] = {(f2){bl0.x, bl0.y}, (f2){bl0.z, bl0.w}, (f2){bl1.x, bl1.y}, (f2){bl1.z, bl1.w}};
#pragma unroll
            for (int ai = 0; ai < 2; ++ai)
#pragma unroll
                for (int m = 0; m < 4; ++m) { int w[2] = {0, 0};
#pragma unroll
                    for (int hp = 0; hp < 4; ++hp) { const int n = hp >> 1, x = (hp & 1) * 2;
                        f2 gl = (f2){acc[ai][0][m][n][x], acc[ai][0][m][n][x + 1]} + bgp[hp], ln = (f2){acc[ai][1][m][n][x], acc[ai][1][m][n][x + 1]} + blp[hp];
                        gl.x = fminf(gl.x, 7.f); gl.y = fminf(gl.y, 7.f); ln.x = __builtin_amdgcn_fmed3f(ln.x, -6.f, 8.f); ln.y = __builtin_amdgcn_fmed3f(ln.y, -6.f, 8.f);
                        f2 t = gl * -2.4554669595930155f;
                        t.x = __builtin_amdgcn_exp2f(t.x); t.y = __builtin_amdgcn_exp2f(t.y); t = t + 1.f; t.x = __builtin_amdgcn_rcpf(t.x); t.y = __builtin_amdgcn_rcpf(t.y);
                        const f2 r = (gl * t) * ln;
                        if (hp & 1) w[n] = __builtin_amdgcn_cvt_pk_fp8_f32(r.x, r.y, w[n], true); else w[n] = __builtin_amdgcn_cvt_pk_fp8_f32(r.x, r.y, w[n], false); }
                    *(v2u*)(act + (size_t)(row0 + ai * 128 + m * 16) * 1024 + col) = (v2u){(unsigned)w[0], (unsigned)w[1]}; }
        } else {
            bf16* yb = (bf16*)(ws + WS_YB); const float* bdn = in[I_BDN] + (size_t)u.e * 1024; const int* list = (const int*)(ws + WS_LIST) + (size_t)u.e * T; const float* gate = (const float*)(ws + WS_GATE);
            const int cnt = (int)misc[MI_CNT + u.e];
#pragma unroll
            for (int ai = 0; ai < 2; ++ai) { int slot[4]; float gt[4];
#pragma unroll
                for (int m = 0; m < 4; ++m) { const int idx = u.i * 256 + rl0 + ai * 128 + m * 16; slot[m] = idx < cnt ? list[idx] : -1; }
#pragma unroll
                for (int m = 0; m < 4; ++m) gt[m] = slot[m] >= 0 ? gate[slot[m]] : 0.f;
#pragma unroll
                for (int bj = 0; bj < 2; ++bj) { const int col = u.pn * 256 + bj * 128 + cl0; const f32x4 b0 = *(const f32x4*)(bdn + col), b1 = *(const f32x4*)(bdn + col + 4);
#pragma unroll
                    for (int m = 0; m < 4; ++m) {
                        if (slot[m] >= 0) {
                            const pg8::f32x4 v0 = (acc[ai][bj][m][0] + b0) * gt[m], v1 = (acc[ai][bj][m][1] + b1) * gt[m];
                            v4u w; w.x = pk2(v0[0], v0[1]); w.y = pk2(v0[2], v0[3]); w.z = pk2(v1[0], v1[1]); w.w = pk2(v1[2], v1[3]);
                            *(v4u*)(yb + (size_t)slot[m] * 1024 + col) = w; } } } }
        }
    }
};

__device__ __forceinline__ void p6_router(Frame& F, const bool dry, const int var) {
    LAS float* wrT = (LAS float*)F.lds;
    LAS int* lcnt = (LAS int*)(F.lds + 131072); LAS int* lbase = lcnt + 32; LAS int* rec = lcnt + 64;
    const float* wr = F.in[I_WR];
    __syncthreads();
    if (var & 1) { f32x4 wv[16];
#pragma unroll
      for (int i = 0; i < 16; ++i) wv[i] = *(const f32x4*)(wr + (size_t)(i * 512 + F.tid) * 4);
#pragma unroll
      for (int i = 0; i < 16; ++i) { const int idx = (i * 512 + F.tid) * 4, k = idx >> 5, e = idx & 31; wrT[e * 1024 + k] = wv[i].x; wrT[(e + 1) * 1024 + k] = wv[i].y; wrT[(e + 2) * 1024 + k] = wv[i].z; wrT[(e + 3) * 1024 + k] = wv[i].w; } }
    for (int rb = F.vcu; rb < T / 64; rb += F.G) {
    __syncthreads();
    if (F.tid < 32) lcnt[F.tid] = 0;
    __syncthreads();
    const int rowblk = rb * 64, b = rowblk / SEQ; const float* mod = (const float*)(F.ws + WS_MOD) + b * 6144; unsigned char* H8 = (unsigned char*)(F.ws + WS_H);
    const float* x1 = F.out;
    f32x4 xn[2][4];
#pragma unroll
    for (int rr = 0; rr < 2; ++rr)
#pragma unroll
        for (int j = 0; j < 4; ++j) xn[rr][j] = *(const f32x4*)(x1 + (size_t)(rowblk + F.wave * 8 + rr) * D + 4 * F.lane + 256 * j);
#pragma unroll 1
    for (int pr = 0; pr < ((var & 2) ? 4 : 0); ++pr) {
        float hv[2][16]; const int rl0 = F.wave * 8 + pr * 2;
        f32x4 xc[2][4];
#pragma unroll
        for (int rr = 0; rr < 2; ++rr)
#pragma unroll
            for (int j = 0; j < 4; ++j) xc[rr][j] = xn[rr][j];
        if (pr < 3) {
#pragma unroll
            for (int rr = 0; rr < 2; ++rr)
#pragma unroll
                for (int j = 0; j < 4; ++j) xn[rr][j] = *(const f32x4*)(x1 + (size_t)(rowblk + rl0 + 2 + rr) * D + 4 * F.lane + 256 * j); }
#pragma unroll
        for (int rr = 0; rr < 2; ++rr) { const size_t t = rowblk + rl0 + rr; f32x4 v[4]; float s = 0.f;
#pragma unroll
            for (int j = 0; j < 4; ++j) { v[j] = xc[rr][j]; s += (v[j].x * v[j].x + v[j].y * v[j].y) + (v[j].z * v[j].z + v[j].w * v[j].w); }
            const float rstd = rsqrtf(wave_sum(s) * (1.f / D) + EPS);
#pragma unroll
            for (int j = 0; j < 4; ++j) { const int col = 4 * F.lane + 256 * j; const f32x4 w = *(const f32x4*)(F.in[I_NFW] + col), sc = *(const f32x4*)(mod + 4096 + col), sh = *(const f32x4*)(mod + 3072 + col);
                const f32x4 h = v[j] * rstd * w * (sc + 1.f) + sh; hv[rr][4 * j] = h.x; hv[rr][4 * j + 1] = h.y; hv[rr][4 * j + 2] = h.z; hv[rr][4 * j + 3] = h.w;
                int w8 = 0; w8 = __builtin_amdgcn_cvt_pk_fp8_f32(h.x, h.y, w8, false); w8 = __builtin_amdgcn_cvt_pk_fp8_f32(h.z, h.w, w8, true); *(unsigned*)(H8 + t * D + col) = (unsigned)w8; } }
        float a[64];
        { typedef float f32x2v __attribute__((ext_vector_type(2)));
          f32x2v h2v[16];
#pragma unroll
          for (int k = 0; k < 16; ++k) h2v[k] = (f32x2v){hv[0][k], hv[1][k]};
#pragma unroll
          for (int eg = 0; eg < 8; ++eg) { f32x4 w[4][4];
#pragma unroll
            for (int ee = 0; ee < 4; ++ee)
#pragma unroll
              for (int j = 0; j < 4; ++j) w[ee][j] = *(const LAS f32x4*)(wrT + (4 * eg + ee) * 1024 + 4 * F.lane + 256 * j);
            __builtin_amdgcn_sched_barrier(0);
#pragma unroll
            for (int ee = 0; ee < 4; ++ee) { f32x2v s = (f32x2v){0.f, 0.f};
#pragma unroll
              for (int j = 0; j < 4; ++j) {
                s = __builtin_elementwise_fma(h2v[4 * j], (f32x2v){w[ee][j].x, w[ee][j].x}, s); s = __builtin_elementwise_fma(h2v[4 * j + 1], (f32x2v){w[ee][j].y, w[ee][j].y}, s);
                s = __builtin_elementwise_fma(h2v[4 * j + 2], (f32x2v){w[ee][j].z, w[ee][j].z}, s); s = __builtin_elementwise_fma(h2v[4 * j + 3], (f32x2v){w[ee][j].w, w[ee][j].w}, s); }
              a[2 * (4 * eg + ee)] = s.x; a[2 * (4 * eg + ee) + 1] = s.y; }
            __builtin_amdgcn_sched_barrier(0); } }
#define RED_STEP(N, M) { _Pragma("unroll") for (int i = 0; i < (N) / 2; ++i) { const bool up = (F.lane & (M)) != 0; const float keep = up ? a[i + (N) / 2] : a[i], send = up ? a[i] : a[i + (N) / 2]; a[i] = keep + __shfl_xor(send, (M)); } }
        RED_STEP(64, 32) RED_STEP(32, 16) RED_STEP(16, 8) RED_STEP(8, 4) RED_STEP(4, 2) RED_STEP(2, 1)
#undef RED_STEP
        const int e = F.lane >> 1, rr = F.lane & 1; float v = a[0] + F.in[I_BR][e];
        float tv[4]; int ti[4];
#pragma unroll
        for (int r = 0; r < 4; ++r) { float m = v; int mi = e;
#pragma unroll
            for (int o = 2; o < 64; o <<= 1) { const float om = __shfl_xor(m, o); const int oi = __shfl_xor(mi, o); if (om > m || (om == m && oi < mi)) { m = om; mi = oi; } }
            tv[r] = m; ti[r] = mi; if (e == mi) v = -INFINITY; }
        if (F.lane < 2) { const float e0 = 1.f, e1 = __expf(tv[1] - tv[0]), e2 = __expf(tv[2] - tv[0]), e3 = __expf(tv[3] - tv[0]); const float inv = 1.f / (e0 + e1 + e2 + e3);
            const float gt[4] = {e0 * inv, e1 * inv, e2 * inv, e3 * inv}; const int rl = rl0 + rr;
#pragma unroll
            for (int r = 0; r < 4; ++r) { const int pos = __hip_atomic_fetch_add(lcnt + ti[r], 1, __ATOMIC_RELAXED, __HIP_MEMORY_SCOPE_WORKGROUP);
                rec[(rl * 4 + r) * 3] = ti[r]; rec[(rl * 4 + r) * 3 + 1] = pos; rec[(rl * 4 + r) * 3 + 2] = __float_as_int(gt[r]); } }
    }
    __syncthreads();
    if (var & 4) {
    if (F.tid < 32) lbase[F.tid] = (int)__hip_atomic_fetch_add((unsigned*)(F.ctl + CW_GCNT) + (dry ? 32 : 0) + 64 * F.tid, (unsigned)lcnt[F.tid], __ATOMIC_RELAXED, __HIP_MEMORY_SCOPE_AGENT);
    __syncthreads();
    if (F.tid < 256) { const int rl = F.tid >> 2, r = F.tid & 3; const int e = rec[F.tid * 3], pos = rec[F.tid * 3 + 1]; const int slot = (rowblk + rl) * 4 + r;
        ((int*)(F.ws + (dry ? 900 * MiB : WS_LIST)))[(size_t)e * T + lbase[e] + pos] = slot; ((float*)(F.ws + (dry ? 910 * MiB : WS_GATE)))[slot] = __int_as_float(rec[F.tid * 3 + 2]); }
    }
    }
}

__device__ __forceinline__ void moe_setup(Frame& F) {
    __syncthreads();
    if (F.tid == 0) { int acc = 0; F.MISC[MI_TSTART] = 0;
        for (int e = 0; e < 32; ++e) { const unsigned cnt = __hip_atomic_load((unsigned*)(F.ctl + CW_GCNT) + 64 * e, RLX_AGENT); F.MISC[MI_CNT + e] = cnt; acc += (int)((cnt + 255u) >> 8); F.MISC[MI_TSTART + e + 1] = (unsigned)acc; } }
    __syncthreads();
    if (F.tid < 320) { int e = 0; while (e < 31 && (int)F.MISC[MI_TSTART + e + 1] <= F.tid) ++e; F.MISC[MI_RT2E + F.tid] = (unsigned)e; }
    __syncthreads();
}

__device__ __forceinline__ void p9_final(Frame& F, const float dscale, float* dst) {
    const bf16* YB = (const bf16*)(F.ws + WS_YB);
#pragma unroll 1
    for (size_t t = F.vcu * NWAVES + F.wave; t < (size_t)T; t += F.G * NWAVES) { const int b = (int)(t / SEQ); const float* ga = (const float*)(F.ws + WS_MOD) + b * 6144 + 5120;
        f32x4 v[4]; float s = 0.f;
#pragma unroll
        for (int j = 0; j < 4; ++j) { const int col = 4 * F.lane + 256 * j; f32x4 m = (f32x4){0.f, 0.f, 0.f, 0.f};
#pragma unroll
            for (int k = 0; k < 4; ++k) { const v2u q = *(const v2u*)(YB + (t * 4 + k) * D + col); m += (f32x4){bflo(q.x), bfhi(q.x), bflo(q.y), bfhi(q.y)}; }
            v[j] = *(const f32x4*)(F.out + t * D + col) + *(const f32x4*)(ga + col) * m; s += (v[j].x * v[j].x + v[j].y * v[j].y) + (v[j].z * v[j].z + v[j].w * v[j].w); }
        const float rstd = rsqrtf(wave_sum(s) * (1.f / D) + EPS);
#pragma unroll
        for (int j = 0; j < 4; ++j) { const int col = 4 * F.lane + 256 * j; *(f32x4*)(dst + t * D + col) = v[j] * (rstd * dscale) * *(const f32x4*)(F.in[I_NFINAL] + col); } }
}
}
namespace mk {
#ifndef MK_N_LAUNCHES
#define MK_N_LAUNCHES 1
#endif
constexpr int NPHASES = 12;
struct Args { const float* in[25]; float* out; unsigned char* ws; int ph_lo, ph_hi, li, pad; };

__global__ void __launch_bounds__(NWAVES * 64, 2) mk_fwd(Args args) {
    extern __shared__ __attribute__((aligned(16))) unsigned char lds[];
    Frame F;
    F.lds = (LAS unsigned char*)lds; F.MISC = (volatile LAS unsigned*)(F.lds + MISC_OFF);
    F.tid = threadIdx.x; F.lane = F.tid & 63; F.wave = __builtin_amdgcn_readfirstlane(F.tid >> 6);
    F.G = gridDim.x; { const int bx = blockIdx.x; F.vcu = (F.G % 8 == 0) ? (bx % 8) * (F.G / 8) + bx / 8 : bx; }
    F.ws = args.ws; F.out = args.out; F.in = args.in; F.ctl = (gu32*)(args.ws + WS_CTL);
    for (int u = F.tid; u < (LDS_BYTES - LDSCTL_OFF) / 4; u += NWAVES * 64) ((LAS unsigned*)(F.lds + LDSCTL_OFF))[u] = 0u;
    __syncthreads();
    XcdBarrier bar = xcd_barrier_post((unsigned*)(F.ctl + CW_BAR) + args.li * XCD_BAR_WORDS, F.MISC + 0);
    const int lo = args.ph_lo, hi = args.ph_hi;
#ifndef MK_PH_MASK
#define MK_PH_MASK 0xFFF
#endif
#define IN(k) (((MK_PH_MASK >> (k)) & 1) && lo <= (k) && (k) < hi)
#define SEAM(k) do { if (IN(k) && IN((k) + 1)) xcd_barrier(bar, F.wave); } while (0)
    LAS unsigned char* ring = F.lds;
    const int cid = (int)blockIdx.x;

    if (IN(0)) { refresh_ids(F); p0_prologue(F); } SEAM(0);
    if (IN(1)) { refresh_ids(F); p1_norm_dt(F); } SEAM(1);
    if (IN(2)) { refresh_ids(F);
        Sched S; S.init_dense(T, 8192, F.G, cid, (const bf16*)(F.ws + WS_H), 1024, (const bf16*)(F.ws + WS_WIN), 1024, 0);
        EpiAll E{0, 0, F.ws, F.in, F.out, F.MISC}; __syncthreads();
        pg8::gemm_phase<EpiAll, Sched, true, true, 0, false>(ring, F.wave, 1024, 1024, 1024, S, E);
    } SEAM(2);
    if (IN(3)) { refresh_ids(F);
#ifndef MK_SVAR
#define MK_SVAR 7
#endif
        const bool dry3 = (args.li == 1); const int var3 = dry3 ? (MK_SVAR) : 7;
        if (var3 & 1) pool_pass(F, dry3);
        asm volatile("" ::: "memory"); __builtin_amdgcn_sched_barrier(0);
        for (int u = F.vcu; u < 1024; u += F.G) ssd_states_unit(F, u, dry3, var3); } SEAM(3);
    if (IN(4)) { refresh_ids(F);
#ifdef MK_DUPSCAN
        ssd_scan(F, args.li == 1);
#else
        if (args.li != 1) ssd_scan(F, false);
#endif

        Sched S; S.init_dense(T, 1024, F.G, cid, (const bf16*)(F.ws + WS_P), 1024, (const bf16*)(F.ws + WS_WPOOL), 256, 256);
        EpiAll E{1, 0, F.ws, F.in, F.out, F.MISC};
        __syncthreads();
        pg8::gemm_phase<EpiAll, Sched, true, true, 0, false>(ring, F.wave, 256, 1024, 256, S, E);
    } SEAM(4);
    if (IN(5)) { refresh_ids(F);
#ifdef MK_VAR
        const int var = (args.li == 1) ? (MK_VAR) : 15; bf16* ydst = (args.li == 1) ? (bf16*)(F.ws + 864 * MiB) : (bf16*)(F.ws + WS_Y);
#else
        const int var = 15; bf16* ydst = (bf16*)(F.ws + WS_Y);
#endif
        for (int u = F.vcu; u < 512; u += F.G) ssd_out_unit(F, u, var, ydst, u == F.vcu, (u + F.G < 512) ? u + F.G : -1); } SEAM(5);
    if (IN(6)) { refresh_ids(F);
        { Sched S; S.init_dense(T, 1024, F.G, cid, (const bf16*)(F.ws + WS_Y), 2048, (const bf16*)(F.ws + WS_WSSD), 2048, 0);
          EpiAll E{2, 0, F.ws, F.in, F.out, F.MISC}; __syncthreads();
          pg8::gemm_phase<EpiAll, Sched, true, true, 0, false>(ring, F.wave, 2048, 2048, 2048, S, E); }
        VM_WAIT(); __syncthreads();
        { Sched S; S.init_dense(T, 1024, F.G, cid, (const bf16*)(F.ws + WS_P2), 1024, (const bf16*)(F.ws + WS_WPO), 1024, 0);
          EpiAll E{3, 0, F.ws, F.in, F.out, F.MISC}; __syncthreads();
          pg8::gemm_phase<EpiAll, Sched, true, true, 0, false>(ring, F.wave, 1024, 1024, 1024, S, E); }
    } SEAM(6);
    if (IN(7)) { refresh_ids(F); Sched S; S.init_dense(T, 1024, F.G, cid, (const bf16*)(F.ws + WS_MERGED), 1024, (const bf16*)(F.ws + WS_WOUT), 1024, 0);
        EpiAll E{4, 0, F.ws, F.in, F.out, F.MISC}; __syncthreads();
        pg8::gemm_phase<EpiAll, Sched, true, true, 0, false>(ring, F.wave, 1024, 1024, 1024, S, E);
    } SEAM(7);
    #ifndef MK_RVAR
#define MK_RVAR 7
#endif
    if (IN(8)) { refresh_ids(F); p6_router(F, args.li == 1, args.li == 1 ? (MK_RVAR) : 7); } SEAM(8);
    if (IN(9)) { refresh_ids(F); moe_setup(F);
        Sched S; S.init_moe(1, F.G, cid, (const bf16*)(F.ws + WS_H), (const bf16*)(F.ws + WS_WGU), (const int*)(F.ws + WS_LIST), F.MISC);
        EpiAll E{5, 0, F.ws, F.in, F.out, F.MISC}; __syncthreads();
#ifdef MK_KLOOP_ONLY
        if (args.li == 1) { EpiNone EN; pg8::gemm_phase<EpiNone, Sched, true, true, 1, true>(ring, F.wave, 512, 512, 512, S, EN); } else
#endif
        pg8::gemm_phase<EpiAll, Sched, true, true, 1, true>(ring, F.wave, 512, 512, 512, S, E);
    } SEAM(9);
    if (IN(10)) { refresh_ids(F); moe_setup(F);
        Sched S; S.init_moe(2, F.G, cid, (const bf16*)(F.ws + WS_ACT), (const bf16*)(F.ws + WS_WDN), (const int*)(F.ws + WS_LIST), F.MISC);
        EpiAll E{6, 0, F.ws, F.in, F.out, F.MISC}; __syncthreads();
        pg8::gemm_phase<EpiAll, Sched, true, true, 1, true>(ring, F.wave, 512, 512, 512, S, E);
    } SEAM(10);
    if (IN(11)) { refresh_ids(F); p9_final(F, 1.f, args.li == 1 ? (float*)(F.ws + 864 * MiB) : F.out); }
#undef IN
#undef SEAM
}

static void run_mk(void* const* d_in, float* out, unsigned char* ws, hipStream_t stream) {
    static int grid = 0;
    if (grid == 0) {
        int dev = 0, cus = 0;
        if (hipGetDevice(&dev) != hipSuccess || hipDeviceGetAttribute(&cus, hipDeviceAttributeMultiprocessorCount, dev) != hipSuccess) { fprintf(stderr, "kernel_launch: device query failed\n"); grid = -1; return; }
        if (hipFuncSetAttribute((const void*)mk_fwd, hipFuncAttributeMaxDynamicSharedMemorySize, LDS_BYTES) != hipSuccess) { fprintf(stderr, "kernel_launch: hipFuncSetAttribute failed\n"); grid = -1; return; }
        (void)hipGetLastError();
        grid = cus;
    }
    if (grid < 0) return;
    (void)hipMemsetAsync(ws + WS_CTL, 0, CTL_ZERO_BYTES, stream);
    Args a{};
    for (int i = 0; i < 25; ++i) a.in[i] = (const float*)d_in[i];
    a.out = out; a.ws = ws;
#ifdef MK_DUP
    const int nl = 3, los[3] = {0, MK_DUP, MK_DUP + 1}, his[3] = {MK_DUP + 1, MK_DUP + 1, NPHASES};
#else
    const int nl = 1, los[1] = {0}, his[1] = {NPHASES};
#endif
    for (int li = 0; li < nl; ++li) {
        if (los[li] >= his[li]) continue;
        a.ph_lo = los[li]; a.ph_hi = his[li]; a.li = li;
        hipLaunchKernelGGL(mk_fwd, dim3(grid), dim3(NWAVES * 64), LDS_BYTES, stream, a);
    }
}
}
extern "C" void kernel_launch(void* const* d_in, const int* in_sizes, int n_in, void* d_out, int out_size, void* d_ws, size_t ws_size, hipStream_t stream) {
    mk::run_mk(d_in, (float*)d_out, (unsigned char*)d_ws, stream);
}
```

```cpp
#include <hip/hip_runtime.h>
#include <cstdio>
#include <cstdint>
#include <cmath>
namespace pg8 {
#define PG8_LAS __attribute__((address_space(3)))
typedef unsigned short bf16_t;
typedef short bf16x8 __attribute__((ext_vector_type(8)));
typedef float f32x4 __attribute__((ext_vector_type(4)));
typedef unsigned u32x4 __attribute__((ext_vector_type(4)));
typedef unsigned u32x2 __attribute__((ext_vector_type(2)));
constexpr int BM = 256, BK = 64, HALF = 128, HTB = HALF * BK * 2  , STAGE_BYTES = 8 * HTB, NXCD = 8, WGM = 8;

__host__ __device__ __forceinline__ int lds_byte(int r, int c) { const int st = (r >> 4) * 2 + (c >> 5), rr = r & 15, cc = c & 31, ob = rr * 64 + cc * 2; return st * 1024 + (ob ^ (((ob >> 9) & 1) << 5)); }
__host__ __device__ __forceinline__ void stage_rc(int b, int& R, int& C) { const int st = b / 1024, sb = b % 1024, swz = sb ^ (((sb >> 9) & 1) << 5); R = (st >> 1) * 16 + swz / 64; C = (st & 1) * 32 + (swz % 64) / 2; }
__host__ __device__ __forceinline__ int perm32(int rho) { const int n = rho >> 4, i = rho & 15; return 8 * (i >> 2) + 4 * n + (i & 3); }

struct Unit { int pm, pn, e, i; };

__device__ __forceinline__ unsigned cvt_pk_bf16(float lo, float hi) { unsigned r; asm volatile("v_cvt_pk_bf16_f32 %0, %1, %2" : "=v"(r) : "v"(lo), "v"(hi)); return r; }

struct StaticOrder {
    int nM, nN, nwg, G, c; const bf16_t* A; const bf16_t* Bt; int lda, ldb, a_pn_off, pad;
    __device__ void init(int M, int N, int G_, int c_, const bf16_t* A_, int lda_, const bf16_t* Bt_, int ldb_, int a_pn_off_) { nM = M / BM; nN = N / BM; nwg = nM * nN; G = G_; c = c_; A = A_; Bt = Bt_; lda = lda_; ldb = ldb_; a_pn_off = a_pn_off_; pad = 0; }
    __device__ bool next(int i, Unit& u) const {
        const long L = (long)i * G + c; if (L >= nwg) return false;
        int wgid = (int)L; { const int q = nwg / NXCD, r = nwg % NXCD, xcd = wgid % NXCD, off = wgid / NXCD; wgid = (xcd < r ? xcd * (q + 1) : r * (q + 1) + (xcd - r) * q) + off; }
        const int nig = WGM * nN, gid = wgid / nig, fm = gid * WGM, gsz = (nM - fm) < WGM ? (nM - fm) : WGM;
        u.pm = fm + ((wgid % nig) % gsz); u.pn = (wgid % nig) / gsz; u.e = 0; u.i = 0; return true;
    }
    __device__ __forceinline__ const char* a_base(const Unit& u) const { return (const char*)(A + (size_t)u.pm * BM * lda + (size_t)u.pn * a_pn_off); }
    __device__ __forceinline__ const char* b_base(const Unit& u) const { return (const char*)(Bt + (size_t)u.pn * BM * ldb); }
    __device__ __forceinline__ unsigned row_off(const Unit&, int) const { return 0u; }
};

typedef int v8i32 __attribute__((ext_vector_type(8))); typedef int i32x4 __attribute__((ext_vector_type(4)));
template <class Epi, class Sched, bool ALIGN_EPI, bool SP2, int GATHER  , bool FP8>
__device__ __forceinline__ void gemm_phase(PG8_LAS unsigned char* lds, const int wave_id, const int K, const int lda, const int ldb, const Sched& S, const Epi& E) {
    int lane_; asm volatile("v_mbcnt_lo_u32_b32 %0, -1, 0\n\tv_mbcnt_hi_u32_b32 %0, -1, %0" : "=v"(lane_));
    const int wid = wave_id, lane = lane_, tid = wid * 64 + lane, wr = wid >> 2, wc = wid & 3, fr = lane & 15, fq = lane >> 4;
    const int nt = K / BK;
    unsigned voffA[2][2], voffN[2][2], voffB[2];
#pragma unroll
    for (int i = 0; i < 2; ++i) { int R, C; stage_rc(tid * 16 + i * 8192, R, C); const int Rb = Epi::PERM ? ((R & ~31) + perm32(R & 31)) : R;
        voffA[0][i] = GATHER ? (unsigned)C * 2u : (unsigned)(R * lda + C) * 2u; voffA[1][i] = voffA[0][i]; voffN[0][i] = 0; voffN[1][i] = 0; voffB[i] = (unsigned)(Rb * ldb + C) * 2u; }
    const unsigned kstep = (unsigned)(BK * 2);
    const unsigned hstepA = GATHER ? 0u : (unsigned)(HALF * lda * 2);
    const unsigned hstepB = (unsigned)(HALF * ldb * 2);
    const __amdgpu_buffer_rsrc_t rsrcA = __builtin_amdgcn_make_buffer_rsrc((void*)S.a_root(), 0, 0xFFFFFFFF, 0x00020000), rsrcB = __builtin_amdgcn_make_buffer_rsrc((void*)S.b_root(), 0, 0xFFFFFFFF, 0x00020000);
    const __amdgpu_buffer_rsrc_t rsrcL = __builtin_amdgcn_make_buffer_rsrc((void*)S.list_root(), 0, 0xFFFFFFFF, 0x00020000);
    const unsigned ldsw = (unsigned)wid * 1024u;
    const int aoff = lds_byte(wr * 64 + fr, fq * 8), boff = lds_byte(wc * 32 + fr, fq * 8);
#define PG8_SA(b, h) (((b) * 2 + (h)) * HTB)
#define PG8_SB(b, h) ((4 + (b) * 2 + (h)) * HTB)
#define PG8_STAGE_B(bufoff, soff) do { _Pragma("unroll") for (int _i = 0; _i < 2; ++_i) \
        __builtin_amdgcn_raw_ptr_buffer_load_lds(rsrcB, (PG8_LAS unsigned*)(lds + (bufoff) + ldsw + _i * 8192), 16, voffB[_i], (soff), 0, 0); } while (0)
#define PG8_STAGE_A(bufoff, soff, h) do { _Pragma("unroll") for (int _i = 0; _i < 2; ++_i) \
        __builtin_amdgcn_raw_ptr_buffer_load_lds(rsrcA, (PG8_LAS unsigned*)(lds + (bufoff) + ldsw + _i * 8192), 16, voffA[GATHER ? (h) : 0][_i], (soff) + (h) * hstepA, 0, 0); } while (0)
#define PG8_LDA(dst, b, h) do { _Pragma("unroll") for (int m = 0; m < 4; ++m) _Pragma("unroll") for (int k = 0; k < 2; ++k) dst[m][k] = *(const PG8_LAS bf16x8*)(lds + PG8_SA(b, h) + aoff + m * 2048 + k * 1024); } while (0)
#define PG8_LDB(dst, b, h) do { _Pragma("unroll") for (int n = 0; n < 2; ++n) _Pragma("unroll") for (int k = 0; k < 2; ++k) dst[n][k] = *(const PG8_LAS bf16x8*)(lds + PG8_SB(b, h) + boff + n * 2048 + k * 1024); } while (0)
#define PG8_CAT(x) (__builtin_shufflevector(__builtin_bit_cast(i32x4, x[0]), __builtin_bit_cast(i32x4, x[1]), 0, 1, 2, 3, 4, 5, 6, 7))
#define PG8_MMA(ai, bj, At, Bt) do { __builtin_amdgcn_s_setprio(1); _Pragma("unroll") for (int m = 0; m < 4; ++m) _Pragma("unroll") for (int n = 0; n < 2; ++n) { \
        if constexpr (FP8) acc[ai][bj][m][n] = __builtin_amdgcn_mfma_scale_f32_16x16x128_f8f6f4(PG8_CAT(Bt[n]), PG8_CAT(At[m]), acc[ai][bj][m][n], 0, 0, 0, 0x7a7a7a7a  , 0, 0x7f7f7f7f); \
        else { _Pragma("unroll") for (int k = 0; k < 2; ++k) acc[ai][bj][m][n] = __builtin_amdgcn_mfma_f32_16x16x32_bf16(Bt[n][k], At[m][k], acc[ai][bj][m][n], 0, 0, 0); } } __builtin_amdgcn_s_setprio(0); } while (0)
#define PG8_WAIT_V(n) asm volatile("s_waitcnt vmcnt(" #n ")" ::: "memory")
#define PG8_WAIT_L(n) asm volatile("s_waitcnt lgkmcnt(" #n ")" ::: "memory")
#define PG8_BAR __builtin_amdgcn_s_barrier()
#define PG8_SCHED __builtin_amdgcn_sched_barrier(0)
#define PG8_GATHER_OFFS(dst, u) do { _Pragma("unroll") for (int _i = 0; _i < 2; ++_i) { int R_, C_; stage_rc(tid * 16 + _i * 8192, R_, C_); _Pragma("unroll") for (int _h = 0; _h < 2; ++_h) dst[_h][_i] = S.row_off(u, _h * HALF + R_) + (unsigned)C_ * 2u; } } while (0)
#define PG8_GATHER_LDS(dst, par) do { _Pragma("unroll") for (int _i = 0; _i < 2; ++_i) { int R_, C_; stage_rc(tid * 16 + _i * 8192, R_, C_); _Pragma("unroll") for (int _h = 0; _h < 2; ++_h) \
        dst[_h][_i] = S.tok_off(nxt, _h * HALF + R_, tokl[(par) * 256 + _h * HALF + R_]) + (unsigned)C_ * 2u; } } while (0)
    PG8_LAS const int* tokl = (PG8_LAS const int*)(lds + 131072);
    f32x4 mk0 = (f32x4){0.f, 0.f, 0.f, 0.f};
    Unit cur, nxt; int ui = 0;
    if (!S.next(0, cur)) return;
    f32x4 acc[2][2][4][2];
#pragma unroll
    for (int a = 0; a < 2; ++a)
#pragma unroll
        for (int b = 0; b < 2; ++b)
#pragma unroll
            for (int m = 0; m < 4; ++m)
#pragma unroll
                for (int n = 0; n < 2; ++n) acc[a][b][m][n] = (f32x4){0.f, 0.f, 0.f, 0.f};
    bf16x8 At[4][2], B0[2][2], B1[2][2];
    unsigned cA = (unsigned)(S.a_base(cur) - (const char*)S.a_root()), cB = (unsigned)(S.b_base(cur) - (const char*)S.b_root());
    if constexpr (GATHER) {
        if (S.gathered()) { int raw_[2][2];
#pragma unroll
            for (int _i = 0; _i < 2; ++_i) { int R_, C_; stage_rc(tid * 16 + _i * 8192, R_, C_);
#pragma unroll
                for (int _h = 0; _h < 2; ++_h) raw_[_h][_i] = S.list_root()[(S.list_off(cur) >> 2) + _h * HALF + R_]; }
#pragma unroll
            for (int _i = 0; _i < 2; ++_i) { int R_, C_; stage_rc(tid * 16 + _i * 8192, R_, C_);
#pragma unroll
                for (int _h = 0; _h < 2; ++_h) voffA[_h][_i] = S.tok_off(cur, _h * HALF + R_, raw_[_h][_i]) + (unsigned)C_ * 2u; } }
        else { PG8_GATHER_OFFS(voffA, cur); } }
    if constexpr (SP2) {
        PG8_STAGE_B(PG8_SB(0, 0), cB); PG8_STAGE_B(PG8_SB(0, 1), cB + hstepB); PG8_STAGE_A(PG8_SA(0, 0), cA, 0); PG8_STAGE_A(PG8_SA(0, 1), cA, 1);
        if (wr == 1) PG8_BAR;
        PG8_WAIT_V(2); PG8_BAR;
        PG8_STAGE_B(PG8_SB(1, 0), cB + kstep); PG8_STAGE_A(PG8_SA(1, 0), cA + kstep, 0); PG8_STAGE_B(PG8_SB(1, 1), cB + hstepB + kstep);
        PG8_WAIT_V(6); PG8_BAR;
    } else {
        PG8_STAGE_B(PG8_SB(0, 0), cB); PG8_STAGE_A(PG8_SA(0, 0), cA, 0); PG8_STAGE_B(PG8_SB(0, 1), cB + hstepB); PG8_STAGE_A(PG8_SA(0, 1), cA, 1);
        if (wr == 1) PG8_BAR;
        PG8_WAIT_V(4); PG8_BAR;
        PG8_STAGE_B(PG8_SB(1, 0), cB + kstep); PG8_STAGE_A(PG8_SA(1, 0), cA + kstep, 0); PG8_STAGE_B(PG8_SB(1, 1), cB + hstepB + kstep);
        PG8_WAIT_V(6); PG8_BAR;
    }
    for (;;) {
        const bool has_next = S.next(ui + 1, nxt);
        const unsigned nA = has_next ? (unsigned)(S.a_base(nxt) - (const char*)S.a_root()) : cA, nB = has_next ? (unsigned)(S.b_base(nxt) - (const char*)S.b_root()) : cB;
#pragma unroll 1
        for (int t = 0; t < nt; t += 2) {
            const bool last = (t == nt - 2);
            const unsigned a1 = cA + (unsigned)(t + 1) * kstep;
            const unsigned a2 = last ? nA : cA + (unsigned)(t + 2) * kstep, b2 = last ? nB : cB + (unsigned)(t + 2) * kstep;
            const unsigned a3 = a2 + kstep, b3 = b2 + kstep;
            if constexpr (Epi::PREFETCH) { if (t == 2) E.pf_dma(cur, wid, lane); }
            if constexpr (Epi::MIDK) {
                if (t == 0) mk0 = E.midk_load(cur, tid);
                if (t == 2) E.midk_park(mk0, tid);
                if (E.midk_at(t)) E.midk(acc, t, wr, fr); }
            if constexpr (GATHER == 1) {
                if (has_next) { if (S.gathered()) { if (t == 0 && wid < 4) __builtin_amdgcn_raw_ptr_buffer_load_lds(rsrcL, (PG8_LAS unsigned*)(lds + 131072 + ((ui + 1) & 1) * 1024 + wid * 256), 4, (unsigned)lane * 4u, S.list_off(nxt) + (unsigned)(wid * 256), 0, 0);
                                                    if (last) { PG8_GATHER_LDS(voffN, (ui + 1) & 1); } }
                                else if (last) { PG8_GATHER_OFFS(voffN, nxt); } } }
            if constexpr (SP2) {
            PG8_LDB(B0, 0, 0); PG8_LDB(B1, 0, 1); PG8_SCHED; PG8_LDA(At, 0, 0); PG8_STAGE_A(PG8_SA(1, 1), a1, 1);
            PG8_WAIT_V(8); PG8_WAIT_L(0); PG8_BAR; PG8_MMA(0, 0, At, B0); PG8_MMA(0, 1, At, B1); PG8_BAR; PG8_SCHED;
            if constexpr (GATHER == 1) { if (last && has_next) {
#pragma unroll
                for (int _h = 0; _h < 2; ++_h)
#pragma unroll
                    for (int _i = 0; _i < 2; ++_i) voffA[_h][_i] = voffN[_h][_i]; } }
            if constexpr (GATHER == 2) { if (last && has_next) { PG8_GATHER_OFFS(voffA, nxt); } }
            PG8_LDA(At, 0, 1); PG8_STAGE_B(PG8_SB(0, 0), b2); PG8_STAGE_B(PG8_SB(0, 1), b2 + hstepB); PG8_STAGE_A(PG8_SA(0, 0), a2, 0);
            PG8_WAIT_V(8); PG8_WAIT_L(0); PG8_BAR; PG8_MMA(1, 0, At, B0); PG8_MMA(1, 1, At, B1); PG8_BAR; PG8_SCHED;
            PG8_LDB(B0, 1, 0); PG8_LDB(B1, 1, 1); PG8_SCHED; PG8_LDA(At, 1, 0); PG8_STAGE_A(PG8_SA(0, 1), a2, 1);
            PG8_WAIT_V(8); PG8_WAIT_L(0); PG8_BAR; PG8_MMA(0, 0, At, B0); PG8_MMA(0, 1, At, B1); PG8_BAR; PG8_SCHED;
            PG8_LDA(At, 1, 1); PG8_STAGE_B(PG8_SB(1, 0), b3); PG8_STAGE_B(PG8_SB(1, 1), b3 + hstepB); PG8_STAGE_A(PG8_SA(1, 0), a3, 0);
            PG8_WAIT_V(8); PG8_WAIT_L(0); PG8_BAR; PG8_MMA(1, 0, At, B0); PG8_MMA(1, 1, At, B1); PG8_BAR; PG8_SCHED;
            } else {
            PG8_LDB(B0, 0, 0); PG8_SCHED; PG8_LDA(At, 0, 0); PG8_STAGE_A(PG8_SA(1, 1), a1, 1);
            PG8_WAIT_L(8); PG8_BAR; PG8_WAIT_L(0); PG8_MMA(0, 0, At, B0); PG8_BAR; PG8_SCHED;
            if constexpr (GATHER == 1) { if (last && has_next) {
#pragma unroll
                for (int _h = 0; _h < 2; ++_h)
#pragma unroll
                    for (int _i = 0; _i < 2; ++_i) voffA[_h][_i] = voffN[_h][_i]; } }
            if constexpr (GATHER == 2) { if (last && has_next) { PG8_GATHER_OFFS(voffA, nxt); } }
            PG8_LDB(B1, 0, 1); PG8_STAGE_B(PG8_SB(0, 0), b2);
            PG8_BAR; PG8_WAIT_L(0); PG8_MMA(0, 1, At, B1); PG8_BAR;
            PG8_LDA(At, 0, 1); PG8_STAGE_A(PG8_SA(0, 0), a2, 0);
            PG8_BAR; PG8_WAIT_L(0); PG8_MMA(1, 0, At, B0); PG8_BAR; PG8_SCHED;
            PG8_STAGE_B(PG8_SB(0, 1), b2 + hstepB);
            PG8_WAIT_V(6); PG8_BAR; PG8_MMA(1, 1, At, B1); PG8_BAR;
            PG8_LDB(B0, 1, 0); PG8_SCHED; PG8_LDA(At, 1, 0); PG8_STAGE_A(PG8_SA(0, 1), a2, 1);
            PG8_WAIT_L(8); PG8_BAR; PG8_WAIT_L(0); PG8_MMA(0, 0, At, B0); PG8_BAR; PG8_SCHED;
            PG8_LDB(B1, 1, 1); PG8_STAGE_B(PG8_SB(1, 0), b3);
            PG8_BAR; PG8_WAIT_L(0); PG8_MMA(0, 1, At, B1); PG8_BAR;
            PG8_LDA(At, 1, 1); PG8_STAGE_A(PG8_SA(1, 0), a3, 0);
            PG8_BAR; PG8_WAIT_L(0); PG8_MMA(1, 0, At, B0); PG8_BAR; PG8_SCHED;
            PG8_STAGE_B(PG8_SB(1, 1), b3 + hstepB);
            PG8_WAIT_V(6); PG8_BAR; PG8_MMA(1, 1, At, B1); PG8_BAR;
            }
        }
        if constexpr (ALIGN_EPI) { if (wr == 0) PG8_BAR; }
        E(acc, cur, wr, wc, fr, fq);
        if (!has_next) break;
#pragma unroll
        for (int a = 0; a < 2; ++a)
#pragma unroll
            for (int b = 0; b < 2; ++b)
#pragma unroll
                for (int m = 0; m < 4; ++m)
#pragma unroll
                    for (int n = 0; n < 2; ++n) acc[a][b][m][n] = (f32x4){0.f, 0.f, 0.f, 0.f};
        cur = nxt; cA = nA; cB = nB; ++ui;
        if constexpr (ALIGN_EPI) { if (wr == 1) PG8_BAR; }
    }
    PG8_WAIT_V(0);
    if constexpr (!ALIGN_EPI) { if (wr == 0) PG8_BAR; }
    PG8_BAR;
#undef PG8_SA
#undef PG8_SB
#undef PG8_STAGE_A
#undef PG8_STAGE_B
#undef PG8_LDA
#undef PG8_LDB
#undef PG8_MMA
#undef PG8_CAT
#undef PG8_WAIT_V
#undef PG8_WAIT_L
#undef PG8_BAR
#undef PG8_SCHED
#undef PG8_GATHER_OFFS
#undef PG8_GATHER_LDS
}
}
namespace mk {
constexpr int NWAVES = 8;
constexpr int T = 16384, D = 1024, SEQ = 4096, NB = 4, NE = 32, NH = 32;
constexpr int DSSD = 2048, DCONV = 3072, NPROJ = 8224;
constexpr float EPS = 1e-5f;
constexpr size_t MiB = 1u << 20;
constexpr size_t WS_CTL = 0, CTL_ZERO_BYTES = 256 * 1024;
constexpr size_t WS_MOD = 128 * 1024;
constexpr size_t WS_CD = 1 * MiB;
constexpr size_t WS_GATE = 1 * MiB + 256 * 1024;
constexpr size_t WS_SSQ = 1 * MiB + 512 * 1024;
constexpr size_t WS_DT = 2 * MiB;
constexpr size_t WS_LIST = 4 * MiB;
constexpr size_t WS_WDT = 6 * MiB;
constexpr size_t WS_WPOOL = 6 * MiB + 512 * 1024;
constexpr size_t WS_WIN = 8 * MiB, WS_WSSD = 24 * MiB, WS_WPO = 28 * MiB, WS_WOUT = 30 * MiB, WS_WGU = 32 * MiB, WS_WDN = 160 * MiB;
constexpr size_t WS_H = 224 * MiB, WS_Z = 256 * MiB, WS_XBC = 320 * MiB, WS_U = 416 * MiB, WS_GATES = 448 * MiB, WS_STATES = 512 * MiB, WS_Y = 576 * MiB;
constexpr size_t WS_P = 640 * MiB, WS_P2 = 672 * MiB, WS_M1 = 704 * MiB, WS_MERGED = 736 * MiB, WS_END = 768 * MiB;
constexpr size_t WS_GATEL = 640 * MiB;
constexpr size_t WS_XC = 768 * MiB;
constexpr size_t WS_ACT = 256 * MiB, WS_YB = 416 * MiB;
constexpr int ACT_ROWS = 73728;
constexpr int CW_TMO = 0, CW_CODE = 1, CW_GCNT = 1024, CW_BAR = 4096;
constexpr int RING_BYTES = 143360;
constexpr int LDSCTL_OFF = RING_BYTES, MISC_OFF = LDSCTL_OFF + 64;
constexpr int LDS_BYTES = 147456;

#define GAS __attribute__((address_space(1)))
#define LAS __attribute__((address_space(3)))
typedef unsigned short bf16;
typedef unsigned v4u __attribute__((ext_vector_type(4)));
typedef unsigned v2u __attribute__((ext_vector_type(2)));
typedef float f32x4 __attribute__((ext_vector_type(4)));
typedef float f32x16 __attribute__((ext_vector_type(16)));
typedef short bf16x8 __attribute__((ext_vector_type(8)));
typedef GAS unsigned gu32;
#define RLX_AGENT __ATOMIC_RELAXED, __HIP_MEMORY_SCOPE_AGENT
#define LDS_WAIT() asm volatile("s_waitcnt lgkmcnt(0)" ::: "memory")
#define VM_WAIT() asm volatile("s_waitcnt vmcnt(0)" ::: "memory")
#ifdef MK_SYNCBAR
#define LDS_BAR() __syncthreads()
#else
#define LDS_BAR() do { asm volatile("s_waitcnt lgkmcnt(0)" ::: "memory"); __builtin_amdgcn_s_barrier(); asm volatile("" ::: "memory"); } while (0)
#endif
__device__ __forceinline__ unsigned f2bf(float f) { unsigned u = __builtin_bit_cast(unsigned, f); return (u + 0x7fffu + ((u >> 16) & 1u)) >> 16; }
typedef float f32x2_t __attribute__((ext_vector_type(2))); typedef __bf16 bf16x2_t __attribute__((ext_vector_type(2)));
__device__ __forceinline__ unsigned pk2(float lo, float hi) { const f32x2_t v = {lo, hi}; const bf16x2_t b = __builtin_convertvector(v, bf16x2_t); return __builtin_bit_cast(unsigned, b); }
__device__ __forceinline__ float bflo(unsigned w) { return __builtin_bit_cast(float, w << 16); }
__device__ __forceinline__ float bfhi(unsigned w) { return __builtin_bit_cast(float, w & 0xffff0000u); }
__device__ __forceinline__ float bf2f(bf16 h) { return __builtin_bit_cast(float, (unsigned)h << 16); }
__device__ __forceinline__ float sigm(float x) { return __builtin_amdgcn_rcpf(1.f + __builtin_amdgcn_exp2f(x * -1.4426950408889634f)); }
__device__ __forceinline__ float silu(float x) { return x * sigm(x); }
template <int CTRL> __device__ __forceinline__ float dpp_f(float v) { return __builtin_bit_cast(float, __builtin_amdgcn_update_dpp(0, __builtin_bit_cast(int, v), CTRL, 0xF, 0xF, true)); }
template <int CTRL> __device__ __forceinline__ int dpp_i(int v) { return __builtin_amdgcn_update_dpp(0, v, CTRL, 0xF, 0xF, true); }
#define DPP_XOR1 0xB1
#define DPP_XOR2 0x4E
#define DPP_HMIRROR 0x141
#define DPP_MIRROR 0x140
#define DPP_ROR(n) (0x120 + (n))
template <int N> __device__ __forceinline__ float dpp_shr_f(float v) { return __builtin_bit_cast(float, __builtin_amdgcn_update_dpp(0, __builtin_bit_cast(int, v), 0x110 + N, 0xF, 0xF, false)); }
__device__ __forceinline__ float wave_incl_scan(float v, int lane) {
    v += dpp_shr_f<1>(v); v += dpp_shr_f<2>(v); v += dpp_shr_f<4>(v); v += dpp_shr_f<8>(v);
    const float t0 = __builtin_bit_cast(float, __builtin_amdgcn_readlane(__builtin_bit_cast(int, v), 15)), t1 = __builtin_bit_cast(float, __builtin_amdgcn_readlane(__builtin_bit_cast(int, v), 31)),
                t2 = __builtin_bit_cast(float, __builtin_amdgcn_readlane(__builtin_bit_cast(int, v), 47));
    const int row = lane >> 4;
    return v + ((row >= 1 ? t0 : 0.f) + (row >= 2 ? t1 : 0.f) + (row >= 3 ? t2 : 0.f));
}
__device__ __forceinline__ float wave_sum(float v) {
    v += dpp_f<DPP_XOR1>(v); v += dpp_f<DPP_XOR2>(v); v += dpp_f<DPP_HMIRROR>(v); v += dpp_f<DPP_MIRROR>(v);
    { const unsigned u = __builtin_bit_cast(unsigned, v); const auto r = __builtin_amdgcn_permlane16_swap(u, u, false, false); v = __builtin_bit_cast(float, (unsigned)r[0]) + __builtin_bit_cast(float, (unsigned)r[1]); }
    { const unsigned u = __builtin_bit_cast(unsigned, v); const auto r = __builtin_amdgcn_permlane32_swap(u, u, false, false); v = __builtin_bit_cast(float, (unsigned)r[0]) + __builtin_bit_cast(float, (unsigned)r[1]); }
    return v;
}

#define XB_TMO      128
#define XB_XCNT(j)  (256  + 64 * (j))
#define XB_XSUB(j)  (1280 + 64 * (j))
#define XB_XGEN(j)  (2304 + 64 * (j))
#define XB_TOP      3328
#define XB_TOPGEN   3392
#define XCD_BAR_WORDS 3456
#define XB_SPIN_CAP (1u << 18)
__device__ __forceinline__ unsigned xb_ld(unsigned* p)              { return __hip_atomic_load(p, __ATOMIC_RELAXED, __HIP_MEMORY_SCOPE_AGENT); }
__device__ __forceinline__ unsigned xb_add(unsigned* p, unsigned v) { return __hip_atomic_fetch_add(p, v, __ATOMIC_RELAXED, __HIP_MEMORY_SCOPE_AGENT); }
__device__ __forceinline__ unsigned xb_xcc_id() { return (unsigned)__builtin_amdgcn_s_getreg((3 << 11) | 20) & 0xFu; }
#define XB_SPIN(cond, bar) do { unsigned _sp = 0; while (cond) { __builtin_amdgcn_s_sleep(1); \
    if ((++_sp & 255u) == 0u) { if (xb_ld(&(bar)[XB_TMO])) break; if (_sp > XB_SPIN_CAP) { atomicAdd(&(bar)[XB_TMO], 1u); break; } } } } while (0)
struct XcdBarrier { unsigned* bar; unsigned x; volatile LAS unsigned* st; };
__device__ __forceinline__ XcdBarrier xcd_barrier_post(unsigned* bar, volatile LAS unsigned* st) {
    XcdBarrier b; b.bar = bar; b.x = xb_xcc_id(); b.st = st;
    if (threadIdx.x == 0) (void)xb_add(&bar[XB_XCNT(b.x)], 1u);
    return b;
}
__device__ __forceinline__ void xcd_barrier_complete(unsigned* bar, unsigned x, unsigned& nloc, unsigned& nx) {
    const unsigned G = gridDim.x * gridDim.y * gridDim.z;
    unsigned sum, cnt, mine, sp = 0u;
    for (;;) {
        sum = 0u; cnt = 0u; mine = 0u;
#pragma unroll
        for (unsigned j = 0; j < 16; ++j) { const unsigned c = xb_ld(&bar[XB_XCNT(j)]); sum += c; cnt += (c > 0u) ? 1u : 0u; mine = (j == x) ? c : mine; }
        if (sum == G) break;
        __builtin_amdgcn_s_sleep(1);
        if ((++sp & 255u) == 0u) { if (xb_ld(&bar[XB_TMO])) break; if (sp > XB_SPIN_CAP) { atomicAdd(&bar[XB_TMO], 1u); break; } }
    }
    nloc = mine > 0u ? mine : 1u; nx = cnt > 0u ? cnt : 1u;
}
__device__ __forceinline__ void xcd_barrier(const XcdBarrier& b, const int wave) {
    asm volatile("s_waitcnt vmcnt(0)" ::: "memory");
    __syncthreads();
    int lane_; asm volatile("v_mbcnt_lo_u32_b32 %0, -1, 0\n\tv_mbcnt_hi_u32_b32 %0, -1, %0" : "=v"(lane_));
    if (wave == 0 && lane_ == 0) {
        unsigned* bar = b.bar;
        __builtin_amdgcn_s_waitcnt(0);
        unsigned nloc = b.st[0], nx = b.st[1];
        if (nloc == 0u) { xcd_barrier_complete(bar, b.x, nloc, nx); b.st[0] = nloc; b.st[1] = nx; }
        const unsigned old = xb_add(&bar[XB_XSUB(b.x)], 1u);
        const unsigned gen = old / nloc;
        if (old + 1u == (gen + 1u) * nloc) {
            __builtin_amdgcn_fence(__ATOMIC_RELEASE, "agent");
            asm volatile("s_waitcnt vmcnt(0)" ::: "memory");
            (void)xb_add(&bar[XB_TOP], 1u);
        }
        const unsigned target = (gen + 1u) * nx;
        XB_SPIN(xb_ld(&bar[XB_TOP]) < target, bar);
        __builtin_amdgcn_fence(__ATOMIC_ACQUIRE, "agent");
        asm volatile("s_waitcnt vmcnt(0)" ::: "memory");
    }
    __syncthreads();
}
}
namespace mk {
struct Frame {
    LAS unsigned char* lds; volatile LAS unsigned* MISC; gu32* ctl; unsigned char* ws; float* out; const float* const* in;
    int tid, lane, wave, vcu, G;
};
__device__ __forceinline__ void refresh_ids(Frame& F) { int l; asm volatile("v_mbcnt_lo_u32_b32 %0, -1, 0\n\tv_mbcnt_hi_u32_b32 %0, -1, %0" : "=v"(l)); F.lane = l; F.tid = F.wave * 64 + l; }
enum { I_X = 0, I_C, I_WADA, I_BADA, I_NMW, I_WIN, I_CONVW, I_CONVB, I_DTB, I_ALOG, I_DSKIP, I_SNW, I_WSSD, I_WPOOL, I_PSCALE, I_WPO, I_WOUT, I_NFW, I_WR, I_BR, I_WGU, I_BGU, I_WDN, I_BDN, I_NFINAL };

__device__ __forceinline__ void p0_tile(const float* src, int ldsrc, int srccol0, int k0, bf16* dst, int lddst, int dstrow0, int nvalid, LAS float* scr, int lane) {
    const int col = (lane & 15) * 4;
    f32x4 tv[16];
#pragma unroll
    for (int i = 0; i < 16; ++i) { const int kk = 4 * i + (lane >> 4); tv[i] = (f32x4){0.f, 0.f, 0.f, 0.f}; if (col < nvalid) tv[i] = __builtin_nontemporal_load((const f32x4*)(src + (size_t)(k0 + kk) * ldsrc + srccol0 + col)); }
#pragma unroll
    for (int i = 0; i < 16; ++i) { const int kk = 4 * i + (lane >> 4); LAS float* s = scr + kk * 65 + col; s[0] = tv[i].x; s[1] = tv[i].y; s[2] = tv[i].z; s[3] = tv[i].w; }
    LDS_WAIT(); asm volatile("" ::: "memory");
    const int c = lane & 7;
#pragma unroll
    for (int j = 0; j < 8; ++j) { const int n = (lane >> 3) + 8 * j; const LAS float* s = scr + (8 * c) * 65 + n;
        v4u o; o.x = pk2(s[0 * 65], s[1 * 65]); o.y = pk2(s[2 * 65], s[3 * 65]); o.z = pk2(s[4 * 65], s[5 * 65]); o.w = pk2(s[6 * 65], s[7 * 65]);
        if (n < nvalid) *(v4u*)(dst + (size_t)(dstrow0 + n) * lddst + k0 + 8 * c) = o; }
    LDS_WAIT(); asm volatile("" ::: "memory");
}
__device__ __forceinline__ void p0_tile8(const float* src, int ldsrc, int srccol0, int k0, unsigned char* dst, int lddst, int dstrow0, float scale, LAS float* scr, int lane) {
    const int col = (lane & 15) * 4;
    f32x4 tv[16];
#pragma unroll
    for (int i = 0; i < 16; ++i) { const int kk = 4 * i + (lane >> 4); tv[i] = *(const f32x4*)(src + (size_t)(k0 + kk) * ldsrc + srccol0 + col); }
#pragma unroll
    for (int i = 0; i < 16; ++i) { const int kk = 4 * i + (lane >> 4); LAS float* s = scr + kk * 65 + col; s[0] = tv[i].x; s[1] = tv[i].y; s[2] = tv[i].z; s[3] = tv[i].w; }
    LDS_WAIT(); asm volatile("" ::: "memory");
    const int c = lane & 7;
#pragma unroll
    for (int j = 0; j < 8; ++j) { const int n = (lane >> 3) + 8 * j; const LAS float* s = scr + (8 * c) * 65 + n;
        int w0 = 0, w1 = 0; w0 = __builtin_amdgcn_cvt_pk_fp8_f32(s[0 * 65] * scale, s[1 * 65] * scale, w0, false); w0 = __builtin_amdgcn_cvt_pk_fp8_f32(s[2 * 65] * scale, s[3 * 65] * scale, w0, true);
        w1 = __builtin_amdgcn_cvt_pk_fp8_f32(s[4 * 65] * scale, s[5 * 65] * scale, w1, false); w1 = __builtin_amdgcn_cvt_pk_fp8_f32(s[6 * 65] * scale, s[7 * 65] * scale, w1, true);
        *(v2u*)(dst + (size_t)(dstrow0 + n) * lddst + k0 + 8 * c) = (v2u){(unsigned)w0, (unsigned)w1}; }
    LDS_WAIT(); asm volatile("" ::: "memory");
}
struct P0Desc { const float* src; unsigned char* dst; int ldsrc, pad; };
__device__ __forceinline__ P0Desc p0_desc_moe(Frame& F, int r) {
    constexpr int N_GU = 16384; P0Desc d; d.pad = 0;
    if (r < N_GU) { const int e = r >> 9, q = r & 511, rb = q >> 4, kb = q & 15; const int rho = rb * 64, pn = rho >> 8, rr = rho & 255;
        const int sc = rr < 128 ? 128 * pn + rr : 1024 + 128 * pn + (rr - 128);
        d.src = F.in[I_WGU] + (size_t)e * 1024 * 2048 + (size_t)(kb * 64) * 2048 + sc; d.ldsrc = 2048; d.dst = F.ws + WS_WGU + (size_t)e * 2048 * 1024 + (size_t)rho * 1024 + kb * 64; return d; }
    r -= N_GU; { const int e = r >> 8, q = r & 255, rb = q >> 4, kb = q & 15;
        d.src = F.in[I_WDN] + (size_t)e * 1024 * 1024 + (size_t)(kb * 64) * 1024 + rb * 64; d.ldsrc = 1024; d.dst = F.ws + WS_WDN + (size_t)e * 1024 * 1024 + (size_t)(rb * 64) * 1024 + kb * 64; }
    return d;
}
__device__ __forceinline__ void p0_load(const P0Desc& d, f32x4 (&tv)[16], int lane) {
    const int col = (lane & 15) * 4;
#pragma unroll
    for (int i = 0; i < 16; ++i) { const int kk = 4 * i + (lane >> 4); tv[i] = __builtin_nontemporal_load((const f32x4*)(d.src + (size_t)kk * d.ldsrc + col)); }
}
__device__ __forceinline__ void p0_finish8(const P0Desc& d, const f32x4 (&tv)[16], LAS float* scr, int lane) {
    const int col = (lane & 15) * 4;
#pragma unroll
    for (int i = 0; i < 16; ++i) { const int kk = 4 * i + (lane >> 4); LAS float* s = scr + kk * 65 + col; s[0] = tv[i].x; s[1] = tv[i].y; s[2] = tv[i].z; s[3] = tv[i].w; }
    LDS_WAIT(); asm volatile("" ::: "memory");
    const int c = lane & 7;
#pragma unroll
    for (int j = 0; j < 8; ++j) { const int n = (lane >> 3) + 8 * j; const LAS float* s = scr + (8 * c) * 65 + n;
        int w0 = 0, w1 = 0; w0 = __builtin_amdgcn_cvt_pk_fp8_f32(s[0 * 65] * 32.f, s[1 * 65] * 32.f, w0, false); w0 = __builtin_amdgcn_cvt_pk_fp8_f32(s[2 * 65] * 32.f, s[3 * 65] * 32.f, w0, true);
        w1 = __builtin_amdgcn_cvt_pk_fp8_f32(s[4 * 65] * 32.f, s[5 * 65] * 32.f, w1, false); w1 = __builtin_amdgcn_cvt_pk_fp8_f32(s[6 * 65] * 32.f, s[7 * 65] * 32.f, w1, true);
        __builtin_nontemporal_store((v2u){(unsigned)w0, (unsigned)w1}, (v2u*)(d.dst + (size_t)n * 1024 + 8 * c)); }
    LDS_WAIT(); asm volatile("" ::: "memory");
}
__device__ __forceinline__ void p0_moe_tiles(Frame& F, const int k0, const int k1) {
    constexpr int N_MOE = 16384 + 8192;
    LAS float* scr = (LAS float*)(F.lds + F.wave * 16896);
    const int gw = F.vcu * NWAVES + F.wave, NGW = F.G * NWAVES;
    int k = k0; int it = gw + k * NGW;
    if (k >= k1 || it >= N_MOE) return;
    P0Desc d0 = p0_desc_moe(F, it); f32x4 tv0[16]; p0_load(d0, tv0, F.lane);
#pragma unroll 1
    for (;;) {
        const int it1 = it + NGW; const bool has1 = (k + 1 < k1) && (it1 < N_MOE); P0Desc d1 = d0; f32x4 tv1[16];
#pragma unroll
        for (int i = 0; i < 16; ++i) tv1[i] = tv0[i];
        if (has1) { d1 = p0_desc_moe(F, it1); p0_load(d1, tv1, F.lane); }
        asm volatile("" ::: "memory"); __builtin_amdgcn_sched_barrier(0);
        p0_finish8(d0, tv0, scr, F.lane);
        if (!has1) break;
        d0 = d1; it = it1; ++k;
#pragma unroll
        for (int i = 0; i < 16; ++i) tv0[i] = tv1[i];
    }
}
__device__ __forceinline__ void p0_prologue(Frame& F, const int var, const int part) {
    LAS float* scr = (LAS float*)(F.lds + F.wave * 16896);
    const int gw = F.vcu * NWAVES + F.wave, NGW = F.G * NWAVES;
    bf16* WIN_T = (bf16*)(F.ws + WS_WIN); bf16* WDT_T = (bf16*)(F.ws + WS_WDT); bf16* WSSD_T = (bf16*)(F.ws + WS_WSSD); bf16* WPO_T = (bf16*)(F.ws + WS_WPO);
    bf16* WOUT_T = (bf16*)(F.ws + WS_WOUT); bf16* WPOOL_T = (bf16*)(F.ws + WS_WPOOL); bf16* WGU_T = (bf16*)(F.ws + WS_WGU); bf16* WDN_T = (bf16*)(F.ws + WS_WDN);
    constexpr int N_IN = 2048, N_DT = 16, N_SSD = 512, N_PO = 256, N_OUT = 256, N_POOL = 64, N_GU = 16384, N_DN = 8192;
    constexpr int NITEMS = N_IN + N_DT + N_SSD + N_PO + N_OUT + N_POOL + N_GU + N_DN;
    for (int it = gw; it < ((var & 1) ? NITEMS : 0); it += NGW) {
        int r = it;
        { const bool is_dt = (r >= N_GU + N_DN + N_IN) && (r < N_GU + N_DN + N_IN + N_DT); if (is_dt != (part == 0)) continue; }
        if (part == 1 && r < N_GU + N_DN) continue;
        if (r < N_GU) { const int e = r >> 9, q = r & 511, rb = q >> 4, kb = q & 15; const int rho = rb * 64, pn = rho >> 8, rr = rho & 255;
            const int sc = rr < 128 ? 128 * pn + rr : 1024 + 128 * pn + (rr - 128);
            p0_tile8(F.in[I_WGU] + (size_t)e * 1024 * 2048, 2048, sc, kb * 64, (unsigned char*)WGU_T + (size_t)e * 2048 * 1024, 1024, rho, 32.f, scr, F.lane); continue; } r -= N_GU;
        if (r < N_DN) { const int e = r >> 8, q = r & 255, rb = q >> 4, kb = q & 15;
            p0_tile8(F.in[I_WDN] + (size_t)e * 1024 * 1024, 1024, rb * 64, kb * 64, (unsigned char*)WDN_T + (size_t)e * 1024 * 1024, 1024, rb * 64, 32.f, scr, F.lane); continue; } r -= N_DN;
        if (r < N_IN) { const int rb = r >> 4, kb = r & 15; const int drow = rb * 64; const int sc = drow + (drow >= 5120 ? 32 : 0);
            p0_tile(F.in[I_WIN], NPROJ, sc, kb * 64, WIN_T, 1024, drow, 64, scr, F.lane); continue; } r -= N_IN;
        if (r < N_DT) { p0_tile(F.in[I_WIN], NPROJ, 5120, r * 64, WDT_T, 1024, 0, 32, scr, F.lane); continue; } r -= N_DT;
        if (r < N_SSD) { const int rb = r >> 5, kb = r & 31; p0_tile(F.in[I_WSSD], 1024, rb * 64, kb * 64, WSSD_T, 2048, rb * 64, 64, scr, F.lane); continue; } r -= N_SSD;
        if (r < N_PO) { const int rb = r >> 4, kb = r & 15; p0_tile(F.in[I_WPO], 1024, rb * 64, kb * 64, WPO_T, 1024, rb * 64, 64, scr, F.lane); continue; } r -= N_PO;
        if (r < N_OUT) { const int rb = r >> 4, kb = r & 15; p0_tile(F.in[I_WOUT], 1024, rb * 64, kb * 64, WOUT_T, 1024, rb * 64, 64, scr, F.lane); continue; } r -= N_OUT;
        { const int g = r >> 4, q = r & 15, rb = q >> 2, kb = q & 3; p0_tile(F.in[I_WPOOL] + (size_t)g * 65536, 256, rb * 64, kb * 64, WPOOL_T, 256, g * 256 + rb * 64, 64, scr, F.lane); }
    }
    if (part != 0) return;
    __syncthreads();
    { float* mod = (float*)(F.ws + WS_MOD); LAS float* red = (LAS float*)F.lds;
      LAS float* scs = (LAS float*)(F.lds + 8192);
      { const float* cc = F.in[I_C];
#pragma unroll
        for (int i = 0; i < 8; ++i) scs[i * 512 + F.tid] = silu(cc[i * 512 + F.tid]); }
      __syncthreads();
      for (int jb = F.vcu; jb < ((var & 2) ? 256 : 0); jb += F.G) {
        const int jj = F.tid & 31, sl = F.tid >> 5, j = jb * 24 + jj; float a0 = 0.f, a1 = 0.f, a2 = 0.f, a3 = 0.f;
        if (jj < 24) { float wv[64];
#pragma unroll
            for (int k = 0; k < 64; ++k) wv[k] = F.in[I_WADA][(size_t)(sl * 64 + k) * 6144 + j];
#pragma unroll
            for (int k = 0; k < 64; ++k) { const int kk = sl * 64 + k; const float w = wv[k];
                a0 += scs[kk] * w; a1 += scs[1024 + kk] * w; a2 += scs[2048 + kk] * w; a3 += scs[3072 + kk] * w; } }
        red[(sl * 4 + 0) * 32 + jj] = a0; red[(sl * 4 + 1) * 32 + jj] = a1; red[(sl * 4 + 2) * 32 + jj] = a2; red[(sl * 4 + 3) * 32 + jj] = a3;
        __syncthreads();
        if (F.tid < 128) { const int b = F.tid >> 5, q = F.tid & 31; if (q < 24) { float s = F.in[I_BADA][jb * 24 + q];
#pragma unroll
                for (int i = 0; i < 16; ++i) s += red[(i * 4 + b) * 32 + q];
                mod[b * 6144 + jb * 24 + q] = s; } }
        __syncthreads();
      } }
}

__device__ __forceinline__ void p1_norm_dt(Frame& F, const int var) {
    constexpr int PITCH = 2064;
    LAS unsigned char* tile = F.lds + F.wave * 16896;
    for (int grp = F.vcu * NWAVES + F.wave; grp < T / 8; grp += F.G * NWAVES) {
    const int t0 = grp * 8, b = t0 / SEQ;
    const float* mod = (const float*)(F.ws + WS_MOD) + b * 6144; bf16* H = (bf16*)(F.ws + WS_H);
    f32x4 wv[4], scv[4], shv[4];
#pragma unroll
    for (int j = 0; j < 4; ++j) { const int col = 4 * F.lane + 256 * j; wv[j] = *(const f32x4*)(F.in[I_NMW] + col); scv[j] = *(const f32x4*)(mod + 1024 + col); shv[j] = *(const f32x4*)(mod + col); }
#pragma unroll 1
    for (int r4 = 0; r4 < 8; r4 += 4) {
      f32x4 xv[4][4];
#pragma unroll
      for (int rr = 0; rr < 4; ++rr)
#pragma unroll
        for (int j = 0; j < 4; ++j) xv[rr][j] = *(const f32x4*)(F.in[I_X] + (size_t)(t0 + r4 + rr) * D + 4 * F.lane + 256 * j);
#pragma unroll
      for (int rr = 0; rr < 4; ++rr) { const int r = r4 + rr;
        f32x4 v[4]; float s = 0.f;
#pragma unroll
        for (int j = 0; j < 4; ++j) { v[j] = xv[rr][j]; s += (v[j].x * v[j].x + v[j].y * v[j].y) + (v[j].z * v[j].z + v[j].w * v[j].w); }
        const float rstd = rsqrtf(wave_sum(s) * (1.f / D) + EPS);
#pragma unroll
        for (int j = 0; j < 4; ++j) { const f32x4 hv = v[j] * rstd * wv[j] * (scv[j] + 1.f) + shv[j];
            v2u o; o.x = pk2(hv.x, hv.y); o.y = pk2(hv.z, hv.w);
            *(v2u*)(H + (size_t)(t0 + r) * D + 4 * F.lane + 256 * j) = o;
            *(LAS v2u*)(tile + r * PITCH + (4 * F.lane + 256 * j) * 2) = o; }
      }
    }
    LDS_WAIT(); asm volatile("" ::: "memory");
    if (!(var & 2)) continue;
    const bf16* WDT_T = (const bf16*)(F.ws + WS_WDT);
    f32x4 acc0 = (f32x4){0.f, 0.f, 0.f, 0.f}, acc1 = acc0; const int fr = F.lane & 15, fq = F.lane >> 4;
#pragma unroll 8
    for (int s = 0; s < 32; ++s) {
        const bf16x8 a = *(const LAS bf16x8*)(tile + (fr & 7) * PITCH + (32 * s + 8 * fq) * 2);
        const bf16x8 b0 = *(const bf16x8*)(WDT_T + (size_t)fr * 1024 + 32 * s + 8 * fq), b1 = *(const bf16x8*)(WDT_T + (size_t)(fr + 16) * 1024 + 32 * s + 8 * fq);
        acc0 = __builtin_amdgcn_mfma_f32_16x16x32_bf16(a, b0, acc0, 0, 0, 0); acc1 = __builtin_amdgcn_mfma_f32_16x16x32_bf16(a, b1, acc1, 0, 0, 0);
    }
    if (fq < 2) { float* DT = (float*)(F.ws + WS_DT); const float db0 = F.in[I_DTB][fr], db1 = F.in[I_DTB][fr + 16];
#pragma unroll
        for (int i = 0; i < 4; ++i) { const int row = t0 + 4 * fq + i; float x0 = acc0[i] + db0, x1 = acc1[i] + db1;
            DT[(size_t)row * 32 + fr] = x0 > 20.f ? x0 : log1pf(__expf(x0)); DT[(size_t)row * 32 + 16 + fr] = x1 > 20.f ? x1 : log1pf(__expf(x1)); } }
    LDS_WAIT();
    }
}

template <int W> __device__ __forceinline__ void pool_item(const bf16* U, bf16* P, int t0, int tt0, int cg) {
    v4u raw[W + 7];
    const __amdgpu_buffer_rsrc_t ru = __builtin_amdgcn_make_buffer_rsrc((void*)U, 0, 0xFFFFFFFF, 0x00020000), rp = __builtin_amdgcn_make_buffer_rsrc((void*)P, 0, 0xFFFFFFFF, 0x00020000);
    const unsigned vo = (unsigned)(t0 * D + cg * 8) * 2u;
#pragma unroll
    for (int r = 0; r < W + 7; ++r) { const int d = r - (W - 1); raw[r] = (v4u){0u, 0u, 0u, 0u}; if (tt0 + d >= 0) raw[r] = __builtin_amdgcn_raw_buffer_load_b128(ru, vo + (unsigned)(d * D * 2), 0, 0); }
    float s[8];
#pragma unroll
    for (int q = 0; q < 8; ++q) s[q] = 0.f;
#pragma unroll
    for (int r = 0; r < W - 1; ++r) { const v4u v = raw[r]; s[0] += bflo(v.x); s[1] += bfhi(v.x); s[2] += bflo(v.y); s[3] += bfhi(v.y); s[4] += bflo(v.z); s[5] += bfhi(v.z); s[6] += bflo(v.w); s[7] += bfhi(v.w); }
#pragma unroll
    for (int i = 0; i < 8; ++i) { const v4u v = raw[W - 1 + i]; const float u[8] = {bflo(v.x), bfhi(v.x), bflo(v.y), bfhi(v.y), bflo(v.z), bfhi(v.z), bflo(v.w), bfhi(v.w)};
#pragma unroll
        for (int q = 0; q < 8; ++q) s[q] += u[q];
        const int tt = tt0 + i; const float inv = 1.f / (float)(tt + 1 < W ? tt + 1 : W);
        v4u o; o.x = pk2(s[0] * inv - u[0], s[1] * inv - u[1]); o.y = pk2(s[2] * inv - u[2], s[3] * inv - u[3]); o.z = pk2(s[4] * inv - u[4], s[5] * inv - u[5]); o.w = pk2(s[6] * inv - u[6], s[7] * inv - u[7]);
        __builtin_amdgcn_raw_buffer_store_b128(o, rp, vo, i * D * 2, 0);
        const v4u z = raw[i]; s[0] -= bflo(z.x); s[1] -= bfhi(z.x); s[2] -= bflo(z.y); s[3] -= bfhi(z.y); s[4] -= bflo(z.z); s[5] -= bfhi(z.z); s[6] -= bflo(z.w); s[7] -= bfhi(z.w); }
}
__device__ __forceinline__ void pool_pass(Frame& F, const bool dry) {
    const bf16* U = (const bf16*)(F.ws + WS_U); bf16* P = (bf16*)(F.ws + (dry ? 864 * MiB : WS_P));
    for (int it = F.vcu * 512 + F.tid; it < 2048 * 128; it += F.G * 512) {
        const int wsel = __builtin_amdgcn_readfirstlane((it >> 6) & 3), cg = wsel * 32 + (it & 31), strip = (it >> 8) * 2 + ((it >> 5) & 1); const int t0 = strip * 8, tt0 = t0 % SEQ;
        if (wsel == 0) pool_item<2>(U, P, t0, tt0, cg); else if (wsel == 1) pool_item<4>(U, P, t0, tt0, cg); else if (wsel == 2) pool_item<8>(U, P, t0, tt0, cg); else pool_item<16>(U, P, t0, tt0, cg);
    }
}

__device__ __forceinline__ int swz16(int row) { return (row ^ (row >> 4)) & 15; }
__device__ __forceinline__ void conv_load(const bf16* XBC, int trow0, bool seq_start, int col, bool active, v4u (&raw)[11]) {
    const __amdgpu_buffer_rsrc_t rs = __builtin_amdgcn_make_buffer_rsrc((void*)XBC, 0, 0xFFFFFFFF, 0x00020000);
    const unsigned voff = (unsigned)(trow0 * DCONV + col) * 2u;
#pragma unroll
    for (int r = 0; r < 11; ++r) { raw[r] = (v4u){0u, 0u, 0u, 0u}; if (active && !(r < 3 && seq_start)) raw[r] = __builtin_amdgcn_raw_buffer_load_b128(rs, voff + (unsigned)((r - 3) * DCONV * 2), 0, 0); }
}
__device__ __forceinline__ void st_item(int unit, int itx, int tid, int& kind, int& strip, int& grp, int& col, int& trow0, bool& seqs) {
    const int hh = unit & 1, g = (unit >> 1) & 3, c = (unit >> 3) & 31, b = unit >> 8;
    if (itx == 0) { kind = 0; strip = tid >> 5; grp = tid & 31; col = g * 512 + hh * 256 + grp * 8; }
    else if (tid < 256) { kind = 1; strip = tid >> 4; grp = tid & 15; col = 2048 + g * 128 + grp * 8; }
    else if (tid < 384) { kind = 2; strip = 8 * hh + ((tid - 256) >> 4); grp = tid & 15; col = 2560 + g * 128 + grp * 8; }
    else { kind = 3; strip = 0; grp = 0; col = 0; }
    trow0 = b * SEQ + c * 128 + strip * 8; seqs = (c == 0 && strip == 0);
}
__device__ __forceinline__ void conv_item(const bf16* XBC, const float* cw, const float* cb, int trow0, bool seq_start, int col, bf16* gdst, const unsigned gvo, const bool do_g, LAS unsigned char* img, const bool do_img, int row0, int chunk, const LAS float* sc, const bool do_sc, const v4u (&raw)[11]) {
    f32x4 wa[4], wb[4];
    const __amdgpu_buffer_rsrc_t rw = __builtin_amdgcn_make_buffer_rsrc((void*)cw, 0, 0xFFFFFFFF, 0x00020000), rb = __builtin_amdgcn_make_buffer_rsrc((void*)cb, 0, 0xFFFFFFFF, 0x00020000);
    const __amdgpu_buffer_rsrc_t rg = __builtin_amdgcn_make_buffer_rsrc((void*)gdst, 0, 0xFFFFFFFF, 0x00020000);
    const unsigned cvo = (unsigned)col * 4u;
#pragma unroll
    for (int k = 0; k < 4; ++k) { wa[k] = __builtin_bit_cast(f32x4, __builtin_amdgcn_raw_buffer_load_b128(rw, cvo, k * DCONV * 4, 0)); wb[k] = __builtin_bit_cast(f32x4, __builtin_amdgcn_raw_buffer_load_b128(rw, cvo + 16u, k * DCONV * 4, 0)); }
    const f32x4 ba = __builtin_bit_cast(f32x4, __builtin_amdgcn_raw_buffer_load_b128(rb, cvo, 0, 0)), bbv = __builtin_bit_cast(f32x4, __builtin_amdgcn_raw_buffer_load_b128(rb, cvo + 16u, 0, 0));
    unsigned la[8];
#pragma unroll
    for (int q = 0; q < 8; ++q) la[q] = (unsigned)((row0 + q) * 256 + ((chunk ^ swz16(row0 + q)) << 4));
#define CI_U(R, Q) (((Q) & 1) ? bfhi(((Q) >> 1) == 0 ? raw[R].x : ((Q) >> 1) == 1 ? raw[R].y : ((Q) >> 1) == 2 ? raw[R].z : raw[R].w) : bflo(((Q) >> 1) == 0 ? raw[R].x : ((Q) >> 1) == 1 ? raw[R].y : ((Q) >> 1) == 2 ? raw[R].z : raw[R].w))
#define CI_W(K, Q) ((Q) < 4 ? wa[K][(Q) & 3] : wb[K][(Q) & 3])
#pragma unroll
    for (int ip = 0; ip < 4; ++ip) {
        float a0[8], a1[8];
#pragma unroll
        for (int q = 0; q < 8; ++q) { const float bq = q < 4 ? ba[q & 3] : bbv[q & 3];
            a0[q] = silu(bq + CI_W(0, q) * CI_U(2 * ip, q) + CI_W(1, q) * CI_U(2 * ip + 1, q) + CI_W(2, q) * CI_U(2 * ip + 2, q) + CI_W(3, q) * CI_U(2 * ip + 3, q));
            a1[q] = silu(bq + CI_W(0, q) * CI_U(2 * ip + 1, q) + CI_W(1, q) * CI_U(2 * ip + 2, q) + CI_W(2, q) * CI_U(2 * ip + 3, q) + CI_W(3, q) * CI_U(2 * ip + 4, q)); }
        if (do_g) { __builtin_amdgcn_raw_buffer_store_b128((v4u){pk2(a0[0], a0[1]), pk2(a0[2], a0[3]), pk2(a0[4], a0[5]), pk2(a0[6], a0[7])}, rg, gvo, (2 * ip) * DCONV * 2, 2  );
                    __builtin_amdgcn_raw_buffer_store_b128((v4u){pk2(a1[0], a1[1]), pk2(a1[2], a1[3]), pk2(a1[4], a1[5]), pk2(a1[6], a1[7])}, rg, gvo, (2 * ip + 1) * DCONV * 2, 2); }
        if (do_img) { float s0 = 1.f, s1 = 1.f; if (do_sc) { s0 = sc[2 * ip]; s1 = sc[2 * ip + 1]; }
#pragma unroll
            for (int q = 0; q < 8; ++q) *(LAS unsigned*)(img + la[q] + 4 * ip) = pk2(a0[q] * s0, a1[q] * s1); }
    }
#undef CI_U
#undef CI_W
}
__device__ __forceinline__ bf16x8 ld_frag(const LAS unsigned char* img, int row, int chunk) { return *(const LAS bf16x8*)(img + row * 256 + ((chunk ^ swz16(row)) << 4)); }

__device__ __forceinline__ void ssd_states_unit(Frame& F, int unit, const bool dry, const int var) {
    const int hh = unit & 1, g = (unit >> 1) & 3, c = (unit >> 3) & 31, b = unit >> 8; const int t0 = b * SEQ + c * 128;
    LAS float* sx = (LAS float*)F.lds;
    LAS unsigned char* Bt = F.lds + 4096; LAS unsigned char* Xt = F.lds + 4096 + 32768;
    const float* DT = (const float*)(F.ws + WS_DT); const bf16* XBC = (const bf16*)(F.ws + WS_XBC); bf16* XC = (bf16*)(F.ws + (dry ? 900 * MiB : WS_XC)); float* CD = (float*)(F.ws + (dry ? 1000 * MiB : WS_CD));
    __syncthreads();
    if (F.wave < 4) {
        const int h = g * 8 + 4 * hh + F.wave; const float A = -__expf(F.in[I_ALOG][h]); const int l = 2 * F.lane;
        const float d0 = DT[(size_t)(t0 + l) * 32 + h], d1 = DT[(size_t)(t0 + l + 1) * 32 + h]; const float a0 = d0 * A, a1 = d1 * A, s = a0 + a1;
        const float incl = wave_incl_scan(s, F.lane);
        const float c0 = incl - s + a0, c1 = incl, total = __builtin_bit_cast(float, __builtin_amdgcn_readlane(__builtin_bit_cast(int, incl), 63));
        sx[F.wave * 128 + l] = d0 * __expf(total - c0); sx[F.wave * 128 + l + 1] = d1 * __expf(total - c1);
        if (F.lane == 0) CD[(b * 32 + c) * 32 + h] = __expf(total);
    }
    __syncthreads();
#pragma unroll 1
    for (int itx = 0; itx < ((var & 2) ? 2 : 0); ++itx) {
        int kind, strip, grp, col, trow0; bool seqs; st_item(unit, itx, F.tid, kind, strip, grp, col, trow0, seqs);
        if (kind < 3) { const int l0 = strip * 8; v4u rawc[11]; conv_load(XBC, trow0, seqs, col, true, rawc);
            conv_item(XBC, F.in[I_CONVW], F.in[I_CONVB], t0 + l0, seqs, col, XC, (unsigned)((t0 + l0) * DCONV + col) * 2u, (kind != 1 || hh == 0),
                      kind ? Bt : Xt, kind < 2, grp * 8, strip, sx + (grp >> 3) * 128 + l0, kind == 0, rawc); }
    }
    __syncthreads();
    if (!(var & 4)) return;
    const int li = F.lane & 31, half = F.lane >> 5, hp = (F.wave >> 1) * 64 + (F.wave & 1) * 32 + li;
    f32x16 acc[4];
#pragma unroll
    for (int nt = 0; nt < 4; ++nt)
#pragma unroll
        for (int r = 0; r < 16; ++r) acc[nt][r] = 0.f;
#pragma unroll 2
    for (int ks = 0; ks < 8; ++ks) { const bf16x8 xb = ld_frag(Xt, hp, 2 * ks + half);
#pragma unroll
        for (int nt = 0; nt < 4; ++nt) { const bf16x8 ba = ld_frag(Bt, 32 * nt + li, 2 * ks + half); acc[nt] = __builtin_amdgcn_mfma_f32_32x32x16_bf16(ba, xb, acc[nt], 0, 0, 0); } }
    __syncthreads();
    LAS unsigned char* OUT = Xt;
#pragma unroll
    for (int nt = 0; nt < 4; ++nt)
#pragma unroll
        for (int rq = 0; rq < 4; ++rq) { const int ch8 = 8 * nt + 2 * rq + half; v2u v; v.x = pk2(acc[nt][4 * rq], acc[nt][4 * rq + 1]); v.y = pk2(acc[nt][4 * rq + 2], acc[nt][4 * rq + 3]);
            *(LAS v2u*)(OUT + hp * 256 + ((ch8 ^ (hp & 31)) << 3)) = v; }
    __syncthreads();
    bf16* ST = (bf16*)(F.ws + (dry ? 928 * MiB : WS_STATES)) + ((size_t)((b * 32 + c) * 32 + g * 8 + 4 * hh)) * 8192;
#pragma unroll
    for (int it = 0; it < 8; ++it) { const int idx = it * 512 + F.tid, lf = idx & 63, ks = (idx >> 6) & 7, ptl = (idx >> 9) & 1, hl = idx >> 10;
        const int row = hl * 64 + ptl * 32 + (lf & 31), j = 2 * ks + (lf >> 5), k = row & 31;
        v4u v = *(const LAS v4u*)(OUT + row * 256 + ((j ^ (k >> 1)) << 4)); if (k & 1) v = (v4u){v.z, v.w, v.x, v.y};
        *(v4u*)(ST + (size_t)idx * 8) = v; }
}

__device__ __forceinline__ void ssd_scan(Frame& F, const bool dry) {
    bf16* ST = (bf16*)(F.ws + WS_STATES); const size_t dofs = dry ? (size_t)(864 * MiB - WS_STATES) / 2 : 0; const float* CD = (const float*)(F.ws + WS_CD);
    for (int gid = F.vcu * 512 + F.tid; gid < 131072; gid += F.G * 512) {
        const int bh = gid >> 10, b = bh >> 5, h = bh & 31, el = (gid & 1023) * 8;
        float st[8];
#pragma unroll
        for (int q = 0; q < 8; ++q) st[q] = 0.f;
#pragma unroll 4
        for (int c = 0; c < 32; ++c) { bf16* p = ST + ((size_t)((b * 32 + c) * 32 + h)) * 8192 + el; const v4u v = *(const v4u*)p; const float cd = CD[__builtin_amdgcn_readfirstlane((b * 32 + c) * 32 + h)];
            v4u o; o.x = pk2(st[0], st[1]); o.y = pk2(st[2], st[3]); o.z = pk2(st[4], st[5]); o.w = pk2(st[6], st[7]); *(v4u*)(p + dofs) = o;
            st[0] = st[0] * cd + bflo(v.x); st[1] = st[1] * cd + bfhi(v.x); st[2] = st[2] * cd + bflo(v.y); st[3] = st[3] * cd + bfhi(v.y);
            st[4] = st[4] * cd + bflo(v.z); st[5] = st[5] * cd + bfhi(v.z); st[6] = st[6] * cd + bflo(v.w); st[7] = st[7] * cd + bfhi(v.w); }
    }
}

__device__ __forceinline__ int off256(int row, int ch) { return 256 * row + 16 * (ch ^ (((row & 3) << 2) | ((row >> 2) & 3))); }
__device__ __forceinline__ int off512(int row, int ch) { return 512 * row + 16 * (ch ^ ((row & 3) << 2)); }
typedef short v4i16_t __attribute__((ext_vector_type(4)));
__device__ __forceinline__ v4i16_t tr_read(const LAS unsigned char* p) { return __builtin_amdgcn_ds_read_tr16_b64_v4i16((LAS v4i16_t*)p); }
__device__ __forceinline__ void ssd_out_stage_dma(Frame& F, int unit, const int part = 3) {
    const int g = unit & 3, c = (unit >> 2) & 31, b = unit >> 7; const int t0 = b * SEQ + c * 128;
    LAS unsigned char* Bn = F.lds + 12288; LAS unsigned char* Cn = Bn + 32768; LAS unsigned char* Xn = Cn + 32768;
    const __amdgpu_buffer_rsrc_t rs = __builtin_amdgcn_make_buffer_rsrc((void*)(F.ws + WS_XC), 0, 0xFFFFFFFF, 0x00020000);
    const unsigned rowbase = (unsigned)t0 * (DCONV * 2);
    if (part & 1)
#pragma unroll
    for (int i = 0; i < 4; ++i) { const int k = F.wave * 4 + i, rl = (F.lane >> 4), row = 4 * k + rl, pc = F.lane & 15, lc = pc ^ (((row & 3) << 2) | ((row >> 2) & 3));
        const unsigned voff = (unsigned)rl * (DCONV * 2) + (unsigned)lc * 16u, soff = rowbase + (unsigned)(4 * k) * (DCONV * 2) + (unsigned)(2048 + g * 128) * 2u;
        __builtin_amdgcn_raw_ptr_buffer_load_lds(rs, (LAS unsigned*)(Bn + k * 1024), 16, voff, soff, 0, 2);
        __builtin_amdgcn_raw_ptr_buffer_load_lds(rs, (LAS unsigned*)(Cn + k * 1024), 16, voff, soff + 1024u, 0, 2); }
    if (part & 2)
#pragma unroll
    for (int i = 0; i < 8; ++i) { const int k = F.wave * 8 + i, rl = (F.lane >> 5), row = 2 * k + rl, pc = F.lane & 31, lc = pc ^ ((row & 3) << 2);
        const unsigned voff = (unsigned)rl * (DCONV * 2) + (unsigned)lc * 16u, soff = rowbase + (unsigned)(2 * k) * (DCONV * 2) + (unsigned)(g * 512) * 2u;
        __builtin_amdgcn_raw_ptr_buffer_load_lds(rs, (LAS unsigned*)(Xn + k * 1024), 16, voff, soff, 0, 2  ); }
}
__device__ __forceinline__ void ssd_out_stage_acum(Frame& F, int unit) {
    const int g = unit & 3, c = (unit >> 2) & 31, b = unit >> 7; const int t0 = b * SEQ + c * 128;
    LAS float* acum = (LAS float*)F.lds; LAS float* dtv = acum + 1024; const float* DT = (const float*)(F.ws + WS_DT);
    const int h = g * 8 + F.wave; const float A = -__expf(F.in[I_ALOG][h]); const int l = 2 * F.lane;
    const float d0 = DT[(size_t)(t0 + l) * 32 + h], d1 = DT[(size_t)(t0 + l + 1) * 32 + h]; const float a0 = d0 * A, a1 = d1 * A, s = a0 + a1;
    const float incl = wave_incl_scan(s, F.lane);
    acum[F.wave * 128 + l] = incl - s + a0; acum[F.wave * 128 + l + 1] = incl; dtv[F.wave * 128 + l] = d0; dtv[F.wave * 128 + l + 1] = d1;
}
__device__ __forceinline__ void ssd_out_unit(Frame& F, int unit, const int var, bf16* Y, const bool first, const int next_unit) {
    const int g = unit & 3, c = (unit >> 2) & 31, b = unit >> 7; const int t0 = b * SEQ + c * 128;
    LAS float* acum = (LAS float*)F.lds; LAS float* dtv = acum + 1024; LAS float* ssq = acum + 2048;
    LAS unsigned char* Bn = F.lds + 12288; LAS unsigned char* Cn = Bn + 32768; LAS unsigned char* Xn = Cn + 32768;
    const bf16* Z = (const bf16*)(F.ws + WS_Z);
    const __amdgpu_buffer_rsrc_t rsx = __builtin_amdgcn_make_buffer_rsrc((void*)(F.ws + WS_XC), 0, 0xFFFFFFFF, 0x00020000);
    const __amdgpu_buffer_rsrc_t rst = __builtin_amdgcn_make_buffer_rsrc((void*)(F.ws + WS_STATES), 0, 0xFFFFFFFF, 0x00020000), rsz = __builtin_amdgcn_make_buffer_rsrc((void*)Z, 0, 0xFFFFFFFF, 0x00020000);
    const unsigned zyvo = (unsigned)((F.tid >> 5) * (DSSD * 2) + (F.tid & 31) * 16);
    if (first) { __syncthreads(); ssd_out_stage_dma(F, unit); ssd_out_stage_acum(F, unit); }
    const int li = F.lane & 31, half = F.lane >> 5, ew = F.wave >> 1, lsel = F.wave & 1;
    const int trq = (F.lane & 15) >> 2, trp = F.lane & 3, trblk = (F.lane >> 4) & 1;
#pragma unroll 1
    for (int ps = 0; ps < 2; ++ps) {
        if (ps) { LDS_BAR();
#pragma unroll
          for (int i = 0; i < 8; ++i) { const int k = F.wave * 8 + i, rl = (F.lane >> 5), row = 2 * k + rl, pc = F.lane & 31, lc = pc ^ ((row & 3) << 2);
            const unsigned voff = (unsigned)rl * (DCONV * 2) + (unsigned)lc * 16u, soff = (unsigned)t0 * (DCONV * 2) + (unsigned)(2 * k) * (DCONV * 2) + (unsigned)(g * 512 + 256) * 2u;
            __builtin_amdgcn_raw_ptr_buffer_load_lds(rsx, (LAS unsigned*)(Xn + k * 1024), 16, voff, soff, 0, 2  ); } }
        const int e = 4 * ps + ew, h = 8 * g + e; const float Dk = F.in[I_DSKIP][h];
        const unsigned prevo = (unsigned)((b * 32 + c) * 32 + h) * 16384u;
        bf16x8 pf[2][8];
#pragma unroll
        for (int pt = 0; pt < 2; ++pt)
#pragma unroll
            for (int ks = 0; ks < 8; ++ks) pf[pt][ks] = __builtin_bit_cast(bf16x8, __builtin_amdgcn_raw_buffer_load_b128(rst, (unsigned)F.lane * 16u, prevo + (unsigned)((pt * 8 + ks) * 1024), 0));
        VM_WAIT(); __syncthreads();
#ifndef MK_NOGPRE
        if (ps == 0) {
            f32x16 g0, g1;
#pragma unroll
            for (int r = 0; r < 16; ++r) { g0[r] = 0.f; g1[r] = 0.f; }
            { const int blk = F.wave, bi = (blk >= 6) ? 3 : (blk >= 3) ? 2 : (blk >= 1) ? 1 : 0, bj = blk - (bi * (bi + 1)) / 2;
#pragma unroll
              for (int ks = 0; ks < 8; ++ks) { const bf16x8 bfm = *(const LAS bf16x8*)(Bn + off256(32 * bj + li, 2 * ks + half)); const bf16x8 cf = *(const LAS bf16x8*)(Cn + off256(32 * bi + li, 2 * ks + half)); g0 = __builtin_amdgcn_mfma_f32_32x32x16_bf16(bfm, cf, g0, 0, 0, 0); } }
            if (F.wave < 2) { const int bj = 2 + F.wave;
#pragma unroll
              for (int ks = 0; ks < 8; ++ks) { const bf16x8 bfm = *(const LAS bf16x8*)(Bn + off256(32 * bj + li, 2 * ks + half)); const bf16x8 cf = *(const LAS bf16x8*)(Cn + off256(96 + li, 2 * ks + half)); g1 = __builtin_amdgcn_mfma_f32_32x32x16_bf16(bfm, cf, g1, 0, 0, 0); } }
            LDS_BAR();
            *(LAS v4u*)(Bn + F.wave * 2048 + F.lane * 16) = (v4u){pk2(g0[0], g0[1]), pk2(g0[2], g0[3]), pk2(g0[4], g0[5]), pk2(g0[6], g0[7])};
            *(LAS v4u*)(Bn + F.wave * 2048 + 1024 + F.lane * 16) = (v4u){pk2(g0[8], g0[9]), pk2(g0[10], g0[11]), pk2(g0[12], g0[13]), pk2(g0[14], g0[15])};
            if (F.wave < 2) {
                *(LAS v4u*)(Bn + (8 + F.wave) * 2048 + F.lane * 16) = (v4u){pk2(g1[0], g1[1]), pk2(g1[2], g1[3]), pk2(g1[4], g1[5]), pk2(g1[6], g1[7])};
                *(LAS v4u*)(Bn + (8 + F.wave) * 2048 + 1024 + F.lane * 16) = (v4u){pk2(g1[8], g1[9]), pk2(g1[10], g1[11]), pk2(g1[12], g1[13]), pk2(g1[14], g1[15])}; }
            LDS_BAR();
        }
#endif
        const LAS float* ac = acum + e * 128; const LAS float* dv = dtv + e * 128;
        f32x16 accs[2][2];
#pragma unroll
        for (int it = 0; it < 2; ++it) {
            const int i = lsel ? (1 + it) : (it ? 3 : 0); const int l = 32 * i + li; const float acl = ac[l];
            f32x16 acc[2];
#pragma unroll
            for (int pt = 0; pt < 2; ++pt)
#pragma unroll
                for (int r = 0; r < 16; ++r) acc[pt][r] = 0.f;
            if (var & 1) {
#pragma unroll
            for (int ks = 0; ks < 8; ++ks) { const bf16x8 cf = *(const LAS bf16x8*)(Cn + off256(l, 2 * ks + half));
#pragma unroll
                for (int pt = 0; pt < 2; ++pt) acc[pt] = __builtin_amdgcn_mfma_f32_32x32x16_bf16(pf[pt][ks], cf, acc[pt], 0, 0, 0); }
            }
            { const float el = __expf(acl);
#pragma unroll
                for (int pt = 0; pt < 2; ++pt)
#pragma unroll
                    for (int r = 0; r < 16; ++r) acc[pt][r] *= el; }
            accs[it][0] = acc[0]; accs[it][1] = acc[1];
        }
        asm volatile("" ::: "memory"); __builtin_amdgcn_sched_barrier(0);
        v4u zq[8];
        if (var & 4) {
#pragma unroll
          for (int k = 0; k < 8; ++k) zq[k] = __builtin_amdgcn_raw_buffer_load_b128(rsz, zyvo, (unsigned)(t0 + 16 * k) * (DSSD * 2) + (unsigned)(g * 512 + ps * 256) * 2u, 2  ); }
        asm volatile("" ::: "memory"); __builtin_amdgcn_sched_barrier(0);
#pragma unroll
        for (int it = 0; it < 2; ++it) {
            const int i = lsel ? (1 + it) : (it ? 3 : 0); const int l = 32 * i + li; const float acl = ac[l];
            f32x16 acc[2]; acc[0] = accs[it][0]; acc[1] = accs[it][1];
#pragma unroll 1
            for (int j = 0; j <= ((var & 2) ? i : -1); ++j) {
#ifdef MK_NOGPRE
                f32x16 gt;
#pragma unroll
                for (int r = 0; r < 16; ++r) gt[r] = 0.f;
#pragma unroll 4
                for (int ks = 0; ks < 8; ++ks) { const bf16x8 bfm = *(const LAS bf16x8*)(Bn + off256(32 * j + li, 2 * ks + half)); const bf16x8 cf = *(const LAS bf16x8*)(Cn + off256(l, 2 * ks + half)); gt = __builtin_amdgcn_mfma_f32_32x32x16_bf16(bfm, cf, gt, 0, 0, 0); }
#else
                float gt[16];
                { const int blk = (i * (i + 1)) / 2 + j; const v4u ga = *(const LAS v4u*)(Bn + blk * 2048 + F.lane * 16), gb = *(const LAS v4u*)(Bn + blk * 2048 + 1024 + F.lane * 16);
                  gt[0] = bflo(ga.x); gt[1] = bfhi(ga.x); gt[2] = bflo(ga.y); gt[3] = bfhi(ga.y); gt[4] = bflo(ga.z); gt[5] = bfhi(ga.z); gt[6] = bflo(ga.w); gt[7] = bfhi(ga.w);
                  gt[8] = bflo(gb.x); gt[9] = bfhi(gb.x); gt[10] = bflo(gb.y); gt[11] = bfhi(gb.y); gt[12] = bflo(gb.z); gt[13] = bfhi(gb.z); gt[14] = bflo(gb.w); gt[15] = bfhi(gb.w); }
#endif
                unsigned wp[8];
#pragma unroll
                for (int rq = 0; rq < 4; ++rq) { const int sb = 32 * j + 8 * rq + 4 * half; const f32x4 as4 = *(const LAS f32x4*)(ac + sb), dt4 = *(const LAS f32x4*)(dv + sb); float wv[4];
#pragma unroll
                    for (int x = 0; x < 4; ++x) { const int s = sb + x; float w = gt[4 * rq + x] * __expf(fminf(acl - as4[x], 0.f)) * dt4[x];
                        if (j == i) { if (s > l) w = 0.f; if (s == l) w += Dk; } wv[x] = w; }
                    wp[2 * rq] = pk2(wv[0], wv[1]); wp[2 * rq + 1] = pk2(wv[2], wv[3]); }
                const bf16x8 wf0 = __builtin_bit_cast(bf16x8, (v4u){wp[0], wp[1], wp[2], wp[3]}), wf1 = __builtin_bit_cast(bf16x8, (v4u){wp[4], wp[5], wp[6], wp[7]});
#pragma unroll
                for (int pt = 0; pt < 2; ++pt) { const int chunk = ew * 8 + 4 * pt + 2 * trblk + (trp >> 1);
#pragma unroll
                    for (int ksub = 0; ksub < 2; ++ksub) { const int r0 = 32 * j + 16 * ksub + 4 * half + trq;
                        const v4i16_t lo = tr_read(Xn + off512(r0, chunk) + 8 * (trp & 1)), hi = tr_read(Xn + off512(r0 + 8, chunk) + 8 * (trp & 1));
                        const bf16x8 xf = (bf16x8){lo[0], lo[1], lo[2], lo[3], hi[0], hi[1], hi[2], hi[3]};
                        acc[pt] = __builtin_amdgcn_mfma_f32_32x32x16_bf16(xf, ksub ? wf1 : wf0, acc[pt], 0, 0, 0); } }
            }
            accs[it][0] = acc[0]; accs[it][1] = acc[1];
            asm volatile("" ::: "memory"); __builtin_amdgcn_sched_barrier(0);
        }
        LDS_BAR();
        if (ps == 1 && next_unit >= 0) ssd_out_stage_dma(F, next_unit, 1);
        LAS unsigned char* Tt = Xn;
        if (var & 4) {
#pragma unroll
        for (int it = 0; it < 2; ++it) { const int i = lsel ? (1 + it) : (it ? 3 : 0); const int l = 32 * i + li;
#pragma unroll
            for (int pt = 0; pt < 2; ++pt)
#pragma unroll
                for (int rq = 0; rq < 4; ++rq) { const int c8 = ew * 16 + 8 * pt + 2 * rq + half;
                    *(LAS v2u*)(Tt + l * 512 + ((c8 ^ (l & 31)) << 3)) = (v2u){pk2(accs[it][pt][4 * rq], accs[it][pt][4 * rq + 1]), pk2(accs[it][pt][4 * rq + 2], accs[it][pt][4 * rq + 3])}; } }
        }
        LDS_BAR();
        if (var & 4)
        { const f32x4 w0 = *(const f32x4*)(F.in[I_SNW] + g * 512 + ps * 256 + (F.tid & 31) * 8), w1 = *(const f32x4*)(F.in[I_SNW] + g * 512 + ps * 256 + (F.tid & 31) * 8 + 4); float sqv[8];
#pragma unroll
          for (int k = 0; k < 8; ++k) { const int idx = k * 512 + F.tid, l = idx >> 5, j = idx & 31, kk = l & 31;
            v4u tq = *(const LAS v4u*)(Tt + l * 512 + ((j ^ (kk >> 1)) << 4)); if (kk & 1) tq = (v4u){tq.z, tq.w, tq.x, tq.y};
            const v4u z4 = zq[k];
            const float y0 = bflo(tq.x) * bflo(z4.x), y1 = bfhi(tq.x) * bfhi(z4.x), y2 = bflo(tq.y) * bflo(z4.y), y3 = bfhi(tq.y) * bfhi(z4.y);
            const float y4 = bflo(tq.z) * bflo(z4.z), y5 = bfhi(tq.z) * bfhi(z4.z), y6 = bflo(tq.w) * bflo(z4.w), y7 = bfhi(tq.w) * bfhi(z4.w);
            float sq = ((y0 * y0 + y1 * y1) + (y2 * y2 + y3 * y3)) + ((y4 * y4 + y5 * y5) + (y6 * y6 + y7 * y7));
            sq += dpp_f<0xB1>(sq); sq += dpp_f<0x4E>(sq); sq += dpp_f<0x141>(sq); sq += dpp_f<0x140>(sq);
            sqv[k] = sq;
            { unsigned char* yk = (unsigned char*)Y + ((size_t)(t0 + 16 * k) * (DSSD * 2) + (size_t)(g * 512 + ps * 256) * 2u);
              *(v4u*)(yk + zyvo) = (v4u){pk2(y0 * w0.x, y1 * w0.y), pk2(y2 * w0.z, y3 * w0.w), pk2(y4 * w1.x, y5 * w1.y), pk2(y6 * w1.z, y7 * w1.w)}; } }
          if ((F.tid & 15) == 0) {
#pragma unroll
            for (int k = 0; k < 8; ++k) ssq[(ps * 128 + k * 16 + (F.tid >> 5)) * 2 + ((F.tid >> 4) & 1)] = sqv[k]; } }
    }
    LDS_BAR();
    if (next_unit >= 0) ssd_out_stage_dma(F, next_unit, 2);
    if (F.tid < 128) ((float*)(F.ws + ((const unsigned char*)Y == F.ws + WS_Y ? WS_SSQ : WS_SSQ + 256 * 1024)))[(size_t)(t0 + F.tid) * 4 + g] = (ssq[2 * F.tid] + ssq[2 * F.tid + 1]) + (ssq[256 + 2 * F.tid] + ssq[256 + 2 * F.tid + 1]);
    if (next_unit >= 0) ssd_out_stage_acum(F, next_unit);
}
}
namespace mk {
using pg8::Unit;
constexpr int MI_TSTART = 16, MI_CNT = 64, MI_RT2E = 128;

struct Sched {
    int mode, nM, nN, nwg, G, c, lda, ldb, a_pn_off, npn, nogather, ibase, ilim;
    const bf16* A; const bf16* Bt; const int* list; const volatile LAS unsigned* misc;
    __device__ __forceinline__ void init_dense(int M, int N, int G_, int c_, const bf16* A_, int lda_, const bf16* Bt_, int ldb_, int a_pn_off_) {
        ibase = 0; ilim = 1 << 30; nogather = 0; mode = 0; nM = M / 256; nN = N / 256; nwg = nM * nN; G = G_; c = c_; A = A_; Bt = Bt_; lda = lda_; ldb = ldb_; a_pn_off = a_pn_off_; npn = 0; list = nullptr; misc = nullptr; }
    __device__ __forceinline__ void init_moe(int mode_, int G_, int c_, const bf16* A_, const bf16* Bt_, const int* list_, const volatile LAS unsigned* misc_) {
        ibase = 0; ilim = 1 << 30; nogather = 0; mode = mode_; G = G_; c = c_; A = A_; Bt = Bt_; lda = 512; ldb = 512; a_pn_off = 0; npn = (mode_ == 1) ? 8 : 4; list = list_; misc = misc_; nM = 0; nN = 0; nwg = __builtin_amdgcn_readfirstlane((int)misc_[MI_TSTART + 32]) * npn; }
    __device__ __forceinline__ bool next(int i_, Unit& u) const {
        const int i = i_ + ibase; if (i >= ilim) return false;
        const long L = (long)i * G + c; if (L >= nwg) return false;
        if (mode == 0) {
            int wgid = (int)L; { const int q = nwg / 8, r = nwg % 8, xcd = wgid % 8, off = wgid / 8; wgid = (xcd < r ? xcd * (q + 1) : r * (q + 1) + (xcd - r) * q) + off; }
            const int nig = 8 * nN, gid = wgid / nig, fm = gid * 8, gsz = (nM - fm) < 8 ? (nM - fm) : 8;
            u.pm = fm + ((wgid % nig) % gsz); u.pn = (wgid % nig) / gsz; u.e = 0; u.i = 0; return true;
        }
        const int rt = (int)L / npn, pn = (int)L % npn; const int e = __builtin_amdgcn_readfirstlane((int)misc[MI_RT2E + rt]);
        u.pm = rt; u.pn = pn; u.e = e; u.i = rt - __builtin_amdgcn_readfirstlane((int)misc[MI_TSTART + e]); return true;
    }
    __device__ __forceinline__ const bf16* a_root() const { return A; }
    __device__ __forceinline__ const bf16* b_root() const { return Bt; }
    __device__ __forceinline__ const char* a_base(const Unit& u) const {
        if (mode == 0) return (const char*)(A + (size_t)u.pm * 256 * lda + (size_t)u.pn * a_pn_off);
        if (mode == 1) return (const char*)A;
        return (const char*)(A + (size_t)u.pm * 256 * 512); }
    __device__ __forceinline__ const char* b_base(const Unit& u) const {
        if (mode == 0) return (const char*)(Bt + (size_t)u.pn * 256 * ldb);
        if (mode == 1) return (const char*)(Bt + (size_t)u.e * 2048 * 512 + (size_t)u.pn * 256 * 512);
        return (const char*)(Bt + (size_t)u.e * 1024 * 512 + (size_t)u.pn * 256 * 512); }
    __device__ __forceinline__ bool gathered() const { return mode == 1 && !nogather; }
    __device__ __forceinline__ unsigned list_off(const Unit& u) const { return (unsigned)((size_t)u.e * T + (size_t)u.i * 256) * 4u; }
    __device__ __forceinline__ const int* list_root() const { return list; }
    __device__ __forceinline__ unsigned tok_off(const Unit& u, int r, int raw) const {
        const int idx = u.i * 256 + r; const int cnt = (int)misc[MI_CNT + u.e]; return idx < cnt ? (unsigned)(raw >> 2) * 1024u : 0u; }
    __device__ __forceinline__ int row_id(const Unit& u, int r) const {
        if (mode == 2 || nogather) return r;
        const int idx = u.i * 256 + r; const int cnt = (int)misc[MI_CNT + u.e]; return idx < cnt ? (list[(size_t)u.e * T + idx] >> 2) : 0; }
    __device__ __forceinline__ unsigned row_off(const Unit& u, int r) const {
        if (mode == 2 || nogather) return (unsigned)r * 1024u;
        if (mode == 0) return (unsigned)r * (unsigned)lda * 2u;
        const int idx = u.i * 256 + r; const int cnt = (int)misc[MI_CNT + u.e];
        const int tok = idx < cnt ? (list[(size_t)u.e * T + idx] >> 2) : 0; return (unsigned)tok * 1024u; }
};

struct EpiNone { static constexpr bool PERM = true, PREFETCH = false, MIDK = false; __device__ __forceinline__ void operator()(const pg8::f32x4 (&acc)[2][2][4][2], const Unit&, int, int, int, int) const {
#pragma unroll
    for (int a = 0; a < 2; ++a)
#pragma unroll
        for (int b = 0; b < 2; ++b) asm volatile("" :: "v"(acc[a][b][0][0]), "v"(acc[a][b][0][1]), "v"(acc[a][b][1][0]), "v"(acc[a][b][1][1]), "v"(acc[a][b][2][0]), "v"(acc[a][b][2][1]), "v"(acc[a][b][3][0]), "v"(acc[a][b][3][1])); } };
struct EpiPackOnly { static constexpr bool PERM = true, PREFETCH = false, MIDK = false; __device__ __forceinline__ void operator()(const pg8::f32x4 (&acc)[2][2][4][2], const Unit&, int, int, int, int) const {
#pragma unroll
    for (int ai = 0; ai < 2; ++ai)
#pragma unroll
        for (int m = 0; m < 4; ++m)
#pragma unroll
            for (int bj = 0; bj < 2; ++bj) { const pg8::f32x4 v0 = acc[ai][bj][m][0], v1 = acc[ai][bj][m][1]; v4u w; w.x = pk2(v0[0], v0[1]); w.y = pk2(v0[2], v0[3]); w.z = pk2(v1[0], v1[1]); w.w = pk2(v1[2], v1[3]); asm volatile("" :: "v"(w)); } } };
struct EpiAll {
    static constexpr bool PERM = true, PREFETCH = true, MIDK = true;
    __device__ __forceinline__ pg8::f32x4 midk_load(const Unit& u, int tid) const { if (kind != 2) return (pg8::f32x4){0.f, 0.f, 0.f, 0.f}; return *(const pg8::f32x4*)((const float*)(ws + WS_SSQ) + (size_t)(u.pm * 256 + (tid & 255)) * 4); }
    __device__ __forceinline__ void midk_park(const pg8::f32x4 v, int tid) const { if (kind != 2) return; if (tid < 256) *(LAS pg8::f32x4*)((LAS unsigned char*)lds_tab + 4096 + tid * 16) = v; }
    __device__ __forceinline__ bool midk_at(int t) const { return kind == 2 && t >= 8 && (t & 7) == 0; }
    __device__ __forceinline__ void midk(pg8::f32x4 (&acc)[2][2][4][2], int t, int wr, int fr) const {
        const LAS float* tab = (const LAS float*)(lds_tab + 4096); const int g = t >> 3;
#pragma unroll
        for (int ai = 0; ai < 2; ++ai)
#pragma unroll
            for (int m = 0; m < 4; ++m) { const int row = ai * 128 + wr * 64 + m * 16 + fr; const float sp = tab[row * 4 + g - 1], sn = tab[row * 4 + g];
                const float ratio = __builtin_sqrtf((sn * (1.f / 512.f) + EPS) * __builtin_amdgcn_rcpf(sp * (1.f / 512.f) + EPS));
#pragma unroll
                for (int bj = 0; bj < 2; ++bj)
#pragma unroll
                    for (int n = 0; n < 2; ++n) acc[ai][bj][m][n] = acc[ai][bj][m][n] * ratio; } }
    __device__ __forceinline__ void pf_dma(const Unit& u, int wave, int lane) const {
        if (kind != 6) return;
        const __amdgpu_buffer_rsrc_t rl = __builtin_amdgcn_make_buffer_rsrc((void*)(ws + (wave < 4 ? WS_LIST : WS_GATEL)), 0, 0xFFFFFFFF, 0x00020000);
        const unsigned off = (unsigned)((size_t)u.e * T + (size_t)u.i * 256) * 4u + (unsigned)((wave & 3) * 256);
        __builtin_amdgcn_raw_ptr_buffer_load_lds(rl, (LAS unsigned*)((LAS unsigned char*)lds_tab + (wave < 4 ? 2048 : 3072) + (wave & 3) * 256), 4, (unsigned)lane * 4u, off, 0, 0); }
    int kind, pad; unsigned char* ws; const float* const* in; float* out; const volatile LAS unsigned* misc; const LAS unsigned char* lds_tab;
    __device__ __forceinline__ void operator()(const pg8::f32x4 (&acc)[2][2][4][2], const Unit& u, int wr, int wc, int fr, int fq) const {
        const int rl0 = wr * 64 + fr, row0 = u.pm * 256 + rl0, cl0 = wc * 32 + 8 * fq;
        if (kind == 0) {
            bf16* base; int ld, colt; bool sg = false, sl = false;
            if (u.pn < 8) { base = (bf16*)(ws + WS_Z); ld = 2048; colt = u.pn * 256; sl = true; }
            else if (u.pn < 20) { base = (bf16*)(ws + WS_XBC); ld = 3072; colt = (u.pn - 8) * 256; }
            else if (u.pn < 24) { base = (bf16*)(ws + WS_U); ld = 1024; colt = (u.pn - 20) * 256; }
            else { base = (bf16*)(ws + WS_GATES); ld = 2048; colt = (u.pn - 24) * 256; sg = true; }
#pragma unroll
            for (int ai = 0; ai < 2; ++ai)
#pragma unroll
                for (int m = 0; m < 4; ++m) { bf16* rowp = base + (size_t)(row0 + ai * 128 + m * 16) * ld + colt + cl0;
#pragma unroll
                    for (int bj = 0; bj < 2; ++bj) { pg8::f32x4 v0 = acc[ai][bj][m][0], v1 = acc[ai][bj][m][1];
                        if (sg) { v0 = (pg8::f32x4){sigm(v0[0]), sigm(v0[1]), sigm(v0[2]), sigm(v0[3])}; v1 = (pg8::f32x4){sigm(v1[0]), sigm(v1[1]), sigm(v1[2]), sigm(v1[3])}; }
                        if (sl) { v0 = (pg8::f32x4){silu(v0[0]), silu(v0[1]), silu(v0[2]), silu(v0[3])}; v1 = (pg8::f32x4){silu(v1[0]), silu(v1[1]), silu(v1[2]), silu(v1[3])}; }
                        v4u w; w.x = pk2(v0[0], v0[1]); w.y = pk2(v0[2], v0[3]); w.z = pk2(v1[0], v1[1]); w.w = pk2(v1[2], v1[3]);
                        if (sg || sl) __builtin_nontemporal_store(w, (v4u*)(rowp + bj * 128)); else *(v4u*)(rowp + bj * 128) = w; } }
        } else if (kind == 1) {
            bf16* base = (bf16*)(ws + WS_P2); const float* ps = in[I_PSCALE];
#pragma unroll
            for (int bj = 0; bj < 2; ++bj) { const int col = u.pn * 256 + bj * 128 + cl0; const f32x4 s0 = *(const f32x4*)(ps + col), s1 = *(const f32x4*)(ps + col + 4);
#pragma unroll
                for (int ai = 0; ai < 2; ++ai)
#pragma unroll
                    for (int m = 0; m < 4; ++m) { const pg8::f32x4 v0 = acc[ai][bj][m][0] * s0, v1 = acc[ai][bj][m][1] * s1;
                        v4u w; w.x = pk2(v0[0], v0[1]); w.y = pk2(v0[2], v0[3]); w.z = pk2(v1[0], v1[1]); w.w = pk2(v1[2], v1[3]);
                        *(v4u*)(base + (size_t)(row0 + ai * 128 + m * 16) * 1024 + col) = w; } }
        } else if (kind == 2 || kind == 3) {
            const bf16* gates = (const bf16*)(ws + WS_GATES) + (kind == 3 ? 1024 : 0); bf16* m1 = (bf16*)(ws + WS_M1); bf16* mg = (bf16*)(ws + WS_MERGED);
#pragma unroll
            for (int ai = 0; ai < 2; ++ai) { v4u gq[4][2], mq[4][2]; float rs[4];
#pragma unroll
                for (int m = 0; m < 4; ++m) rs[m] = (kind == 2) ? rsqrtf(((const LAS float*)(lds_tab + 4096))[(rl0 + ai * 128 + m * 16) * 4 + 3] * (1.f / 512.f) + EPS) : 1.f;
#pragma unroll
                for (int m = 0; m < 4; ++m)
#pragma unroll
                    for (int bj = 0; bj < 2; ++bj) { const size_t row = row0 + ai * 128 + m * 16; const int col = u.pn * 256 + bj * 128 + cl0; gq[m][bj] = __builtin_nontemporal_load((const v4u*)(gates + row * 2048 + col));
                        if (kind == 2) mq[m][bj] = __builtin_nontemporal_load((const v4u*)(m1 + row * 1024 + col)); else mq[m][bj] = (v4u){0u, 0u, 0u, 0u}; }
#pragma unroll
                for (int m = 0; m < 4; ++m)
#pragma unroll
                    for (int bj = 0; bj < 2; ++bj) { const size_t row = row0 + ai * 128 + m * 16; const int col = u.pn * 256 + bj * 128 + cl0; const v4u g4 = gq[m][bj], m4 = mq[m][bj];
                        const pg8::f32x4 a0 = (kind == 2) ? acc[ai][bj][m][0] * rs[m] : acc[ai][bj][m][0], a1 = (kind == 2) ? acc[ai][bj][m][1] * rs[m] : acc[ai][bj][m][1];
                        float r[8] = {a0[0] * bflo(g4.x), a0[1] * bfhi(g4.x), a0[2] * bflo(g4.y), a0[3] * bfhi(g4.y),
                                      a1[0] * bflo(g4.z), a1[1] * bfhi(g4.z), a1[2] * bflo(g4.w), a1[3] * bfhi(g4.w)};
                        if (kind == 2) { r[0] += bflo(m4.x); r[1] += bfhi(m4.x); r[2] += bflo(m4.y); r[3] += bfhi(m4.y); r[4] += bflo(m4.z); r[5] += bfhi(m4.z); r[6] += bflo(m4.w); r[7] += bfhi(m4.w); }
                        v4u w; w.x = pk2(r[0], r[1]); w.y = pk2(r[2], r[3]); w.z = pk2(r[4], r[5]); w.w = pk2(r[6], r[7]);
                        *(v4u*)((kind == 2 ? mg : m1) + row * 1024 + col) = w; } }
        } else if (kind == 4) {
            const int b = (u.pm * 256) / SEQ; const float* ga = (const float*)(ws + WS_MOD) + b * 6144 + 2048; const float* x = in[I_X];
            f32x4 g0[2], g1[2];
#pragma unroll
            for (int bj = 0; bj < 2; ++bj) { const int col = u.pn * 256 + bj * 128 + cl0; g0[bj] = *(const f32x4*)(ga + col); g1[bj] = *(const f32x4*)(ga + col + 4); }
#pragma unroll
            for (int ai = 0; ai < 2; ++ai) { f32x4 xa[4][2], xb[4][2];
#pragma unroll
              for (int m = 0; m < 4; ++m)
#pragma unroll
                for (int bj = 0; bj < 2; ++bj) { const size_t off = (size_t)(row0 + ai * 128 + m * 16) * 1024 + u.pn * 256 + bj * 128 + cl0; xa[m][bj] = *(const f32x4*)(x + off); xb[m][bj] = *(const f32x4*)(x + off + 4); }
#pragma unroll
              for (int m = 0; m < 4; ++m)
#pragma unroll
                for (int bj = 0; bj < 2; ++bj) { const size_t off = (size_t)(row0 + ai * 128 + m * 16) * 1024 + u.pn * 256 + bj * 128 + cl0;
                    *(f32x4*)(out + off) = xa[m][bj] + g0[bj] * acc[ai][bj][m][0]; *(f32x4*)(out + off + 4) = xb[m][bj] + g1[bj] * acc[ai][bj][m][1]; } }
        } else if (kind == 5) {
            typedef float f2 __attribute__((ext_vector_type(2)));
            unsigned char* act = (unsigned char*)(ws + WS_ACT); const float* bgu = in[I_BGU] + (size_t)u.e * 2048; const int col = u.pn * 128 + cl0;
            const f32x4 bg0 = *(const f32x4*)(bgu + col), bg1 = *(const f32x4*)(bgu + col + 4), bl0 = *(const f32x4*)(bgu + 1024 + col) + 1.f, bl1 = *(const f32x4*)(bgu + 1024 + col + 4) + 1.f;
            const f2 bgp[4] = {(f2){bg0.x, bg0.y}, (f2){bg0.z, bg0.w}, (f2){bg1.x, bg1.y}, (f2){bg1.z, bg1.w}}, blp[4] = {(f2){bl0.x, bl0.y}, (f2){bl0.z, bl0.w}, (f2){bl1.x, bl1.y}, (f2){bl1.z, bl1.w}};
#pragma unroll
            for (int ai = 0; ai < 2; ++ai)
#pragma unroll
                for (int m = 0; m < 4; ++m) { int w[2] = {0, 0};
#pragma unroll
                    for (int hp = 0; hp < 4; ++hp) { const int n = hp >> 1, x = (hp & 1) * 2;
                        f2 gl = (f2){acc[ai][0][m][n][x], acc[ai][0][m][n][x + 1]} + bgp[hp], ln = (f2){acc[ai][1][m][n][x], acc[ai][1][m][n][x + 1]} + blp[hp];
                        gl.x = fminf(gl.x, 7.f); gl.y = fminf(gl.y, 7.f); ln.x = __builtin_amdgcn_fmed3f(ln.x, -6.f, 8.f); ln.y = __builtin_amdgcn_fmed3f(ln.y, -6.f, 8.f);
                        f2 t = gl * -2.4554669595930155f;
                        t.x = __builtin_amdgcn_exp2f(t.x); t.y = __builtin_amdgcn_exp2f(t.y); t = t + 1.f; t.x = __builtin_amdgcn_rcpf(t.x); t.y = __builtin_amdgcn_rcpf(t.y);
                        const f2 r = (gl * t) * ln;
                        if (hp & 1) w[n] = __builtin_amdgcn_cvt_pk_fp8_f32(r.x, r.y, w[n], true); else w[n] = __builtin_amdgcn_cvt_pk_fp8_f32(r.x, r.y, w[n], false); }
                    *(v2u*)(act + (size_t)(row0 + ai * 128 + m * 16) * 1024 + col) = (v2u){(unsigned)w[0], (unsigned)w[1]}; }
        } else {
            unsigned char* yb = (unsigned char*)(ws + WS_YB); const float* bdn = in[I_BDN] + (size_t)u.e * 1024;
            const LAS int* slotl = (const LAS int*)(lds_tab + 2048); const LAS float* gatel = (const LAS float*)(lds_tab + 3072);
            f32x4 bb0[2], bb1[2];
#pragma unroll
            for (int bj = 0; bj < 2; ++bj) { const int col = u.pn * 256 + bj * 128 + cl0; bb0[bj] = *(const f32x4*)(bdn + col); bb1[bj] = *(const f32x4*)(bdn + col + 4); }
#pragma unroll
            for (int ai = 0; ai < 2; ++ai) { int slot[4]; float gt[4];
#pragma unroll
                for (int m = 0; m < 4; ++m) { const int rl = rl0 + ai * 128 + m * 16; const bool ok = u.i * 256 + rl < (int)misc[MI_CNT + u.e]; slot[m] = ok ? slotl[rl] : -1; gt[m] = ok ? gatel[rl] : 0.f; }
#pragma unroll
                for (int bj = 0; bj < 2; ++bj) { const f32x4 b0 = bb0[bj], b1 = bb1[bj]; unsigned wa[4], wb[4];
#pragma unroll
                    for (int m = 0; m < 4; ++m) {
                        const float g16 = gt[m] * 16.f;
                        const pg8::f32x4 v0 = (acc[ai][bj][m][0] + b0) * g16, v1 = (acc[ai][bj][m][1] + b1) * g16;
                        int w0 = 0, w1 = 0; w0 = __builtin_amdgcn_cvt_pk_fp8_f32(v0[0], v0[1], w0, false); w0 = __builtin_amdgcn_cvt_pk_fp8_f32(v0[2], v0[3], w0, true);
                        w1 = __builtin_amdgcn_cvt_pk_fp8_f32(v1[0], v1[1], w1, false); w1 = __builtin_amdgcn_cvt_pk_fp8_f32(v1[2], v1[3], w1, true);
                        wa[m] = (unsigned)w0; wb[m] = (unsigned)w1; }
#pragma unroll
                    for (int mp = 0; mp < 4; mp += 2) {
                        const auto rx = __builtin_amdgcn_permlane16_swap(wa[mp], wa[mp + 1], false, false), ry = __builtin_amdgcn_permlane16_swap(wb[mp], wb[mp + 1], false, false);
                        const int sl = (fq & 1) ? slot[mp + 1] : slot[mp]; const int colw = u.pn * 256 + bj * 128 + wc * 32 + (fq >> 1) * 16;
                        if (sl >= 0) *(v4u*)(yb + (size_t)sl * 1024 + colw) = (v4u){(unsigned)rx[0], (unsigned)ry[0], (unsigned)rx[1], (unsigned)ry[1]}; } } }
        }
    }
};

__device__ __forceinline__ void p6_router(Frame& F, const bool dry, const int var) {
    LAS float* wrT = (LAS float*)F.lds;
    LAS int* lcnt = (LAS int*)(F.lds + 131072); LAS int* lbase = lcnt + 32; LAS int* rec = lcnt + 64;
    const float* wr = F.in[I_WR];
    __syncthreads();
    if (var & 1) { f32x4 wv[16];
#pragma unroll
      for (int i = 0; i < 16; ++i) wv[i] = *(const f32x4*)(wr + (size_t)(i * 512 + F.tid) * 4);
#pragma unroll
      for (int i = 0; i < 16; ++i) { const int idx = (i * 512 + F.tid) * 4, k = idx >> 5, e = idx & 31; wrT[e * 1024 + k] = wv[i].x; wrT[(e + 1) * 1024 + k] = wv[i].y; wrT[(e + 2) * 1024 + k] = wv[i].z; wrT[(e + 3) * 1024 + k] = wv[i].w; } }
    for (int rb = F.vcu; rb < T / 64; rb += F.G) {
    __syncthreads();
    if (F.tid < 32) lcnt[F.tid] = 0;
    const int rowblk = rb * 64, b = rowblk / SEQ; const float* mod = (const float*)(F.ws + WS_MOD) + b * 6144; unsigned char* H8 = (unsigned char*)(F.ws + WS_H);
    LAS f32x4* nA = (LAS f32x4*)(F.lds + 135168); LAS f32x4* nS = nA + 256;
    if (F.tid < 256) { const int col = 4 * F.tid; nA[F.tid] = *(const f32x4*)(F.in[I_NFW] + col) * (*(const f32x4*)(mod + 4096 + col) + 1.f); nS[F.tid] = *(const f32x4*)(mod + 3072 + col); }
    __syncthreads();
    const float* x1 = F.out;
    const float brv = F.in[I_BR][F.lane >> 1];
    f32x4 xn[2][4];
#pragma unroll
    for (int rr = 0; rr < 2; ++rr)
#pragma unroll
        for (int j = 0; j < 4; ++j) xn[rr][j] = *(const f32x4*)(x1 + (size_t)(rowblk + F.wave * 8 + rr) * D + 4 * F.lane + 256 * j);
#pragma unroll 1
    for (int pr = 0; pr < ((var & 2) ? 4 : 0); ++pr) {
        float hv[2][16]; const int rl0 = F.wave * 8 + pr * 2;
        f32x4 xc[2][4];
#pragma unroll
        for (int rr = 0; rr < 2; ++rr)
#pragma unroll
            for (int j = 0; j < 4; ++j) xc[rr][j] = xn[rr][j];
        if (pr < 3) {
#pragma unroll
            for (int rr = 0; rr < 2; ++rr)
#pragma unroll
                for (int j = 0; j < 4; ++j) xn[rr][j] = *(const f32x4*)(x1 + (size_t)(rowblk + rl0 + 2 + rr) * D + 4 * F.lane + 256 * j); }
#pragma unroll
        for (int rr = 0; rr < 2; ++rr) { const size_t t = rowblk + rl0 + rr; f32x4 v[4]; float s = 0.f;
#pragma unroll
            for (int j = 0; j < 4; ++j) { v[j] = xc[rr][j]; s += (v[j].x * v[j].x + v[j].y * v[j].y) + (v[j].z * v[j].z + v[j].w * v[j].w); }
            const float rstd = rsqrtf(wave_sum(s) * (1.f / D) + EPS);
#pragma unroll
            for (int j = 0; j < 4; ++j) { const int col = 4 * F.lane + 256 * j;
                const f32x4 h = v[j] * rstd * nA[F.lane + 64 * j] + nS[F.lane + 64 * j]; hv[rr][4 * j] = h.x; hv[rr][4 * j + 1] = h.y; hv[rr][4 * j + 2] = h.z; hv[rr][4 * j + 3] = h.w;
                int w8 = 0; w8 = __builtin_amdgcn_cvt_pk_fp8_f32(h.x, h.y, w8, false); w8 = __builtin_amdgcn_cvt_pk_fp8_f32(h.z, h.w, w8, true); *(unsigned*)(H8 + t * D + col) = (unsigned)w8; } }
        float a[64];
        { typedef float f32x2v __attribute__((ext_vector_type(2)));
          f32x2v h2v[16];
#pragma unroll
          for (int k = 0; k < 16; ++k) h2v[k] = (f32x2v){hv[0][k], hv[1][k]};
#pragma unroll
          for (int eg = 0; eg < 8; ++eg) { f32x4 w[4][4];
#pragma unroll
            for (int ee = 0; ee < 4; ++ee)
#pragma unroll
              for (int j = 0; j < 4; ++j) w[ee][j] = *(const LAS f32x4*)(wrT + (4 * eg + ee) * 1024 + 4 * F.lane + 256 * j);
            __builtin_amdgcn_sched_barrier(0);
#pragma unroll
            for (int ee = 0; ee < 4; ++ee) { f32x2v s = (f32x2v){0.f, 0.f};
#pragma unroll
              for (int j = 0; j < 4; ++j) {
                s = __builtin_elementwise_fma(h2v[4 * j], (f32x2v){w[ee][j].x, w[ee][j].x}, s); s = __builtin_elementwise_fma(h2v[4 * j + 1], (f32x2v){w[ee][j].y, w[ee][j].y}, s);
                s = __builtin_elementwise_fma(h2v[4 * j + 2], (f32x2v){w[ee][j].z, w[ee][j].z}, s); s = __builtin_elementwise_fma(h2v[4 * j + 3], (f32x2v){w[ee][j].w, w[ee][j].w}, s); }
              a[2 * (4 * eg + ee)] = s.x; a[2 * (4 * eg + ee) + 1] = s.y; }
            __builtin_amdgcn_sched_barrier(0); } }
#define RED_SWAP(N, BUILTIN) { _Pragma("unroll") for (int i = 0; i < (N) / 2; ++i) { const auto r_ = BUILTIN(__builtin_bit_cast(unsigned, a[i]), __builtin_bit_cast(unsigned, a[i + (N) / 2]), false, false); \
            a[i] = __builtin_bit_cast(float, (unsigned)r_[0]) + __builtin_bit_cast(float, (unsigned)r_[1]); } }
#define RED_STEP(N, M, XCH) { _Pragma("unroll") for (int i = 0; i < (N) / 2; ++i) { const bool up = (F.lane & (M)) != 0; const float keep = up ? a[i + (N) / 2] : a[i], send = up ? a[i] : a[i + (N) / 2]; a[i] = keep + XCH(send); } }
#define XCH8(v) dpp_f<DPP_ROR(8)>(v)
#define XCH4(v) __builtin_bit_cast(float, __builtin_amdgcn_update_dpp(__builtin_amdgcn_update_dpp(0, __builtin_bit_cast(int, v), 0x114  , 0xF, 0xA, false), __builtin_bit_cast(int, v), 0x104  , 0xF, 0x5, false))
#define XCH2(v) dpp_f<DPP_XOR2>(v)
#define XCH1(v) dpp_f<DPP_XOR1>(v)
        RED_SWAP(64, __builtin_amdgcn_permlane32_swap) RED_SWAP(32, __builtin_amdgcn_permlane16_swap) RED_STEP(16, 8, XCH8) RED_STEP(8, 4, XCH4) RED_STEP(4, 2, XCH2) RED_STEP(2, 1, XCH1)
#undef RED_STEP
#undef RED_SWAP
#undef XCH8
#undef XCH4
#undef XCH2
#undef XCH1
        const int e = F.lane >> 1, rr = F.lane & 1; float v = a[0] + brv;
        float tv[4]; int ti[4];
#pragma unroll
        for (int r = 0; r < 4; ++r) { float m = v; int mi = e;
            (void)0;
#define TOPK_CMB(OM, OI) { const float om_ = (OM); const int oi_ = (OI); if (om_ > m || (om_ == m && oi_ < mi)) { m = om_; mi = oi_; } }
            TOPK_CMB(dpp_f<DPP_XOR2>(m), dpp_i<DPP_XOR2>(mi)) TOPK_CMB(dpp_f<DPP_ROR(4)>(m), dpp_i<DPP_ROR(4)>(mi)) TOPK_CMB(dpp_f<DPP_ROR(8)>(m), dpp_i<DPP_ROR(8)>(mi))
            { const auto rv = __builtin_amdgcn_permlane16_swap(__builtin_bit_cast(unsigned, m), __builtin_bit_cast(unsigned, m), false, false); const auto ri = __builtin_amdgcn_permlane16_swap((unsigned)mi, (unsigned)mi, false, false);
              m = __builtin_bit_cast(float, (unsigned)rv[0]); mi = (int)ri[0]; TOPK_CMB(__builtin_bit_cast(float, (unsigned)rv[1]), (int)ri[1]) }
            { const auto rv = __builtin_amdgcn_permlane32_swap(__builtin_bit_cast(unsigned, m), __builtin_bit_cast(unsigned, m), false, false); const auto ri = __builtin_amdgcn_permlane32_swap((unsigned)mi, (unsigned)mi, false, false);
              m = __builtin_bit_cast(float, (unsigned)rv[0]); mi = (int)ri[0]; TOPK_CMB(__builtin_bit_cast(float, (unsigned)rv[1]), (int)ri[1]) }
#undef TOPK_CMB
            tv[r] = m; ti[r] = mi; if (e == mi) v = -INFINITY; }
        if (F.lane < 2) { const float e0 = 1.f, e1 = __expf(tv[1] - tv[0]), e2 = __expf(tv[2] - tv[0]), e3 = __expf(tv[3] - tv[0]); const float inv = 1.f / (e0 + e1 + e2 + e3);
            const float gt[4] = {e0 * inv, e1 * inv, e2 * inv, e3 * inv}; const int rl = rl0 + rr;
#pragma unroll
            for (int r = 0; r < 4; ++r) { const int pos = __hip_atomic_fetch_add(lcnt + ti[r], 1, __ATOMIC_RELAXED, __HIP_MEMORY_SCOPE_WORKGROUP);
                rec[(rl * 4 + r) * 3] = ti[r]; rec[(rl * 4 + r) * 3 + 1] = pos; rec[(rl * 4 + r) * 3 + 2] = __float_as_int(gt[r]); } }
    }
    __syncthreads();
    if (var & 4) {
    if (F.tid < 32) lbase[F.tid] = (int)__hip_atomic_fetch_add((unsigned*)(F.ctl + CW_GCNT) + (dry ? 32 : 0) + 64 * F.tid, (unsigned)lcnt[F.tid], __ATOMIC_RELAXED, __HIP_MEMORY_SCOPE_AGENT);
    __syncthreads();
    if (F.tid < 256) { const int rl = F.tid >> 2, r = F.tid & 3; const int e = rec[F.tid * 3], pos = rec[F.tid * 3 + 1]; const int slot = (rowblk + rl) * 4 + r;
        ((int*)(F.ws + (dry ? 900 * MiB : WS_LIST)))[(size_t)e * T + lbase[e] + pos] = slot; ((float*)(F.ws + (dry ? 910 * MiB : WS_GATE)))[slot] = __int_as_float(rec[F.tid * 3 + 2]);
        ((float*)(F.ws + (dry ? 905 * MiB : WS_GATEL)))[(size_t)e * T + lbase[e] + pos] = __int_as_float(rec[F.tid * 3 + 2]); }
    }
    }
}

__device__ __forceinline__ void moe_setup(Frame& F) {
    __syncthreads();
    if (F.wave == 0) {
        const int e = F.lane & 31; const unsigned cnt = __hip_atomic_load((unsigned*)(F.ctl + CW_GCNT) + 64 * e, RLX_AGENT);
        const float tiles = (F.lane < 32) ? (float)((cnt + 255u) >> 8) : 0.f;
        const int incl = (int)wave_incl_scan(tiles, F.lane);
        if (F.lane < 32) { F.MISC[MI_CNT + e] = cnt; F.MISC[MI_TSTART + e + 1] = (unsigned)incl; }
        if (F.lane == 0) F.MISC[MI_TSTART] = 0; }
    __syncthreads();
    if (F.tid < 320) { int e = 0;
#pragma unroll
        for (int step = 16; step >= 1; step >>= 1) if ((int)F.MISC[MI_TSTART + e + step] <= F.tid) e += step;
        F.MISC[MI_RT2E + F.tid] = (unsigned)e; }
    __syncthreads();
}

__device__ __forceinline__ void p9_final(Frame& F, const float dscale, float* dst) {
    const unsigned char* YB = (const unsigned char*)(F.ws + WS_YB);
    f32x4 nf[4];
#pragma unroll
    for (int j = 0; j < 4; ++j) nf[j] = *(const f32x4*)(F.in[I_NFINAL] + 4 * F.lane + 256 * j) * dscale;
    const size_t stride = (size_t)F.G * NWAVES;
    size_t t = (size_t)F.vcu * NWAVES + F.wave;
    if (t >= (size_t)T) return;
    unsigned q[4][4]; f32x4 xa[4], gv[4];
#define P9_LOAD(TT, Q, XA, GV) { const int b_ = (int)((TT) / SEQ); const float* ga_ = (const float*)(F.ws + WS_MOD) + b_ * 6144 + 5120; \
        _Pragma("unroll") for (int j = 0; j < 4; ++j) { const int col = 4 * F.lane + 256 * j; \
            _Pragma("unroll") for (int k = 0; k < 4; ++k) Q[j][k] = *(const unsigned*)(YB + ((TT) * 4 + k) * D + col); \
            XA[j] = *(const f32x4*)(F.out + (TT) * D + col); GV[j] = *(const f32x4*)(ga_ + col); } }
    P9_LOAD(t, q, xa, gv)
#pragma unroll 1
    for (;;) {
        const size_t tn = t + stride; const bool has = tn < (size_t)T;
        unsigned qn[4][4]; f32x4 xan[4], gvn[4];
#pragma unroll
        for (int j = 0; j < 4; ++j) { xan[j] = xa[j]; gvn[j] = gv[j];
#pragma unroll
            for (int k = 0; k < 4; ++k) qn[j][k] = q[j][k]; }
        if (has) P9_LOAD(tn, qn, xan, gvn)
        asm volatile("" ::: "memory"); __builtin_amdgcn_sched_barrier(0);
        f32x4 v[4]; float s = 0.f;
#pragma unroll
        for (int j = 0; j < 4; ++j) { f32x4 m = (f32x4){0.f, 0.f, 0.f, 0.f};
#pragma unroll
            for (int k = 0; k < 4; ++k) { const auto lo = __builtin_amdgcn_cvt_pk_f32_fp8((int)q[j][k], false), hi = __builtin_amdgcn_cvt_pk_f32_fp8((int)q[j][k], true); m += (f32x4){lo[0], lo[1], hi[0], hi[1]}; }
            v[j] = xa[j] + gv[j] * (m * 0.0625f); s += (v[j].x * v[j].x + v[j].y * v[j].y) + (v[j].z * v[j].z + v[j].w * v[j].w); }
        const float rstd = rsqrtf(wave_sum(s) * (1.f / D) + EPS);
#pragma unroll
        for (int j = 0; j < 4; ++j) { const int col = 4 * F.lane + 256 * j; *(f32x4*)(dst + t * D + col) = v[j] * rstd * nf[j]; }
        if (!has) break;
        t = tn;
#pragma unroll
        for (int j = 0; j < 4; ++j) { xa[j] = xan[j]; gv[j] = gvn[j];
#pragma unroll
            for (int k = 0; k < 4; ++k) q[j][k] = qn[j][k]; }
    }
#undef P9_LOAD
}
}
namespace mk {
#ifndef MK_N_LAUNCHES
#define MK_N_LAUNCHES 1
#endif
constexpr int NPHASES = 12;
struct Args { const float* in[25]; float* out; unsigned char* ws; int ph_lo, ph_hi, li, pad; };

__global__ void __launch_bounds__(NWAVES * 64, 2) mk_fwd(Args args) {
    extern __shared__ __attribute__((aligned(16))) unsigned char lds[];
    Frame F;
    F.lds = (LAS unsigned char*)lds; F.MISC = (volatile LAS unsigned*)(F.lds + MISC_OFF);
    F.tid = threadIdx.x; F.lane = F.tid & 63; F.wave = __builtin_amdgcn_readfirstlane(F.tid >> 6);
    F.G = gridDim.x; { const int bx = blockIdx.x; F.vcu = (F.G % 8 == 0) ? (bx % 8) * (F.G / 8) + bx / 8 : bx; }
    F.ws = args.ws; F.out = args.out; F.in = args.in; F.ctl = (gu32*)(args.ws + WS_CTL);
    for (int u = F.tid; u < (LDS_BYTES - LDSCTL_OFF) / 4; u += NWAVES * 64) ((LAS unsigned*)(F.lds + LDSCTL_OFF))[u] = 0u;
    __syncthreads();
    XcdBarrier bar = xcd_barrier_post((unsigned*)(F.ctl + CW_BAR) + args.li * XCD_BAR_WORDS, F.MISC + 0);
    const int lo = args.ph_lo, hi = args.ph_hi;
#ifndef MK_PH_MASK
#define MK_PH_MASK 0xFFF
#endif
#define IN(k) (((MK_PH_MASK >> (k)) & 1) && lo <= (k) && (k) < hi)
#define SEAM(k) do { if (IN(k) && IN((k) + 1)) xcd_barrier(bar, F.wave); } while (0)
    LAS unsigned char* ring = F.lds;
    const int cid = (int)blockIdx.x;

    #ifndef MK_P0VAR
#define MK_P0VAR 3
#endif
    if (IN(0)) { refresh_ids(F); p0_prologue(F, args.li == 1 ? (MK_P0VAR) : 3, 0); } SEAM(0);
    #ifndef MK_P1VAR
#define MK_P1VAR 3
#endif
    if (IN(1)) { refresh_ids(F); p1_norm_dt(F, args.li == 1 ? (MK_P1VAR) : 3); p0_prologue(F, 3, 1); } SEAM(1);
    if (IN(2)) { refresh_ids(F);
        Sched S; S.init_dense(T, 8192, F.G, cid, (const bf16*)(F.ws + WS_H), 1024, (const bf16*)(F.ws + WS_WIN), 1024, 0);
        EpiAll E{0, 0, F.ws, F.in, F.out, F.MISC, F.lds + 131072}; __syncthreads();
        const int moe_nk = (16384 + 8192 + F.G * NWAVES - 1) / (F.G * NWAVES), moe_g = F.vcu & 7;
#ifndef MK_STAGGER
#define MK_STAGGER 0
#endif
#if MK_STAGGER > 0
        { const unsigned long long t0s = __builtin_amdgcn_s_memrealtime(); const unsigned long long dl = (unsigned long long)(F.vcu & 7) * (MK_STAGGER);
          while (__builtin_amdgcn_s_memrealtime() - t0s < dl) __builtin_amdgcn_s_sleep(8); }
#endif
        S.ibase = 0; S.ilim = moe_g;
        pg8::gemm_phase<EpiAll, Sched, true, true, 0, false>(ring, F.wave, 1024, 1024, 1024, S, E);
        __syncthreads(); refresh_ids(F); p0_moe_tiles(F, 0, moe_nk); __syncthreads(); refresh_ids(F);
        S.ibase = moe_g; S.ilim = 1 << 30;
#ifdef MK_KLOOP_ONLY2
        if (args.li == 1) { EpiPackOnly EN; pg8::gemm_phase<EpiPackOnly, Sched, true, true, 0, false>(ring, F.wave, 1024, 1024, 1024, S, EN); } else
#endif
        pg8::gemm_phase<EpiAll, Sched, true, true, 0, false>(ring, F.wave, 1024, 1024, 1024, S, E);
    } SEAM(2);
#ifdef MK_XBAR
    if (IN(2) && IN(3)) { for (int xb_i = 0; xb_i < (MK_XBAR); ++xb_i) xcd_barrier(bar, F.wave); }
#endif
    if (IN(3)) { refresh_ids(F);
#ifndef MK_SVAR
#define MK_SVAR 7
#endif
        const bool dry3 = (args.li == 1); const int var3 = dry3 ? (MK_SVAR) : 7;
        if (var3 & 1) pool_pass(F, dry3);
        asm volatile("" ::: "memory"); __builtin_amdgcn_sched_barrier(0);
        for (int u = F.vcu; u < 1024; u += F.G) ssd_states_unit(F, u, dry3, var3); } SEAM(3);
    if (IN(4)) { refresh_ids(F);
#ifdef MK_DUPSCAN
        ssd_scan(F, args.li == 1);
#else
        if (args.li != 1) ssd_scan(F, false);
#endif

        Sched S; S.init_dense(T, 1024, F.G, cid, (const bf16*)(F.ws + WS_P), 1024, (const bf16*)(F.ws + WS_WPOOL), 256, 256);
        EpiAll E{1, 0, F.ws, F.in, F.out, F.MISC, F.lds + 131072};
        __syncthreads();
        pg8::gemm_phase<EpiAll, Sched, true, true, 0, false>(ring, F.wave, 256, 1024, 256, S, E);
    } SEAM(4);
    if (IN(5)) { refresh_ids(F);
#ifdef MK_VAR
        const int var = (args.li == 1) ? (MK_VAR) : 15; bf16* ydst = (args.li == 1) ? (bf16*)(F.ws + 864 * MiB) : (bf16*)(F.ws + WS_Y);
#else
        const int var = 15; bf16* ydst = (bf16*)(F.ws + WS_Y);
#endif
        const bool g3_first = (F.vcu & 1) != 0;
#define MK_G3_TILE() do { __syncthreads(); refresh_ids(F); \
            Sched S; S.init_dense(T, 1024, F.G, cid, (const bf16*)(F.ws + WS_P2), 1024, (const bf16*)(F.ws + WS_WPO), 1024, 0); \
            EpiAll E{3, 0, F.ws, F.in, F.out, F.MISC, F.lds + 131072}; __syncthreads(); \
            pg8::gemm_phase<EpiAll, Sched, true, true, 0, false>(ring, F.wave, 1024, 1024, 1024, S, E); __syncthreads(); refresh_ids(F); } while (0)
        if (g3_first && args.li != 1) MK_G3_TILE();
        for (int u = F.vcu; u < 512; u += F.G) ssd_out_unit(F, u, var, ydst, u == F.vcu, (u + F.G < 512) ? u + F.G : -1);
        if (!g3_first && args.li != 1) MK_G3_TILE();
#undef MK_G3_TILE
        } SEAM(5);
    if (IN(6)) { refresh_ids(F);
        { Sched S; S.init_dense(T, 1024, F.G, cid, (const bf16*)(F.ws + WS_Y), 2048, (const bf16*)(F.ws + WS_WSSD), 2048, 0);
          EpiAll E{2, 0, F.ws, F.in, F.out, F.MISC, F.lds + 131072}; __syncthreads();
          pg8::gemm_phase<EpiAll, Sched, true, true, 0, false>(ring, F.wave, 2048, 2048, 2048, S, E); }
    } SEAM(6);
    if (IN(7)) { refresh_ids(F); Sched S; S.init_dense(T, 1024, F.G, cid, (const bf16*)(F.ws + WS_MERGED), 1024, (const bf16*)(F.ws + WS_WOUT), 1024, 0);
        EpiAll E{4, 0, F.ws, F.in, F.out, F.MISC, F.lds + 131072}; __syncthreads();
        pg8::gemm_phase<EpiAll, Sched, true, true, 0, false>(ring, F.wave, 1024, 1024, 1024, S, E);
    } SEAM(7);
    #ifndef MK_RVAR
#define MK_RVAR 7
#endif
    if (IN(8)) { refresh_ids(F); p6_router(F, args.li == 1, args.li == 1 ? (MK_RVAR) : 7); } SEAM(8);
    if (IN(9)) { refresh_ids(F); moe_setup(F);
        Sched S; S.init_moe(1, F.G, cid, (const bf16*)(F.ws + WS_H), (const bf16*)(F.ws + WS_WGU), (const int*)(F.ws + WS_LIST), F.MISC);
        EpiAll E{5, 0, F.ws, F.in, F.out, F.MISC, F.lds + 131072}; __syncthreads();
#ifdef MK_KLOOP_ONLY
        if (args.li == 1) { EpiNone EN;
#ifdef MK_NOGATHER
            S.nogather = 1;
#endif
            pg8::gemm_phase<EpiNone, Sched, true, true, 1, true>(ring, F.wave, 512, 512, 512, S, EN); } else
#endif
        pg8::gemm_phase<EpiAll, Sched, true, false, 1, true>(ring, F.wave, 512, 512, 512, S, E);
    } SEAM(9);
    if (IN(10)) { refresh_ids(F); if (!IN(9)) moe_setup(F);
        Sched S; S.init_moe(2, F.G, cid, (const bf16*)(F.ws + WS_ACT), (const bf16*)(F.ws + WS_WDN), (const int*)(F.ws + WS_LIST), F.MISC);
        EpiAll E{6, 0, F.ws, F.in, F.out, F.MISC, F.lds + 131072}; __syncthreads();
        pg8::gemm_phase<EpiAll, Sched, true, false, 1, true>(ring, F.wave, 512, 512, 512, S, E);
    } SEAM(10);
    if (IN(11)) { refresh_ids(F); p9_final(F, 1.f, args.li == 1 ? (float*)(F.ws + 864 * MiB) : F.out); }
#undef IN
#undef SEAM
}

static void run_mk(void* const* d_in, float* out, unsigned char* ws, hipStream_t stream) {
    static int grid = 0;
    if (grid == 0) {
        int dev = 0, cus = 0;
        if (hipGetDevice(&dev) != hipSuccess || hipDeviceGetAttribute(&cus, hipDeviceAttributeMultiprocessorCount, dev) != hipSuccess) { fprintf(stderr, "kernel_launch: device query failed\n"); grid = -1; return; }
        if (hipFuncSetAttribute((const void*)mk_fwd, hipFuncAttributeMaxDynamicSharedMemorySize, LDS_BYTES) != hipSuccess) { fprintf(stderr, "kernel_launch: hipFuncSetAttribute failed\n"); grid = -1; return; }
        (void)hipGetLastError();
        grid = cus;
    }
    if (grid < 0) return;
    (void)hipMemsetAsync(ws + WS_CTL, 0, CTL_ZERO_BYTES, stream);
    Args a{};
    for (int i = 0; i < 25; ++i) a.in[i] = (const float*)d_in[i];
    a.out = out; a.ws = ws;
#ifdef MK_DUP
    const int nl = 3, los[3] = {0, MK_DUP, MK_DUP + 1}, his[3] = {MK_DUP + 1, MK_DUP + 1, NPHASES};
#else
    const int nl = 1, los[1] = {0}, his[1] = {NPHASES};
#endif
    for (int li = 0; li < nl; ++li) {
        if (los[li] >= his[li]) continue;
        a.ph_lo = los[li]; a.ph_hi = his[li]; a.li = li;
        hipLaunchKernelGGL(mk_fwd, dim3(grid), dim3(NWAVES * 64), LDS_BYTES, stream, a);
    }
}
}
extern "C" void kernel_launch(void* const* d_in, const int* in_sizes, int n_in, void* d_out, int out_size, void* d_ws, size_t ws_size, hipStream_t stream) {
    mk::run_mk(d_in, (float*)d_out, (unsigned char*)d_ws, stream);
}
```
